# Optimizing an MI355X kernel written in HIP

```python
import math
import jax, jax.numpy as jnp
from jax import lax
import numpy as np

D_MODEL = 1024
BATCH = 8
SEQ = 2048
DEPTH = 2
DEC_BATCH = 128
DEC_SEQ = 8
PAST_LEN = 16384
PAGE_SIZE = 128

MIX_W = D_MODEL // 2
N_BRANCH = 4
RET_HEADS = 4
RET_DK = MIX_W // RET_HEADS
RET_DV = MIX_W // RET_HEADS
RET_CHUNK = 64
ROPE_BASE = 10000.0
SSD_HEADDIM = 64
SSD_HEADS = MIX_W // SSD_HEADDIM
SSD_GROUPS = 2
SSD_HPG = SSD_HEADS // SSD_GROUPS
SSD_STATE = 128
SSD_CONV = 4
SSD_CHUNK = 64
SSD_CONV_DIM = MIX_W + 2 * SSD_GROUPS * SSD_STATE
HG_HEADS = 4
HG_DK = MIX_W // HG_HEADS
HG_DV = MIX_W // HG_HEADS
HG_CHUNK = 64
S5_GROUP = 16
S5_GROUPS = MIX_W // S5_GROUP
S5_STATE = 64
D_FF = 4 * D_MODEL
GATE_COLS = N_BRANCH * D_MODEL
IN_COLS = 4 * MIX_W + (MIX_W + SSD_CONV_DIM + SSD_HEADS) + 4 * MIX_W + MIX_W + GATE_COLS
EPS = 1e-6

kernel_name = 'hybrid_ret_ssd_hgrn2_s5_gated_step'


def _rmsnorm(x, g):
    xf = x.astype(jnp.float32)
    y = xf * lax.rsqrt(jnp.mean(xf * xf, axis=-1, keepdims=True) + EPS)
    return (y * g.astype(jnp.float32)).astype(x.dtype)


def _head_groupnorm(o, g):
    mu = jnp.mean(o, axis=-1, keepdims=True)
    var = jnp.mean(jnp.square(o - mu), axis=-1, keepdims=True)
    return (o - mu) * lax.rsqrt(var + EPS) * g.astype(jnp.float32)


def _chunk_len(L, c):
    return c if L % c == 0 else L


def _to_chunks(a, c):
    B, L = a.shape[:2]
    return jnp.moveaxis(a.reshape((B, L // c, c) + a.shape[2:]), 1, 0)


def _from_chunks(a):
    a = jnp.moveaxis(a, 0, 1)
    return a.reshape((a.shape[0], a.shape[1] * a.shape[2]) + a.shape[3:])


def _masked_exp(mask, seg):
    return jnp.where(mask, jnp.exp(jnp.where(mask, seg, 0.0)), 0.0)


def _rope(x, pos):
    half = x.shape[-1] // 2
    inv = ROPE_BASE ** (-jnp.arange(half, dtype=jnp.float32) / half)
    ang = pos.astype(jnp.float32)[:, None] * inv[None, :]
    cos = jnp.cos(ang)[None, :, None, :]
    sin = jnp.sin(ang)[None, :, None, :]
    x1, x2 = x[..., :half], x[..., half:]
    return jnp.concatenate([x1 * cos - x2 * sin, x1 * sin + x2 * cos], axis=-1)


def _retention(q, k, v, pos, s0):
    L = q.shape[1]
    c = _chunk_len(L, RET_CHUNK)
    q = _rope(q, pos)
    k = _rope(k, pos) * (RET_DK ** -0.5)
    log_g = jnp.log(1.0 - 2.0 ** (-5.0 - jnp.arange(RET_HEADS, dtype=jnp.float32)))
    idx = jnp.arange(c, dtype=jnp.float32)
    diff = idx[:, None] - idx[None, :]
    dmat = jnp.where(diff >= 0, jnp.exp(log_g[:, None, None] * jnp.maximum(diff, 0.0)), 0.0)
    q_dec = jnp.exp(log_g[None, :] * (idx[:, None] + 1.0))
    k_dec = jnp.exp(log_g[None, :] * (c - 1.0 - idx[:, None]))
    chunk_dec = jnp.exp(log_g * c)

    def step(S, blk):
        qc, kc, vc = blk
        att = jnp.einsum('bihd,bjhd->bhij', qc, kc) * dmat
        o = jnp.einsum('bhij,bjhe->bihe', att, vc)
        o = o + jnp.einsum('bihd,bhde->bihe', qc * q_dec[None, :, :, None], S)
        S = S * chunk_dec[None, :, None, None] + jnp.einsum('bjhd,bjhe->bhde', kc * k_dec[None, :, :, None], vc)
        return S, o

    S, o = lax.scan(step, s0, (_to_chunks(q, c), _to_chunks(k, c), _to_chunks(v, c)))
    return _from_chunks(o), S


def _causal_conv(xbc, buf, w, b):
    L = xbc.shape[1]
    full = jnp.concatenate([buf, xbc], axis=1)
    w = w.astype(jnp.float32)
    out = b.astype(jnp.float32) + full[:, 0:L] * w[0]
    for j in range(1, SSD_CONV):
        out = out + full[:, j:j + L] * w[j]
    return jax.nn.silu(out), full[:, -(SSD_CONV - 1):]


def _ssd(x, dt_raw, bm, cm, s0, a_log, dt_bias, d_skip):
    L = x.shape[1]
    c = _chunk_len(L, SSD_CHUNK)
    A = -jnp.exp(a_log.astype(jnp.float32))
    dt = jax.nn.softplus(dt_raw + dt_bias.astype(jnp.float32))
    dA = dt * A
    xdt = x * dt[..., None]
    mask = jnp.tril(jnp.ones((c, c), dtype=bool))

    def step(S, blk):
        xdtc, dAc, bc, cc = blk
        cum = jnp.cumsum(dAc, axis=1)
        cum_t = jnp.moveaxis(cum, 1, -1)
        seg = cum_t[..., :, None] - cum_t[..., None, :]
        lmat = _masked_exp(mask, seg)
        cb = jnp.einsum('bign,bjgn->bgij', cc, bc)
        y = jnp.einsum('bgrij,bjgrp->bigrp', cb[:, :, None] * lmat, xdtc)
        y = y + jnp.einsum('bign,bgrpn->bigrp', cc, S) * jnp.exp(cum)[..., None]
        decay_end = jnp.exp(cum[:, -1:] - cum)
        S = S * jnp.exp(cum[:, -1])[..., None, None] + jnp.einsum('bjgn,bjgrp->bgrpn', bc, xdtc * decay_end[..., None])
        return S, y

    S, y = lax.scan(step, s0, tuple(_to_chunks(a, c) for a in (xdt, dA, bm, cm)))
    y = _from_chunks(y) + x * d_skip.astype(jnp.float32)[..., None]
    return y, S


def _hgrn2(q, f_logit, i, lb, s0):
    L = q.shape[1]
    c = _chunk_len(L, HG_CHUNK)
    q = jax.nn.silu(q)
    f = lb + (1.0 - lb) * jax.nn.sigmoid(f_logit)
    log_f = jnp.log(f)
    k = (1.0 - lb) * jax.nn.sigmoid(-f_logit)
    mask = jnp.tril(jnp.ones((c, c), dtype=bool))[:, :, None, None]

    def step(S, blk):
        qc, kc, ic, lfc = blk
        G = jnp.cumsum(lfc, axis=1)
        seg = G[:, :, None] - G[:, None, :]
        dec = _masked_exp(mask, seg)
        att = jnp.einsum('bijhd,bjhd->bhij', qc[:, :, None] * dec, kc)
        o = jnp.einsum('bhij,bjhe->bihe', att, ic)
        o = o + jnp.einsum('bihd,bhde->bihe', qc * jnp.exp(G), S)
        g_last = G[:, -1]
        S = S * jnp.exp(g_last)[..., None] + jnp.einsum('bjhd,bjhe->bhde', kc * jnp.exp(g_last[:, None] - G), ic)
        return S, o

    S, o = lax.scan(step, s0, tuple(_to_chunks(a, c) for a in (q, k, i, log_f)))
    return _from_chunks(o), S


def _cmul(ar, ai, br, bi):
    return ar * br - ai * bi, ar * bi + ai * br


def _s5_combine(e1, e2):
    a1r, a1i, b1r, b1i = e1
    a2r, a2i, b2r, b2i = e2
    ar, ai = _cmul(a2r, a2i, a1r, a1i)
    br, bi = _cmul(a2r, a2i, b1r, b1i)
    return ar, ai, br + b2r, bi + b2i


def _s5(u, h0_re, h0_im, a_re, a_im, b_re, b_im, c_re, c_im, d, log_dt, w_glu):
    B, L = u.shape[:2]
    a_re, a_im, b_re, b_im, c_re, c_im, d, log_dt = (t.astype(jnp.float32) for t in (a_re, a_im, b_re, b_im, c_re, c_im, d, log_dt))
    dt = jnp.exp(log_dt)[:, None]
    mag = jnp.exp(dt * a_re)
    ab_re, ab_im = mag * jnp.cos(dt * a_im), mag * jnp.sin(dt * a_im)
    den = a_re * a_re + a_im * a_im
    n_re, n_im = ab_re - 1.0, ab_im
    f_re = (n_re * a_re + n_im * a_im) / den
    f_im = (n_im * a_re - n_re * a_im) / den
    bb_re = f_re[..., None] * b_re - f_im[..., None] * b_im
    bb_im = f_re[..., None] * b_im + f_im[..., None] * b_re
    bu_re = jnp.einsum('blgm,gpm->blgp', u, bb_re)
    bu_im = jnp.einsum('blgm,gpm->blgp', u, bb_im)
    i_re, i_im = _cmul(ab_re, ab_im, h0_re, h0_im)
    bu_re = bu_re.at[:, 0].add(i_re)
    bu_im = bu_im.at[:, 0].add(i_im)
    a_re_t = jnp.broadcast_to(ab_re, bu_re.shape)
    a_im_t = jnp.broadcast_to(ab_im, bu_im.shape)
    _, _, h_re, h_im = lax.associative_scan(_s5_combine, (a_re_t, a_im_t, bu_re, bu_im), axis=1)
    y = jnp.einsum('gmp,blgp->blgm', c_re, h_re) - jnp.einsum('gmp,blgp->blgm', c_im, h_im) + d * u
    z = jax.nn.gelu(y.reshape(B, L, MIX_W))
    out = z * jax.nn.sigmoid(jnp.matmul(z, w_glu.astype(jnp.float32)))
    return out, h_re[:, -1], h_im[:, -1]


def _layer(x, st, p, lb, pos):
    B, L, _ = x.shape
    h = _rmsnorm(x, p['g_pre_mix'])
    proj = jnp.matmul(h, p['w_in']).astype(jnp.float32)
    sizes = (MIX_W,) * 4 + (MIX_W, SSD_CONV_DIM, SSD_HEADS) + (MIX_W,) * 4 + (MIX_W, GATE_COLS)
    (rq, rk, rv, rg, sz, sxbc, sdt, hq, hf, hi, hg, su, gl) = jnp.split(proj, np.cumsum(sizes)[:-1].tolist(), axis=-1)

    def heads(a, n):
        return a.reshape(B, L, n, a.shape[-1] // n)

    o_ret, s_ret = _retention(heads(rq, RET_HEADS), heads(rk, RET_HEADS), heads(rv, RET_HEADS), pos, st['ret'])
    o_ret = _head_groupnorm(o_ret, p['ret_gn']).reshape(B, L, MIX_W) * jax.nn.silu(rg)

    xbc, conv_new = _causal_conv(sxbc, st['conv'], p['ssd_conv_w'], p['ssd_conv_b'])
    xs, bm, cm = jnp.split(xbc, [MIX_W, MIX_W + SSD_GROUPS * SSD_STATE], axis=-1)
    grp = (SSD_GROUPS, SSD_HPG)
    y, s_ssd = _ssd(xs.reshape(B, L, SSD_GROUPS, SSD_HPG, SSD_HEADDIM), sdt.reshape(B, L, SSD_GROUPS, SSD_HPG),
                    bm.reshape(B, L, SSD_GROUPS, SSD_STATE), cm.reshape(B, L, SSD_GROUPS, SSD_STATE),
                    st['ssd'].reshape(B, SSD_GROUPS, SSD_HPG, SSD_HEADDIM, SSD_STATE),
                    p['ssd_a_log'].reshape(grp), p['ssd_dt_bias'].reshape(grp), p['ssd_d'].reshape(grp))
    y = y.reshape(B, L, MIX_W) * jax.nn.silu(sz)
    o_ssd = _rmsnorm(y.reshape(B, L, SSD_GROUPS, MIX_W // SSD_GROUPS), p['ssd_norm'].reshape(SSD_GROUPS, MIX_W // SSD_GROUPS)).reshape(B, L, MIX_W)
    s_ssd = s_ssd.reshape(B, SSD_HEADS, SSD_HEADDIM, SSD_STATE)

    o_hg, s_hg = _hgrn2(heads(hq, HG_HEADS), heads(hf, HG_HEADS), heads(hi, HG_HEADS), lb.reshape(HG_HEADS, HG_DK), st['hgrn'])
    o_hg = _rmsnorm(o_hg, p['hg_norm']).reshape(B, L, MIX_W) * jax.nn.sigmoid(hg)

    o_s5, s5_re, s5_im = _s5(su.reshape(B, L, S5_GROUPS, S5_GROUP), st['s5_re'], st['s5_im'],
                             p['s5_a_re'], p['s5_a_im'], p['s5_b_re'], p['s5_b_im'], p['s5_c_re'], p['s5_c_im'],
                             p['s5_d'], p['s5_log_dt'], p['s5_w_glu'])

    branches = jnp.stack([o_ret, o_ssd, o_hg, o_s5], axis=2).astype(x.dtype)
    gates = jax.nn.sigmoid(gl.reshape(B, L, N_BRANCH, D_MODEL)).astype(x.dtype)
    merged = jnp.sum(gates * jnp.einsum('blmw,mwd->blmd', branches, p['w_branch']), axis=2)
    x = x + _rmsnorm(jnp.matmul(merged, p['w_out']), p['g_post_mix']).astype(x.dtype)

    h = _rmsnorm(x, p['g_pre_ffn'])
    u = jnp.square(jax.nn.relu(jnp.matmul(h, p['w_ff1'])))
    x = x + _rmsnorm(jnp.matmul(u, p['w_ff2']), p['g_post_ffn']).astype(x.dtype)
    new = {'ret': s_ret, 'ssd': s_ssd, 'conv': conv_new, 'hgrn': s_hg, 's5_re': s5_re, 's5_im': s5_im}
    return x, new


def _trunk(x, states, params, lb_logits, pos):
    w = jax.nn.softmax(lb_logits.astype(jnp.float32), axis=0)
    lbs = jnp.cumsum(w, axis=0) - w[0]
    names = ('ret', 'ssd', 'conv', 'hgrn', 's5_re', 's5_im')
    collected = {n: [] for n in names}
    for l in range(DEPTH):
        p = {name: arr[l] for name, arr in params.items()}
        st = {n: states[n][l].astype(jnp.float32) for n in names}
        x, new = _layer(x, st, p, lbs[l], pos)
        for n in names:
            collected[n].append(new[n])
    return x, {n: jnp.stack(collected[n]) for n in names}


def setup_inputs(seed: int = 0) -> dict:
    key = jax.random.key(seed)
    k = jax.random.split(key, 35)
    f32 = jnp.float32

    def nrm(i, shape, s=1.0):
        return jax.random.normal(k[i], shape, f32) * s

    def unif(i, shape, lo, hi):
        return jax.random.uniform(k[i], shape, f32, lo, hi)

    dt0 = jnp.exp(unif(17, (DEPTH, SSD_HEADS), math.log(1e-3), math.log(1e-1)))
    a_im0 = math.pi * jnp.arange(S5_STATE, dtype=f32)
    return {
        'x_prompt': nrm(0, (BATCH, SEQ, D_MODEL)),
        'x_sample': nrm(1, (DEC_BATCH, DEC_SEQ, D_MODEL)),
        'state_ret': nrm(2, (DEPTH, DEC_BATCH, RET_HEADS, RET_DK, RET_DV), 0.5),
        'state_ssd': nrm(3, (DEPTH, DEC_BATCH, SSD_HEADS, SSD_HEADDIM, SSD_STATE), 0.5),
        'state_conv': nrm(4, (DEPTH, DEC_BATCH, SSD_CONV - 1, SSD_CONV_DIM)),
        'state_hgrn': nrm(5, (DEPTH, DEC_BATCH, HG_HEADS, HG_DK, HG_DV), 0.5),
        'state_s5_re': nrm(6, (DEPTH, DEC_BATCH, S5_GROUPS, S5_STATE), 0.5),
        'state_s5_im': nrm(7, (DEPTH, DEC_BATCH, S5_GROUPS, S5_STATE), 0.5),
        'g_pre_mix': 1.0 + nrm(8, (DEPTH, D_MODEL), 0.05),
        'g_post_mix': 1.0 + nrm(9, (DEPTH, D_MODEL), 0.05),
        'g_pre_ffn': 1.0 + nrm(10, (DEPTH, D_MODEL), 0.05),
        'g_post_ffn': 1.0 + nrm(11, (DEPTH, D_MODEL), 0.05),
        'w_in': nrm(12, (DEPTH, D_MODEL, IN_COLS), D_MODEL ** -0.5),
        'ret_gn': 1.0 + nrm(13, (DEPTH, RET_HEADS, RET_DV), 0.05),
        'ssd_conv_w': nrm(14, (DEPTH, SSD_CONV, SSD_CONV_DIM), SSD_CONV ** -0.5),
        'ssd_conv_b': nrm(15, (DEPTH, SSD_CONV_DIM), 0.01),
        'ssd_a_log': jnp.log(unif(16, (DEPTH, SSD_HEADS), 1.0, 16.0)),
        'ssd_dt_bias': dt0 + jnp.log(-jnp.expm1(-dt0)),
        'ssd_d': 1.0 + nrm(18, (DEPTH, SSD_HEADS), 0.1),
        'ssd_norm': 1.0 + nrm(19, (DEPTH, MIX_W), 0.05),
        'hg_lb_logits': nrm(20, (DEPTH, HG_HEADS * HG_DK), 0.1),
        'hg_norm': 1.0 + nrm(21, (DEPTH, HG_DV), 0.05),
        's5_a_re': -0.5 + nrm(22, (DEPTH, S5_GROUPS, S5_STATE), 0.01),
        's5_a_im': a_im0 + nrm(23, (DEPTH, S5_GROUPS, S5_STATE), 0.01),
        's5_b_re': nrm(24, (DEPTH, S5_GROUPS, S5_STATE, S5_GROUP), (2 * S5_GROUP) ** -0.5),
        's5_b_im': nrm(25, (DEPTH, S5_GROUPS, S5_STATE, S5_GROUP), (2 * S5_GROUP) ** -0.5),
        's5_c_re': nrm(26, (DEPTH, S5_GROUPS, S5_GROUP, S5_STATE), S5_STATE ** -0.5),
        's5_c_im': nrm(27, (DEPTH, S5_GROUPS, S5_GROUP, S5_STATE), S5_STATE ** -0.5),
        's5_d': nrm(28, (DEPTH, S5_GROUPS, S5_GROUP)),
        's5_log_dt': unif(29, (DEPTH, S5_GROUPS), math.log(1e-3), math.log(1e-1)),
        's5_w_glu': nrm(30, (DEPTH, MIX_W, MIX_W), MIX_W ** -0.5),
        'w_branch': nrm(31, (DEPTH, N_BRANCH, MIX_W, D_MODEL), MIX_W ** -0.5),
        'w_out': nrm(32, (DEPTH, D_MODEL, D_MODEL), D_MODEL ** -0.5),
        'w_ff1': nrm(33, (DEPTH, D_MODEL, D_FF), D_MODEL ** -0.5),
        'w_ff2': nrm(34, (DEPTH, D_FF, D_MODEL), D_FF ** -0.5),
    }


def reference(x_prompt, x_sample, state_ret, state_ssd, state_conv, state_hgrn, state_s5_re, state_s5_im,
              g_pre_mix, g_post_mix, g_pre_ffn, g_post_ffn, w_in, ret_gn, ssd_conv_w, ssd_conv_b,
              ssd_a_log, ssd_dt_bias, ssd_d, ssd_norm, hg_lb_logits, hg_norm, s5_a_re, s5_a_im,
              s5_b_re, s5_b_im, s5_c_re, s5_c_im, s5_d, s5_log_dt, s5_w_glu, w_branch, w_out, w_ff1, w_ff2):
    params = {
        'g_pre_mix': g_pre_mix, 'g_post_mix': g_post_mix, 'g_pre_ffn': g_pre_ffn, 'g_post_ffn': g_post_ffn,
        'w_in': w_in, 'ret_gn': ret_gn, 'ssd_conv_w': ssd_conv_w, 'ssd_conv_b': ssd_conv_b,
        'ssd_a_log': ssd_a_log, 'ssd_dt_bias': ssd_dt_bias, 'ssd_d': ssd_d, 'ssd_norm': ssd_norm,
        'hg_norm': hg_norm, 's5_a_re': s5_a_re, 's5_a_im': s5_a_im, 's5_b_re': s5_b_re, 's5_b_im': s5_b_im,
        's5_c_re': s5_c_re, 's5_c_im': s5_c_im, 's5_d': s5_d, 's5_log_dt': s5_log_dt, 's5_w_glu': s5_w_glu,
        'w_branch': w_branch, 'w_out': w_out, 'w_ff1': w_ff1, 'w_ff2': w_ff2,
    }
    bp = x_prompt.shape[0]
    f32 = jnp.float32
    zero_states = {
        'ret': jnp.zeros((DEPTH, bp, RET_HEADS, RET_DK, RET_DV), f32),
        'ssd': jnp.zeros((DEPTH, bp, SSD_HEADS, SSD_HEADDIM, SSD_STATE), f32),
        'conv': jnp.zeros((DEPTH, bp, SSD_CONV - 1, SSD_CONV_DIM), f32),
        'hgrn': jnp.zeros((DEPTH, bp, HG_HEADS, HG_DK, HG_DV), f32),
        's5_re': jnp.zeros((DEPTH, bp, S5_GROUPS, S5_STATE), f32),
        's5_im': jnp.zeros((DEPTH, bp, S5_GROUPS, S5_STATE), f32),
    }
    sample_states = {'ret': state_ret, 'ssd': state_ssd, 'conv': state_conv, 'hgrn': state_hgrn,
                     's5_re': state_s5_re, 's5_im': state_s5_im}
    pos_p = jnp.arange(x_prompt.shape[1], dtype=jnp.int32)
    pos_s = PAST_LEN + jnp.arange(x_sample.shape[1], dtype=jnp.int32)
    y_prompt, new_p = _trunk(x_prompt, zero_states, params, hg_lb_logits, pos_p)
    y_sample, new_s = _trunk(x_sample, sample_states, params, hg_lb_logits, pos_s)
    return (y_prompt, y_sample,
            new_p['ret'], new_s['ret'], new_p['ssd'], new_s['ssd'], new_p['conv'], new_s['conv'],
            new_p['hgrn'], new_s['hgrn'], new_p['s5_re'], new_s['s5_re'], new_p['s5_im'], new_s['s5_im'])
```

```cpp
#include <hip/hip_runtime.h>
#include <hip/hip_cooperative_groups.h>
#include <cstdio>
#include <cstdint>
namespace cg = cooperative_groups;

#ifndef SINGLE_LAUNCH
#define SINGLE_LAUNCH 0
#endif
#ifndef ONLY
#define ONLY -1
#endif
#define EN(k) (ONLY < 0 || ONLY == (k))

typedef unsigned short u16;
using bf16x8 = __attribute__((ext_vector_type(8))) short;
using bf16x4 = __attribute__((ext_vector_type(4))) short;
using f32x4  = __attribute__((ext_vector_type(4))) float;
#define DI __device__ __forceinline__
#define MFMA16(a, b, c) __builtin_amdgcn_mfma_f32_16x16x32_bf16((a), (b), (c), 0, 0, 0)

constexpr int MTOK = 17408;
constexpr int MPR  = 16384;
constexpr int DM   = 1024;
constexpr int NP   = 6272;
constexpr int NIN  = 10368;
constexpr int DFF  = 4096;
constexpr int INC  = 10248;
constexpr int C_RQ = 0, C_RK = 512, C_RV = 1024, C_RG = 1536, C_SZ = 2048, C_SXBC = 2560;
constexpr int C_HQ = 3584, C_HF = 4096, C_HI = 4608, C_HG = 5120, C_SU = 5632, C_SDT = 6144;
constexpr float EPS = 1e-6f;
constexpr int NITEMS = 160 + 128 * 20;
constexpr int NPHASE = 20;

struct Params {
  const float* in[35];
  float* out;
  u16 *wt_in, *wt_ff1, *wt_ff2, *wt_br, *wt_out, *wt_glu;
  u16 *hb, *pbuf, *obuf, *zs5;
  float* tbuf;
  unsigned* counters;
  float* ssq;
  size_t o_ret_p, o_ret_s, o_ssd_p, o_ssd_s, o_conv_p, o_conv_s, o_hg_p, o_hg_s, o_s5r_p, o_s5r_s, o_s5i_p, o_s5i_s;
};

DI int tidq() { int t = threadIdx.x; asm volatile("" : "+v"(t)); return t; }
DI u16 f2bf(float f) { unsigned u = __float_as_uint(f); u += 0x7fffu + ((u >> 16) & 1u); return (u16)(u >> 16); }
DI float bf2f(u16 h) { return __uint_as_float(((unsigned)h) << 16); }
DI unsigned pack2(float a, float b) { return (unsigned)f2bf(a) | ((unsigned)f2bf(b) << 16); }
DI float sigmoidf_(float x) { return 1.f / (1.f + __expf(-x)); }
DI float siluf_(float x) { return x / (1.f + __expf(-x)); }
DI float softplusf_(float x) { return x > 20.f ? x : log1pf(__expf(x)); }
DI float gelu_tanh(float x) {
  float u = 0.7978845608028654f * (x + 0.044715f * x * x * x);
  float e = __expf(2.f * u);
  float th = 1.f - 2.f / (e + 1.f);
  return 0.5f * x * (1.f + th);
}
DI float wave_sum(float v) {
#pragma unroll
  for (int m = 32; m >= 1; m >>= 1) v += __shfl_xor(v, m);
  return v;
}
DI float sum16(float v) {
#pragma unroll
  for (int m = 8; m >= 1; m >>= 1) v += __shfl_xor(v, m);
  return v;
}
DI void sincos_red(float a, float& s, float& c) {
  float n = rintf(a * 0.15915494309189535f);
  float r = fmaf(-n, 6.28125f, a);
  r = fmaf(-n, 1.9353071795864769e-3f, r);
  s = __sinf(r); c = __cosf(r);
}

DI int map_win(int my) {
  if (my < 3584) return my;
  if (my < 6144) return my + 8;
  if (my < 6152) return my - 6144 + 3584;
  if (my < 6272) return -1;
  return my - 120;
}
DI void transpose_tile(const float* __restrict__ src, int src_ld, u16* __restrict__ dst, int dst_ld,
                       int k0, int n0, int mapmode, char* smem) {
  float* tile = (float*)smem;
  const int tid = tidq();
  {
    const int n = tid & 63;
    int sc = n0 + n;
    if (mapmode) sc = map_win(sc);
#pragma unroll
    for (int i = 0; i < 16; ++i) {
      int k = (tid >> 6) + 4 * i;
      float v = (sc >= 0) ? src[(size_t)(k0 + k) * src_ld + sc] : 0.f;
      tile[n * 65 + k] = v;
    }
  }
  __syncthreads();
  {
    const int n = tid >> 2, kc = (tid & 3) * 16;
    unsigned pk[8];
#pragma unroll
    for (int x = 0; x < 8; ++x) pk[x] = pack2(tile[n * 65 + kc + 2 * x], tile[n * 65 + kc + 2 * x + 1]);
    uint4* d = (uint4*)(dst + (size_t)(n0 + n) * dst_ld + k0 + kc);
    d[0] = make_uint4(pk[0], pk[1], pk[2], pk[3]);
    d[1] = make_uint4(pk[4], pk[5], pk[6], pk[7]);
  }
  __syncthreads();
}

__device__ void phase_convert(const Params& p, char* smem) {
  constexpr int PER = 5472;
  for (int t = blockIdx.x; t < 2 * PER; t += gridDim.x) {
    int l = t / PER, r = t % PER;
    if (r < 2592) {
      int nt = r / 16, kt = r % 16;
      transpose_tile(p.in[12] + (size_t)l * DM * INC, INC, p.wt_in + (size_t)l * NIN * DM, DM, kt * 64, nt * 64, 1, smem);
    } else if (r < 3616) {
      r -= 2592; int nt = r / 16, kt = r % 16;
      transpose_tile(p.in[33] + (size_t)l * DM * DFF, DFF, p.wt_ff1 + (size_t)l * DFF * DM, DM, kt * 64, nt * 64, 0, smem);
    } else if (r < 4640) {
      r -= 3616; int nt = r / 64, kt = r % 64;
      transpose_tile(p.in[34] + (size_t)l * DFF * DM, DM, p.wt_ff2 + (size_t)l * DM * DFF, DFF, kt * 64, nt * 64, 0, smem);
    } else if (r < 4896) {
      r -= 4640; int nt = r / 16, kt = r % 16;
      transpose_tile(p.in[32] + (size_t)l * DM * DM, DM, p.wt_out + (size_t)l * DM * DM, DM, kt * 64, nt * 64, 0, smem);
    } else if (r < 5408) {
      r -= 4896; int b = r / 128; r %= 128; int nt = r / 8, kt = r % 8;
      transpose_tile(p.in[31] + (size_t)(l * 4 + b) * 512 * DM, DM, p.wt_br + (size_t)(l * 4 + b) * DM * 512, 512, kt * 64, nt * 64, 0, smem);
    } else {
      r -= 5408; int nt = r / 8, kt = r % 8;
      transpose_tile(p.in[30] + (size_t)l * 512 * 512, 512, p.wt_glu + (size_t)l * 512 * 512, 512, kt * 64, nt * 64, 0, smem);
    }
  }
}

__device__ void phase_rownorm(const Params& p, bool from_input, const float* __restrict__ t, const float* __restrict__ gpost,
                              const float* __restrict__ gpre, u16* __restrict__ hout) {
  const int lane = tidq() & 63, w = tidq() >> 6;
  float* xbuf = p.out;
  for (int row = blockIdx.x * 4 + w; row < MTOK; row += gridDim.x * 4) {
    const float* xin = from_input ? (row < MPR ? p.in[0] + (size_t)row * DM : p.in[1] + (size_t)(row - MPR) * DM)
                                  : xbuf + (size_t)row * DM;
    float4 x[4];
#pragma unroll
    for (int k = 0; k < 4; ++k) x[k] = *(const float4*)(xin + lane * 4 + 256 * k);
    if (t) {
      float4 tv[4];
      float ss = 0.f;
#pragma unroll
      for (int k = 0; k < 4; ++k) {
        tv[k] = *(const float4*)(t + (size_t)row * DM + lane * 4 + 256 * k);
        ss += tv[k].x * tv[k].x + tv[k].y * tv[k].y + tv[k].z * tv[k].z + tv[k].w * tv[k].w;
      }
      ss = wave_sum(ss);
      float r = rsqrtf(ss * (1.f / DM) + EPS);
#pragma unroll
      for (int k = 0; k < 4; ++k) {
        float4 g = *(const float4*)(gpost + lane * 4 + 256 * k);
        x[k].x += tv[k].x * r * g.x; x[k].y += tv[k].y * r * g.y; x[k].z += tv[k].z * r * g.z; x[k].w += tv[k].w * r * g.w;
      }
    }
#pragma unroll
    for (int k = 0; k < 4; ++k) *(float4*)(xbuf + (size_t)row * DM + lane * 4 + 256 * k) = x[k];
    if (hout) {
      float ss = 0.f;
#pragma unroll
      for (int k = 0; k < 4; ++k) ss += x[k].x * x[k].x + x[k].y * x[k].y + x[k].z * x[k].z + x[k].w * x[k].w;
      ss = wave_sum(ss);
      float r = rsqrtf(ss * (1.f / DM) + EPS);
#pragma unroll
      for (int k = 0; k < 4; ++k) {
        float4 g = *(const float4*)(gpre + lane * 4 + 256 * k);
        uint2 o;
        o.x = pack2(x[k].x * r * g.x, x[k].y * r * g.y);
        o.y = pack2(x[k].z * r * g.z, x[k].w * r * g.w);
        *(uint2*)(hout + (size_t)row * DM + lane * 4 + 256 * k) = o;
      }
    }
  }
}

DI int swz(int r, int c) { return r * 128 + ((c ^ ((r >> 1) & 7)) << 4); }

DI void gemm_kloop(f32x4 (&acc)[4][4], const u16* __restrict__ A, int lda, const u16* __restrict__ Bt, int ldb,
                   int K, int m0, int n0, char* smem) {
  const int tid = tidq(), lane = tid & 63, w = tid >> 6, wm = w >> 1, wn = w & 1, r16 = lane & 15, quad = lane >> 4;
  const int lr = tid >> 3, lc = tid & 7;
  const u16* ag = A + (size_t)(m0 + lr) * lda + lc * 8;
  const u16* bg = Bt + (size_t)(n0 + lr) * ldb + lc * 8;
  uint4 ra[4], rb[4];
#pragma unroll
  for (int i = 0; i < 4; ++i) {
    ra[i] = *(const uint4*)(ag + (size_t)i * 32 * lda);
    rb[i] = *(const uint4*)(bg + (size_t)i * 32 * ldb);
  }
#pragma unroll
  for (int i = 0; i < 4; ++i) {
    *(uint4*)(smem + swz(lr + 32 * i, lc)) = ra[i];
    *(uint4*)(smem + 16384 + swz(lr + 32 * i, lc)) = rb[i];
  }
  __syncthreads();
  const int nk = K >> 6;
  for (int kt = 0; kt < nk; ++kt) {
    const bool more = (kt + 1 < nk);
    if (more) {
#pragma unroll
      for (int i = 0; i < 4; ++i) {
        ra[i] = *(const uint4*)(ag + (size_t)i * 32 * lda + (kt + 1) * 64);
        rb[i] = *(const uint4*)(bg + (size_t)i * 32 * ldb + (kt + 1) * 64);
      }
    }
    const char* as = smem + (kt & 1) * 32768;
    const char* bs = as + 16384;
#pragma unroll
    for (int s = 0; s < 2; ++s) {
      bf16x8 af[4], bfr[4];
#pragma unroll
      for (int i = 0; i < 4; ++i) af[i] = *(const bf16x8*)(as + swz(wm * 64 + i * 16 + r16, s * 4 + quad));
#pragma unroll
      for (int j = 0; j < 4; ++j) bfr[j] = *(const bf16x8*)(bs + swz(wn * 64 + j * 16 + r16, s * 4 + quad));
#pragma unroll
      for (int i = 0; i < 4; ++i)
#pragma unroll
        for (int j = 0; j < 4; ++j) acc[i][j] = MFMA16(bfr[j], af[i], acc[i][j]);
    }
    if (more) {
      char* an = smem + ((kt + 1) & 1) * 32768;
#pragma unroll
      for (int i = 0; i < 4; ++i) {
        *(uint4*)(an + swz(lr + 32 * i, lc)) = ra[i];
        *(uint4*)(an + 16384 + swz(lr + 32 * i, lc)) = rb[i];
      }
    }
    __syncthreads();
  }
}

DI void zero_acc(f32x4 (&acc)[4][4]) {
#pragma unroll
  for (int i = 0; i < 4; ++i)
#pragma unroll
    for (int j = 0; j < 4; ++j) acc[i][j] = f32x4{0.f, 0.f, 0.f, 0.f};
}

enum { EPI_BF16 = 0, EPI_SIG = 1, EPI_RELU2 = 2, EPI_F32 = 3, EPI_GLU = 4 };

template <int EPI>
DI void gemm_tile(const u16* A, int lda, const u16* Bt, int ldb, int K, int m0, int n0,
                  void* outp, int ldc, const u16* aux, int ldaux, char* smem) {
  f32x4 acc[4][4];
  zero_acc(acc);
  gemm_kloop(acc, A, lda, Bt, ldb, K, m0, n0, smem);
  const int lane = tidq() & 63, w = tidq() >> 6, wm = w >> 1, wn = w & 1, r16 = lane & 15, quad = lane >> 4;
#pragma unroll
  for (int i = 0; i < 4; ++i) {
    const int m = m0 + wm * 64 + i * 16 + r16;
#pragma unroll
    for (int j = 0; j < 4; ++j) {
      const int n = n0 + wn * 64 + j * 16 + quad * 4;
      f32x4 v = acc[i][j];
      if (EPI == EPI_F32) {
        *(float4*)((float*)outp + (size_t)m * ldc + n) = make_float4(v[0], v[1], v[2], v[3]);
      } else {
        if (EPI == EPI_SIG) {
#pragma unroll
          for (int x = 0; x < 4; ++x) v[x] = sigmoidf_(v[x]);
        } else if (EPI == EPI_RELU2) {
#pragma unroll
          for (int x = 0; x < 4; ++x) { float r = fmaxf(v[x], 0.f); v[x] = r * r; }
        } else if (EPI == EPI_GLU) {
          uint2 zz = *(const uint2*)(aux + (size_t)m * ldaux + n);
          v[0] = bf2f((u16)(zz.x & 0xffff)) * sigmoidf_(v[0]);
          v[1] = bf2f((u16)(zz.x >> 16)) * sigmoidf_(v[1]);
          v[2] = bf2f((u16)(zz.y & 0xffff)) * sigmoidf_(v[2]);
          v[3] = bf2f((u16)(zz.y >> 16)) * sigmoidf_(v[3]);
        }
        uint2 o; o.x = pack2(v[0], v[1]); o.y = pack2(v[2], v[3]);
        *(uint2*)((u16*)outp + (size_t)m * ldc + n) = o;
      }
    }
  }
}

DI void merge_tile(const Params& p, int l, int m0, int n0, char* smem) {
  f32x4 macc[4][4];
  zero_acc(macc);
  const int lane = tidq() & 63, w = tidq() >> 6, wm = w >> 1, wn = w & 1, r16 = lane & 15, quad = lane >> 4;
  const u16* gates = p.pbuf;
  for (int b = 0; b < 4; ++b) {
    f32x4 acc[4][4];
    zero_acc(acc);
    gemm_kloop(acc, p.obuf + b * 512, 2048, p.wt_br + (size_t)(l * 4 + b) * DM * 512, 512, 512, m0, n0, smem);
#pragma unroll
    for (int i = 0; i < 4; ++i) {
      const int m = m0 + wm * 64 + i * 16 + r16;
#pragma unroll
      for (int j = 0; j < 4; ++j) {
        const int n = n0 + wn * 64 + j * 16 + quad * 4;
        uint2 gg = *(const uint2*)(gates + (size_t)m * 4096 + b * 1024 + n);
        macc[i][j][0] += bf2f((u16)(gg.x & 0xffff)) * acc[i][j][0];
        macc[i][j][1] += bf2f((u16)(gg.x >> 16)) * acc[i][j][1];
        macc[i][j][2] += bf2f((u16)(gg.y & 0xffff)) * acc[i][j][2];
        macc[i][j][3] += bf2f((u16)(gg.y >> 16)) * acc[i][j][3];
      }
    }
  }
#pragma unroll
  for (int i = 0; i < 4; ++i) {
    const int m = m0 + wm * 64 + i * 16 + r16;
#pragma unroll
    for (int j = 0; j < 4; ++j) {
      const int n = n0 + wn * 64 + j * 16 + quad * 4;
      uint2 o; o.x = pack2(macc[i][j][0], macc[i][j][1]); o.y = pack2(macc[i][j][2], macc[i][j][3]);
      *(uint2*)(p.hb + (size_t)m * DM + n) = o;
    }
  }
}

constexpr int QS = 136;
constexpr int TS = 20;
constexpr int OFS = 260;

template <int MODE>
__device__ void run_chain(const Params& p, int l, int seq, int sub, char* smem) {
  constexpr int NE = 2;
  const int tid = tidq(), lane = tid & 63, w = tid >> 6, r16 = lane & 15, quad = lane >> 4;
  const bool prompt = seq < 8;
  const int bidx = prompt ? seq : seq - 8;
  const int NB = prompt ? 8 : 128;
  const int L = prompt ? 2048 : 8;
  const int row0 = prompt ? seq * 2048 : MPR + (seq - 8) * 8;
  const int pos0 = prompt ? 0 : 16384;
  const int nch = prompt ? 128 : 1;

  u16* Qa = (u16*)smem;
  u16* Ka = (u16*)(smem + 4352);
  u16* KuT = (u16*)(smem + 8704);
  u16* VaT = (u16*)(smem + 13824);
  u16* VuT = (MODE == 1) ? (u16*)(smem + 24064) : VaT;
  float* tmpK = (float*)(smem + 24064);
  float* Of = (float*)(smem + 34304);
  u16* Raw = (u16*)(smem + 34304);
  u16* Xc = (u16*)(smem + 50944);
  float* tmpC = (float*)(smem + 50944);
  float* cdec = (float*)(smem + 59136);
  float* dtl = (float*)(smem + 59392);
  float* rsc = (float*)(smem + 59648);
  float* clast = (float*)(smem + 60160);

  const float* sin_ = nullptr;
  float* sout = nullptr;
  if (MODE == 0) {
    if (!prompt) sin_ = p.in[2] + (((size_t)l * 128 + bidx) * 4 + sub) * 16384;
    sout = p.out + (prompt ? p.o_ret_p : p.o_ret_s) + (((size_t)l * NB + bidx) * 4 + sub) * 16384;
  } else if (MODE == 2) {
    if (!prompt) sin_ = p.in[5] + (((size_t)l * 128 + bidx) * 4 + sub) * 16384;
    sout = p.out + (prompt ? p.o_hg_p : p.o_hg_s) + (((size_t)l * NB + bidx) * 4 + sub) * 16384;
  } else {
    if (!prompt) sin_ = p.in[3] + (((size_t)l * 128 + bidx) * 8 + sub * 2 + (w >> 1)) * 8192;
    sout = p.out + (prompt ? p.o_ssd_p : p.o_ssd_s) + (((size_t)l * NB + bidx) * 8 + sub * 2 + (w >> 1)) * 8192;
  }

  int sbase = (MODE == 1) ? (((w & 1) * 32 + r16) * 128 + quad * 4) : (quad * 512 + w * 32 + r16);
  asm volatile("" : "+v"(sbase));
  f32x4 S[8][NE];
#pragma unroll
  for (int t = 0; t < 8; ++t)
#pragma unroll
    for (int u = 0; u < NE; ++u) {
      if (sin_) {
        if (MODE == 1) {
          S[t][u] = *(const f32x4*)(sin_ + sbase + u * 2048 + t * 16);
        } else {
#pragma unroll
          for (int jj = 0; jj < 4; ++jj) S[t][u][jj] = sin_[sbase + t * 2048 + jj * 128 + u * 16];
        }
      } else {
        S[t][u] = f32x4{0.f, 0.f, 0.f, 0.f};
      }
    }

  float lg = 0.f;
  float lbv = 0.f;
  float cprev[2][3];
  float cw[2][4], cb[2];
  int ccidx[2];
  const int gg = sub >> 1, pair = sub & 1;
  if (MODE == 0) lg = log1pf(-exp2f(-5.f - (float)sub));
  if (MODE == 2) {
    if (l == 1 && tid < 128) {
      float a0 = p.in[20][sub * 128 + tid], a1 = p.in[20][512 + sub * 128 + tid];
      float mx = fmaxf(a0, a1);
      float e0 = __expf(a0 - mx), e1 = __expf(a1 - mx);
      lbv = e1 / (e0 + e1);
    }
  }
  if (MODE == 1) {
#pragma unroll
    for (int k = 0; k < 2; ++k) {
      int ci = tid + 256 * k;
      int cc = 0;
      if (ci < 128) cc = gg * 256 + pair * 128 + ci;
      else if (ci < 256) cc = 512 + gg * 128 + (ci - 128);
      else cc = 768 + gg * 128 + (ci - 256);
      if (ci >= 384) cc = 0;
      ccidx[k] = cc;
#pragma unroll
      for (int j = 0; j < 4; ++j) cw[k][j] = p.in[14][((size_t)l * 4 + j) * 1024 + cc];
      cb[k] = p.in[15][l * 1024 + cc];
#pragma unroll
      for (int j = 0; j < 3; ++j)
        cprev[k][j] = prompt ? 0.f : p.in[4][(((size_t)l * 128 + bidx) * 3 + j) * 1024 + cc];
    }
  }

  const int lt = tid >> 4, lc = tid & 15;
  uint4 r0, r1, r2, g0;
  unsigned rdt = 0;
  const uint4 z4 = make_uint4(0, 0, 0, 0);
  r0 = r1 = r2 = g0 = z4;
  auto load_raw = [&](int ch) {
    const int t0 = ch * 16;
    const int nv = (L - t0 < 16) ? (L - t0) : 16;
    const u16* Pr = p.pbuf + (size_t)(row0 + t0 + lt) * NP;
    r0 = r1 = r2 = g0 = z4;
    rdt = 0;
    if (lt < nv) {
      if (MODE == 0) {
        r0 = *(const uint4*)(Pr + C_RQ + sub * 128 + lc * 8);
        r1 = *(const uint4*)(Pr + C_RK + sub * 128 + lc * 8);
        r2 = *(const uint4*)(Pr + C_RV + sub * 128 + lc * 8);
        g0 = *(const uint4*)(Pr + C_RG + sub * 128 + lc * 8);
      } else if (MODE == 2) {
        r0 = *(const uint4*)(Pr + C_HQ + sub * 128 + lc * 8);
        r1 = *(const uint4*)(Pr + C_HF + sub * 128 + lc * 8);
        r2 = *(const uint4*)(Pr + C_HI + sub * 128 + lc * 8);
        g0 = *(const uint4*)(Pr + C_HG + sub * 128 + lc * 8);
      } else {
        r0 = *(const uint4*)(Pr + C_SXBC + gg * 256 + pair * 128 + lc * 8);
        r1 = *(const uint4*)(Pr + C_SXBC + 512 + gg * 128 + lc * 8);
        r2 = *(const uint4*)(Pr + C_SXBC + 768 + gg * 128 + lc * 8);
        g0 = *(const uint4*)(Pr + C_SZ + gg * 256 + pair * 128 + lc * 8);
        if (lc < 2) rdt = Pr[C_SDT + sub * 2 + lc];
      }
    }
  };
  load_raw(0);

  for (int ch = 0; ch < nch; ++ch) {
    const int t0 = ch * 16;
    const int nvalid = (L - t0 < 16) ? (L - t0) : 16;
    float sscale = 1.f;
    int tidv = tidq();
    asm volatile("" : "+v"(tidv));
    const int tid = tidv, lane = tid & 63, w = tid >> 6, r16 = lane & 15, quad = lane >> 4, lt = tid >> 4, lc = tid & 15;

    *(uint4*)(Raw + lt * 128 + lc * 8) = r0;
    *(uint4*)(Raw + 2048 + lt * 128 + lc * 8) = r1;
    *(uint4*)(Raw + 4096 + lt * 128 + lc * 8) = r2;
    if (MODE == 1) { if (lc < 2) Raw[6144 + lt * 2 + lc] = (u16)rdt; }
    const uint4 gc0 = g0;
    __syncthreads();
    if (ch + 1 < nch) load_raw(ch + 1);

    if (MODE == 0) {
      if (tid < 128) {
        const int isK = tid >> 6, pr = tid & 63;
        const u16* R = Raw + (isK ? 2048 : 0);
        const float inv = exp2f(-(float)pr * (13.287712379549449f / 64.f));
#pragma unroll 4
        for (int t = 0; t < 16; ++t) {
          float x1 = bf2f(R[t * 128 + pr]);
          float x2 = bf2f(R[t * 128 + pr + 64]);
          float ang = (float)(pos0 + t0 + t) * inv;
          float sn, cs; sincos_red(ang, sn, cs);
          float y1 = x1 * cs - x2 * sn, y2 = x1 * sn + x2 * cs;
          if (isK) {
            y1 *= 0.08838834764831845f; y2 *= 0.08838834764831845f;
            Ka[t * QS + pr] = f2bf(y1); Ka[t * QS + pr + 64] = f2bf(y2);
            float kd = (t < nvalid) ? __expf(lg * (float)(nvalid - 1 - t)) : 0.f;
            KuT[pr * TS + t] = f2bf(y1 * kd);
            KuT[(pr + 64) * TS + t] = f2bf(y2 * kd);
          } else {
            Qa[t * QS + pr] = f2bf(y1); Qa[t * QS + pr + 64] = f2bf(y2);
          }
        }
      } else {
        const int e = tid - 128;
#pragma unroll 4
        for (int t = 0; t < 16; ++t) VaT[e * TS + t] = Raw[4096 + t * 128 + e];
      }
      if (tid < 16) cdec[tid] = lg * (float)(tid + 1);
      sscale = __expf(lg * (float)nvalid);
    } else if (MODE == 2) {
      if (tid < 128) {
        const int d = tid;
        float c = 0.f;
#pragma unroll 4
        for (int t = 0; t < 16; ++t) {
          float qv = 0.f, kk = 0.f;
          if (t < nvalid) {
            float hq = bf2f(Raw[t * 128 + d]);
            float z = bf2f(Raw[2048 + t * 128 + d]);
            float sg = sigmoidf_(z);
            float f = lbv + (1.f - lbv) * sg;
            c += __logf(f);
            kk = (1.f - lbv) * (1.f - sg);
            qv = siluf_(hq);
          }
          tmpC[t * 128 + d] = c; tmpK[t * 128 + d] = kk;
          Qa[t * QS + d] = f2bf(qv * __expf(c));
          Ka[t * QS + d] = f2bf(kk * __expf(-c));
        }
#pragma unroll 4
        for (int t = 0; t < 16; ++t)
          KuT[d * TS + t] = f2bf(tmpK[t * 128 + d] * __expf(c - tmpC[t * 128 + d]));
        rsc[d] = __expf(c);
      } else {
        const int e = tid - 128;
#pragma unroll 4
        for (int t = 0; t < 16; ++t) VaT[e * TS + t] = Raw[4096 + t * 128 + e];
      }
    } else {
      if (tid < 2) {
        const int hh = sub * 2 + tid;
        const float Ah = -__expf(p.in[16][l * 8 + hh]);
        const float bias = p.in[17][l * 8 + hh];
        float c = 0.f;
#pragma unroll 4
        for (int t = 0; t < 16; ++t) {
          float dtv = 0.f;
          if (t < nvalid) {
            dtv = softplusf_(bf2f(Raw[6144 + t * 2 + tid]) + bias);
            c += dtv * Ah;
          }
          cdec[tid * 16 + t] = c;
          dtl[tid * 16 + t] = dtv;
        }
        clast[tid] = c;
      }
      __syncthreads();
#pragma unroll
      for (int k = 0; k < 2; ++k) {
        const int ci = tid + 256 * k;
        if (ci < 384) {
          const int hl = (ci < 128) ? (ci >> 6) : 0;
          const float cl = clast[hl];
          const u16* R = Raw + ((ci < 128) ? ci : ((ci < 256) ? (2048 + (ci - 128)) : (4096 + (ci - 256))));
          const int rs = 128;
#pragma unroll 4
          for (int t = 0; t < 16; ++t) {
            float v = 0.f;
            if (t < nvalid) {
              float raw = bf2f(R[t * rs]);
              float o = cb[k] + cprev[k][0] * cw[k][0] + cprev[k][1] * cw[k][1] + cprev[k][2] * cw[k][2] + raw * cw[k][3];
              cprev[k][0] = cprev[k][1]; cprev[k][1] = cprev[k][2]; cprev[k][2] = raw;
              v = siluf_(o);
            }
            if (ci < 128) {
              Xc[t * 128 + ci] = f2bf(v);
              float dtv = dtl[hl * 16 + t];
              VaT[ci * TS + t] = f2bf(v * dtv);
              VuT[ci * TS + t] = f2bf(v * dtv * __expf(cl - cdec[hl * 16 + t]));
            } else if (ci < 256) {
              u16 a = f2bf(v);
              Ka[t * QS + (ci - 128)] = a;
              KuT[(ci - 128) * TS + t] = a;
            } else {
              Qa[t * QS + (ci - 256)] = f2bf(v);
            }
          }
        }
      }
    }
    __syncthreads();

    {
      const float* cd = cdec + ((MODE == 1) ? (w >> 1) * 16 : 0);
      f32x4 at = f32x4{0.f, 0.f, 0.f, 0.f};
#pragma unroll
      for (int s = 0; s < 4; ++s) {
        bf16x8 a = *(const bf16x8*)(Ka + r16 * QS + s * 32 + quad * 8);
        bf16x8 b = *(const bf16x8*)(Qa + r16 * QS + s * 32 + quad * 8);
        at = MFMA16(a, b, at);
      }
      bf16x8 attA;
      {
        float ci_ = (MODE != 2) ? cd[r16] : 0.f;
        float vv[4];
#pragma unroll
        for (int jj = 0; jj < 4; ++jj) {
          int j = quad * 4 + jj;
          float v = at[jj];
          if (MODE != 2) v *= __expf(fminf(ci_ - cd[j], 0.f));
          vv[jj] = (j <= r16) ? v : 0.f;
        }
        attA[0] = (short)f2bf(vv[0]); attA[1] = (short)f2bf(vv[1]); attA[2] = (short)f2bf(vv[2]); attA[3] = (short)f2bf(vv[3]);
        attA[4] = 0; attA[5] = 0; attA[6] = 0; attA[7] = 0;
      }
      float rr[4];
#pragma unroll
      for (int jj = 0; jj < 4; ++jj) rr[jj] = (MODE != 2) ? __expf(cd[quad * 4 + jj]) : 1.f;

      bf16x8 qf[4];
#pragma unroll
      for (int s = 0; s < 4; ++s) {
        bf16x4 lo = *(const bf16x4*)(Qa + r16 * QS + s * 32 + quad * 4);
        bf16x4 hi = *(const bf16x4*)(Qa + r16 * QS + s * 32 + 16 + quad * 4);
        qf[s] = bf16x8{lo[0], lo[1], lo[2], lo[3], hi[0], hi[1], hi[2], hi[3]};
      }
      __syncthreads();
#pragma unroll
      for (int u = 0; u < NE; ++u) {
        const int e0 = (w * NE + u) * 16;
        bf16x4 v4 = *(const bf16x4*)(VaT + (e0 + r16) * TS + quad * 4);
        bf16x8 vb = bf16x8{v4[0], v4[1], v4[2], v4[3], 0, 0, 0, 0};
        f32x4 o1 = MFMA16(attA, vb, (f32x4{0.f, 0.f, 0.f, 0.f}));
        f32x4 o2 = f32x4{0.f, 0.f, 0.f, 0.f};
#pragma unroll
        for (int s = 0; s < 4; ++s) {
          bf16x8 sb;
          sb[0] = (short)f2bf(S[2 * s][u][0]); sb[1] = (short)f2bf(S[2 * s][u][1]);
          sb[2] = (short)f2bf(S[2 * s][u][2]); sb[3] = (short)f2bf(S[2 * s][u][3]);
          sb[4] = (short)f2bf(S[2 * s + 1][u][0]); sb[5] = (short)f2bf(S[2 * s + 1][u][1]);
          sb[6] = (short)f2bf(S[2 * s + 1][u][2]); sb[7] = (short)f2bf(S[2 * s + 1][u][3]);
          o2 = MFMA16(qf[s], sb, o2);
        }
#pragma unroll
        for (int jj = 0; jj < 4; ++jj) Of[(quad * 4 + jj) * OFS + e0 + r16] = o1[jj] + rr[jj] * o2[jj];
      }
      float hs = 1.f;
      if (MODE == 0) hs = sscale;
      if (MODE == 1) hs = __expf(clast[w >> 1]);
#pragma unroll
      for (int u = 0; u < NE; ++u) {
        const int e0 = (w * NE + u) * 16;
        bf16x4 v4 = *(const bf16x4*)(VuT + (e0 + r16) * TS + quad * 4);
        bf16x8 vb = bf16x8{v4[0], v4[1], v4[2], v4[3], 0, 0, 0, 0};
#pragma unroll
        for (int t = 0; t < 8; ++t) {
          bf16x4 k4 = *(const bf16x4*)(KuT + (t * 16 + r16) * TS + quad * 4);
          bf16x8 ka = bf16x8{k4[0], k4[1], k4[2], k4[3], 0, 0, 0, 0};
          f32x4 sv = S[t][u];
          if (MODE == 2) {
            f32x4 r4 = *(const f32x4*)(rsc + t * 16 + quad * 4);
            sv[0] *= r4[0]; sv[1] *= r4[1]; sv[2] *= r4[2]; sv[3] *= r4[3];
          } else {
            sv[0] *= hs; sv[1] *= hs; sv[2] *= hs; sv[3] *= hs;
          }
          S[t][u] = MFMA16(ka, vb, sv);
        }
      }
    }
    __syncthreads();

    {
      const int i = tid >> 4, eg = tid & 15;
      const int grow = row0 + t0 + i;
      if (MODE == 0 || MODE == 2) {
        float o[8];
#pragma unroll
        for (int x = 0; x < 8; ++x) o[x] = Of[i * OFS + eg * 8 + x];
        float s1 = 0.f;
        float mu = 0.f;
        if (MODE == 0) {
#pragma unroll
          for (int x = 0; x < 8; ++x) s1 += o[x];
          mu = sum16(s1) * (1.f / 128.f);
        }
        float s2 = 0.f;
#pragma unroll
        for (int x = 0; x < 8; ++x) { o[x] -= mu; s2 += o[x] * o[x]; }
        float r = rsqrtf(sum16(s2) * (1.f / 128.f) + EPS);
        if (i < nvalid) {
          unsigned gw[4] = {gc0.x, gc0.y, gc0.z, gc0.w};
          const float* gain = (MODE == 0) ? (p.in[13] + (l * 4 + sub) * 128 + eg * 8) : (p.in[21] + l * 128 + eg * 8);
          float res[8];
#pragma unroll
          for (int x = 0; x < 8; ++x) {
            float g = bf2f((u16)((x & 1) ? (gw[x >> 1] >> 16) : (gw[x >> 1] & 0xffff)));
            float gate = (MODE == 0) ? siluf_(g) : sigmoidf_(g);
            res[x] = o[x] * r * gain[x] * gate;
          }
          uint4 ov = make_uint4(pack2(res[0], res[1]), pack2(res[2], res[3]), pack2(res[4], res[5]), pack2(res[6], res[7]));
          const int ocol = ((MODE == 0) ? 0 : 1024) + sub * 128 + eg * 8;
          *(uint4*)(p.obuf + (size_t)grow * 2048 + ocol) = ov;
        }
      } else {
        float y[8];
        const int chb = eg * 8;
        const float Dh = p.in[18][l * 8 + sub * 2 + (chb >> 6)];
        float s2 = 0.f;
        unsigned gw[4] = {gc0.x, gc0.y, gc0.z, gc0.w};
#pragma unroll
        for (int x = 0; x < 8; ++x) {
          float g = bf2f((u16)((x & 1) ? (gw[x >> 1] >> 16) : (gw[x >> 1] & 0xffff)));
          float v = Of[i * OFS + chb + x] + bf2f(Xc[i * 128 + chb + x]) * Dh;
          v *= siluf_(g);
          y[x] = v; s2 += v * v;
        }
        s2 = sum16(s2);
        if (i < nvalid) {
          if (eg == 0) p.ssq[(size_t)grow * 4 + sub] = s2;
          uint4 ov = make_uint4(pack2(y[0], y[1]), pack2(y[2], y[3]), pack2(y[4], y[5]), pack2(y[6], y[7]));
          *(uint4*)(p.obuf + (size_t)grow * 2048 + 512 + sub * 128 + chb) = ov;
        }
      }
    }
    __syncthreads();
  }

  asm volatile("" : "+v"(sbase));
#pragma unroll
  for (int t = 0; t < 8; ++t)
#pragma unroll
    for (int u = 0; u < NE; ++u) {
      if (MODE == 1) {
        *(f32x4*)(sout + sbase + u * 2048 + t * 16) = S[t][u];
      } else {
#pragma unroll
        for (int jj = 0; jj < 4; ++jj) sout[sbase + t * 2048 + jj * 128 + u * 16] = S[t][u][jj];
      }
    }
  if (MODE == 1) {
    float* co = p.out + (prompt ? p.o_conv_p : p.o_conv_s) + ((size_t)l * NB + bidx) * 3 * 1024;
#pragma unroll
    for (int k = 0; k < 2; ++k) {
      const int ci = tid + 256 * k;
      if (ci < 128 || (ci < 384 && pair == 0)) {
#pragma unroll
        for (int j = 0; j < 3; ++j) co[j * 1024 + ccidx[k]] = cprev[k][j];
      }
    }
  }
}

__device__ void run_s5(const Params& p, int l, int seq, int gq, char* smem) {
  const int tid = tidq(), lane = tid & 63, w = tid >> 6;
  const int g = gq * 4 + w;
  const bool prompt = seq < 8;
  const int bidx = prompt ? seq : seq - 8;
  const int NB = prompt ? 8 : 128;
  const int L = prompt ? 2048 : 8;
  const int row0 = prompt ? seq * 2048 : MPR + (seq - 8) * 8;
  const int nsub = L / 8;
  float* base = (float*)(smem + w * 13568);
  float* hre = base;
  float* him = base + 544;
  float* cre = base + 1088;
  float* cim = base + 2176;
  float* ub = base + 3264;
  const int lg_ = l * 32 + g;
#pragma unroll
  for (int m = 0; m < 16; ++m) {
    cre[m * 68 + lane] = p.in[26][((size_t)lg_ * 16 + m) * 64 + lane];
    cim[m * 68 + lane] = p.in[27][((size_t)lg_ * 16 + m) * 64 + lane];
  }
  const float dt = __expf(p.in[29][lg_]);
  const float are = p.in[22][lg_ * 64 + lane], aim = p.in[23][lg_ * 64 + lane];
  const float th = dt * aim;
  float sn, cs; sincos_red(th, sn, cs);
  float shalf, chalf; sincos_red(0.5f * th, shalf, chalf);
  const float em1 = expm1f(dt * are);
  const float mag = em1 + 1.f;
  const float abr = mag * cs, abi = mag * sn;
  const float nre = em1 * cs - 2.f * shalf * shalf, nim = abi;
  const float den = are * are + aim * aim;
  const float fre = (nre * are + nim * aim) / den, fim = (nim * are - nre * aim) / den;
  float bbr[16], bbi[16];
#pragma unroll
  for (int m = 0; m < 16; ++m) {
    float br = p.in[24][((size_t)lg_ * 64 + lane) * 16 + m], bi = p.in[25][((size_t)lg_ * 64 + lane) * 16 + m];
    bbr[m] = fre * br - fim * bi;
    bbi[m] = fre * bi + fim * br;
  }
  float hr = 0.f, hi = 0.f;
  if (!prompt) {
    hr = p.in[6][((size_t)(l * 128 + bidx) * 32 + g) * 64 + lane];
    hi = p.in[7][((size_t)(l * 128 + bidx) * 32 + g) * 64 + lane];
  }
  const int oi = lane & 7, mg = lane >> 3, m0 = mg * 2;
  const float dm0 = p.in[28][lg_ * 16 + m0], dm1 = p.in[28][lg_ * 16 + m0 + 1];
  const int ti = lane >> 3, cp = lane & 7;
  const u16* ubase = p.pbuf + (size_t)(row0 + ti) * NP + C_SU + g * 16 + cp * 2;
  unsigned nxt = *(const unsigned*)ubase;
  for (int sc = 0; sc < nsub; ++sc) {
    unsigned cur = nxt;
    if (sc + 1 < nsub) nxt = *(const unsigned*)(ubase + (size_t)(sc + 1) * 8 * NP);
    ub[ti * 16 + cp * 2] = bf2f((u16)(cur & 0xffff));
    ub[ti * 16 + cp * 2 + 1] = bf2f((u16)(cur >> 16));
    __syncthreads();
#pragma unroll
    for (int i = 0; i < 8; ++i) {
      float bur = 0.f, bui = 0.f;
#pragma unroll
      for (int m4 = 0; m4 < 4; ++m4) {
        f32x4 u4 = *(const f32x4*)(ub + i * 16 + m4 * 4);
#pragma unroll
        for (int x = 0; x < 4; ++x) { bur += bbr[m4 * 4 + x] * u4[x]; bui += bbi[m4 * 4 + x] * u4[x]; }
      }
      float nr = abr * hr - abi * hi + bur;
      float ni = abr * hi + abi * hr + bui;
      hr = nr; hi = ni;
      hre[i * 68 + lane] = hr; him[i * 68 + lane] = hi;
    }
    __syncthreads();
    float y0 = 0.f, y1 = 0.f;
#pragma unroll
    for (int p4 = 0; p4 < 16; ++p4) {
      f32x4 h4r = *(const f32x4*)(hre + oi * 68 + p4 * 4);
      f32x4 h4i = *(const f32x4*)(him + oi * 68 + p4 * 4);
      f32x4 c0r = *(const f32x4*)(cre + m0 * 68 + p4 * 4);
      f32x4 c0i = *(const f32x4*)(cim + m0 * 68 + p4 * 4);
      f32x4 c1r = *(const f32x4*)(cre + (m0 + 1) * 68 + p4 * 4);
      f32x4 c1i = *(const f32x4*)(cim + (m0 + 1) * 68 + p4 * 4);
#pragma unroll
      for (int x = 0; x < 4; ++x) {
        y0 += c0r[x] * h4r[x] - c0i[x] * h4i[x];
        y1 += c1r[x] * h4r[x] - c1i[x] * h4i[x];
      }
    }
    y0 += dm0 * ub[oi * 16 + m0];
    y1 += dm1 * ub[oi * 16 + m0 + 1];
    *(unsigned*)(p.zs5 + (size_t)(row0 + sc * 8 + oi) * 512 + g * 16 + m0) = pack2(gelu_tanh(y0), gelu_tanh(y1));
    __syncthreads();
  }
  p.out[(prompt ? p.o_s5r_p : p.o_s5r_s) + ((size_t)(l * NB + bidx) * 32 + g) * 64 + lane] = hr;
  p.out[(prompt ? p.o_s5i_p : p.o_s5i_s) + ((size_t)(l * NB + bidx) * 32 + g) * 64 + lane] = hi;
}

__device__ void phase_mixers(const Params& p, int l, char* smem) {
  int* s_item = (int*)(smem + 65536);
  for (;;) {
    if (tidq() == 0) *s_item = (int)atomicAdd(&p.counters[l * 64], 1u);
    __syncthreads();
    const int item = *s_item;
    __syncthreads();
    if (item >= NITEMS) break;
    int mode, seq, sub;
    if (item < 32) { mode = 1; seq = item >> 2; sub = item & 3; }
    else if (item < 96) { int k = item - 32; seq = k >> 3; sub = k & 7; mode = (sub < 4) ? 0 : 2; sub &= 3; }
    else if (item < 160) { int k = item - 96; mode = 3; seq = k >> 3; sub = k & 7; }
    else {
      int k = item - 160; int b = k / 20; sub = k % 20; seq = 8 + b;
      if (sub < 4) mode = 1;
      else if (sub < 8) { mode = 0; sub -= 4; }
      else if (sub < 12) { mode = 2; sub -= 8; }
      else { mode = 3; sub -= 12; }
    }
    if (mode == 0) { if (EN(2) || ONLY == 20) run_chain<0>(p, l, seq, sub, smem); }
    else if (mode == 1) { if (EN(2) || ONLY == 21) run_chain<1>(p, l, seq, sub, smem); }
    else if (mode == 2) { if (EN(2) || ONLY == 22) run_chain<2>(p, l, seq, sub, smem); }
    else { if (EN(2) || ONLY == 23) run_s5(p, l, seq, sub, smem); }
    __syncthreads();
  }
}

__device__ void run_phase(const Params& p, int ph, char* smem) {
  constexpr int NMT = MTOK / 128;
  if (ph == 0) { if (EN(9)) phase_convert(p, smem); return; }
  if (ph == NPHASE - 1) {
    if (EN(10)) phase_rownorm(p, false, p.tbuf, p.in[11] + 1 * DM, nullptr, nullptr);
    return;
  }
  const int l = (ph - 1) / 9, s = (ph - 1) % 9;
  switch (s) {
    case 0:
      if (!EN(0)) break;
      if (l == 0) phase_rownorm(p, true, nullptr, nullptr, p.in[8], p.hb);
      else phase_rownorm(p, false, p.tbuf, p.in[11] + (l - 1) * DM, p.in[8] + l * DM, p.hb);
      break;
    case 1: if (EN(1)) {
      constexpr int NN = NP / 128;
      for (int t = blockIdx.x; t < NMT * NN; t += gridDim.x)
        gemm_tile<EPI_BF16>(p.hb, DM, p.wt_in + (size_t)l * NIN * DM, DM, DM, (t / NN) * 128, (t % NN) * 128, p.pbuf, NP, nullptr, 0, smem);
    } break;
    case 2: if (EN(2) || (ONLY >= 20 && ONLY <= 23)) phase_mixers(p, l, smem); break;
    case 3: if (EN(3)) {
      constexpr int NG = 32, NGLU = 4;
      {
        const int lane = tidq() & 63, w = tidq() >> 6;
        for (int row = blockIdx.x * 4 + w; row < MTOK; row += gridDim.x * 4) {
          const float4 sq = *(const float4*)(p.ssq + (size_t)row * 4);
          const float ms = (lane < 32) ? (sq.x + sq.y) : (sq.z + sq.w);
          const float r = rsqrtf(ms * (1.f / 256.f) + EPS);
          u16* ptr = p.obuf + (size_t)row * 2048 + 512 + lane * 8;
          uint4 v = *(const uint4*)ptr;
          const float* gn = p.in[19] + l * 512 + lane * 8;
          unsigned vw[4] = {v.x, v.y, v.z, v.w};
          unsigned ow[4];
#pragma unroll
          for (int x = 0; x < 4; ++x)
            ow[x] = pack2(bf2f((u16)(vw[x] & 0xffff)) * r * gn[2 * x], bf2f((u16)(vw[x] >> 16)) * r * gn[2 * x + 1]);
          *(uint4*)ptr = make_uint4(ow[0], ow[1], ow[2], ow[3]);
        }
      }
      for (int t = blockIdx.x; t < NMT * (NG + NGLU); t += gridDim.x) {
        if (t < NMT * NG)
          gemm_tile<EPI_SIG>(p.hb, DM, p.wt_in + ((size_t)l * NIN + NP) * DM, DM, DM, (t / NG) * 128, (t % NG) * 128, p.pbuf, 4096, nullptr, 0, smem);
        else {
          int r = t - NMT * NG;
          gemm_tile<EPI_GLU>(p.zs5, 512, p.wt_glu + (size_t)l * 512 * 512, 512, 512, (r / NGLU) * 128, (r % NGLU) * 128,
                             p.obuf + 1536, 2048, p.zs5, 512, smem);
        }
      }
    } break;
    case 4:
      if (EN(4)) for (int t = blockIdx.x; t < NMT * 8; t += gridDim.x) merge_tile(p, l, (t / 8) * 128, (t % 8) * 128, smem);
      break;
    case 5:
      if (EN(5)) for (int t = blockIdx.x; t < NMT * 8; t += gridDim.x)
        gemm_tile<EPI_F32>(p.hb, DM, p.wt_out + (size_t)l * DM * DM, DM, DM, (t / 8) * 128, (t % 8) * 128, p.tbuf, DM, nullptr, 0, smem);
      break;
    case 6:
      if (EN(6)) phase_rownorm(p, false, p.tbuf, p.in[9] + l * DM, p.in[10] + l * DM, p.hb);
      break;
    case 7:
      if (EN(7)) for (int t = blockIdx.x; t < NMT * 32; t += gridDim.x)
        gemm_tile<EPI_RELU2>(p.hb, DM, p.wt_ff1 + (size_t)l * DFF * DM, DM, DM, (t / 32) * 128, (t % 32) * 128, p.pbuf, DFF, nullptr, 0, smem);
      break;
    case 8:
      if (EN(8)) for (int t = blockIdx.x; t < NMT * 8; t += gridDim.x)
        gemm_tile<EPI_F32>(p.pbuf, DFF, p.wt_ff2 + (size_t)l * DM * DFF, DFF, DFF, (t / 8) * 128, (t % 8) * 128, p.tbuf, DM, nullptr, 0, smem);
      break;
  }
}

__global__ void __launch_bounds__(256, 2) mega_kernel(Params p, int ph_lo, int ph_hi) {
  __shared__ __attribute__((aligned(16))) char smem[65536 + 16];
  for (int ph = ph_lo; ph < ph_hi; ++ph) {
    if (ph > ph_lo) cg::this_grid().sync();
    run_phase(p, ph, smem);
  }
}

extern "C" void kernel_launch(void* const* d_in, const int* in_sizes, int n_in, void* d_out, int out_size,
                              void* d_ws, size_t ws_size, hipStream_t stream) {
  Params p{};
  for (int i = 0; i < 35; ++i) p.in[i] = (const float*)d_in[i];
  p.out = (float*)d_out;
  char* ws = (char*)d_ws;
  size_t off = 0;
  auto take = [&](size_t bytes) { char* r = ws + off; off += (bytes + 255) & ~(size_t)255; return r; };
  p.wt_in  = (u16*)take((size_t)2 * NIN * DM * 2);
  p.wt_ff1 = (u16*)take((size_t)2 * DFF * DM * 2);
  p.wt_ff2 = (u16*)take((size_t)2 * DM * DFF * 2);
  p.wt_br  = (u16*)take((size_t)2 * 4 * DM * 512 * 2);
  p.wt_out = (u16*)take((size_t)2 * DM * DM * 2);
  p.wt_glu = (u16*)take((size_t)2 * 512 * 512 * 2);
  p.hb     = (u16*)take((size_t)MTOK * DM * 2);
  p.pbuf   = (u16*)take((size_t)MTOK * NP * 2);
  p.obuf   = (u16*)take((size_t)MTOK * 2048 * 2);
  p.zs5    = (u16*)take((size_t)MTOK * 512 * 2);
  p.counters = (unsigned*)take(4096);
  p.ssq = (float*)take((size_t)MTOK * 4 * 4);
  p.tbuf = (float*)(p.pbuf + (size_t)MTOK * 4096);
  if (off > ws_size) { fprintf(stderr, "workspace too small: need %zu have %zu\n", off, ws_size); return; }
  size_t o = (size_t)MTOK * DM;
  p.o_ret_p = o;  o += (size_t)2 * 8 * 65536;
  p.o_ret_s = o;  o += (size_t)2 * 128 * 65536;
  p.o_ssd_p = o;  o += (size_t)2 * 8 * 65536;
  p.o_ssd_s = o;  o += (size_t)2 * 128 * 65536;
  p.o_conv_p = o; o += (size_t)2 * 8 * 3 * 1024;
  p.o_conv_s = o; o += (size_t)2 * 128 * 3 * 1024;
  p.o_hg_p = o;   o += (size_t)2 * 8 * 65536;
  p.o_hg_s = o;   o += (size_t)2 * 128 * 65536;
  p.o_s5r_p = o;  o += (size_t)2 * 8 * 2048;
  p.o_s5r_s = o;  o += (size_t)2 * 128 * 2048;
  p.o_s5i_p = o;  o += (size_t)2 * 8 * 2048;
  p.o_s5i_s = o;  o += (size_t)2 * 128 * 2048;

  static int grid_blocks = 0;
  if (!grid_blocks) {
    int dev = 0, cus = 0, per_cu = 0;
    hipGetDevice(&dev);
    hipDeviceGetAttribute(&cus, hipDeviceAttributeMultiprocessorCount, dev);
    hipOccupancyMaxActiveBlocksPerMultiprocessor(&per_cu, mega_kernel, 256, 0);
    if (per_cu > 2) per_cu = 2;
    if (per_cu < 1) per_cu = 1;
    grid_blocks = cus * per_cu;
  }
  hipMemsetAsync(p.counters, 0, 4096, stream);
#if SINGLE_LAUNCH
  int lo = 0, hi = NPHASE;
  void* args[] = {&p, &lo, &hi};
  hipError_t e = hipLaunchCooperativeKernel((void*)mega_kernel, dim3(grid_blocks), dim3(256), args, 0, stream);
  if (e != hipSuccess) fprintf(stderr, "cooperative launch failed: %s (grid %d)\n", hipGetErrorString(e), grid_blocks);
#else
  for (int ph = 0; ph < NPHASE; ++ph)
    hipLaunchKernelGGL(mega_kernel, dim3(grid_blocks), dim3(256), 0, stream, p, ph, ph + 1);
#endif
}
```

```cpp
#include <hip/hip_runtime.h>
#include <hip/hip_cooperative_groups.h>
#include <cstdio>
#include <cstdint>
namespace cg = cooperative_groups;

#ifndef SINGLE_LAUNCH
#define SINGLE_LAUNCH 1
#endif
#ifndef ONLY
#define ONLY -1
#endif
#define EN(k) (ONLY < 0 || ONLY == (k))

typedef unsigned short u16;
using bf16x8 = __attribute__((ext_vector_type(8))) short;
using bf16x4 = __attribute__((ext_vector_type(4))) short;
using f32x4  = __attribute__((ext_vector_type(4))) float;
#define DI __device__ __forceinline__
#define MFMA16(a, b, c) __builtin_amdgcn_mfma_f32_16x16x32_bf16((a), (b), (c), 0, 0, 0)

constexpr int MTOK = 17408;
constexpr int MPR  = 16384;
constexpr int DM   = 1024;
constexpr int NP   = 6272;
constexpr int NIN  = 10368;
constexpr int DFF  = 4096;
constexpr int INC  = 10248;
constexpr int C_RQ = 0, C_RK = 512, C_RV = 1024, C_RG = 1536, C_SZ = 2048, C_SXBC = 2560;
constexpr int C_HQ = 3584, C_HF = 4096, C_HI = 4608, C_HG = 5120, C_SU = 5632, C_SDT = 6144;
constexpr float EPS = 1e-6f;
constexpr int HLD = 1088, WLD1 = 1088, ULD = 4160, WLD4 = 4160, OLD = 2112, ZLD = 576, WLD5 = 576;
constexpr int NITEMS = 160 + 128 * 20;
constexpr int NPHASE = 20;

struct Params {
  const float* in[35];
  float* out;
  u16 *wt_in, *wt_ff1, *wt_ff2, *wt_br, *wt_out, *wt_glu;
  u16 *hb, *pbuf, *obuf, *zs5;
  float* tbuf;
  unsigned* counters;
  float* ssq;
  size_t o_ret_p, o_ret_s, o_ssd_p, o_ssd_s, o_conv_p, o_conv_s, o_hg_p, o_hg_s, o_s5r_p, o_s5r_s, o_s5i_p, o_s5i_s;
};

DI int tidq() { int t = threadIdx.x; asm volatile("" : "+v"(t)); return t; }
DI u16 f2bf(float f) { unsigned u = __float_as_uint(f); u += 0x7fffu + ((u >> 16) & 1u); return (u16)(u >> 16); }
DI float bf2f(u16 h) { return __uint_as_float(((unsigned)h) << 16); }
DI unsigned pack2(float a, float b) { return (unsigned)f2bf(a) | ((unsigned)f2bf(b) << 16); }
DI float sigmoidf_(float x) { return 1.f / (1.f + __expf(-x)); }
DI float siluf_(float x) { return x / (1.f + __expf(-x)); }
DI float softplusf_(float x) { return x > 20.f ? x : log1pf(__expf(x)); }
DI float gelu_tanh(float x) {
  float u = 0.7978845608028654f * (x + 0.044715f * x * x * x);
  float e = __expf(2.f * u);
  float th = 1.f - 2.f / (e + 1.f);
  return 0.5f * x * (1.f + th);
}
DI float wave_sum(float v) {
#pragma unroll
  for (int m = 32; m >= 1; m >>= 1) v += __shfl_xor(v, m);
  return v;
}
DI float sum16(float v) {
#pragma unroll
  for (int m = 8; m >= 1; m >>= 1) v += __shfl_xor(v, m);
  return v;
}
DI void sincos_red(float a, float& s, float& c) {
  float n = rintf(a * 0.15915494309189535f);
  float r = fmaf(-n, 6.28125f, a);
  r = fmaf(-n, 1.9353071795864769e-3f, r);
  s = __sinf(r); c = __cosf(r);
}

DI int map_win(int my) {
  if (my < 3584) return my;
  if (my < 6144) return my + 8;
  if (my < 6152) return my - 6144 + 3584;
  if (my < 6272) return -1;
  return my - 120;
}
DI void transpose_tile(const float* __restrict__ src, int src_ld, u16* __restrict__ dst, int dst_ld,
                       int k0, int n0, int mapmode, char* smem) {
  float* tile = (float*)smem;
  const int tid = tidq();
  {
    const int n = tid & 63;
    int sc = n0 + n;
    if (mapmode) sc = map_win(sc);
#pragma unroll
    for (int i = 0; i < 16; ++i) {
      int k = (tid >> 6) + 4 * i;
      float v = (sc >= 0) ? src[(size_t)(k0 + k) * src_ld + sc] : 0.f;
      tile[n * 65 + k] = v;
    }
  }
  __syncthreads();
  {
    const int n = tid >> 2, kc = (tid & 3) * 16;
    unsigned pk[8];
#pragma unroll
    for (int x = 0; x < 8; ++x) pk[x] = pack2(tile[n * 65 + kc + 2 * x], tile[n * 65 + kc + 2 * x + 1]);
    uint4* d = (uint4*)(dst + (size_t)(n0 + n) * dst_ld + k0 + kc);
    d[0] = make_uint4(pk[0], pk[1], pk[2], pk[3]);
    d[1] = make_uint4(pk[4], pk[5], pk[6], pk[7]);
  }
  __syncthreads();
}

__device__ void phase_convert(const Params& p, char* smem) {
  constexpr int PER = 5472;
  for (int t = blockIdx.x; t < 2 * PER; t += gridDim.x) {
    int l = t / PER, r = t % PER;
    if (r < 2592) {
      int nt = r / 16, kt = r % 16;
      transpose_tile(p.in[12] + (size_t)l * DM * INC, INC, p.wt_in + (size_t)l * NIN * WLD1, WLD1, kt * 64, nt * 64, 1, smem);
    } else if (r < 3616) {
      r -= 2592; int nt = r / 16, kt = r % 16;
      transpose_tile(p.in[33] + (size_t)l * DM * DFF, DFF, p.wt_ff1 + (size_t)l * DFF * WLD1, WLD1, kt * 64, nt * 64, 0, smem);
    } else if (r < 4640) {
      r -= 3616; int nt = r / 64, kt = r % 64;
      transpose_tile(p.in[34] + (size_t)l * DFF * DM, DM, p.wt_ff2 + (size_t)l * DM * WLD4, WLD4, kt * 64, nt * 64, 0, smem);
    } else if (r < 4896) {
      r -= 4640; int nt = r / 16, kt = r % 16;
      transpose_tile(p.in[32] + (size_t)l * DM * DM, DM, p.wt_out + (size_t)l * DM * WLD1, WLD1, kt * 64, nt * 64, 0, smem);
    } else if (r < 5408) {
      r -= 4896; int b = r / 128; r %= 128; int nt = r / 8, kt = r % 8;
      transpose_tile(p.in[31] + (size_t)(l * 4 + b) * 512 * DM, DM, p.wt_br + (size_t)(l * 4 + b) * DM * WLD5, WLD5, kt * 64, nt * 64, 0, smem);
    } else {
      r -= 5408; int nt = r / 8, kt = r % 8;
      transpose_tile(p.in[30] + (size_t)l * 512 * 512, 512, p.wt_glu + (size_t)l * 512 * WLD5, WLD5, kt * 64, nt * 64, 0, smem);
    }
  }
}

__device__ void phase_rownorm(const Params& p, bool from_input, const float* __restrict__ t, const float* __restrict__ gpost,
                              const float* __restrict__ gpre, u16* __restrict__ hout) {
  const int lane = tidq() & 63, w = tidq() >> 6;
  float* xbuf = p.out;
  for (int row = blockIdx.x * 4 + w; row < MTOK; row += gridDim.x * 4) {
    const float* xin = from_input ? (row < MPR ? p.in[0] + (size_t)row * DM : p.in[1] + (size_t)(row - MPR) * DM)
                                  : xbuf + (size_t)row * DM;
    float4 x[4];
#pragma unroll
    for (int k = 0; k < 4; ++k) x[k] = *(const float4*)(xin + lane * 4 + 256 * k);
    if (t) {
      float4 tv[4];
      float ss = 0.f;
#pragma unroll
      for (int k = 0; k < 4; ++k) {
        tv[k] = *(const float4*)(t + (size_t)row * DM + lane * 4 + 256 * k);
        ss += tv[k].x * tv[k].x + tv[k].y * tv[k].y + tv[k].z * tv[k].z + tv[k].w * tv[k].w;
      }
      ss = wave_sum(ss);
      float r = rsqrtf(ss * (1.f / DM) + EPS);
#pragma unroll
      for (int k = 0; k < 4; ++k) {
        float4 g = *(const float4*)(gpost + lane * 4 + 256 * k);
        x[k].x += tv[k].x * r * g.x; x[k].y += tv[k].y * r * g.y; x[k].z += tv[k].z * r * g.z; x[k].w += tv[k].w * r * g.w;
      }
    }
#pragma unroll
    for (int k = 0; k < 4; ++k) *(float4*)(xbuf + (size_t)row * DM + lane * 4 + 256 * k) = x[k];
    if (hout) {
      float ss = 0.f;
#pragma unroll
      for (int k = 0; k < 4; ++k) ss += x[k].x * x[k].x + x[k].y * x[k].y + x[k].z * x[k].z + x[k].w * x[k].w;
      ss = wave_sum(ss);
      float r = rsqrtf(ss * (1.f / DM) + EPS);
#pragma unroll
      for (int k = 0; k < 4; ++k) {
        float4 g = *(const float4*)(gpre + lane * 4 + 256 * k);
        uint2 o;
        o.x = pack2(x[k].x * r * g.x, x[k].y * r * g.y);
        o.y = pack2(x[k].z * r * g.z, x[k].w * r * g.w);
        *(uint2*)(hout + (size_t)row * HLD + lane * 4 + 256 * k) = o;
      }
    }
  }
}

DI int swz(int r, int c) { return r * 128 + ((c ^ ((r >> 1) & 7)) << 4); }

#define GEMM_COMPUTE(AS_) do { const char* as_ = (AS_); const char* bs_ = as_ + 16384; \
  _Pragma("unroll") for (int s_ = 0; s_ < 2; ++s_) { \
    bf16x8 af_[4], bfr_[4]; \
    _Pragma("unroll") for (int i_ = 0; i_ < 4; ++i_) af_[i_] = *(const bf16x8*)(as_ + swz(wm * 64 + i_ * 16 + r16, s_ * 4 + quad)); \
    _Pragma("unroll") for (int j_ = 0; j_ < 4; ++j_) bfr_[j_] = *(const bf16x8*)(bs_ + swz(wn * 64 + j_ * 16 + r16, s_ * 4 + quad)); \
    _Pragma("unroll") for (int i_ = 0; i_ < 4; ++i_) \
      _Pragma("unroll") for (int j_ = 0; j_ < 4; ++j_) acc[i_][j_] = MFMA16(bfr_[j_], af_[i_], acc[i_][j_]); \
  } } while (0)

typedef unsigned u32x4 __attribute__((ext_vector_type(4)));
struct Stage { u32x4 a0, a1, a2, a3, b0, b1, b2, b3; };
DI void gload(Stage& s, const u16* ag, const u16* bg, int lda, int ldb, int kt) {
  s.a0 = *(const u32x4*)(ag + (size_t)0 * 32 * lda + kt * 64);
  s.a1 = *(const u32x4*)(ag + (size_t)1 * 32 * lda + kt * 64);
  s.a2 = *(const u32x4*)(ag + (size_t)2 * 32 * lda + kt * 64);
  s.a3 = *(const u32x4*)(ag + (size_t)3 * 32 * lda + kt * 64);
  s.b0 = *(const u32x4*)(bg + (size_t)0 * 32 * ldb + kt * 64);
  s.b1 = *(const u32x4*)(bg + (size_t)1 * 32 * ldb + kt * 64);
  s.b2 = *(const u32x4*)(bg + (size_t)2 * 32 * ldb + kt * 64);
  s.b3 = *(const u32x4*)(bg + (size_t)3 * 32 * ldb + kt * 64);
}
DI void lwrite(const Stage& s, char* d, int lr, int lc) {
  *(u32x4*)(d + swz(lr, lc)) = s.a0;
  *(u32x4*)(d + swz(lr + 32, lc)) = s.a1;
  *(u32x4*)(d + swz(lr + 64, lc)) = s.a2;
  *(u32x4*)(d + swz(lr + 96, lc)) = s.a3;
  *(u32x4*)(d + 16384 + swz(lr, lc)) = s.b0;
  *(u32x4*)(d + 16384 + swz(lr + 32, lc)) = s.b1;
  *(u32x4*)(d + 16384 + swz(lr + 64, lc)) = s.b2;
  *(u32x4*)(d + 16384 + swz(lr + 96, lc)) = s.b3;
}

template <bool DEEP>
DI void gemm_kloop(f32x4 (&acc)[4][4], const u16* __restrict__ A, int lda, const u16* __restrict__ Bt, int ldb,
                   int K, int m0, int n0, char* smem) {
  const int tid = tidq(), lane = tid & 63, w = tid >> 6, wm = w >> 1, wn = w & 1, r16 = lane & 15, quad = lane >> 4;
  const int lr = tid >> 3, lc = tid & 7;
  const u16* ag = A + (size_t)(m0 + lr) * lda + lc * 8;
  const u16* bg = Bt + (size_t)(n0 + lr) * ldb + lc * 8;
  const int nk = K >> 6;
  Stage s0;
  gload(s0, ag, bg, lda, ldb, 0);
  if (DEEP) {
    Stage s1;
    gload(s1, ag, bg, lda, ldb, 1);
    lwrite(s0, smem, lr, lc);
    __syncthreads();
    for (int kt = 0; kt < nk; kt += 2) {
      if (kt + 2 < nk) gload(s0, ag, bg, lda, ldb, kt + 2);
      GEMM_COMPUTE(smem);
      lwrite(s1, smem + 32768, lr, lc);
      __syncthreads();
      if (kt + 3 < nk) gload(s1, ag, bg, lda, ldb, kt + 3);
      GEMM_COMPUTE(smem + 32768);
      if (kt + 2 < nk) lwrite(s0, smem, lr, lc);
      __syncthreads();
    }
  } else {
    lwrite(s0, smem, lr, lc);
    __syncthreads();
    for (int kt = 0; kt < nk; ++kt) {
      const bool more = (kt + 1 < nk);
      if (more) gload(s0, ag, bg, lda, ldb, kt + 1);
      GEMM_COMPUTE(smem + (kt & 1) * 32768);
      if (more) lwrite(s0, smem + ((kt + 1) & 1) * 32768, lr, lc);
      __syncthreads();
    }
  }
}

DI void zero_acc(f32x4 (&acc)[4][4]) {
#pragma unroll
  for (int i = 0; i < 4; ++i)
#pragma unroll
    for (int j = 0; j < 4; ++j) acc[i][j] = f32x4{0.f, 0.f, 0.f, 0.f};
}

enum { EPI_BF16 = 0, EPI_SIG = 1, EPI_RELU2 = 2, EPI_F32 = 3, EPI_GLU = 4 };

template <int EPI>
DI void gemm_tile(const u16* A, int lda, const u16* Bt, int ldb, int K, int m0, int n0,
                  void* outp, int ldc, const u16* aux, int ldaux, char* smem) {
  f32x4 acc[4][4];
  zero_acc(acc);
  gemm_kloop<true>(acc, A, lda, Bt, ldb, K, m0, n0, smem);
#ifdef VAR_NOSTORE
  if (*(volatile int*)(smem + 65536 + 8) == 1 && acc[0][0][0] != 12345.678f) return;
#endif
  const int lane = tidq() & 63, w = tidq() >> 6, wm = w >> 1, wn = w & 1, r16 = lane & 15, quad = lane >> 4;
#pragma unroll
  for (int i = 0; i < 4; ++i) {
    const int m = m0 + wm * 64 + i * 16 + r16;
#pragma unroll
    for (int j = 0; j < 4; ++j) {
      const int n = n0 + wn * 64 + j * 16 + quad * 4;
      f32x4 v = acc[i][j];
      if (EPI == EPI_F32) {
        *(float4*)((float*)outp + (size_t)m * ldc + n) = make_float4(v[0], v[1], v[2], v[3]);
      } else {
        if (EPI == EPI_SIG) {
#pragma unroll
          for (int x = 0; x < 4; ++x) v[x] = sigmoidf_(v[x]);
        } else if (EPI == EPI_RELU2) {
#pragma unroll
          for (int x = 0; x < 4; ++x) { float r = fmaxf(v[x], 0.f); v[x] = r * r; }
        } else if (EPI == EPI_GLU) {
          uint2 zz = *(const uint2*)(aux + (size_t)m * ldaux + n);
          v[0] = bf2f((u16)(zz.x & 0xffff)) * sigmoidf_(v[0]);
          v[1] = bf2f((u16)(zz.x >> 16)) * sigmoidf_(v[1]);
          v[2] = bf2f((u16)(zz.y & 0xffff)) * sigmoidf_(v[2]);
          v[3] = bf2f((u16)(zz.y >> 16)) * sigmoidf_(v[3]);
        }
        uint2 o; o.x = pack2(v[0], v[1]); o.y = pack2(v[2], v[3]);
        *(uint2*)((u16*)outp + (size_t)m * ldc + n) = o;
      }
    }
  }
}

DI void merge_tile(const Params& p, int l, int m0, int n0, char* smem) {
  f32x4 macc[4][4];
  zero_acc(macc);
  const int lane = tidq() & 63, w = tidq() >> 6, wm = w >> 1, wn = w & 1, r16 = lane & 15, quad = lane >> 4;
  const u16* gates = p.pbuf;
  for (int b = 0; b < 4; ++b) {
    f32x4 acc[4][4];
    zero_acc(acc);
    gemm_kloop<false>(acc, p.obuf + b * 512, OLD, p.wt_br + (size_t)(l * 4 + b) * DM * WLD5, WLD5, 512, m0, n0, smem);
#pragma unroll
    for (int i = 0; i < 4; ++i) {
      const int m = m0 + wm * 64 + i * 16 + r16;
#pragma unroll
      for (int j = 0; j < 4; ++j) {
        const int n = n0 + wn * 64 + j * 16 + quad * 4;
        uint2 gg = *(const uint2*)(gates + (size_t)m * 4096 + b * 1024 + n);
        macc[i][j][0] += bf2f((u16)(gg.x & 0xffff)) * acc[i][j][0];
        macc[i][j][1] += bf2f((u16)(gg.x >> 16)) * acc[i][j][1];
        macc[i][j][2] += bf2f((u16)(gg.y & 0xffff)) * acc[i][j][2];
        macc[i][j][3] += bf2f((u16)(gg.y >> 16)) * acc[i][j][3];
      }
    }
  }
#pragma unroll
  for (int i = 0; i < 4; ++i) {
    const int m = m0 + wm * 64 + i * 16 + r16;
#pragma unroll
    for (int j = 0; j < 4; ++j) {
      const int n = n0 + wn * 64 + j * 16 + quad * 4;
      uint2 o; o.x = pack2(macc[i][j][0], macc[i][j][1]); o.y = pack2(macc[i][j][2], macc[i][j][3]);
      *(uint2*)(p.hb + (size_t)m * HLD + n) = o;
    }
  }
}

constexpr int QS = 136;
constexpr int TS = 20;
constexpr int OFS = 260;

template <int MODE>
__device__ void run_chain(const Params& p, int l, int seq, int sub, char* smem) {
  constexpr int NE = 2;
  const int tid = tidq(), lane = tid & 63, w = tid >> 6, r16 = lane & 15, quad = lane >> 4;
  const bool prompt = seq < 8;
  const int bidx = prompt ? seq : seq - 8;
  const int NB = prompt ? 8 : 128;
  const int L = prompt ? 2048 : 8;
  const int row0 = prompt ? seq * 2048 : MPR + (seq - 8) * 8;
  const int pos0 = prompt ? 0 : 16384;
  const int nch = prompt ? 128 : 1;

  u16* Qa = (u16*)smem;
  u16* Ka = (u16*)(smem + 4352);
  u16* KuT = (u16*)(smem + 8704);
  u16* VaT = (u16*)(smem + 13824);
  u16* VuT = (MODE == 1) ? (u16*)(smem + 24064) : VaT;
  float* tmpK = (float*)(smem + 24064);
  float* Of = (float*)(smem + 34304);
  u16* Raw = (u16*)(smem + 34304);
  u16* Xc = (u16*)(smem + 50944);
  float* tmpC = (float*)(smem + 50944);
  float* cdec = (float*)(smem + 59136);
  float* dtl = (float*)(smem + 59392);
  float* rsc = (float*)(smem + 59648);
  float* clast = (float*)(smem + 60160);

  const float* sin_ = nullptr;
  float* sout = nullptr;
  if (MODE == 0) {
    if (!prompt) sin_ = p.in[2] + (((size_t)l * 128 + bidx) * 4 + sub) * 16384;
    sout = p.out + (prompt ? p.o_ret_p : p.o_ret_s) + (((size_t)l * NB + bidx) * 4 + sub) * 16384;
  } else if (MODE == 2) {
    if (!prompt) sin_ = p.in[5] + (((size_t)l * 128 + bidx) * 4 + sub) * 16384;
    sout = p.out + (prompt ? p.o_hg_p : p.o_hg_s) + (((size_t)l * NB + bidx) * 4 + sub) * 16384;
  } else {
    if (!prompt) sin_ = p.in[3] + (((size_t)l * 128 + bidx) * 8 + sub * 2 + (w >> 1)) * 8192;
    sout = p.out + (prompt ? p.o_ssd_p : p.o_ssd_s) + (((size_t)l * NB + bidx) * 8 + sub * 2 + (w >> 1)) * 8192;
  }

  int sbase = (MODE == 1) ? (((w & 1) * 32 + r16) * 128 + quad * 4) : (quad * 512 + w * 32 + r16);
  asm volatile("" : "+v"(sbase));
  f32x4 S[8][NE];
#pragma unroll
  for (int t = 0; t < 8; ++t)
#pragma unroll
    for (int u = 0; u < NE; ++u) {
      if (sin_) {
        if (MODE == 1) {
          S[t][u] = *(const f32x4*)(sin_ + sbase + u * 2048 + t * 16);
        } else {
#pragma unroll
          for (int jj = 0; jj < 4; ++jj) S[t][u][jj] = sin_[sbase + t * 2048 + jj * 128 + u * 16];
        }
      } else {
        S[t][u] = f32x4{0.f, 0.f, 0.f, 0.f};
      }
    }

  float lg = 0.f;
  float lbv = 0.f;
  float cprev[2][3];
  float cw[2][4], cb[2];
  int ccidx[2];
  const int gg = sub >> 1, pair = sub & 1;
  if (MODE == 0) lg = log1pf(-exp2f(-5.f - (float)sub));
  if (MODE == 2) {
    if (l == 1 && tid < 128) {
      float a0 = p.in[20][sub * 128 + tid], a1 = p.in[20][512 + sub * 128 + tid];
      float mx = fmaxf(a0, a1);
      float e0 = __expf(a0 - mx), e1 = __expf(a1 - mx);
      lbv = e1 / (e0 + e1);
    }
  }
  if (MODE == 1) {
#pragma unroll
    for (int k = 0; k < 2; ++k) {
      int ci = tid + 256 * k;
      int cc = 0;
      if (ci < 128) cc = gg * 256 + pair * 128 + ci;
      else if (ci < 256) cc = 512 + gg * 128 + (ci - 128);
      else cc = 768 + gg * 128 + (ci - 256);
      if (ci >= 384) cc = 0;
      ccidx[k] = cc;
#pragma unroll
      for (int j = 0; j < 4; ++j) cw[k][j] = p.in[14][((size_t)l * 4 + j) * 1024 + cc];
      cb[k] = p.in[15][l * 1024 + cc];
#pragma unroll
      for (int j = 0; j < 3; ++j)
        cprev[k][j] = prompt ? 0.f : p.in[4][(((size_t)l * 128 + bidx) * 3 + j) * 1024 + cc];
    }
  }

  const int lt = tid >> 4, lc = tid & 15;
  uint4 r0, r1, r2, g0;
  unsigned rdt = 0;
  const uint4 z4 = make_uint4(0, 0, 0, 0);
  r0 = r1 = r2 = g0 = z4;
  auto load_raw = [&](int ch) {
    const int t0 = ch * 16;
    const int nv = (L - t0 < 16) ? (L - t0) : 16;
    const u16* Pr = p.pbuf + (size_t)(row0 + t0 + lt) * NP;
    r0 = r1 = r2 = g0 = z4;
    rdt = 0;
    if (lt < nv) {
      if (MODE == 0) {
        r0 = *(const uint4*)(Pr + C_RQ + sub * 128 + lc * 8);
        r1 = *(const uint4*)(Pr + C_RK + sub * 128 + lc * 8);
        r2 = *(const uint4*)(Pr + C_RV + sub * 128 + lc * 8);
        g0 = *(const uint4*)(Pr + C_RG + sub * 128 + lc * 8);
      } else if (MODE == 2) {
        r0 = *(const uint4*)(Pr + C_HQ + sub * 128 + lc * 8);
        r1 = *(const uint4*)(Pr + C_HF + sub * 128 + lc * 8);
        r2 = *(const uint4*)(Pr + C_HI + sub * 128 + lc * 8);
        g0 = *(const uint4*)(Pr + C_HG + sub * 128 + lc * 8);
      } else {
        r0 = *(const uint4*)(Pr + C_SXBC + gg * 256 + pair * 128 + lc * 8);
        r1 = *(const uint4*)(Pr + C_SXBC + 512 + gg * 128 + lc * 8);
        r2 = *(const uint4*)(Pr + C_SXBC + 768 + gg * 128 + lc * 8);
        g0 = *(const uint4*)(Pr + C_SZ + gg * 256 + pair * 128 + lc * 8);
        if (lc < 2) rdt = Pr[C_SDT + sub * 2 + lc];
      }
    }
  };
  load_raw(0);

  for (int ch = 0; ch < nch; ++ch) {
    const int t0 = ch * 16;
    const int nvalid = (L - t0 < 16) ? (L - t0) : 16;
    float sscale = 1.f;
    int tidv = tidq();
    asm volatile("" : "+v"(tidv));
    const int tid = tidv, lane = tid & 63, w = tid >> 6, r16 = lane & 15, quad = lane >> 4, lt = tid >> 4, lc = tid & 15;

    *(uint4*)(Raw + lt * 128 + lc * 8) = r0;
    *(uint4*)(Raw + 2048 + lt * 128 + lc * 8) = r1;
    *(uint4*)(Raw + 4096 + lt * 128 + lc * 8) = r2;
    if (MODE == 1) { if (lc < 2) Raw[6144 + lt * 2 + lc] = (u16)rdt; }
    const uint4 gc0 = g0;
    __syncthreads();
    if (ch + 1 < nch) load_raw(ch + 1);

    if (MODE == 0) {
      if (tid < 128) {
        const int isK = tid >> 6, pr = tid & 63;
        const u16* R = Raw + (isK ? 2048 : 0);
        const float inv = exp2f(-(float)pr * (13.287712379549449f / 64.f));
#pragma unroll 4
        for (int t = 0; t < 16; ++t) {
          float x1 = bf2f(R[t * 128 + pr]);
          float x2 = bf2f(R[t * 128 + pr + 64]);
          float ang = (float)(pos0 + t0 + t) * inv;
          float sn, cs; sincos_red(ang, sn, cs);
          float y1 = x1 * cs - x2 * sn, y2 = x1 * sn + x2 * cs;
          if (isK) {
            y1 *= 0.08838834764831845f; y2 *= 0.08838834764831845f;
            Ka[t * QS + pr] = f2bf(y1); Ka[t * QS + pr + 64] = f2bf(y2);
            float kd = (t < nvalid) ? __expf(lg * (float)(nvalid - 1 - t)) : 0.f;
            KuT[pr * TS + t] = f2bf(y1 * kd);
            KuT[(pr + 64) * TS + t] = f2bf(y2 * kd);
          } else {
            Qa[t * QS + pr] = f2bf(y1); Qa[t * QS + pr + 64] = f2bf(y2);
          }
        }
      } else {
        const int e = tid - 128;
#pragma unroll 4
        for (int t = 0; t < 16; ++t) VaT[e * TS + t] = Raw[4096 + t * 128 + e];
      }
      if (tid < 16) cdec[tid] = lg * (float)(tid + 1);
      sscale = __expf(lg * (float)nvalid);
    } else if (MODE == 2) {
      if (tid < 128) {
        const int d = tid;
        float c = 0.f;
#pragma unroll 4
        for (int t = 0; t < 16; ++t) {
          float qv = 0.f, kk = 0.f;
          if (t < nvalid) {
            float hq = bf2f(Raw[t * 128 + d]);
            float z = bf2f(Raw[2048 + t * 128 + d]);
            float sg = sigmoidf_(z);
            float f = lbv + (1.f - lbv) * sg;
            c += __logf(f);
            kk = (1.f - lbv) * (1.f - sg);
            qv = siluf_(hq);
          }
          tmpC[t * 128 + d] = c; tmpK[t * 128 + d] = kk;
          Qa[t * QS + d] = f2bf(qv * __expf(c));
          Ka[t * QS + d] = f2bf(kk * __expf(-c));
        }
#pragma unroll 4
        for (int t = 0; t < 16; ++t)
          KuT[d * TS + t] = f2bf(tmpK[t * 128 + d] * __expf(c - tmpC[t * 128 + d]));
        rsc[d] = __expf(c);
      } else {
        const int e = tid - 128;
#pragma unroll 4
        for (int t = 0; t < 16; ++t) VaT[e * TS + t] = Raw[4096 + t * 128 + e];
      }
    } else {
      if (tid < 2) {
        const int hh = sub * 2 + tid;
        const float Ah = -__expf(p.in[16][l * 8 + hh]);
        const float bias = p.in[17][l * 8 + hh];
        float c = 0.f;
#pragma unroll 4
        for (int t = 0; t < 16; ++t) {
          float dtv = 0.f;
          if (t < nvalid) {
            dtv = softplusf_(bf2f(Raw[6144 + t * 2 + tid]) + bias);
            c += dtv * Ah;
          }
          cdec[tid * 16 + t] = c;
          dtl[tid * 16 + t] = dtv;
        }
        clast[tid] = c;
      }
      __syncthreads();
#pragma unroll
      for (int k = 0; k < 2; ++k) {
        const int ci = tid + 256 * k;
        if (ci < 384) {
          const int hl = (ci < 128) ? (ci >> 6) : 0;
          const float cl = clast[hl];
          const u16* R = Raw + ((ci < 128) ? ci : ((ci < 256) ? (2048 + (ci - 128)) : (4096 + (ci - 256))));
          const int rs = 128;
#pragma unroll 4
          for (int t = 0; t < 16; ++t) {
            float v = 0.f;
            if (t < nvalid) {
              float raw = bf2f(R[t * rs]);
              float o = cb[k] + cprev[k][0] * cw[k][0] + cprev[k][1] * cw[k][1] + cprev[k][2] * cw[k][2] + raw * cw[k][3];
              cprev[k][0] = cprev[k][1]; cprev[k][1] = cprev[k][2]; cprev[k][2] = raw;
              v = siluf_(o);
            }
            if (ci < 128) {
              Xc[t * 128 + ci] = f2bf(v);
              float dtv = dtl[hl * 16 + t];
              VaT[ci * TS + t] = f2bf(v * dtv);
              VuT[ci * TS + t] = f2bf(v * dtv * __expf(cl - cdec[hl * 16 + t]));
            } else if (ci < 256) {
              u16 a = f2bf(v);
              Ka[t * QS + (ci - 128)] = a;
              KuT[(ci - 128) * TS + t] = a;
            } else {
              Qa[t * QS + (ci - 256)] = f2bf(v);
            }
          }
        }
      }
    }
    __syncthreads();

    {
      const float* cd = cdec + ((MODE == 1) ? (w >> 1) * 16 : 0);
      f32x4 at = f32x4{0.f, 0.f, 0.f, 0.f};
#pragma unroll
      for (int s = 0; s < 4; ++s) {
        bf16x8 a = *(const bf16x8*)(Ka + r16 * QS + s * 32 + quad * 8);
        bf16x8 b = *(const bf16x8*)(Qa + r16 * QS + s * 32 + quad * 8);
        at = MFMA16(a, b, at);
      }
      bf16x8 attA;
      {
        float ci_ = (MODE != 2) ? cd[r16] : 0.f;
        float vv[4];
#pragma unroll
        for (int jj = 0; jj < 4; ++jj) {
          int j = quad * 4 + jj;
          float v = at[jj];
          if (MODE != 2) v *= __expf(fminf(ci_ - cd[j], 0.f));
          vv[jj] = (j <= r16) ? v : 0.f;
        }
        attA[0] = (short)f2bf(vv[0]); attA[1] = (short)f2bf(vv[1]); attA[2] = (short)f2bf(vv[2]); attA[3] = (short)f2bf(vv[3]);
        attA[4] = 0; attA[5] = 0; attA[6] = 0; attA[7] = 0;
      }
      float rr[4];
#pragma unroll
      for (int jj = 0; jj < 4; ++jj) rr[jj] = (MODE != 2) ? __expf(cd[quad * 4 + jj]) : 1.f;

      bf16x8 qf[4];
#pragma unroll
      for (int s = 0; s < 4; ++s) {
        bf16x4 lo = *(const bf16x4*)(Qa + r16 * QS + s * 32 + quad * 4);
        bf16x4 hi = *(const bf16x4*)(Qa + r16 * QS + s * 32 + 16 + quad * 4);
        qf[s] = bf16x8{lo[0], lo[1], lo[2], lo[3], hi[0], hi[1], hi[2], hi[3]};
      }
      __syncthreads();
#pragma unroll
      for (int u = 0; u < NE; ++u) {
        const int e0 = (w * NE + u) * 16;
        bf16x4 v4 = *(const bf16x4*)(VaT + (e0 + r16) * TS + quad * 4);
        bf16x8 vb = bf16x8{v4[0], v4[1], v4[2], v4[3], 0, 0, 0, 0};
        f32x4 o1 = MFMA16(attA, vb, (f32x4{0.f, 0.f, 0.f, 0.f}));
        f32x4 o2 = f32x4{0.f, 0.f, 0.f, 0.f};
#pragma unroll
        for (int s = 0; s < 4; ++s) {
          bf16x8 sb;
          sb[0] = (short)f2bf(S[2 * s][u][0]); sb[1] = (short)f2bf(S[2 * s][u][1]);
          sb[2] = (short)f2bf(S[2 * s][u][2]); sb[3] = (short)f2bf(S[2 * s][u][3]);
          sb[4] = (short)f2bf(S[2 * s + 1][u][0]); sb[5] = (short)f2bf(S[2 * s + 1][u][1]);
          sb[6] = (short)f2bf(S[2 * s + 1][u][2]); sb[7] = (short)f2bf(S[2 * s + 1][u][3]);
          o2 = MFMA16(qf[s], sb, o2);
        }
#pragma unroll
        for (int jj = 0; jj < 4; ++jj) Of[(quad * 4 + jj) * OFS + e0 + r16] = o1[jj] + rr[jj] * o2[jj];
      }
      float hs = 1.f;
      if (MODE == 0) hs = sscale;
      if (MODE == 1) hs = __expf(clast[w >> 1]);
#pragma unroll
      for (int u = 0; u < NE; ++u) {
        const int e0 = (w * NE + u) * 16;
        bf16x4 v4 = *(const bf16x4*)(VuT + (e0 + r16) * TS + quad * 4);
        bf16x8 vb = bf16x8{v4[0], v4[1], v4[2], v4[3], 0, 0, 0, 0};
#pragma unroll
        for (int t = 0; t < 8; ++t) {
          bf16x4 k4 = *(const bf16x4*)(KuT + (t * 16 + r16) * TS + quad * 4);
          bf16x8 ka = bf16x8{k4[0], k4[1], k4[2], k4[3], 0, 0, 0, 0};
          f32x4 sv = S[t][u];
          if (MODE == 2) {
            f32x4 r4 = *(const f32x4*)(rsc + t * 16 + quad * 4);
            sv[0] *= r4[0]; sv[1] *= r4[1]; sv[2] *= r4[2]; sv[3] *= r4[3];
          } else {
            sv[0] *= hs; sv[1] *= hs; sv[2] *= hs; sv[3] *= hs;
          }
          S[t][u] = MFMA16(ka, vb, sv);
        }
      }
    }
    __syncthreads();

    {
      const int i = tid >> 4, eg = tid & 15;
      const int grow = row0 + t0 + i;
      if (MODE == 0 || MODE == 2) {
        float o[8];
#pragma unroll
        for (int x = 0; x < 8; ++x) o[x] = Of[i * OFS + eg * 8 + x];
        float s1 = 0.f;
        float mu = 0.f;
        if (MODE == 0) {
#pragma unroll
          for (int x = 0; x < 8; ++x) s1 += o[x];
          mu = sum16(s1) * (1.f / 128.f);
        }
        float s2 = 0.f;
#pragma unroll
        for (int x = 0; x < 8; ++x) { o[x] -= mu; s2 += o[x] * o[x]; }
        float r = rsqrtf(sum16(s2) * (1.f / 128.f) + EPS);
        if (i < nvalid) {
          unsigned gw[4] = {gc0.x, gc0.y, gc0.z, gc0.w};
          const float* gain = (MODE == 0) ? (p.in[13] + (l * 4 + sub) * 128 + eg * 8) : (p.in[21] + l * 128 + eg * 8);
          float res[8];
#pragma unroll
          for (int x = 0; x < 8; ++x) {
            float g = bf2f((u16)((x & 1) ? (gw[x >> 1] >> 16) : (gw[x >> 1] & 0xffff)));
            float gate = (MODE == 0) ? siluf_(g) : sigmoidf_(g);
            res[x] = o[x] * r * gain[x] * gate;
          }
          uint4 ov = make_uint4(pack2(res[0], res[1]), pack2(res[2], res[3]), pack2(res[4], res[5]), pack2(res[6], res[7]));
          const int ocol = ((MODE == 0) ? 0 : 1024) + sub * 128 + eg * 8;
          *(uint4*)(p.obuf + (size_t)grow * OLD + ocol) = ov;
        }
      } else {
        float y[8];
        const int chb = eg * 8;
        const float Dh = p.in[18][l * 8 + sub * 2 + (chb >> 6)];
        float s2 = 0.f;
        unsigned gw[4] = {gc0.x, gc0.y, gc0.z, gc0.w};
#pragma unroll
        for (int x = 0; x < 8; ++x) {
          float g = bf2f((u16)((x & 1) ? (gw[x >> 1] >> 16) : (gw[x >> 1] & 0xffff)));
          float v = Of[i * OFS + chb + x] + bf2f(Xc[i * 128 + chb + x]) * Dh;
          v *= siluf_(g);
          y[x] = v; s2 += v * v;
        }
        s2 = sum16(s2);
        if (i < nvalid) {
          if (eg == 0) p.ssq[(size_t)grow * 4 + sub] = s2;
          uint4 ov = make_uint4(pack2(y[0], y[1]), pack2(y[2], y[3]), pack2(y[4], y[5]), pack2(y[6], y[7]));
          *(uint4*)(p.obuf + (size_t)grow * OLD + 512 + sub * 128 + chb) = ov;
        }
      }
    }
    __syncthreads();
  }

  asm volatile("" : "+v"(sbase));
#pragma unroll
  for (int t = 0; t < 8; ++t)
#pragma unroll
    for (int u = 0; u < NE; ++u) {
      if (MODE == 1) {
        *(f32x4*)(sout + sbase + u * 2048 + t * 16) = S[t][u];
      } else {
#pragma unroll
        for (int jj = 0; jj < 4; ++jj) sout[sbase + t * 2048 + jj * 128 + u * 16] = S[t][u][jj];
      }
    }
  if (MODE == 1) {
    float* co = p.out + (prompt ? p.o_conv_p : p.o_conv_s) + ((size_t)l * NB + bidx) * 3 * 1024;
#pragma unroll
    for (int k = 0; k < 2; ++k) {
      const int ci = tid + 256 * k;
      if (ci < 128 || (ci < 384 && pair == 0)) {
#pragma unroll
        for (int j = 0; j < 3; ++j) co[j * 1024 + ccidx[k]] = cprev[k][j];
      }
    }
  }
}

__device__ void run_s5(const Params& p, int l, int seq, int gq, char* smem) {
  const int tid = tidq(), lane = tid & 63, w = tid >> 6;
  const int g = gq * 4 + w;
  const bool prompt = seq < 8;
  const int bidx = prompt ? seq : seq - 8;
  const int NB = prompt ? 8 : 128;
  const int L = prompt ? 2048 : 8;
  const int row0 = prompt ? seq * 2048 : MPR + (seq - 8) * 8;
  const int nsub = L / 8;
  float* base = (float*)(smem + w * 13568);
  float* hre = base;
  float* him = base + 544;
  float* cre = base + 1088;
  float* cim = base + 2176;
  float* ub = base + 3264;
  const int lg_ = l * 32 + g;
#pragma unroll
  for (int m = 0; m < 16; ++m) {
    cre[m * 68 + lane] = p.in[26][((size_t)lg_ * 16 + m) * 64 + lane];
    cim[m * 68 + lane] = p.in[27][((size_t)lg_ * 16 + m) * 64 + lane];
  }
  const float dt = __expf(p.in[29][lg_]);
  const float are = p.in[22][lg_ * 64 + lane], aim = p.in[23][lg_ * 64 + lane];
  const float th = dt * aim;
  float sn, cs; sincos_red(th, sn, cs);
  float shalf, chalf; sincos_red(0.5f * th, shalf, chalf);
  const float em1 = expm1f(dt * are);
  const float mag = em1 + 1.f;
  const float abr = mag * cs, abi = mag * sn;
  const float nre = em1 * cs - 2.f * shalf * shalf, nim = abi;
  const float den = are * are + aim * aim;
  const float fre = (nre * are + nim * aim) / den, fim = (nim * are - nre * aim) / den;
  float bbr[16], bbi[16];
#pragma unroll
  for (int m = 0; m < 16; ++m) {
    float br = p.in[24][((size_t)lg_ * 64 + lane) * 16 + m], bi = p.in[25][((size_t)lg_ * 64 + lane) * 16 + m];
    bbr[m] = fre * br - fim * bi;
    bbi[m] = fre * bi + fim * br;
  }
  float hr = 0.f, hi = 0.f;
  if (!prompt) {
    hr = p.in[6][((size_t)(l * 128 + bidx) * 32 + g) * 64 + lane];
    hi = p.in[7][((size_t)(l * 128 + bidx) * 32 + g) * 64 + lane];
  }
  const int oi = lane & 7, mg = lane >> 3, m0 = mg * 2;
  const float dm0 = p.in[28][lg_ * 16 + m0], dm1 = p.in[28][lg_ * 16 + m0 + 1];
  const int ti = lane >> 3, cp = lane & 7;
  const u16* ubase = p.pbuf + (size_t)(row0 + ti) * NP + C_SU + g * 16 + cp * 2;
  unsigned nxt = *(const unsigned*)ubase;
  for (int sc = 0; sc < nsub; ++sc) {
    unsigned cur = nxt;
    if (sc + 1 < nsub) nxt = *(const unsigned*)(ubase + (size_t)(sc + 1) * 8 * NP);
    ub[ti * 16 + cp * 2] = bf2f((u16)(cur & 0xffff));
    ub[ti * 16 + cp * 2 + 1] = bf2f((u16)(cur >> 16));
    __syncthreads();
#pragma unroll
    for (int i = 0; i < 8; ++i) {
      float bur = 0.f, bui = 0.f;
#pragma unroll
      for (int m4 = 0; m4 < 4; ++m4) {
        f32x4 u4 = *(const f32x4*)(ub + i * 16 + m4 * 4);
#pragma unroll
        for (int x = 0; x < 4; ++x) { bur += bbr[m4 * 4 + x] * u4[x]; bui += bbi[m4 * 4 + x] * u4[x]; }
      }
      float nr = abr * hr - abi * hi + bur;
      float ni = abr * hi + abi * hr + bui;
      hr = nr; hi = ni;
      hre[i * 68 + lane] = hr; him[i * 68 + lane] = hi;
    }
    __syncthreads();
    float y0 = 0.f, y1 = 0.f;
#pragma unroll
    for (int p4 = 0; p4 < 16; ++p4) {
      f32x4 h4r = *(const f32x4*)(hre + oi * 68 + p4 * 4);
      f32x4 h4i = *(const f32x4*)(him + oi * 68 + p4 * 4);
      f32x4 c0r = *(const f32x4*)(cre + m0 * 68 + p4 * 4);
      f32x4 c0i = *(const f32x4*)(cim + m0 * 68 + p4 * 4);
      f32x4 c1r = *(const f32x4*)(cre + (m0 + 1) * 68 + p4 * 4);
      f32x4 c1i = *(const f32x4*)(cim + (m0 + 1) * 68 + p4 * 4);
#pragma unroll
      for (int x = 0; x < 4; ++x) {
        y0 += c0r[x] * h4r[x] - c0i[x] * h4i[x];
        y1 += c1r[x] * h4r[x] - c1i[x] * h4i[x];
      }
    }
    y0 += dm0 * ub[oi * 16 + m0];
    y1 += dm1 * ub[oi * 16 + m0 + 1];
    *(unsigned*)(p.zs5 + (size_t)(row0 + sc * 8 + oi) * ZLD + g * 16 + m0) = pack2(gelu_tanh(y0), gelu_tanh(y1));
    __syncthreads();
  }
  p.out[(prompt ? p.o_s5r_p : p.o_s5r_s) + ((size_t)(l * NB + bidx) * 32 + g) * 64 + lane] = hr;
  p.out[(prompt ? p.o_s5i_p : p.o_s5i_s) + ((size_t)(l * NB + bidx) * 32 + g) * 64 + lane] = hi;
}

__device__ void phase_mixers(const Params& p, int l, char* smem, int visit) {
  int* s_item = (int*)(smem + 65536);
  unsigned* cnt = p.counters + l * 64 + visit * 16;
  for (;;) {
    if (tidq() == 0) *s_item = (int)atomicAdd(cnt, 1u);
    __syncthreads();
    const int item = *s_item;
    __syncthreads();
    if (item >= NITEMS) break;
    int mode, seq, sub;
    if (item < 32) { mode = 1; seq = item >> 2; sub = item & 3; }
    else if (item < 96) { int k = item - 32; seq = k >> 3; sub = k & 7; mode = (sub < 4) ? 0 : 2; sub &= 3; }
    else if (item < 160) { int k = item - 96; mode = 3; seq = k >> 3; sub = k & 7; }
    else {
      int k = item - 160; int b = k / 20; sub = k % 20; seq = 8 + b;
      if (sub < 4) mode = 1;
      else if (sub < 8) { mode = 0; sub -= 4; }
      else if (sub < 12) { mode = 2; sub -= 8; }
      else { mode = 3; sub -= 12; }
    }
    if (mode == 0) { if (EN(2) || ONLY == 20) run_chain<0>(p, l, seq, sub, smem); }
    else if (mode == 1) { if (EN(2) || ONLY == 21) run_chain<1>(p, l, seq, sub, smem); }
    else if (mode == 2) { if (EN(2) || ONLY == 22) run_chain<2>(p, l, seq, sub, smem); }
    else { if (EN(2) || ONLY == 23) run_s5(p, l, seq, sub, smem); }
    __syncthreads();
  }
}

DI bool tile_at(int i, int T, int& t) {
  const int bpx = gridDim.x >> 3;
  t = ((blockIdx.x & 7) + 8 * i) * bpx + (blockIdx.x >> 3);
  return t < T;
}
DI void tile_mn(int t, int nN, int& m0, int& n0) {
  const int per = 8 * nN;
  const int grp = t / per, r = t - grp * per;
  m0 = (grp * 8 + (r & 7)) * 128;
  n0 = (r >> 3) * 128;
}

__device__ void run_phase(const Params& p, int ph, char* smem, int visit) {
  constexpr int NMT = MTOK / 128;
  if (ph == 0) { if (EN(9)) phase_convert(p, smem); return; }
  if (ph == NPHASE - 1) {
    if (EN(10)) phase_rownorm(p, false, p.tbuf, p.in[11] + 1 * DM, nullptr, nullptr);
    return;
  }
  const int l = (ph - 1) / 9, s = (ph - 1) % 9;
  switch (s) {
    case 0:
      if (!EN(0)) break;
      if (l == 0) phase_rownorm(p, true, nullptr, nullptr, p.in[8], p.hb);
      else phase_rownorm(p, false, p.tbuf, p.in[11] + (l - 1) * DM, p.in[8] + l * DM, p.hb);
      break;
    case 1: if (EN(1)) {
      constexpr int NN = NP / 128;
      int t, m0, n0;
      for (int i = 0; tile_at(i, NMT * NN, t); ++i) {
        tile_mn(t, NN, m0, n0);
        gemm_tile<EPI_BF16>(p.hb, HLD, p.wt_in + (size_t)l * NIN * WLD1, WLD1, DM, m0, n0, p.pbuf, NP, nullptr, 0, smem);
      }
    } break;
    case 2: if (EN(2) || (ONLY >= 20 && ONLY <= 23)) phase_mixers(p, l, smem, visit); break;
    case 3: if (EN(3)) {
      constexpr int NG = 32, NGLU = 4;
      {
        const int lane = tidq() & 63, w = tidq() >> 6;
        for (int row = blockIdx.x * 4 + w; row < MTOK; row += gridDim.x * 4) {
          const float4 sq = *(const float4*)(p.ssq + (size_t)row * 4);
          const float ms = (lane < 32) ? (sq.x + sq.y) : (sq.z + sq.w);
          const float r = rsqrtf(ms * (1.f / 256.f) + EPS);
          u16* ptr = p.obuf + (size_t)row * OLD + 512 + lane * 8;
          uint4 v = *(const uint4*)ptr;
          const float* gn = p.in[19] + l * 512 + lane * 8;
          unsigned vw[4] = {v.x, v.y, v.z, v.w};
          unsigned ow[4];
#pragma unroll
          for (int x = 0; x < 4; ++x)
            ow[x] = pack2(bf2f((u16)(vw[x] & 0xffff)) * r * gn[2 * x], bf2f((u16)(vw[x] >> 16)) * r * gn[2 * x + 1]);
          *(uint4*)ptr = make_uint4(ow[0], ow[1], ow[2], ow[3]);
        }
      }
      int t, m0, n0;
      for (int i = 0; tile_at(i, NMT * (NG + NGLU), t); ++i) {
        if (t < NMT * NG) {
          tile_mn(t, NG, m0, n0);
          gemm_tile<EPI_SIG>(p.hb, HLD, p.wt_in + ((size_t)l * NIN + NP) * WLD1, WLD1, DM, m0, n0, p.pbuf, 4096, nullptr, 0, smem);
        } else {
          tile_mn(t - NMT * NG, NGLU, m0, n0);
          gemm_tile<EPI_GLU>(p.zs5, ZLD, p.wt_glu + (size_t)l * 512 * WLD5, WLD5, 512, m0, n0,
                             p.obuf + 1536, OLD, p.zs5, ZLD, smem);
        }
      }
    } break;
    case 4:
      if (EN(4)) {
        int t, m0, n0;
        for (int i = 0; tile_at(i, NMT * 8, t); ++i) { tile_mn(t, 8, m0, n0); merge_tile(p, l, m0, n0, smem); }
      }
      break;
    case 5:
      if (EN(5)) {
        int t, m0, n0;
        for (int i = 0; tile_at(i, NMT * 8, t); ++i) {
          tile_mn(t, 8, m0, n0);
          gemm_tile<EPI_F32>(p.hb, HLD, p.wt_out + (size_t)l * DM * WLD1, WLD1, DM, m0, n0, p.tbuf, DM, nullptr, 0, smem);
        }
      }
      break;
    case 6:
      if (EN(6)) phase_rownorm(p, false, p.tbuf, p.in[9] + l * DM, p.in[10] + l * DM, p.hb);
      break;
    case 7:
      if (EN(7)) {
        int t, m0, n0;
        for (int i = 0; tile_at(i, NMT * 32, t); ++i) {
          tile_mn(t, 32, m0, n0);
          gemm_tile<EPI_RELU2>(p.hb, HLD, p.wt_ff1 + (size_t)l * DFF * WLD1, WLD1, DM, m0, n0, p.pbuf, ULD, nullptr, 0, smem);
        }
      }
      break;
    case 8:
      if (EN(8)) {
        int t, m0, n0;
        for (int i = 0; tile_at(i, NMT * 8, t); ++i) {
          tile_mn(t, 8, m0, n0);
          gemm_tile<EPI_F32>(p.pbuf, ULD, p.wt_ff2 + (size_t)l * DM * WLD4, WLD4, DFF, m0, n0, p.tbuf, DM, nullptr, 0, smem);
        }
      }
      break;
  }
}

#ifndef DUP_S
#define DUP_S -1
#endif
DI void grid_barrier(unsigned* bar, unsigned& gen) {
  asm volatile("s_waitcnt vmcnt(0)" ::: "memory");
  __syncthreads();
  gen += 1;
  if (threadIdx.x == 0) {
    __builtin_amdgcn_fence(__ATOMIC_RELEASE, "agent");
    asm volatile("s_waitcnt vmcnt(0)" ::: "memory");
    __hip_atomic_fetch_add(bar, 1u, __ATOMIC_RELAXED, __HIP_MEMORY_SCOPE_AGENT);
    const unsigned target = gen * gridDim.x;
    while (__hip_atomic_load(bar, __ATOMIC_RELAXED, __HIP_MEMORY_SCOPE_AGENT) < target) __builtin_amdgcn_s_sleep(1);
    __builtin_amdgcn_fence(__ATOMIC_ACQUIRE, "agent");
    asm volatile("s_waitcnt vmcnt(0)" ::: "memory");
  }
  __syncthreads();
}

__global__ void __launch_bounds__(256, 2) mega_kernel(Params p, int ph_lo, int ph_hi) {
  __shared__ __attribute__((aligned(16))) char smem[65536 + 16];
  unsigned gen = 0;
  unsigned* bar = p.counters + 512;
  for (int ph = ph_lo; ph < ph_hi; ++ph) {
    if (ph > ph_lo) {
      if (ph == ph_lo + 1) cg::this_grid().sync();
      else grid_barrier(bar, gen);
    }
    const int reps = (DUP_S >= 0 && ph == 1 + DUP_S) ? 2 : 1;
    for (int r = 0; r < reps; ++r) {
      if (r) grid_barrier(bar, gen);
#ifdef VAR_NOSTORE
      if (tidq() == 0) *(volatile int*)(smem + 65536 + 8) = r;
      __syncthreads();
#endif
      run_phase(p, ph, smem, r);
    }
  }
}

extern "C" void kernel_launch(void* const* d_in, const int* in_sizes, int n_in, void* d_out, int out_size,
                              void* d_ws, size_t ws_size, hipStream_t stream) {
  Params p{};
  for (int i = 0; i < 35; ++i) p.in[i] = (const float*)d_in[i];
  p.out = (float*)d_out;
  char* ws = (char*)d_ws;
  size_t off = 0;
  auto take = [&](size_t bytes) { char* r = ws + off; off += (bytes + 255) & ~(size_t)255; return r; };
  p.wt_in  = (u16*)take((size_t)2 * NIN * WLD1 * 2);
  p.wt_ff1 = (u16*)take((size_t)2 * DFF * WLD1 * 2);
  p.wt_ff2 = (u16*)take((size_t)2 * DM * WLD4 * 2);
  p.wt_br  = (u16*)take((size_t)2 * 4 * DM * WLD5 * 2);
  p.wt_out = (u16*)take((size_t)2 * DM * WLD1 * 2);
  p.wt_glu = (u16*)take((size_t)2 * 512 * WLD5 * 2);
  p.hb     = (u16*)take((size_t)MTOK * HLD * 2);
  p.pbuf   = (u16*)take((size_t)MTOK * NP * 2);
  p.obuf   = (u16*)take((size_t)MTOK * OLD * 2);
  p.zs5    = (u16*)take((size_t)MTOK * ZLD * 2);
  p.counters = (unsigned*)take(4096);
  p.ssq = (float*)take((size_t)MTOK * 4 * 4);
  p.tbuf = (float*)(p.pbuf + (size_t)MTOK * ULD);
  if (off > ws_size) { fprintf(stderr, "workspace too small: need %zu have %zu\n", off, ws_size); return; }
  size_t o = (size_t)MTOK * DM;
  p.o_ret_p = o;  o += (size_t)2 * 8 * 65536;
  p.o_ret_s = o;  o += (size_t)2 * 128 * 65536;
  p.o_ssd_p = o;  o += (size_t)2 * 8 * 65536;
  p.o_ssd_s = o;  o += (size_t)2 * 128 * 65536;
  p.o_conv_p = o; o += (size_t)2 * 8 * 3 * 1024;
  p.o_conv_s = o; o += (size_t)2 * 128 * 3 * 1024;
  p.o_hg_p = o;   o += (size_t)2 * 8 * 65536;
  p.o_hg_s = o;   o += (size_t)2 * 128 * 65536;
  p.o_s5r_p = o;  o += (size_t)2 * 8 * 2048;
  p.o_s5r_s = o;  o += (size_t)2 * 128 * 2048;
  p.o_s5i_p = o;  o += (size_t)2 * 8 * 2048;
  p.o_s5i_s = o;  o += (size_t)2 * 128 * 2048;

  static int grid_blocks = 0;
  if (!grid_blocks) {
    int dev = 0, cus = 0, per_cu = 0;
    hipGetDevice(&dev);
    hipDeviceGetAttribute(&cus, hipDeviceAttributeMultiprocessorCount, dev);
    hipOccupancyMaxActiveBlocksPerMultiprocessor(&per_cu, mega_kernel, 256, 0);
    if (per_cu > 2) per_cu = 2;
    if (per_cu < 1) per_cu = 1;
    grid_blocks = cus * per_cu;
  }
  hipMemsetAsync(p.counters, 0, 4096, stream);
#if SINGLE_LAUNCH
  int lo = 0, hi = NPHASE;
  void* args[] = {&p, &lo, &hi};
  hipError_t e = hipLaunchCooperativeKernel((void*)mega_kernel, dim3(grid_blocks), dim3(256), args, 0, stream);
  if (e != hipSuccess) fprintf(stderr, "cooperative launch failed: %s (grid %d)\n", hipGetErrorString(e), grid_blocks);
#else
  for (int ph = 0; ph < NPHASE; ++ph)
    hipLaunchKernelGGL(mega_kernel, dim3(grid_blocks), dim3(256), 0, stream, p, ph, ph + 1);
#endif
}
```

```cpp
#include <hip/hip_runtime.h>
#include <hip/hip_cooperative_groups.h>
#include <cstdio>
#include <cstdint>
namespace cg = cooperative_groups;

#ifndef SINGLE_LAUNCH
#define SINGLE_LAUNCH 1
#endif
#ifndef ONLY
#define ONLY -1
#endif
#define EN(k) (ONLY < 0 || ONLY == (k))

typedef unsigned short u16;
using bf16x8 = __attribute__((ext_vector_type(8))) short;
using bf16x4 = __attribute__((ext_vector_type(4))) short;
using f32x4  = __attribute__((ext_vector_type(4))) float;
typedef unsigned u32x4 __attribute__((ext_vector_type(4)));
#define DI __device__ __forceinline__
#define MFMA16(a, b, c) __builtin_amdgcn_mfma_f32_16x16x32_bf16((a), (b), (c), 0, 0, 0)

constexpr int MTOK = 17408;
constexpr int MPR  = 16384;
constexpr int DM   = 1024;
constexpr int NP   = 6272;
constexpr int NIN  = 10368;
constexpr int DFF  = 4096;
constexpr int INC  = 10248;
constexpr int C_RQ = 0, C_RK = 512, C_RV = 1024, C_RG = 1536, C_SZ = 2048, C_SXBC = 2560;
constexpr int C_HQ = 3584, C_HF = 4096, C_HI = 4608, C_HG = 5120, C_SU = 5632, C_SDT = 6144;
constexpr float EPS = 1e-6f;
constexpr int HLD = 1024, WLD1 = 1024, ULD = 4096, WLD4 = 4096, OLD = 2048, ZLD = 512, WLD5 = 512;
constexpr int NITEMS = 160 + 128 * 20;
constexpr int NPHASE = 22;

struct Params {
  const float* in[35];
  float* out;
  u16 *wt_in, *wt_ff1, *wt_ff2, *wt_br, *wt_out, *wt_glu;
  u16 *hb, *pbuf, *obuf, *zs5;
  float* tbuf;
  unsigned* counters;
  float* ssq;
  u16* slocal;
  float* segdec;
  float* hlocal;
  int nseg, cps;
  size_t o_ret_p, o_ret_s, o_ssd_p, o_ssd_s, o_conv_p, o_conv_s, o_hg_p, o_hg_s, o_s5r_p, o_s5r_s, o_s5i_p, o_s5i_s;
};

DI int tidq() { int t = threadIdx.x; asm volatile("" : "+v"(t)); return t; }
typedef __bf16 bf16v2 __attribute__((ext_vector_type(2)));
typedef float f32v2 __attribute__((ext_vector_type(2)));
DI unsigned pack2(float a, float b) { f32v2 v = {a, b}; return __builtin_bit_cast(unsigned, __builtin_convertvector(v, bf16v2)); }
DI u16 f2bf(float f) { return (u16)(pack2(f, 0.f) & 0xffffu); }
DI float bf2f(u16 h) { return __uint_as_float(((unsigned)h) << 16); }
DI float sigmoidf_(float x) { return 1.f / (1.f + __expf(-x)); }
DI float siluf_(float x) { return x / (1.f + __expf(-x)); }
DI float softplusf_(float x) { return x > 20.f ? x : log1pf(__expf(x)); }
DI float gelu_tanh(float x) {
  float u = 0.7978845608028654f * (x + 0.044715f * x * x * x);
  float e = __expf(2.f * u);
  float th = 1.f - 2.f / (e + 1.f);
  return 0.5f * x * (1.f + th);
}
DI float wave_sum(float v) {
#pragma unroll
  for (int m = 32; m >= 1; m >>= 1) v += __shfl_xor(v, m);
  return v;
}
DI float sum16(float v) {
#pragma unroll
  for (int m = 8; m >= 1; m >>= 1) v += __shfl_xor(v, m);
  return v;
}
DI void sincos_red(float a, float& s, float& c) {
  float n = rintf(a * 0.15915494309189535f);
  float r = fmaf(-n, 6.28125f, a);
  r = fmaf(-n, 1.9353071795864769e-3f, r);
  s = __sinf(r); c = __cosf(r);
}

DI int map_win(int my) {
  if (my < 3584) return my;
  if (my < 6144) return my + 8;
  if (my < 6152) return my - 6144 + 3584;
  if (my < 6272) return -1;
  return my - 120;
}
DI void transpose_tile(const float* __restrict__ src, int src_ld, u16* __restrict__ dst, int dst_ld,
                       int k0, int n0, int mapmode, char* smem) {
  float* tile = (float*)smem;
  const int tid = tidq();
  {
    const int n = tid & 63;
    int sc = n0 + n;
    if (mapmode) sc = map_win(sc);
#pragma unroll
    for (int i = 0; i < 16; ++i) {
      int k = (tid >> 6) + 4 * i;
      float v = (sc >= 0) ? src[(size_t)(k0 + k) * src_ld + sc] : 0.f;
      tile[n * 65 + k] = v;
    }
  }
  __syncthreads();
  {
    const int n = tid >> 2, kc = (tid & 3) * 16;
    unsigned pk[8];
#pragma unroll
    for (int x = 0; x < 8; ++x) pk[x] = pack2(tile[n * 65 + kc + 2 * x], tile[n * 65 + kc + 2 * x + 1]);
    uint4* d = (uint4*)(dst + (size_t)(n0 + n) * dst_ld + k0 + kc);
    d[0] = make_uint4(pk[0], pk[1], pk[2], pk[3]);
    d[1] = make_uint4(pk[4], pk[5], pk[6], pk[7]);
  }
  __syncthreads();
}

__device__ void phase_convert(const Params& p, char* smem) {
  constexpr int PER = 5472;
  for (int t = blockIdx.x; t < 2 * PER; t += gridDim.x) {
    int l = t / PER, r = t % PER;
    if (r < 2592) {
      int nt = r / 16, kt = r % 16;
      transpose_tile(p.in[12] + (size_t)l * DM * INC, INC, p.wt_in + (size_t)l * NIN * WLD1, WLD1, kt * 64, nt * 64, 1, smem);
    } else if (r < 3616) {
      r -= 2592; int nt = r / 16, kt = r % 16;
      transpose_tile(p.in[33] + (size_t)l * DM * DFF, DFF, p.wt_ff1 + (size_t)l * DFF * WLD1, WLD1, kt * 64, nt * 64, 0, smem);
    } else if (r < 4640) {
      r -= 3616; int nt = r / 64, kt = r % 64;
      transpose_tile(p.in[34] + (size_t)l * DFF * DM, DM, p.wt_ff2 + (size_t)l * DM * WLD4, WLD4, kt * 64, nt * 64, 0, smem);
    } else if (r < 4896) {
      r -= 4640; int nt = r / 16, kt = r % 16;
      transpose_tile(p.in[32] + (size_t)l * DM * DM, DM, p.wt_out + (size_t)l * DM * WLD1, WLD1, kt * 64, nt * 64, 0, smem);
    } else if (r < 5408) {
      r -= 4896; int b = r / 128; r %= 128; int nt = r / 8, kt = r % 8;
      transpose_tile(p.in[31] + (size_t)(l * 4 + b) * 512 * DM, DM, p.wt_br + (size_t)(l * 4 + b) * DM * WLD5, WLD5, kt * 64, nt * 64, 0, smem);
    } else {
      r -= 5408; int nt = r / 8, kt = r % 8;
      transpose_tile(p.in[30] + (size_t)l * 512 * 512, 512, p.wt_glu + (size_t)l * 512 * WLD5, WLD5, kt * 64, nt * 64, 0, smem);
    }
  }
}

__device__ void phase_rownorm(const Params& p, bool from_input, const float* __restrict__ t, const float* __restrict__ gpost,
                              const float* __restrict__ gpre, u16* __restrict__ hout) {
  const int lane = tidq() & 63, w = tidq() >> 6;
  float* xbuf = p.out;
  for (int row = blockIdx.x * 4 + w; row < MTOK; row += gridDim.x * 4) {
    const float* xin = from_input ? (row < MPR ? p.in[0] + (size_t)row * DM : p.in[1] + (size_t)(row - MPR) * DM)
                                  : xbuf + (size_t)row * DM;
    float4 x[4];
#pragma unroll
    for (int k = 0; k < 4; ++k) x[k] = *(const float4*)(xin + lane * 4 + 256 * k);
    if (t) {
      float4 tv[4];
      float ss = 0.f;
#pragma unroll
      for (int k = 0; k < 4; ++k) {
        tv[k] = *(const float4*)(t + (size_t)row * DM + lane * 4 + 256 * k);
        ss += tv[k].x * tv[k].x + tv[k].y * tv[k].y + tv[k].z * tv[k].z + tv[k].w * tv[k].w;
      }
      ss = wave_sum(ss);
      float r = rsqrtf(ss * (1.f / DM) + EPS);
#pragma unroll
      for (int k = 0; k < 4; ++k) {
        float4 g = *(const float4*)(gpost + lane * 4 + 256 * k);
        x[k].x += tv[k].x * r * g.x; x[k].y += tv[k].y * r * g.y; x[k].z += tv[k].z * r * g.z; x[k].w += tv[k].w * r * g.w;
      }
    }
#pragma unroll
    for (int k = 0; k < 4; ++k) *(float4*)(xbuf + (size_t)row * DM + lane * 4 + 256 * k) = x[k];
    if (hout) {
      float ss = 0.f;
#pragma unroll
      for (int k = 0; k < 4; ++k) ss += x[k].x * x[k].x + x[k].y * x[k].y + x[k].z * x[k].z + x[k].w * x[k].w;
      ss = wave_sum(ss);
      float r = rsqrtf(ss * (1.f / DM) + EPS);
#pragma unroll
      for (int k = 0; k < 4; ++k) {
        float4 g = *(const float4*)(gpre + lane * 4 + 256 * k);
        uint2 o;
        o.x = pack2(x[k].x * r * g.x, x[k].y * r * g.y);
        o.y = pack2(x[k].z * r * g.z, x[k].w * r * g.w);
        *(uint2*)(hout + (size_t)row * HLD + lane * 4 + 256 * k) = o;
      }
    }
  }
}

DI int swz(int r, int c) { return r * 128 + ((c ^ ((r >> 1) & 7)) << 4); }

#define GEMM_COMPUTE(AS_) do { const char* as_ = (AS_); const char* bs_ = as_ + 16384; \
  _Pragma("unroll") for (int s_ = 0; s_ < 2; ++s_) { \
    bf16x8 af_[4], bfr_[4]; \
    _Pragma("unroll") for (int i_ = 0; i_ < 4; ++i_) af_[i_] = *(const bf16x8*)(as_ + swz(wm * 64 + i_ * 16 + r16, s_ * 4 + quad)); \
    _Pragma("unroll") for (int j_ = 0; j_ < 4; ++j_) bfr_[j_] = *(const bf16x8*)(bs_ + swz(wn * 64 + j_ * 16 + r16, s_ * 4 + quad)); \
    _Pragma("unroll") for (int i_ = 0; i_ < 4; ++i_) \
      _Pragma("unroll") for (int j_ = 0; j_ < 4; ++j_) acc[i_][j_] = MFMA16(bfr_[j_], af_[i_], acc[i_][j_]); \
  } } while (0)

struct Stage { u32x4 a0, a1, a2, a3, b0, b1, b2, b3; };
DI void gload(Stage& s, const u16* ag, const u16* bg, int lda, int ldb, int kt) {
  s.a0 = *(const u32x4*)(ag + (size_t)0 * 32 * lda + kt * 64);
  s.a1 = *(const u32x4*)(ag + (size_t)1 * 32 * lda + kt * 64);
  s.a2 = *(const u32x4*)(ag + (size_t)2 * 32 * lda + kt * 64);
  s.a3 = *(const u32x4*)(ag + (size_t)3 * 32 * lda + kt * 64);
  s.b0 = *(const u32x4*)(bg + (size_t)0 * 32 * ldb + kt * 64);
  s.b1 = *(const u32x4*)(bg + (size_t)1 * 32 * ldb + kt * 64);
  s.b2 = *(const u32x4*)(bg + (size_t)2 * 32 * ldb + kt * 64);
  s.b3 = *(const u32x4*)(bg + (size_t)3 * 32 * ldb + kt * 64);
}
DI void lwrite(const Stage& s, char* d, int lr, int lc) {
  *(u32x4*)(d + swz(lr, lc)) = s.a0;
  *(u32x4*)(d + swz(lr + 32, lc)) = s.a1;
  *(u32x4*)(d + swz(lr + 64, lc)) = s.a2;
  *(u32x4*)(d + swz(lr + 96, lc)) = s.a3;
  *(u32x4*)(d + 16384 + swz(lr, lc)) = s.b0;
  *(u32x4*)(d + 16384 + swz(lr + 32, lc)) = s.b1;
  *(u32x4*)(d + 16384 + swz(lr + 64, lc)) = s.b2;
  *(u32x4*)(d + 16384 + swz(lr + 96, lc)) = s.b3;
}

template <bool DEEP>
DI void gemm_kloop(f32x4 (&acc)[4][4], const u16* __restrict__ A, int lda, const u16* __restrict__ Bt, int ldb,
                   int K, int m0, int n0, char* smem) {
  const int tid = tidq(), lane = tid & 63, w = tid >> 6, wm = w >> 1, wn = w & 1, r16 = lane & 15, quad = lane >> 4;
  const int lr = tid >> 3, lc = tid & 7;
  const u16* ag = A + (size_t)(m0 + lr) * lda + lc * 8;
  const u16* bg = Bt + (size_t)(n0 + lr) * ldb + lc * 8;
  const int nk = K >> 6;
  Stage s0;
  gload(s0, ag, bg, lda, ldb, 0);
  if (DEEP) {
    Stage s1;
    gload(s1, ag, bg, lda, ldb, 1);
    lwrite(s0, smem, lr, lc);
    __syncthreads();
    for (int kt = 0; kt < nk; kt += 2) {
      if (kt + 2 < nk) gload(s0, ag, bg, lda, ldb, kt + 2);
      GEMM_COMPUTE(smem);
      lwrite(s1, smem + 32768, lr, lc);
      __syncthreads();
      if (kt + 3 < nk) gload(s1, ag, bg, lda, ldb, kt + 3);
      GEMM_COMPUTE(smem + 32768);
      if (kt + 2 < nk) lwrite(s0, smem, lr, lc);
      __syncthreads();
    }
  } else {
    lwrite(s0, smem, lr, lc);
    __syncthreads();
    for (int kt = 0; kt < nk; ++kt) {
      const bool more = (kt + 1 < nk);
      if (more) gload(s0, ag, bg, lda, ldb, kt + 1);
      GEMM_COMPUTE(smem + (kt & 1) * 32768);
      if (more) lwrite(s0, smem + ((kt + 1) & 1) * 32768, lr, lc);
      __syncthreads();
    }
  }
}

DI void zero_acc(f32x4 (&acc)[4][4]) {
#pragma unroll
  for (int i = 0; i < 4; ++i)
#pragma unroll
    for (int j = 0; j < 4; ++j) acc[i][j] = f32x4{0.f, 0.f, 0.f, 0.f};
}

enum { EPI_BF16 = 0, EPI_SIG = 1, EPI_RELU2 = 2, EPI_F32 = 3, EPI_GLU = 4 };

template <int EPI>
DI void gemm_tile(const u16* A, int lda, const u16* Bt, int ldb, int K, int m0, int n0,
                  void* outp, int ldc, const u16* aux, int ldaux, char* smem) {
  f32x4 acc[4][4];
  zero_acc(acc);
  gemm_kloop<true>(acc, A, lda, Bt, ldb, K, m0, n0, smem);
#ifdef VAR_NOSTORE
  if (*(volatile int*)(smem + 65536 + 8) == 1 && acc[0][0][0] != 12345.678f) return;
#endif
  const int lane = tidq() & 63, w = tidq() >> 6, wm = w >> 1, wn = w & 1, r16 = lane & 15, quad = lane >> 4;
#pragma unroll
  for (int i = 0; i < 4; ++i) {
    const int m = m0 + wm * 64 + i * 16 + r16;
#pragma unroll
    for (int j = 0; j < 4; ++j) {
      const int n = n0 + wn * 64 + j * 16 + quad * 4;
      f32x4 v = acc[i][j];
      if (EPI == EPI_F32) {
        *(float4*)((float*)outp + (size_t)m * ldc + n) = make_float4(v[0], v[1], v[2], v[3]);
      } else {
        if (EPI == EPI_SIG) {
#pragma unroll
          for (int x = 0; x < 4; ++x) v[x] = sigmoidf_(v[x]);
        } else if (EPI == EPI_RELU2) {
#pragma unroll
          for (int x = 0; x < 4; ++x) { float r = fmaxf(v[x], 0.f); v[x] = r * r; }
        } else if (EPI == EPI_GLU) {
          uint2 zz = *(const uint2*)(aux + (size_t)m * ldaux + n);
          v[0] = bf2f((u16)(zz.x & 0xffff)) * sigmoidf_(v[0]);
          v[1] = bf2f((u16)(zz.x >> 16)) * sigmoidf_(v[1]);
          v[2] = bf2f((u16)(zz.y & 0xffff)) * sigmoidf_(v[2]);
          v[3] = bf2f((u16)(zz.y >> 16)) * sigmoidf_(v[3]);
        }
        uint2 o; o.x = pack2(v[0], v[1]); o.y = pack2(v[2], v[3]);
        *(uint2*)((u16*)outp + (size_t)m * ldc + n) = o;
      }
    }
  }
}

DI void merge_tile(const Params& p, int l, int m0, int n0, char* smem) {
  f32x4 macc[4][4];
  zero_acc(macc);
  const int lane = tidq() & 63, w = tidq() >> 6, wm = w >> 1, wn = w & 1, r16 = lane & 15, quad = lane >> 4;
  const u16* gates = p.pbuf;
  for (int b = 0; b < 4; ++b) {
    f32x4 acc[4][4];
    zero_acc(acc);
    gemm_kloop<false>(acc, p.obuf + b * 512, OLD, p.wt_br + (size_t)(l * 4 + b) * DM * WLD5, WLD5, 512, m0, n0, smem);
#pragma unroll
    for (int i = 0; i < 4; ++i) {
      const int m = m0 + wm * 64 + i * 16 + r16;
#pragma unroll
      for (int j = 0; j < 4; ++j) {
        const int n = n0 + wn * 64 + j * 16 + quad * 4;
        uint2 gg = *(const uint2*)(gates + (size_t)m * 4096 + b * 1024 + n);
        macc[i][j][0] += bf2f((u16)(gg.x & 0xffff)) * acc[i][j][0];
        macc[i][j][1] += bf2f((u16)(gg.x >> 16)) * acc[i][j][1];
        macc[i][j][2] += bf2f((u16)(gg.y & 0xffff)) * acc[i][j][2];
        macc[i][j][3] += bf2f((u16)(gg.y >> 16)) * acc[i][j][3];
      }
    }
  }
#pragma unroll
  for (int i = 0; i < 4; ++i) {
    const int m = m0 + wm * 64 + i * 16 + r16;
#pragma unroll
    for (int j = 0; j < 4; ++j) {
      const int n = n0 + wn * 64 + j * 16 + quad * 4;
      uint2 o; o.x = pack2(macc[i][j][0], macc[i][j][1]); o.y = pack2(macc[i][j][2], macc[i][j][3]);
      *(uint2*)(p.hb + (size_t)m * HLD + n) = o;
    }
  }
}

constexpr int QS = 136;
constexpr int TS = 20;
constexpr int OFS = 260;

template <int MODE>
__device__ void run_chain(const Params& p, int l, int seq, int sub, int seg, int pass, char* smem) {
  constexpr int NE = 2;
  const int tid = tidq(), lane = tid & 63, w = tid >> 6, r16 = lane & 15, quad = lane >> 4;
  const bool prompt = seq < 8;
  const int bidx = prompt ? seq : seq - 8;
  const int NB = prompt ? 8 : 128;
  const int L = prompt ? 2048 : 8;
  const int row0 = prompt ? seq * 2048 : MPR + (seq - 8) * 8;
  const int pos0 = prompt ? 0 : 16384;
  const int cps = p.cps;
  const int ch_begin = prompt ? seg * cps : 0;
  const int ch_end = prompt ? ch_begin + cps : 1;
  const bool light = prompt && (pass == 1);
  const bool last_seg = !prompt || (seg == p.nseg - 1);
  const int cid = seq * 12 + MODE * 4 + sub;

  u16* Qa = (u16*)smem;
  u16* Ka = (u16*)(smem + 4352);
  u16* KuT = (u16*)(smem + 8704);
  u16* VaT = (u16*)(smem + 13824);
  u16* VuT = (MODE == 1) ? (u16*)(smem + 24064) : VaT;
  float* Of = (float*)(smem + 34304);
  u16* Raw = (u16*)(smem + 34304);
  u16* Xc = (u16*)(smem + 50944);
  float* tot = (float*)(smem + 55040);
  float* cdec = (float*)(smem + 59136);
  float* dtl = (float*)(smem + 59392);
  float* rsc = (float*)(smem + 59648);
  float* clast = (float*)(smem + 60160);
  float* segacc = (float*)(smem + 60176);

  const float* sin_ = nullptr;
  float* sout = nullptr;
  if (MODE == 0) {
    if (!prompt) sin_ = p.in[2] + (((size_t)l * 128 + bidx) * 4 + sub) * 16384;
    sout = p.out + (prompt ? p.o_ret_p : p.o_ret_s) + (((size_t)l * NB + bidx) * 4 + sub) * 16384;
  } else if (MODE == 2) {
    if (!prompt) sin_ = p.in[5] + (((size_t)l * 128 + bidx) * 4 + sub) * 16384;
    sout = p.out + (prompt ? p.o_hg_p : p.o_hg_s) + (((size_t)l * NB + bidx) * 4 + sub) * 16384;
  } else {
    if (!prompt) sin_ = p.in[3] + (((size_t)l * 128 + bidx) * 8 + sub * 2 + (w >> 1)) * 8192;
    sout = p.out + (prompt ? p.o_ssd_p : p.o_ssd_s) + (((size_t)l * NB + bidx) * 8 + sub * 2 + (w >> 1)) * 8192;
  }

  float lg = 0.f;
  if (MODE == 0) lg = log1pf(-exp2f(-5.f - (float)sub));

  int sbase = (MODE == 1) ? (((w & 1) * 32 + r16) * 128 + quad * 4) : (quad * 512 + w * 32 + r16);
  asm volatile("" : "+v"(sbase));
  f32x4 S[8][NE];
#pragma unroll
  for (int t = 0; t < 8; ++t)
#pragma unroll
    for (int u = 0; u < NE; ++u) {
      if (sin_) {
        if (MODE == 1) {
          S[t][u] = *(const f32x4*)(sin_ + sbase + u * 2048 + t * 16);
        } else {
#pragma unroll
          for (int jj = 0; jj < 4; ++jj) S[t][u][jj] = sin_[sbase + t * 2048 + jj * 128 + u * 16];
        }
      } else {
        S[t][u] = f32x4{0.f, 0.f, 0.f, 0.f};
      }
    }
  if (prompt && pass == 2) {
    for (int r = 0; r < seg; ++r) {
      const uint2* sl = (const uint2*)(p.slocal + (size_t)(cid * (p.nseg - 1) + r) * 16384) + tid;
      const float* sd = p.segdec + (size_t)(cid * 7 + r) * 128;
      float dsc = 1.f;
      if (MODE == 0) dsc = __expf(lg * (float)(16 * cps));
      if (MODE == 1) dsc = __expf(sd[w >> 1]);
#pragma unroll
      for (int t = 0; t < 8; ++t) {
        f32x4 dv = f32x4{dsc, dsc, dsc, dsc};
        if (MODE == 2) {
          f32x4 lv = *(const f32x4*)(sd + t * 16 + quad * 4);
          dv = f32x4{__expf(lv[0]), __expf(lv[1]), __expf(lv[2]), __expf(lv[3])};
        }
#pragma unroll
        for (int u = 0; u < NE; ++u) {
          uint2 pk = sl[(t * NE + u) * 256];
          S[t][u][0] = S[t][u][0] * dv[0] + bf2f((u16)(pk.x & 0xffff));
          S[t][u][1] = S[t][u][1] * dv[1] + bf2f((u16)(pk.x >> 16));
          S[t][u][2] = S[t][u][2] * dv[2] + bf2f((u16)(pk.y & 0xffff));
          S[t][u][3] = S[t][u][3] * dv[3] + bf2f((u16)(pk.y >> 16));
        }
      }
    }
  }

  float lbv = 0.f;
  float hg_tot = 0.f;
  float cprev[2][3];
  float cw[2][4], cb[2];
  int ccidx[2];
  float dt_bias = 0.f, dt_A = 0.f;
  float rinv = 0.f, rcD = 1.f, rsD = 0.f;
  const int gg = sub >> 1, pair = sub & 1;
  if (MODE == 0) {
    rinv = exp2f(-(float)(tid & 63) * (13.287712379549449f / 64.f));
    rsD = __sinf(rinv); rcD = __cosf(rinv);
  }
  if (MODE == 2) {
    if (l == 1) {
      float a0 = p.in[20][sub * 128 + (tid & 127)], a1 = p.in[20][512 + sub * 128 + (tid & 127)];
      float mx = fmaxf(a0, a1);
      float e0 = __expf(a0 - mx), e1 = __expf(a1 - mx);
      lbv = e1 / (e0 + e1);
    }
  }
  if (MODE == 1) {
    if (tid < 32) {
      const int hh = sub * 2 + (tid >> 4);
      dt_A = -__expf(p.in[16][l * 8 + hh]);
      dt_bias = p.in[17][l * 8 + hh];
    }
    if (tid < 2) segacc[tid] = 0.f;
#pragma unroll
    for (int k = 0; k < 2; ++k) {
      int ci = tid + 256 * k;
      int cc = 0;
      if (ci < 128) cc = gg * 256 + pair * 128 + ci;
      else if (ci < 256) cc = 512 + gg * 128 + (ci - 128);
      else cc = 768 + gg * 128 + (ci - 256);
      if (ci >= 384) cc = 0;
      ccidx[k] = cc;
#pragma unroll
      for (int j = 0; j < 4; ++j) cw[k][j] = p.in[14][((size_t)l * 4 + j) * 1024 + cc];
      cb[k] = p.in[15][l * 1024 + cc];
#pragma unroll
      for (int j = 0; j < 3; ++j) {
        float v = 0.f;
        if (!prompt) v = p.in[4][(((size_t)l * 128 + bidx) * 3 + j) * 1024 + cc];
        else if (ch_begin > 0) v = bf2f(p.pbuf[(size_t)(row0 + ch_begin * 16 - 3 + j) * NP + C_SXBC + cc]);
        cprev[k][j] = v;
      }
    }
  }

  const int lt = tid >> 4, lc = tid & 15;
  uint4 r0, r1, r2, g0;
  unsigned rdt = 0;
  const uint4 z4 = make_uint4(0, 0, 0, 0);
  r0 = r1 = r2 = g0 = z4;
  auto load_raw = [&](int ch) {
    const int t0 = ch * 16;
    const int nv = (L - t0 < 16) ? (L - t0) : 16;
    const u16* Pr = p.pbuf + (size_t)(row0 + t0 + lt) * NP;
    r0 = r1 = r2 = g0 = z4;
    rdt = 0;
    if (lt < nv) {
      if (MODE == 0) {
        r0 = *(const uint4*)(Pr + C_RQ + sub * 128 + lc * 8);
        r1 = *(const uint4*)(Pr + C_RK + sub * 128 + lc * 8);
        r2 = *(const uint4*)(Pr + C_RV + sub * 128 + lc * 8);
        g0 = *(const uint4*)(Pr + C_RG + sub * 128 + lc * 8);
      } else if (MODE == 2) {
        r0 = *(const uint4*)(Pr + C_HQ + sub * 128 + lc * 8);
        r1 = *(const uint4*)(Pr + C_HF + sub * 128 + lc * 8);
        r2 = *(const uint4*)(Pr + C_HI + sub * 128 + lc * 8);
        g0 = *(const uint4*)(Pr + C_HG + sub * 128 + lc * 8);
      } else {
        r0 = *(const uint4*)(Pr + C_SXBC + gg * 256 + pair * 128 + lc * 8);
        r1 = *(const uint4*)(Pr + C_SXBC + 512 + gg * 128 + lc * 8);
        r2 = *(const uint4*)(Pr + C_SXBC + 768 + gg * 128 + lc * 8);
        g0 = *(const uint4*)(Pr + C_SZ + gg * 256 + pair * 128 + lc * 8);
        if (lc < 2) rdt = Pr[C_SDT + sub * 2 + lc];
      }
    }
  };
  load_raw(ch_begin);

  for (int ch = ch_begin; ch < ch_end; ++ch) {
    const int t0 = ch * 16;
    const int nvalid = (L - t0 < 16) ? (L - t0) : 16;
    float sscale = 1.f;
    int tidv = threadIdx.x;
    asm volatile("" : "+v"(tidv));
    const int tid = tidv, lane = tid & 63, w = tid >> 6, r16 = lane & 15, quad = lane >> 4, lt = tid >> 4, lc = tid & 15;

    *(uint4*)(Raw + lt * 128 + lc * 8) = r0;
    *(uint4*)(Raw + 2048 + lt * 128 + lc * 8) = r1;
    *(uint4*)(Raw + 4096 + lt * 128 + lc * 8) = r2;
    if (MODE == 1) { if (lc < 2) Raw[6144 + lt * 2 + lc] = (u16)rdt; }
    const uint4 gc0 = g0;
    __syncthreads();
    if (ch + 1 < ch_end) load_raw(ch + 1);

    if (MODE == 0) {
      const int which = tid >> 7, pr = tid & 63, th = (tid >> 6) & 1;
      if (which == 1 || !light) {
        const u16* R = Raw + which * 2048;
        float sn, cs;
        sincos_red((float)(pos0 + t0 + th * 8) * rinv, sn, cs);
#pragma unroll
        for (int x = 0; x < 8; ++x) {
          const int t = th * 8 + x;
          float x1 = bf2f(R[t * 128 + pr]);
          float x2 = bf2f(R[t * 128 + pr + 64]);
          float y1 = x1 * cs - x2 * sn, y2 = x1 * sn + x2 * cs;
          if (which) {
            y1 *= 0.08838834764831845f; y2 *= 0.08838834764831845f;
            Ka[t * QS + pr] = f2bf(y1); Ka[t * QS + pr + 64] = f2bf(y2);
            float kd = __expf(lg * (float)(nvalid - 1 - t));
            KuT[pr * TS + t] = f2bf(y1 * kd);
            KuT[(pr + 64) * TS + t] = f2bf(y2 * kd);
          } else {
            Qa[t * QS + pr] = f2bf(y1); Qa[t * QS + pr + 64] = f2bf(y2);
          }
          float ncs = cs * rcD - sn * rsD;
          sn = sn * rcD + cs * rsD; cs = ncs;
        }
      }
      if (tid < 16) cdec[tid] = lg * (float)(tid + 1);
      sscale = __expf(lg * (float)nvalid);
    } else if (MODE == 2) {
      const int d = tid & 127, th = tid >> 7;
      float cl[8], kk[8], qv[8];
      float c = 0.f;
#pragma unroll
      for (int x = 0; x < 8; ++x) {
        const int t = th * 8 + x;
        kk[x] = 0.f; qv[x] = 0.f;
        if (t < nvalid) {
          float z = bf2f(Raw[2048 + t * 128 + d]);
          float sg = sigmoidf_(z);
          float f = lbv + (1.f - lbv) * sg;
          c += __logf(f);
          kk[x] = (1.f - lbv) * (1.f - sg);
          if (!light) qv[x] = siluf_(bf2f(Raw[t * 128 + d]));
        }
        cl[x] = c;
      }
      tot[th * 128 + d] = c;
      __syncthreads();
      const float c_lo = tot[d];
      const float c_all = c_lo + tot[128 + d];
      const float off = th ? c_lo : 0.f;
#pragma unroll
      for (int x = 0; x < 8; ++x) {
        const int t = th * 8 + x;
        const float ct = off + cl[x];
        if (!light) {
          Qa[t * QS + d] = f2bf(qv[x] * __expf(ct));
          Ka[t * QS + d] = f2bf(kk[x] * __expf(-ct));
        }
        KuT[d * TS + t] = f2bf(kk[x] * __expf(c_all - ct));
      }
      if (th == 0) { rsc[d] = __expf(c_all); hg_tot += c_all; }
    } else {
      if (tid < 32) {
        const int hl = tid >> 4, t = tid & 15;
        float dtv = 0.f, c = 0.f;
        if (t < nvalid) {
          dtv = softplusf_(bf2f(Raw[6144 + t * 2 + hl]) + dt_bias);
          c = dtv * dt_A;
        }
#pragma unroll
        for (int o = 1; o < 16; o <<= 1) {
          float v = __shfl_up(c, o, 16);
          if (t >= o) c += v;
        }
        cdec[hl * 16 + t] = c;
        dtl[hl * 16 + t] = dtv;
        if (t == 15) { clast[hl] = c; segacc[hl] += c; }
      }
      __syncthreads();
#pragma unroll
      for (int k = 0; k < 2; ++k) {
        const int ci = tid + 256 * k;
        if (ci < 256 || (ci < 384 && !light)) {
          const int hl = (ci < 128) ? (ci >> 6) : 0;
          const float cl = clast[hl];
          const u16* R = Raw + ((ci < 128) ? ci : ((ci < 256) ? (2048 + (ci - 128)) : (4096 + (ci - 256))));
#pragma unroll 4
          for (int t = 0; t < 16; ++t) {
            float v = 0.f;
            if (t < nvalid) {
              float raw = bf2f(R[t * 128]);
              float o = cb[k] + cprev[k][0] * cw[k][0] + cprev[k][1] * cw[k][1] + cprev[k][2] * cw[k][2] + raw * cw[k][3];
              cprev[k][0] = cprev[k][1]; cprev[k][1] = cprev[k][2]; cprev[k][2] = raw;
              v = siluf_(o);
            }
            if (ci < 128) {
              float dtv = dtl[hl * 16 + t];
              if (!light) { Xc[t * 128 + ci] = f2bf(v); VaT[ci * TS + t] = f2bf(v * dtv); }
              VuT[ci * TS + t] = f2bf(v * dtv * __expf(cl - cdec[hl * 16 + t]));
            } else if (ci < 256) {
              u16 a = f2bf(v);
              if (!light) Ka[t * QS + (ci - 128)] = a;
              KuT[(ci - 128) * TS + t] = a;
            } else {
              Qa[t * QS + (ci - 256)] = f2bf(v);
            }
          }
        }
      }
    }
    if (MODE != 1) {
      const int e = tid & 127, th = tid >> 7;
#pragma unroll
      for (int x = 0; x < 4; ++x) {
        const int t = th * 8 + 2 * x;
        unsigned lo = Raw[4096 + t * 128 + e], hi = Raw[4096 + (t + 1) * 128 + e];
        *(unsigned*)(VaT + e * TS + t) = lo | (hi << 16);
      }
    }
    __syncthreads();

    {
      const float* cd = cdec + ((MODE == 1) ? (w >> 1) * 16 : 0);
      bf16x8 attA;
      float rr[4];
      bf16x8 qf[4];
      if (!light) {
        f32x4 at = f32x4{0.f, 0.f, 0.f, 0.f};
#pragma unroll
        for (int s = 0; s < 4; ++s) {
          bf16x8 a = *(const bf16x8*)(Ka + r16 * QS + s * 32 + quad * 8);
          bf16x8 b = *(const bf16x8*)(Qa + r16 * QS + s * 32 + quad * 8);
          at = MFMA16(a, b, at);
        }
        float ci_ = (MODE != 2) ? cd[r16] : 0.f;
        float vv[4];
#pragma unroll
        for (int jj = 0; jj < 4; ++jj) {
          int j = quad * 4 + jj;
          float v = at[jj];
          if (MODE != 2) v *= __expf(fminf(ci_ - cd[j], 0.f));
          vv[jj] = (j <= r16) ? v : 0.f;
        }
        unsigned a01 = pack2(vv[0], vv[1]), a23 = pack2(vv[2], vv[3]);
        attA = __builtin_bit_cast(bf16x8, (u32x4){a01, a23, 0u, 0u});
#pragma unroll
        for (int jj = 0; jj < 4; ++jj) rr[jj] = (MODE != 2) ? __expf(cd[quad * 4 + jj]) : 1.f;
#pragma unroll
        for (int s = 0; s < 4; ++s) {
          bf16x4 lo = *(const bf16x4*)(Qa + r16 * QS + s * 32 + quad * 4);
          bf16x4 hi = *(const bf16x4*)(Qa + r16 * QS + s * 32 + 16 + quad * 4);
          qf[s] = bf16x8{lo[0], lo[1], lo[2], lo[3], hi[0], hi[1], hi[2], hi[3]};
        }
      }
      __syncthreads();
      if (!light) {
#pragma unroll
        for (int u = 0; u < NE; ++u) {
          const int e0 = (w * NE + u) * 16;
          bf16x4 v4 = *(const bf16x4*)(VaT + (e0 + r16) * TS + quad * 4);
          bf16x8 vb = bf16x8{v4[0], v4[1], v4[2], v4[3], 0, 0, 0, 0};
          f32x4 o1 = MFMA16(attA, vb, (f32x4{0.f, 0.f, 0.f, 0.f}));
          f32x4 o2 = f32x4{0.f, 0.f, 0.f, 0.f};
#pragma unroll
          for (int s = 0; s < 4; ++s) {
            u32x4 sp = {pack2(S[2 * s][u][0], S[2 * s][u][1]), pack2(S[2 * s][u][2], S[2 * s][u][3]),
                        pack2(S[2 * s + 1][u][0], S[2 * s + 1][u][1]), pack2(S[2 * s + 1][u][2], S[2 * s + 1][u][3])};
            o2 = MFMA16(qf[s], __builtin_bit_cast(bf16x8, sp), o2);
          }
#pragma unroll
          for (int jj = 0; jj < 4; ++jj) Of[(quad * 4 + jj) * OFS + e0 + r16] = o1[jj] + rr[jj] * o2[jj];
        }
      }
      float hs = 1.f;
      if (MODE == 0) hs = sscale;
      if (MODE == 1) hs = __expf(clast[w >> 1]);
#pragma unroll
      for (int u = 0; u < NE; ++u) {
        const int e0 = (w * NE + u) * 16;
        bf16x4 v4 = *(const bf16x4*)(VuT + (e0 + r16) * TS + quad * 4);
        bf16x8 vb = bf16x8{v4[0], v4[1], v4[2], v4[3], 0, 0, 0, 0};
#pragma unroll
        for (int t = 0; t < 8; ++t) {
          bf16x4 k4 = *(const bf16x4*)(KuT + (t * 16 + r16) * TS + quad * 4);
          bf16x8 ka = bf16x8{k4[0], k4[1], k4[2], k4[3], 0, 0, 0, 0};
          f32x4 sv = S[t][u];
          if (MODE == 2) {
            f32x4 r4 = *(const f32x4*)(rsc + t * 16 + quad * 4);
            sv[0] *= r4[0]; sv[1] *= r4[1]; sv[2] *= r4[2]; sv[3] *= r4[3];
          } else {
            sv[0] *= hs; sv[1] *= hs; sv[2] *= hs; sv[3] *= hs;
          }
          S[t][u] = MFMA16(ka, vb, sv);
        }
      }
    }
    __syncthreads();

    if (!light) {
      const int i = tid >> 4, eg = tid & 15;
      const int grow = row0 + t0 + i;
      unsigned gw[4] = {gc0.x, gc0.y, gc0.z, gc0.w};
      if (MODE == 0 || MODE == 2) {
        float o[8];
#pragma unroll
        for (int x = 0; x < 8; ++x) o[x] = Of[i * OFS + eg * 8 + x];
        float s1 = 0.f;
        float mu = 0.f;
        if (MODE == 0) {
#pragma unroll
          for (int x = 0; x < 8; ++x) s1 += o[x];
          mu = sum16(s1) * (1.f / 128.f);
        }
        float s2 = 0.f;
#pragma unroll
        for (int x = 0; x < 8; ++x) { o[x] -= mu; s2 += o[x] * o[x]; }
        float r = rsqrtf(sum16(s2) * (1.f / 128.f) + EPS);
        if (i < nvalid) {
          const float* gain = (MODE == 0) ? (p.in[13] + (l * 4 + sub) * 128 + eg * 8) : (p.in[21] + l * 128 + eg * 8);
          float res[8];
#pragma unroll
          for (int x = 0; x < 8; ++x) {
            float g = bf2f((u16)((x & 1) ? (gw[x >> 1] >> 16) : (gw[x >> 1] & 0xffff)));
            float gate = (MODE == 0) ? siluf_(g) : sigmoidf_(g);
            res[x] = o[x] * r * gain[x] * gate;
          }
          uint4 ov = make_uint4(pack2(res[0], res[1]), pack2(res[2], res[3]), pack2(res[4], res[5]), pack2(res[6], res[7]));
          const int ocol = ((MODE == 0) ? 0 : 1024) + sub * 128 + eg * 8;
          *(uint4*)(p.obuf + (size_t)grow * OLD + ocol) = ov;
        }
      } else {
        float y[8];
        const int chb = eg * 8;
        const float Dh = p.in[18][l * 8 + sub * 2 + (chb >> 6)];
        float s2 = 0.f;
#pragma unroll
        for (int x = 0; x < 8; ++x) {
          float g = bf2f((u16)((x & 1) ? (gw[x >> 1] >> 16) : (gw[x >> 1] & 0xffff)));
          float v = Of[i * OFS + chb + x] + bf2f(Xc[i * 128 + chb + x]) * Dh;
          v *= siluf_(g);
          y[x] = v; s2 += v * v;
        }
        s2 = sum16(s2);
        if (i < nvalid) {
          if (eg == 0) p.ssq[(size_t)grow * 4 + sub] = s2;
          uint4 ov = make_uint4(pack2(y[0], y[1]), pack2(y[2], y[3]), pack2(y[4], y[5]), pack2(y[6], y[7]));
          *(uint4*)(p.obuf + (size_t)grow * OLD + 512 + sub * 128 + chb) = ov;
        }
      }
    }
    __syncthreads();
  }

  if (light) {
    uint2* sl = (uint2*)(p.slocal + (size_t)(cid * (p.nseg - 1) + seg) * 16384) + tid;
#pragma unroll
    for (int t = 0; t < 8; ++t)
#pragma unroll
      for (int u = 0; u < NE; ++u)
        sl[(t * NE + u) * 256] = make_uint2(pack2(S[t][u][0], S[t][u][1]), pack2(S[t][u][2], S[t][u][3]));
    float* sd = p.segdec + (size_t)(cid * 7 + seg) * 128;
    if (MODE == 1) { if (tid < 2) sd[tid] = segacc[tid]; }
    if (MODE == 2) { if (tid < 128) sd[tid] = hg_tot; }
  } else if (last_seg) {
    asm volatile("" : "+v"(sbase));
#pragma unroll
    for (int t = 0; t < 8; ++t)
#pragma unroll
      for (int u = 0; u < NE; ++u) {
        if (MODE == 1) {
          *(f32x4*)(sout + sbase + u * 2048 + t * 16) = S[t][u];
        } else {
#pragma unroll
          for (int jj = 0; jj < 4; ++jj) sout[sbase + t * 2048 + jj * 128 + u * 16] = S[t][u][jj];
        }
      }
    if (MODE == 1) {
      float* co = p.out + (prompt ? p.o_conv_p : p.o_conv_s) + ((size_t)l * NB + bidx) * 3 * 1024;
#pragma unroll
      for (int k = 0; k < 2; ++k) {
        const int ci = tid + 256 * k;
        if (ci < 128 || (ci < 384 && pair == 0)) {
#pragma unroll
          for (int j = 0; j < 3; ++j) co[j * 1024 + ccidx[k]] = cprev[k][j];
        }
      }
    }
  }
}

__device__ void run_s5(const Params& p, int l, int seq, int gq, int seg, int pass, char* smem) {
  const int tid = tidq(), lane = tid & 63, w = tid >> 6;
  const int g = gq * 4 + w;
  const bool prompt = seq < 8;
  const int bidx = prompt ? seq : seq - 8;
  const int NB = prompt ? 8 : 128;
  const int row0 = prompt ? seq * 2048 : MPR + (seq - 8) * 8;
  const int sps = prompt ? p.cps * 2 : 1;
  const int sc_begin = prompt ? seg * sps : 0;
  const int sc_end = sc_begin + sps;
  const bool light = prompt && (pass == 1);
  const bool last_seg = !prompt || (seg == p.nseg - 1);
  float* base = (float*)(smem + w * 13568);
  float* hre = base;
  float* him = base + 544;
  float* cre = base + 1088;
  float* cim = base + 2176;
  float* ub = base + 3264;
  const int lg_ = l * 32 + g;
  if (!light) {
#pragma unroll
    for (int m = 0; m < 16; ++m) {
      cre[m * 68 + lane] = p.in[26][((size_t)lg_ * 16 + m) * 64 + lane];
      cim[m * 68 + lane] = p.in[27][((size_t)lg_ * 16 + m) * 64 + lane];
    }
  }
  const float dt = __expf(p.in[29][lg_]);
  const float are = p.in[22][lg_ * 64 + lane], aim = p.in[23][lg_ * 64 + lane];
  const float th = dt * aim;
  float sn, cs; sincos_red(th, sn, cs);
  float shalf, chalf; sincos_red(0.5f * th, shalf, chalf);
  const float em1 = expm1f(dt * are);
  const float mag = em1 + 1.f;
  const float abr = mag * cs, abi = mag * sn;
  const float nre = em1 * cs - 2.f * shalf * shalf, nim = abi;
  const float den = are * are + aim * aim;
  const float fre = (nre * are + nim * aim) / den, fim = (nim * are - nre * aim) / den;
  float bbr[16], bbi[16];
#pragma unroll
  for (int m = 0; m < 16; ++m) {
    float br = p.in[24][((size_t)lg_ * 64 + lane) * 16 + m], bi = p.in[25][((size_t)lg_ * 64 + lane) * 16 + m];
    bbr[m] = fre * br - fim * bi;
    bbi[m] = fre * bi + fim * br;
  }
  float hr = 0.f, hi = 0.f;
  if (!prompt) {
    hr = p.in[6][((size_t)(l * 128 + bidx) * 32 + g) * 64 + lane];
    hi = p.in[7][((size_t)(l * 128 + bidx) * 32 + g) * 64 + lane];
  } else if (pass == 2 && seg > 0) {
    const float len = (float)(sps * 8);
    const float pm = __expf(len * dt * are);
    float ps, pc; sincos_red(len * th, ps, pc);
    const float pr_ = pm * pc, pi_ = pm * ps;
    for (int r = 0; r < seg; ++r) {
      const float* hl = p.hlocal + ((size_t)((seq * 32 + g) * 7 + r)) * 128;
      float lr_ = hl[lane], li_ = hl[64 + lane];
      float nr = pr_ * hr - pi_ * hi + lr_;
      float ni = pr_ * hi + pi_ * hr + li_;
      hr = nr; hi = ni;
    }
  }
  const int oi = lane & 7, mg = lane >> 3, m0 = mg * 2;
  const float dm0 = p.in[28][lg_ * 16 + m0], dm1 = p.in[28][lg_ * 16 + m0 + 1];
  const int ti = lane >> 3, cp = lane & 7;
  const u16* ubase = p.pbuf + (size_t)(row0 + ti) * NP + C_SU + g * 16 + cp * 2;
  unsigned nxt = *(const unsigned*)(ubase + (size_t)sc_begin * 8 * NP);
  for (int sc = sc_begin; sc < sc_end; ++sc) {
    unsigned cur = nxt;
    if (sc + 1 < sc_end) nxt = *(const unsigned*)(ubase + (size_t)(sc + 1) * 8 * NP);
    ub[ti * 16 + cp * 2] = bf2f((u16)(cur & 0xffff));
    ub[ti * 16 + cp * 2 + 1] = bf2f((u16)(cur >> 16));
    __syncthreads();
#pragma unroll
    for (int i = 0; i < 8; ++i) {
      float bur = 0.f, bui = 0.f;
#pragma unroll
      for (int m4 = 0; m4 < 4; ++m4) {
        f32x4 u4 = *(const f32x4*)(ub + i * 16 + m4 * 4);
#pragma unroll
        for (int x = 0; x < 4; ++x) { bur += bbr[m4 * 4 + x] * u4[x]; bui += bbi[m4 * 4 + x] * u4[x]; }
      }
      float nr = abr * hr - abi * hi + bur;
      float ni = abr * hi + abi * hr + bui;
      hr = nr; hi = ni;
      if (!light) { hre[i * 68 + lane] = hr; him[i * 68 + lane] = hi; }
    }
    __syncthreads();
    if (!light) {
      float y0 = 0.f, y1 = 0.f;
#pragma unroll
      for (int p4 = 0; p4 < 16; ++p4) {
        f32x4 h4r = *(const f32x4*)(hre + oi * 68 + p4 * 4);
        f32x4 h4i = *(const f32x4*)(him + oi * 68 + p4 * 4);
        f32x4 c0r = *(const f32x4*)(cre + m0 * 68 + p4 * 4);
        f32x4 c0i = *(const f32x4*)(cim + m0 * 68 + p4 * 4);
        f32x4 c1r = *(const f32x4*)(cre + (m0 + 1) * 68 + p4 * 4);
        f32x4 c1i = *(const f32x4*)(cim + (m0 + 1) * 68 + p4 * 4);
#pragma unroll
        for (int x = 0; x < 4; ++x) {
          y0 += c0r[x] * h4r[x] - c0i[x] * h4i[x];
          y1 += c1r[x] * h4r[x] - c1i[x] * h4i[x];
        }
      }
      y0 += dm0 * ub[oi * 16 + m0];
      y1 += dm1 * ub[oi * 16 + m0 + 1];
      *(unsigned*)(p.zs5 + (size_t)(row0 + sc * 8 + oi) * ZLD + g * 16 + m0) = pack2(gelu_tanh(y0), gelu_tanh(y1));
      __syncthreads();
    }
  }
  if (light) {
    float* hl = p.hlocal + ((size_t)((seq * 32 + g) * 7 + seg)) * 128;
    hl[lane] = hr; hl[64 + lane] = hi;
  } else if (last_seg) {
    p.out[(prompt ? p.o_s5r_p : p.o_s5r_s) + ((size_t)(l * NB + bidx) * 32 + g) * 64 + lane] = hr;
    p.out[(prompt ? p.o_s5i_p : p.o_s5i_s) + ((size_t)(l * NB + bidx) * 32 + g) * 64 + lane] = hi;
  }
}

__device__ void phase_mixers(const Params& p, int l, int pass, char* smem, int visit) {
  int* s_item = (int*)(smem + 65536);
  unsigned* cnt = p.counters + l * 64 + (pass - 1) * 32 + visit * 16;
  const int nseg = p.nseg;
  const int ns1 = nseg - 1;
  const int n_chain = (pass == 1) ? 96 * ns1 : 96 * nseg;
  const int n_s5 = (pass == 1) ? 64 * ns1 : 64 * nseg;
  const int n_items = n_chain + n_s5 + ((pass == 1) ? 128 * 20 : 0);
  for (;;) {
    if (tidq() == 0) *s_item = (int)atomicAdd(cnt, 1u);
    __syncthreads();
    const int item = *s_item;
    __syncthreads();
    if (item >= n_items) break;
    int mode, seq, sub, seg = 0;
    const int per = (pass == 1) ? ns1 : nseg;
    if (item < n_chain) {
      const int c = item / per; seg = item % per;
      const int kind = c >> 5, r = c & 31;
      seq = r >> 2; sub = r & 3;
      mode = (kind == 0) ? 1 : ((kind == 1) ? 2 : 0);
    } else if (item < n_chain + n_s5) {
      const int k = item - n_chain;
      const int c = k / per; seg = k % per;
      mode = 3; seq = c >> 3; sub = c & 7;
    } else {
      int k = item - n_chain - n_s5; int b = k / 20; sub = k % 20; seq = 8 + b;
      if (sub < 4) mode = 1;
      else if (sub < 8) { mode = 0; sub -= 4; }
      else if (sub < 12) { mode = 2; sub -= 8; }
      else { mode = 3; sub -= 12; }
    }
    const int ps = (seq >= 8) ? 2 : pass;
    if (mode == 0) { if (EN(2) || ONLY == 20) run_chain<0>(p, l, seq, sub, seg, ps, smem); }
    else if (mode == 1) { if (EN(2) || ONLY == 21) run_chain<1>(p, l, seq, sub, seg, ps, smem); }
    else if (mode == 2) { if (EN(2) || ONLY == 22) run_chain<2>(p, l, seq, sub, seg, ps, smem); }
    else { if (EN(2) || ONLY == 23) run_s5(p, l, seq, sub, seg, ps, smem); }
    __syncthreads();
  }
}

DI bool tile_at(int i, int T, int& t) {
  const int bpx = gridDim.x >> 3;
  t = ((blockIdx.x & 7) + 8 * i) * bpx + (blockIdx.x >> 3);
  return t < T;
}
DI void tile_mn(int t, int nN, int& m0, int& n0) {
  const int per = 8 * nN;
  const int grp = t / per, r = t - grp * per;
  m0 = (grp * 8 + (r & 7)) * 128;
  n0 = (r >> 3) * 128;
}

__device__ void run_phase(const Params& p, int ph, char* smem, int visit) {
  constexpr int NMT = MTOK / 128;
  if (ph == 0) { if (EN(9)) phase_convert(p, smem); return; }
  if (ph == NPHASE - 1) {
    if (EN(10)) phase_rownorm(p, false, p.tbuf, p.in[11] + 1 * DM, nullptr, nullptr);
    return;
  }
  const int l = (ph - 1) / 10, s0_ = (ph - 1) % 10;
  const int s = (s0_ <= 2) ? s0_ : s0_ - 1;
  switch (s) {
    case 0:
      if (!EN(0)) break;
      if (l == 0) phase_rownorm(p, true, nullptr, nullptr, p.in[8], p.hb);
      else phase_rownorm(p, false, p.tbuf, p.in[11] + (l - 1) * DM, p.in[8] + l * DM, p.hb);
      break;
    case 1: if (EN(1)) {
      constexpr int NN = NP / 128;
      int t, m0, n0;
      for (int i = 0; tile_at(i, NMT * NN, t); ++i) {
        tile_mn(t, NN, m0, n0);
        gemm_tile<EPI_BF16>(p.hb, HLD, p.wt_in + (size_t)l * NIN * WLD1, WLD1, DM, m0, n0, p.pbuf, NP, nullptr, 0, smem);
      }
    } break;
    case 2: if (EN(2) || (ONLY >= 20 && ONLY <= 23)) phase_mixers(p, l, (s0_ == 2) ? 1 : 2, smem, visit); break;
    case 3: if (EN(3)) {
      constexpr int NG = 32, NGLU = 4;
      {
        const int lane = tidq() & 63, w = tidq() >> 6;
        for (int row = blockIdx.x * 4 + w; row < MTOK; row += gridDim.x * 4) {
          const float4 sq = *(const float4*)(p.ssq + (size_t)row * 4);
          const float ms = (lane < 32) ? (sq.x + sq.y) : (sq.z + sq.w);
          const float r = rsqrtf(ms * (1.f / 256.f) + EPS);
          u16* ptr = p.obuf + (size_t)row * OLD + 512 + lane * 8;
          uint4 v = *(const uint4*)ptr;
          const float* gn = p.in[19] + l * 512 + lane * 8;
          unsigned vw[4] = {v.x, v.y, v.z, v.w};
          unsigned ow[4];
#pragma unroll
          for (int x = 0; x < 4; ++x)
            ow[x] = pack2(bf2f((u16)(vw[x] & 0xffff)) * r * gn[2 * x], bf2f((u16)(vw[x] >> 16)) * r * gn[2 * x + 1]);
          *(uint4*)ptr = make_uint4(ow[0], ow[1], ow[2], ow[3]);
        }
      }
      int t, m0, n0;
      for (int i = 0; tile_at(i, NMT * (NG + NGLU), t); ++i) {
        if (t < NMT * NG) {
          tile_mn(t, NG, m0, n0);
          gemm_tile<EPI_SIG>(p.hb, HLD, p.wt_in + ((size_t)l * NIN + NP) * WLD1, WLD1, DM, m0, n0, p.pbuf, 4096, nullptr, 0, smem);
        } else {
          tile_mn(t - NMT * NG, NGLU, m0, n0);
          gemm_tile<EPI_GLU>(p.zs5, ZLD, p.wt_glu + (size_t)l * 512 * WLD5, WLD5, 512, m0, n0,
                             p.obuf + 1536, OLD, p.zs5, ZLD, smem);
        }
      }
    } break;
    case 4:
      if (EN(4)) {
        int t, m0, n0;
        for (int i = 0; tile_at(i, NMT * 8, t); ++i) { tile_mn(t, 8, m0, n0); merge_tile(p, l, m0, n0, smem); }
      }
      break;
    case 5:
      if (EN(5)) {
        int t, m0, n0;
        for (int i = 0; tile_at(i, NMT * 8, t); ++i) {
          tile_mn(t, 8, m0, n0);
          gemm_tile<EPI_F32>(p.hb, HLD, p.wt_out + (size_t)l * DM * WLD1, WLD1, DM, m0, n0, p.tbuf, DM, nullptr, 0, smem);
        }
      }
      break;
    case 6:
      if (EN(6)) phase_rownorm(p, false, p.tbuf, p.in[9] + l * DM, p.in[10] + l * DM, p.hb);
      break;
    case 7:
      if (EN(7)) {
        int t, m0, n0;
        for (int i = 0; tile_at(i, NMT * 32, t); ++i) {
          tile_mn(t, 32, m0, n0);
          gemm_tile<EPI_RELU2>(p.hb, HLD, p.wt_ff1 + (size_t)l * DFF * WLD1, WLD1, DM, m0, n0, p.pbuf, ULD, nullptr, 0, smem);
        }
      }
      break;
    case 8:
      if (EN(8)) {
        int t, m0, n0;
        for (int i = 0; tile_at(i, NMT * 8, t); ++i) {
          tile_mn(t, 8, m0, n0);
          gemm_tile<EPI_F32>(p.pbuf, ULD, p.wt_ff2 + (size_t)l * DM * WLD4, WLD4, DFF, m0, n0, p.tbuf, DM, nullptr, 0, smem);
        }
      }
      break;
  }
}

#ifndef DUP_S
#define DUP_S -1
#endif
DI void grid_barrier(unsigned* bar, unsigned& gen) {
  asm volatile("s_waitcnt vmcnt(0)" ::: "memory");
  __syncthreads();
  gen += 1;
  if (threadIdx.x == 0) {
    __builtin_amdgcn_fence(__ATOMIC_RELEASE, "agent");
    asm volatile("s_waitcnt vmcnt(0)" ::: "memory");
    __hip_atomic_fetch_add(bar, 1u, __ATOMIC_RELAXED, __HIP_MEMORY_SCOPE_AGENT);
    const unsigned target = gen * gridDim.x;
    while (__hip_atomic_load(bar, __ATOMIC_RELAXED, __HIP_MEMORY_SCOPE_AGENT) < target) __builtin_amdgcn_s_sleep(1);
    __builtin_amdgcn_fence(__ATOMIC_ACQUIRE, "agent");
    asm volatile("s_waitcnt vmcnt(0)" ::: "memory");
  }
  __syncthreads();
}

__global__ void __launch_bounds__(256, 2) mega_kernel(Params p, int ph_lo, int ph_hi) {
  __shared__ __attribute__((aligned(16))) char smem[65536 + 16];
  unsigned gen = 0;
  unsigned* bar = p.counters + 512;
  for (int ph = ph_lo; ph < ph_hi; ++ph) {
    if (ph > ph_lo) {
      if (ph == ph_lo + 1) cg::this_grid().sync();
      else grid_barrier(bar, gen);
    }
    const int reps = (DUP_S >= 0 && ph == 1 + DUP_S) ? 2 : 1;
    for (int r = 0; r < reps; ++r) {
      if (r) grid_barrier(bar, gen);
#ifdef VAR_NOSTORE
      if (tidq() == 0) *(volatile int*)(smem + 65536 + 8) = r;
      __syncthreads();
#endif
      run_phase(p, ph, smem, r);
    }
  }
}

extern "C" void kernel_launch(void* const* d_in, const int* in_sizes, int n_in, void* d_out, int out_size,
                              void* d_ws, size_t ws_size, hipStream_t stream) {
  Params p{};
  for (int i = 0; i < 35; ++i) p.in[i] = (const float*)d_in[i];
  p.out = (float*)d_out;
  char* ws = (char*)d_ws;
  size_t off = 0;
  auto take = [&](size_t bytes) { char* r = ws + off; off += (bytes + 255) & ~(size_t)255; return r; };
  p.wt_in  = (u16*)take((size_t)2 * NIN * WLD1 * 2);
  p.wt_ff1 = (u16*)take((size_t)2 * DFF * WLD1 * 2);
  p.wt_ff2 = (u16*)take((size_t)2 * DM * WLD4 * 2);
  p.wt_br  = (u16*)take((size_t)2 * 4 * DM * WLD5 * 2);
  p.wt_out = (u16*)take((size_t)2 * DM * WLD1 * 2);
  p.wt_glu = (u16*)take((size_t)2 * 512 * WLD5 * 2);
  p.hb     = (u16*)take((size_t)MTOK * HLD * 2);
  p.pbuf   = (u16*)take((size_t)MTOK * NP * 2);
  p.obuf   = (u16*)take((size_t)MTOK * OLD * 2);
  p.zs5    = (u16*)take((size_t)MTOK * ZLD * 2);
  p.counters = (unsigned*)take(4096);
  p.ssq = (float*)take((size_t)MTOK * 4 * 4);
  p.segdec = (float*)take((size_t)96 * 7 * 128 * 4);
  p.hlocal = (float*)take((size_t)8 * 32 * 7 * 128 * 4);
  p.nseg = 8;
  if (off + (size_t)96 * 7 * 32768 > ws_size) p.nseg = 4;
  p.cps = 128 / p.nseg;
  p.slocal = (u16*)take((size_t)96 * (p.nseg - 1) * 32768);
  p.tbuf = (float*)(p.pbuf + (size_t)MTOK * ULD);
  if (off > ws_size) { fprintf(stderr, "workspace too small: need %zu have %zu\n", off, ws_size); return; }
  size_t o = (size_t)MTOK * DM;
  p.o_ret_p = o;  o += (size_t)2 * 8 * 65536;
  p.o_ret_s = o;  o += (size_t)2 * 128 * 65536;
  p.o_ssd_p = o;  o += (size_t)2 * 8 * 65536;
  p.o_ssd_s = o;  o += (size_t)2 * 128 * 65536;
  p.o_conv_p = o; o += (size_t)2 * 8 * 3 * 1024;
  p.o_conv_s = o; o += (size_t)2 * 128 * 3 * 1024;
  p.o_hg_p = o;   o += (size_t)2 * 8 * 65536;
  p.o_hg_s = o;   o += (size_t)2 * 128 * 65536;
  p.o_s5r_p = o;  o += (size_t)2 * 8 * 2048;
  p.o_s5r_s = o;  o += (size_t)2 * 128 * 2048;
  p.o_s5i_p = o;  o += (size_t)2 * 8 * 2048;
  p.o_s5i_s = o;  o += (size_t)2 * 128 * 2048;

  static int grid_blocks = 0;
  if (!grid_blocks) {
    int dev = 0, cus = 0, per_cu = 0;
    hipGetDevice(&dev);
    hipDeviceGetAttribute(&cus, hipDeviceAttributeMultiprocessorCount, dev);
    hipOccupancyMaxActiveBlocksPerMultiprocessor(&per_cu, mega_kernel, 256, 0);
    if (per_cu > 2) per_cu = 2;
    if (per_cu < 1) per_cu = 1;
    grid_blocks = cus * per_cu;
  }
  hipMemsetAsync(p.counters, 0, 4096, stream);
#if SINGLE_LAUNCH
  int lo = 0, hi = NPHASE;
  void* args[] = {&p, &lo, &hi};
  hipError_t e = hipLaunchCooperativeKernel((void*)mega_kernel, dim3(grid_blocks), dim3(256), args, 0, stream);
  if (e != hipSuccess) fprintf(stderr, "cooperative launch failed: %s (grid %d)\n", hipGetErrorString(e), grid_blocks);
#else
  for (int ph = 0; ph < NPHASE; ++ph)
    hipLaunchKernelGGL(mega_kernel, dim3(grid_blocks), dim3(256), 0, stream, p, ph, ph + 1);
#endif
}
```

```cpp
#include <hip/hip_runtime.h>
#include <hip/hip_cooperative_groups.h>
#include <cstdio>
#include <cstdint>
namespace cg = cooperative_groups;

#ifndef SINGLE_LAUNCH
#define SINGLE_LAUNCH 1
#endif
#ifndef ONLY
#define ONLY -1
#endif
#define EN(k) (ONLY < 0 || ONLY == (k))

typedef unsigned short u16;
using bf16x8 = __attribute__((ext_vector_type(8))) short;
using bf16x4 = __attribute__((ext_vector_type(4))) short;
using f32x4  = __attribute__((ext_vector_type(4))) float;
typedef unsigned u32x4 __attribute__((ext_vector_type(4)));
#define DI __device__ __forceinline__
#define MFMA16(a, b, c) __builtin_amdgcn_mfma_f32_16x16x32_bf16((a), (b), (c), 0, 0, 0)

constexpr int MTOK = 17408;
constexpr int MPR  = 16384;
constexpr int DM   = 1024;
constexpr int NP   = 6272;
constexpr int NIN  = 10368;
constexpr int DFF  = 4096;
constexpr int INC  = 10248;
constexpr int C_RQ = 0, C_RK = 512, C_RV = 1024, C_RG = 1536, C_SZ = 2048, C_SXBC = 2560;
constexpr int C_HQ = 3584, C_HF = 4096, C_HI = 4608, C_HG = 5120, C_SU = 5632, C_SDT = 6144;
constexpr float EPS = 1e-6f;
constexpr int HLD = 1024, WLD1 = 1024, ULD = 4096, WLD4 = 4096, OLD = 2048, ZLD = 512, WLD5 = 512;
constexpr int NITEMS = 160 + 128 * 20;
constexpr int NPHASE = 21;

struct Params {
  const float* in[35];
  float* out;
  u16 *wt_in, *wt_ff1, *wt_ff2, *wt_br, *wt_out, *wt_glu;
  u16 *hb, *pbuf, *obuf, *zs5;
  float* tbuf;
  unsigned* counters;
  unsigned* bar;
  float* ssq;
  u16* slocal;
  float* segdec;
  float* hlocal;
  int nseg, cps;
  size_t o_ret_p, o_ret_s, o_ssd_p, o_ssd_s, o_conv_p, o_conv_s, o_hg_p, o_hg_s, o_s5r_p, o_s5r_s, o_s5i_p, o_s5i_s;
};

DI int tidq() { int t = threadIdx.x; asm volatile("" : "+v"(t)); return t; }
typedef __bf16 bf16v2 __attribute__((ext_vector_type(2)));
typedef float f32v2 __attribute__((ext_vector_type(2)));
DI unsigned pack2(float a, float b) { f32v2 v = {a, b}; return __builtin_bit_cast(unsigned, __builtin_convertvector(v, bf16v2)); }
DI u16 f2bf(float f) { return (u16)(pack2(f, 0.f) & 0xffffu); }
DI float bf2f(u16 h) { return __uint_as_float(((unsigned)h) << 16); }
DI float sigmoidf_(float x) { return 1.f / (1.f + __expf(-x)); }
DI float siluf_(float x) { return x / (1.f + __expf(-x)); }
DI float softplusf_(float x) { return x > 20.f ? x : log1pf(__expf(x)); }
DI float gelu_tanh(float x) {
  float u = 0.7978845608028654f * (x + 0.044715f * x * x * x);
  float e = __expf(2.f * u);
  float th = 1.f - 2.f / (e + 1.f);
  return 0.5f * x * (1.f + th);
}
DI float wave_sum(float v) {
#pragma unroll
  for (int m = 32; m >= 1; m >>= 1) v += __shfl_xor(v, m);
  return v;
}
DI float sum16(float v) {
#pragma unroll
  for (int m = 8; m >= 1; m >>= 1) v += __shfl_xor(v, m);
  return v;
}
DI void sincos_red(float a, float& s, float& c) {
  float n = rintf(a * 0.15915494309189535f);
  float r = fmaf(-n, 6.28125f, a);
  r = fmaf(-n, 1.9353071795864769e-3f, r);
  s = __sinf(r); c = __cosf(r);
}

DI int map_win(int my) {
  if (my < 3584) return my;
  if (my < 6144) return my + 8;
  if (my < 6152) return my - 6144 + 3584;
  if (my < 6272) return -1;
  return my - 120;
}
DI void transpose_tile(const float* __restrict__ src, int src_ld, u16* __restrict__ dst, int dst_ld,
                       int k0, int n0, int mapmode, char* smem) {
  float* tile = (float*)smem;
  const int tid = tidq();
  {
    const int n = tid & 63;
    int sc = n0 + n;
    if (mapmode) sc = map_win(sc);
#pragma unroll
    for (int i = 0; i < 16; ++i) {
      int k = (tid >> 6) + 4 * i;
      float v = (sc >= 0) ? src[(size_t)(k0 + k) * src_ld + sc] : 0.f;
      tile[n * 65 + k] = v;
    }
  }
  __syncthreads();
  {
    const int n = tid >> 2, kc = (tid & 3) * 16;
    unsigned pk[8];
#pragma unroll
    for (int x = 0; x < 8; ++x) pk[x] = pack2(tile[n * 65 + kc + 2 * x], tile[n * 65 + kc + 2 * x + 1]);
    uint4* d = (uint4*)(dst + (size_t)(n0 + n) * dst_ld + k0 + kc);
    d[0] = make_uint4(pk[0], pk[1], pk[2], pk[3]);
    d[1] = make_uint4(pk[4], pk[5], pk[6], pk[7]);
  }
  __syncthreads();
}

__device__ void phase_convert(const Params& p, char* smem) {
  constexpr int PER = 5472;
  for (int t = blockIdx.x; t < 2 * PER; t += gridDim.x) {
    int l = t / PER, r = t % PER;
    if (r < 2592) {
      int nt = r / 16, kt = r % 16;
      transpose_tile(p.in[12] + (size_t)l * DM * INC, INC, p.wt_in + (size_t)l * NIN * WLD1, WLD1, kt * 64, nt * 64, 1, smem);
    } else if (r < 3616) {
      r -= 2592; int nt = r / 16, kt = r % 16;
      transpose_tile(p.in[33] + (size_t)l * DM * DFF, DFF, p.wt_ff1 + (size_t)l * DFF * WLD1, WLD1, kt * 64, nt * 64, 0, smem);
    } else if (r < 4640) {
      r -= 3616; int nt = r / 64, kt = r % 64;
      transpose_tile(p.in[34] + (size_t)l * DFF * DM, DM, p.wt_ff2 + (size_t)l * DM * WLD4, WLD4, kt * 64, nt * 64, 0, smem);
    } else if (r < 4896) {
      r -= 4640; int nt = r / 16, kt = r % 16;
      transpose_tile(p.in[32] + (size_t)l * DM * DM, DM, p.wt_out + (size_t)l * DM * WLD1, WLD1, kt * 64, nt * 64, 0, smem);
    } else if (r < 5408) {
      r -= 4896; int b = r / 128; r %= 128; int nt = r / 8, kt = r % 8;
      transpose_tile(p.in[31] + (size_t)(l * 4 + b) * 512 * DM, DM, p.wt_br + (size_t)(l * 4 + b) * DM * WLD5, WLD5, kt * 64, nt * 64, 0, smem);
    } else {
      r -= 5408; int nt = r / 8, kt = r % 8;
      transpose_tile(p.in[30] + (size_t)l * 512 * 512, 512, p.wt_glu + (size_t)l * 512 * WLD5, WLD5, kt * 64, nt * 64, 0, smem);
    }
  }
}

__device__ void phase_rownorm(const Params& p, bool from_input, const float* __restrict__ t, const float* __restrict__ gpost,
                              const float* __restrict__ gpre, u16* __restrict__ hout) {
  const int lane = tidq() & 63, w = tidq() >> 6;
  float* xbuf = p.out;
  for (int row = blockIdx.x * 4 + w; row < MTOK; row += gridDim.x * 4) {
    const float* xin = from_input ? (row < MPR ? p.in[0] + (size_t)row * DM : p.in[1] + (size_t)(row - MPR) * DM)
                                  : xbuf + (size_t)row * DM;
    float4 x[4];
#pragma unroll
    for (int k = 0; k < 4; ++k) x[k] = *(const float4*)(xin + lane * 4 + 256 * k);
    if (t) {
      float4 tv[4];
      float ss = 0.f;
#pragma unroll
      for (int k = 0; k < 4; ++k) {
        tv[k] = *(const float4*)(t + (size_t)row * DM + lane * 4 + 256 * k);
        ss += tv[k].x * tv[k].x + tv[k].y * tv[k].y + tv[k].z * tv[k].z + tv[k].w * tv[k].w;
      }
      ss = wave_sum(ss);
      float r = rsqrtf(ss * (1.f / DM) + EPS);
#pragma unroll
      for (int k = 0; k < 4; ++k) {
        float4 g = *(const float4*)(gpost + lane * 4 + 256 * k);
        x[k].x += tv[k].x * r * g.x; x[k].y += tv[k].y * r * g.y; x[k].z += tv[k].z * r * g.z; x[k].w += tv[k].w * r * g.w;
      }
    }
#pragma unroll
    for (int k = 0; k < 4; ++k) *(float4*)(xbuf + (size_t)row * DM + lane * 4 + 256 * k) = x[k];
    if (hout) {
      float ss = 0.f;
#pragma unroll
      for (int k = 0; k < 4; ++k) ss += x[k].x * x[k].x + x[k].y * x[k].y + x[k].z * x[k].z + x[k].w * x[k].w;
      ss = wave_sum(ss);
      float r = rsqrtf(ss * (1.f / DM) + EPS);
#pragma unroll
      for (int k = 0; k < 4; ++k) {
        float4 g = *(const float4*)(gpre + lane * 4 + 256 * k);
        uint2 o;
        o.x = pack2(x[k].x * r * g.x, x[k].y * r * g.y);
        o.y = pack2(x[k].z * r * g.z, x[k].w * r * g.w);
        *(uint2*)(hout + (size_t)row * HLD + lane * 4 + 256 * k) = o;
      }
    }
  }
}

DI int swz(int r, int c) { return r * 128 + ((c ^ ((r >> 1) & 7)) << 4); }

#define GEMM_COMPUTE(AS_) do { const char* as_ = (AS_); const char* bs_ = as_ + 16384; \
  _Pragma("unroll") for (int s_ = 0; s_ < 2; ++s_) { \
    bf16x8 af_[4], bfr_[4]; \
    _Pragma("unroll") for (int i_ = 0; i_ < 4; ++i_) af_[i_] = *(const bf16x8*)(as_ + swz(wm * 64 + i_ * 16 + r16, s_ * 4 + quad)); \
    _Pragma("unroll") for (int j_ = 0; j_ < 4; ++j_) bfr_[j_] = *(const bf16x8*)(bs_ + swz(wn * 64 + j_ * 16 + r16, s_ * 4 + quad)); \
    _Pragma("unroll") for (int i_ = 0; i_ < 4; ++i_) \
      _Pragma("unroll") for (int j_ = 0; j_ < 4; ++j_) acc[i_][j_] = MFMA16(bfr_[j_], af_[i_], acc[i_][j_]); \
  } } while (0)

struct Stage { u32x4 a0, a1, a2, a3, b0, b1, b2, b3; };
DI void gload(Stage& s, const u16* ag, const u16* bg, int lda, int ldb, int kt) {
  s.a0 = *(const u32x4*)(ag + (size_t)0 * 32 * lda + kt * 64);
  s.a1 = *(const u32x4*)(ag + (size_t)1 * 32 * lda + kt * 64);
  s.a2 = *(const u32x4*)(ag + (size_t)2 * 32 * lda + kt * 64);
  s.a3 = *(const u32x4*)(ag + (size_t)3 * 32 * lda + kt * 64);
  s.b0 = *(const u32x4*)(bg + (size_t)0 * 32 * ldb + kt * 64);
  s.b1 = *(const u32x4*)(bg + (size_t)1 * 32 * ldb + kt * 64);
  s.b2 = *(const u32x4*)(bg + (size_t)2 * 32 * ldb + kt * 64);
  s.b3 = *(const u32x4*)(bg + (size_t)3 * 32 * ldb + kt * 64);
}
DI void lwrite(const Stage& s, char* d, int lr, int lc) {
  *(u32x4*)(d + swz(lr, lc)) = s.a0;
  *(u32x4*)(d + swz(lr + 32, lc)) = s.a1;
  *(u32x4*)(d + swz(lr + 64, lc)) = s.a2;
  *(u32x4*)(d + swz(lr + 96, lc)) = s.a3;
  *(u32x4*)(d + 16384 + swz(lr, lc)) = s.b0;
  *(u32x4*)(d + 16384 + swz(lr + 32, lc)) = s.b1;
  *(u32x4*)(d + 16384 + swz(lr + 64, lc)) = s.b2;
  *(u32x4*)(d + 16384 + swz(lr + 96, lc)) = s.b3;
}

template <bool DEEP>
DI void gemm_kloop(f32x4 (&acc)[4][4], const u16* __restrict__ A, int lda, const u16* __restrict__ Bt, int ldb,
                   int K, int m0, int n0, char* smem) {
  const int tid = tidq(), lane = tid & 63, w = tid >> 6, wm = w >> 1, wn = w & 1, r16 = lane & 15, quad = lane >> 4;
  const int lr = tid >> 3, lc = tid & 7;
  const u16* ag = A + (size_t)(m0 + lr) * lda + lc * 8;
  const u16* bg = Bt + (size_t)(n0 + lr) * ldb + lc * 8;
  const int nk = K >> 6;
  Stage s0;
  gload(s0, ag, bg, lda, ldb, 0);
  if (DEEP) {
    Stage s1;
    gload(s1, ag, bg, lda, ldb, 1);
    lwrite(s0, smem, lr, lc);
    __syncthreads();
    for (int kt = 0; kt < nk; kt += 2) {
      if (kt + 2 < nk) gload(s0, ag, bg, lda, ldb, kt + 2);
      GEMM_COMPUTE(smem);
      lwrite(s1, smem + 32768, lr, lc);
      __syncthreads();
      if (kt + 3 < nk) gload(s1, ag, bg, lda, ldb, kt + 3);
      GEMM_COMPUTE(smem + 32768);
      if (kt + 2 < nk) lwrite(s0, smem, lr, lc);
      __syncthreads();
    }
  } else {
    lwrite(s0, smem, lr, lc);
    __syncthreads();
    for (int kt = 0; kt < nk; ++kt) {
      const bool more = (kt + 1 < nk);
      if (more) gload(s0, ag, bg, lda, ldb, kt + 1);
      GEMM_COMPUTE(smem + (kt & 1) * 32768);
      if (more) lwrite(s0, smem + ((kt + 1) & 1) * 32768, lr, lc);
      __syncthreads();
    }
  }
}

DI void zero_acc(f32x4 (&acc)[4][4]) {
#pragma unroll
  for (int i = 0; i < 4; ++i)
#pragma unroll
    for (int j = 0; j < 4; ++j) acc[i][j] = f32x4{0.f, 0.f, 0.f, 0.f};
}

enum { EPI_BF16 = 0, EPI_SIG = 1, EPI_RELU2 = 2, EPI_F32 = 3, EPI_GLU = 4 };

template <int EPI>
DI void gemm_tile(const u16* A, int lda, const u16* Bt, int ldb, int K, int m0, int n0,
                  void* outp, int ldc, const u16* aux, int ldaux, char* smem) {
  f32x4 acc[4][4];
  zero_acc(acc);
  gemm_kloop<true>(acc, A, lda, Bt, ldb, K, m0, n0, smem);
#ifdef VAR_NOSTORE
  if (*(volatile int*)(smem + 65536 + 8) == 1 && acc[0][0][0] != 12345.678f) return;
#endif
  const int lane = tidq() & 63, w = tidq() >> 6, wm = w >> 1, wn = w & 1, r16 = lane & 15, quad = lane >> 4;
#pragma unroll
  for (int i = 0; i < 4; ++i) {
    const int m = m0 + wm * 64 + i * 16 + r16;
#pragma unroll
    for (int j = 0; j < 4; ++j) {
      const int n = n0 + wn * 64 + j * 16 + quad * 4;
      f32x4 v = acc[i][j];
      if (EPI == EPI_F32) {
        *(float4*)((float*)outp + (size_t)m * ldc + n) = make_float4(v[0], v[1], v[2], v[3]);
      } else {
        if (EPI == EPI_SIG) {
#pragma unroll
          for (int x = 0; x < 4; ++x) v[x] = sigmoidf_(v[x]);
        } else if (EPI == EPI_RELU2) {
#pragma unroll
          for (int x = 0; x < 4; ++x) { float r = fmaxf(v[x], 0.f); v[x] = r * r; }
        } else if (EPI == EPI_GLU) {
          uint2 zz = *(const uint2*)(aux + (size_t)m * ldaux + n);
          v[0] = bf2f((u16)(zz.x & 0xffff)) * sigmoidf_(v[0]);
          v[1] = bf2f((u16)(zz.x >> 16)) * sigmoidf_(v[1]);
          v[2] = bf2f((u16)(zz.y & 0xffff)) * sigmoidf_(v[2]);
          v[3] = bf2f((u16)(zz.y >> 16)) * sigmoidf_(v[3]);
        }
        uint2 o; o.x = pack2(v[0], v[1]); o.y = pack2(v[2], v[3]);
        *(uint2*)((u16*)outp + (size_t)m * ldc + n) = o;
      }
    }
  }
}

DI void merge_tile(const Params& p, int l, int m0, int n0, char* smem) {
  f32x4 macc[4][4];
  zero_acc(macc);
  const int lane = tidq() & 63, w = tidq() >> 6, wm = w >> 1, wn = w & 1, r16 = lane & 15, quad = lane >> 4;
  const u16* gates = p.pbuf;
  for (int b = 0; b < 4; ++b) {
    f32x4 acc[4][4];
    zero_acc(acc);
    gemm_kloop<false>(acc, p.obuf + b * 512, OLD, p.wt_br + (size_t)(l * 4 + b) * DM * WLD5, WLD5, 512, m0, n0, smem);
#pragma unroll
    for (int i = 0; i < 4; ++i) {
      const int m = m0 + wm * 64 + i * 16 + r16;
#pragma unroll
      for (int j = 0; j < 4; ++j) {
        const int n = n0 + wn * 64 + j * 16 + quad * 4;
        uint2 gg = *(const uint2*)(gates + (size_t)m * 4096 + b * 1024 + n);
        macc[i][j][0] += bf2f((u16)(gg.x & 0xffff)) * acc[i][j][0];
        macc[i][j][1] += bf2f((u16)(gg.x >> 16)) * acc[i][j][1];
        macc[i][j][2] += bf2f((u16)(gg.y & 0xffff)) * acc[i][j][2];
        macc[i][j][3] += bf2f((u16)(gg.y >> 16)) * acc[i][j][3];
      }
    }
  }
#pragma unroll
  for (int i = 0; i < 4; ++i) {
    const int m = m0 + wm * 64 + i * 16 + r16;
#pragma unroll
    for (int j = 0; j < 4; ++j) {
      const int n = n0 + wn * 64 + j * 16 + quad * 4;
      uint2 o; o.x = pack2(macc[i][j][0], macc[i][j][1]); o.y = pack2(macc[i][j][2], macc[i][j][3]);
      *(uint2*)(p.hb + (size_t)m * HLD + n) = o;
    }
  }
}

constexpr int QS = 136;
constexpr int TS = 20;
constexpr int OFS = 260;

template <int MODE>
__device__ void run_chain(const Params& p, int l, int seq, int sub, int seg, int pass, char* smem) {
  constexpr int NE = 2;
  const int tid = tidq(), lane = tid & 63, w = tid >> 6, r16 = lane & 15, quad = lane >> 4;
  const bool prompt = seq < 8;
  const int bidx = prompt ? seq : seq - 8;
  const int NB = prompt ? 8 : 128;
  const int L = prompt ? 2048 : 8;
  const int row0 = prompt ? seq * 2048 : MPR + (seq - 8) * 8;
  const int pos0 = prompt ? 0 : 16384;
  const int cps = p.cps;
  const int ch_begin = prompt ? seg * cps : 0;
  const int ch_end = prompt ? ch_begin + cps : 1;
  const bool light = prompt && (pass == 1);
  const bool last_seg = !prompt || (seg == p.nseg - 1);
  const int cid = seq * 12 + MODE * 4 + sub;

  u16* Qa = (u16*)smem;
  u16* Ka = (u16*)(smem + 4352);
  u16* KuT = (u16*)(smem + 8704);
  u16* VaT = (u16*)(smem + 13824);
  u16* VuT = (MODE == 1) ? (u16*)(smem + 24064) : VaT;
  float* Of = (float*)(smem + 34304);
  u16* Raw = (u16*)(smem + 34304);
  u16* Xc = (u16*)(smem + 50944);
  float* tot = (float*)(smem + 55040);
  float* cdec = (float*)(smem + 59136);
  float* dtl = (float*)(smem + 59392);
  float* rsc = (float*)(smem + 59648);
  float* clast = (float*)(smem + 60160);
  float* segacc = (float*)(smem + 60176);

  const float* sin_ = nullptr;
  float* sout = nullptr;
  if (MODE == 0) {
    if (!prompt) sin_ = p.in[2] + (((size_t)l * 128 + bidx) * 4 + sub) * 16384;
    sout = p.out + (prompt ? p.o_ret_p : p.o_ret_s) + (((size_t)l * NB + bidx) * 4 + sub) * 16384;
  } else if (MODE == 2) {
    if (!prompt) sin_ = p.in[5] + (((size_t)l * 128 + bidx) * 4 + sub) * 16384;
    sout = p.out + (prompt ? p.o_hg_p : p.o_hg_s) + (((size_t)l * NB + bidx) * 4 + sub) * 16384;
  } else {
    if (!prompt) sin_ = p.in[3] + (((size_t)l * 128 + bidx) * 8 + sub * 2 + (w >> 1)) * 8192;
    sout = p.out + (prompt ? p.o_ssd_p : p.o_ssd_s) + (((size_t)l * NB + bidx) * 8 + sub * 2 + (w >> 1)) * 8192;
  }

  float lg = 0.f;
  if (MODE == 0) lg = log1pf(-exp2f(-5.f - (float)sub));

  int sbase = (MODE == 1) ? (((w & 1) * 32 + r16) * 128 + quad * 4) : (quad * 512 + w * 32 + r16);
  asm volatile("" : "+v"(sbase));
  f32x4 S[8][NE];
#pragma unroll
  for (int t = 0; t < 8; ++t)
#pragma unroll
    for (int u = 0; u < NE; ++u) {
      if (sin_) {
        if (MODE == 1) {
          S[t][u] = *(const f32x4*)(sin_ + sbase + u * 2048 + t * 16);
        } else {
#pragma unroll
          for (int jj = 0; jj < 4; ++jj) S[t][u][jj] = sin_[sbase + t * 2048 + jj * 128 + u * 16];
        }
      } else {
        S[t][u] = f32x4{0.f, 0.f, 0.f, 0.f};
      }
    }
  if (prompt && pass == 2) {
    for (int r = 0; r < seg; ++r) {
      const uint2* sl = (const uint2*)(p.slocal + (size_t)(cid * (p.nseg - 1) + r) * 16384) + tid;
      const float* sd = p.segdec + (size_t)(cid * 7 + r) * 128;
      float dsc = 1.f;
      if (MODE == 0) dsc = __expf(lg * (float)(16 * cps));
      if (MODE == 1) dsc = __expf(sd[w >> 1]);
#pragma unroll
      for (int t = 0; t < 8; ++t) {
        f32x4 dv = f32x4{dsc, dsc, dsc, dsc};
        if (MODE == 2) {
          f32x4 lv = *(const f32x4*)(sd + t * 16 + quad * 4);
          dv = f32x4{__expf(lv[0]), __expf(lv[1]), __expf(lv[2]), __expf(lv[3])};
        }
#pragma unroll
        for (int u = 0; u < NE; ++u) {
          uint2 pk = sl[(t * NE + u) * 256];
          S[t][u][0] = S[t][u][0] * dv[0] + bf2f((u16)(pk.x & 0xffff));
          S[t][u][1] = S[t][u][1] * dv[1] + bf2f((u16)(pk.x >> 16));
          S[t][u][2] = S[t][u][2] * dv[2] + bf2f((u16)(pk.y & 0xffff));
          S[t][u][3] = S[t][u][3] * dv[3] + bf2f((u16)(pk.y >> 16));
        }
      }
    }
  }

  float lbv = 0.f;
  float hg_tot = 0.f;
  float cprev[2][3];
  float cw[2][4], cb[2];
  int ccidx[2];
  float dt_bias = 0.f, dt_A = 0.f;
  float rinv = 0.f, rcD = 1.f, rsD = 0.f;
  const int gg = sub >> 1, pair = sub & 1;
  if (MODE == 0) {
    rinv = exp2f(-(float)(tid & 63) * (13.287712379549449f / 64.f));
    rsD = __sinf(rinv); rcD = __cosf(rinv);
  }
  if (MODE == 2) {
    if (l == 1) {
      float a0 = p.in[20][sub * 128 + (tid & 127)], a1 = p.in[20][512 + sub * 128 + (tid & 127)];
      float mx = fmaxf(a0, a1);
      float e0 = __expf(a0 - mx), e1 = __expf(a1 - mx);
      lbv = e1 / (e0 + e1);
    }
  }
  if (MODE == 1) {
    if (tid < 32) {
      const int hh = sub * 2 + (tid >> 4);
      dt_A = -__expf(p.in[16][l * 8 + hh]);
      dt_bias = p.in[17][l * 8 + hh];
    }
    if (tid < 2) segacc[tid] = 0.f;
#pragma unroll
    for (int k = 0; k < 2; ++k) {
      int ci = tid + 256 * k;
      int cc = 0;
      if (ci < 128) cc = gg * 256 + pair * 128 + ci;
      else if (ci < 256) cc = 512 + gg * 128 + (ci - 128);
      else cc = 768 + gg * 128 + (ci - 256);
      if (ci >= 384) cc = 0;
      ccidx[k] = cc;
#pragma unroll
      for (int j = 0; j < 4; ++j) cw[k][j] = p.in[14][((size_t)l * 4 + j) * 1024 + cc];
      cb[k] = p.in[15][l * 1024 + cc];
#pragma unroll
      for (int j = 0; j < 3; ++j) {
        float v = 0.f;
        if (!prompt) v = p.in[4][(((size_t)l * 128 + bidx) * 3 + j) * 1024 + cc];
        else if (ch_begin > 0) v = bf2f(p.pbuf[(size_t)(row0 + ch_begin * 16 - 3 + j) * NP + C_SXBC + cc]);
        cprev[k][j] = v;
      }
    }
  }

  const int lt = tid >> 4, lc = tid & 15;
  uint4 r0, r1, r2, g0;
  unsigned rdt = 0;
  const uint4 z4 = make_uint4(0, 0, 0, 0);
  r0 = r1 = r2 = g0 = z4;
  auto load_raw = [&](int ch) {
    const int t0 = ch * 16;
    const int nv = (L - t0 < 16) ? (L - t0) : 16;
    const u16* Pr = p.pbuf + (size_t)(row0 + t0 + lt) * NP;
    r0 = r1 = r2 = g0 = z4;
    rdt = 0;
    if (lt < nv) {
      if (MODE == 0) {
        r0 = *(const uint4*)(Pr + C_RQ + sub * 128 + lc * 8);
        r1 = *(const uint4*)(Pr + C_RK + sub * 128 + lc * 8);
        r2 = *(const uint4*)(Pr + C_RV + sub * 128 + lc * 8);
        g0 = *(const uint4*)(Pr + C_RG + sub * 128 + lc * 8);
      } else if (MODE == 2) {
        r0 = *(const uint4*)(Pr + C_HQ + sub * 128 + lc * 8);
        r1 = *(const uint4*)(Pr + C_HF + sub * 128 + lc * 8);
        r2 = *(const uint4*)(Pr + C_HI + sub * 128 + lc * 8);
        g0 = *(const uint4*)(Pr + C_HG + sub * 128 + lc * 8);
      } else {
        r0 = *(const uint4*)(Pr + C_SXBC + gg * 256 + pair * 128 + lc * 8);
        r1 = *(const uint4*)(Pr + C_SXBC + 512 + gg * 128 + lc * 8);
        r2 = *(const uint4*)(Pr + C_SXBC + 768 + gg * 128 + lc * 8);
        g0 = *(const uint4*)(Pr + C_SZ + gg * 256 + pair * 128 + lc * 8);
        if (lc < 2) rdt = Pr[C_SDT + sub * 2 + lc];
      }
    }
  };
  load_raw(ch_begin);

  for (int ch = ch_begin; ch < ch_end; ++ch) {
    const int t0 = ch * 16;
    const int nvalid = (L - t0 < 16) ? (L - t0) : 16;
    float sscale = 1.f;
    int tidv = threadIdx.x;
    asm volatile("" : "+v"(tidv));
    const int tid = tidv, lane = tid & 63, w = tid >> 6, r16 = lane & 15, quad = lane >> 4, lt = tid >> 4, lc = tid & 15;

    *(uint4*)(Raw + lt * 128 + lc * 8) = r0;
    *(uint4*)(Raw + 2048 + lt * 128 + lc * 8) = r1;
    *(uint4*)(Raw + 4096 + lt * 128 + lc * 8) = r2;
    if (MODE == 1) { if (lc < 2) Raw[6144 + lt * 2 + lc] = (u16)rdt; }
    const uint4 gc0 = g0;
    __syncthreads();
    if (ch + 1 < ch_end) load_raw(ch + 1);

    if (MODE == 0) {
      const int which = tid >> 7, pr = tid & 63, th = (tid >> 6) & 1;
      if (which == 1 || !light) {
        const u16* R = Raw + which * 2048;
        float sn, cs;
        sincos_red((float)(pos0 + t0 + th * 8) * rinv, sn, cs);
#pragma unroll
        for (int x = 0; x < 8; ++x) {
          const int t = th * 8 + x;
          float x1 = bf2f(R[t * 128 + pr]);
          float x2 = bf2f(R[t * 128 + pr + 64]);
          float y1 = x1 * cs - x2 * sn, y2 = x1 * sn + x2 * cs;
          if (which) {
            y1 *= 0.08838834764831845f; y2 *= 0.08838834764831845f;
            Ka[t * QS + pr] = f2bf(y1); Ka[t * QS + pr + 64] = f2bf(y2);
            float kd = __expf(lg * (float)(nvalid - 1 - t));
            KuT[pr * TS + t] = f2bf(y1 * kd);
            KuT[(pr + 64) * TS + t] = f2bf(y2 * kd);
          } else {
            Qa[t * QS + pr] = f2bf(y1); Qa[t * QS + pr + 64] = f2bf(y2);
          }
          float ncs = cs * rcD - sn * rsD;
          sn = sn * rcD + cs * rsD; cs = ncs;
        }
      }
      if (tid < 16) cdec[tid] = lg * (float)(tid + 1);
      sscale = __expf(lg * (float)nvalid);
    } else if (MODE == 2) {
      const int d = tid & 127, th = tid >> 7;
      float cl[8], kk[8], qv[8];
      float c = 0.f;
#pragma unroll
      for (int x = 0; x < 8; ++x) {
        const int t = th * 8 + x;
        kk[x] = 0.f; qv[x] = 0.f;
        if (t < nvalid) {
          float z = bf2f(Raw[2048 + t * 128 + d]);
          float sg = sigmoidf_(z);
          float f = lbv + (1.f - lbv) * sg;
          c += __logf(f);
          kk[x] = (1.f - lbv) * (1.f - sg);
          if (!light) qv[x] = siluf_(bf2f(Raw[t * 128 + d]));
        }
        cl[x] = c;
      }
      tot[th * 128 + d] = c;
      __syncthreads();
      const float c_lo = tot[d];
      const float c_all = c_lo + tot[128 + d];
      const float off = th ? c_lo : 0.f;
#pragma unroll
      for (int x = 0; x < 8; ++x) {
        const int t = th * 8 + x;
        const float ct = off + cl[x];
        if (!light) {
          Qa[t * QS + d] = f2bf(qv[x] * __expf(ct));
          Ka[t * QS + d] = f2bf(kk[x] * __expf(-ct));
        }
        KuT[d * TS + t] = f2bf(kk[x] * __expf(c_all - ct));
      }
      if (th == 0) { rsc[d] = __expf(c_all); hg_tot += c_all; }
    } else {
      if (tid < 32) {
        const int hl = tid >> 4, t = tid & 15;
        float dtv = 0.f, c = 0.f;
        if (t < nvalid) {
          dtv = softplusf_(bf2f(Raw[6144 + t * 2 + hl]) + dt_bias);
          c = dtv * dt_A;
        }
#pragma unroll
        for (int o = 1; o < 16; o <<= 1) {
          float v = __shfl_up(c, o, 16);
          if (t >= o) c += v;
        }
        cdec[hl * 16 + t] = c;
        dtl[hl * 16 + t] = dtv;
        if (t == 15) { clast[hl] = c; segacc[hl] += c; }
      }
      __syncthreads();
#pragma unroll
      for (int k = 0; k < 2; ++k) {
        const int ci = tid + 256 * k;
        if (ci < 256 || (ci < 384 && !light)) {
          const int hl = (ci < 128) ? (ci >> 6) : 0;
          const float cl = clast[hl];
          const u16* R = Raw + ((ci < 128) ? ci : ((ci < 256) ? (2048 + (ci - 128)) : (4096 + (ci - 256))));
#pragma unroll 4
          for (int t = 0; t < 16; ++t) {
            float v = 0.f;
            if (t < nvalid) {
              float raw = bf2f(R[t * 128]);
              float o = cb[k] + cprev[k][0] * cw[k][0] + cprev[k][1] * cw[k][1] + cprev[k][2] * cw[k][2] + raw * cw[k][3];
              cprev[k][0] = cprev[k][1]; cprev[k][1] = cprev[k][2]; cprev[k][2] = raw;
              v = siluf_(o);
            }
            if (ci < 128) {
              float dtv = dtl[hl * 16 + t];
              if (!light) { Xc[t * 128 + ci] = f2bf(v); VaT[ci * TS + t] = f2bf(v * dtv); }
              VuT[ci * TS + t] = f2bf(v * dtv * __expf(cl - cdec[hl * 16 + t]));
            } else if (ci < 256) {
              u16 a = f2bf(v);
              if (!light) Ka[t * QS + (ci - 128)] = a;
              KuT[(ci - 128) * TS + t] = a;
            } else {
              Qa[t * QS + (ci - 256)] = f2bf(v);
            }
          }
        }
      }
    }
    if (MODE != 1) {
      const int e = tid & 127, th = tid >> 7;
#pragma unroll
      for (int x = 0; x < 4; ++x) {
        const int t = th * 8 + 2 * x;
        unsigned lo = Raw[4096 + t * 128 + e], hi = Raw[4096 + (t + 1) * 128 + e];
        *(unsigned*)(VaT + e * TS + t) = lo | (hi << 16);
      }
    }
    __syncthreads();

    {
      const float* cd = cdec + ((MODE == 1) ? (w >> 1) * 16 : 0);
      bf16x8 attA;
      float rr[4];
      bf16x8 qf[4];
      if (!light) {
        f32x4 at = f32x4{0.f, 0.f, 0.f, 0.f};
#pragma unroll
        for (int s = 0; s < 4; ++s) {
          bf16x8 a = *(const bf16x8*)(Ka + r16 * QS + s * 32 + quad * 8);
          bf16x8 b = *(const bf16x8*)(Qa + r16 * QS + s * 32 + quad * 8);
          at = MFMA16(a, b, at);
        }
        float ci_ = (MODE != 2) ? cd[r16] : 0.f;
        float vv[4];
#pragma unroll
        for (int jj = 0; jj < 4; ++jj) {
          int j = quad * 4 + jj;
          float v = at[jj];
          if (MODE != 2) v *= __expf(fminf(ci_ - cd[j], 0.f));
          vv[jj] = (j <= r16) ? v : 0.f;
        }
        unsigned a01 = pack2(vv[0], vv[1]), a23 = pack2(vv[2], vv[3]);
        attA = __builtin_bit_cast(bf16x8, (u32x4){a01, a23, 0u, 0u});
#pragma unroll
        for (int jj = 0; jj < 4; ++jj) rr[jj] = (MODE != 2) ? __expf(cd[quad * 4 + jj]) : 1.f;
#pragma unroll
        for (int s = 0; s < 4; ++s) {
          bf16x4 lo = *(const bf16x4*)(Qa + r16 * QS + s * 32 + quad * 4);
          bf16x4 hi = *(const bf16x4*)(Qa + r16 * QS + s * 32 + 16 + quad * 4);
          qf[s] = bf16x8{lo[0], lo[1], lo[2], lo[3], hi[0], hi[1], hi[2], hi[3]};
        }
      }
      __syncthreads();
      if (!light) {
#pragma unroll
        for (int u = 0; u < NE; ++u) {
          const int e0 = (w * NE + u) * 16;
          bf16x4 v4 = *(const bf16x4*)(VaT + (e0 + r16) * TS + quad * 4);
          bf16x8 vb = bf16x8{v4[0], v4[1], v4[2], v4[3], 0, 0, 0, 0};
          f32x4 o1 = MFMA16(attA, vb, (f32x4{0.f, 0.f, 0.f, 0.f}));
          f32x4 o2 = f32x4{0.f, 0.f, 0.f, 0.f};
#pragma unroll
          for (int s = 0; s < 4; ++s) {
            u32x4 sp = {pack2(S[2 * s][u][0], S[2 * s][u][1]), pack2(S[2 * s][u][2], S[2 * s][u][3]),
                        pack2(S[2 * s + 1][u][0], S[2 * s + 1][u][1]), pack2(S[2 * s + 1][u][2], S[2 * s + 1][u][3])};
            o2 = MFMA16(qf[s], __builtin_bit_cast(bf16x8, sp), o2);
          }
#pragma unroll
          for (int jj = 0; jj < 4; ++jj) Of[(quad * 4 + jj) * OFS + e0 + r16] = o1[jj] + rr[jj] * o2[jj];
        }
      }
      float hs = 1.f;
      if (MODE == 0) hs = sscale;
      if (MODE == 1) hs = __expf(clast[w >> 1]);
#pragma unroll
      for (int u = 0; u < NE; ++u) {
        const int e0 = (w * NE + u) * 16;
        bf16x4 v4 = *(const bf16x4*)(VuT + (e0 + r16) * TS + quad * 4);
        bf16x8 vb = bf16x8{v4[0], v4[1], v4[2], v4[3], 0, 0, 0, 0};
#pragma unroll
        for (int t = 0; t < 8; ++t) {
          bf16x4 k4 = *(const bf16x4*)(KuT + (t * 16 + r16) * TS + quad * 4);
          bf16x8 ka = bf16x8{k4[0], k4[1], k4[2], k4[3], 0, 0, 0, 0};
          f32x4 sv = S[t][u];
          if (MODE == 2) {
            f32x4 r4 = *(const f32x4*)(rsc + t * 16 + quad * 4);
            sv[0] *= r4[0]; sv[1] *= r4[1]; sv[2] *= r4[2]; sv[3] *= r4[3];
          } else {
            sv[0] *= hs; sv[1] *= hs; sv[2] *= hs; sv[3] *= hs;
          }
          S[t][u] = MFMA16(ka, vb, sv);
        }
      }
    }
    __syncthreads();

    if (!light) {
      const int i = tid >> 4, eg = tid & 15;
      const int grow = row0 + t0 + i;
      unsigned gw[4] = {gc0.x, gc0.y, gc0.z, gc0.w};
      if (MODE == 0 || MODE == 2) {
        float o[8];
#pragma unroll
        for (int x = 0; x < 8; ++x) o[x] = Of[i * OFS + eg * 8 + x];
        float s1 = 0.f;
        float mu = 0.f;
        if (MODE == 0) {
#pragma unroll
          for (int x = 0; x < 8; ++x) s1 += o[x];
          mu = sum16(s1) * (1.f / 128.f);
        }
        float s2 = 0.f;
#pragma unroll
        for (int x = 0; x < 8; ++x) { o[x] -= mu; s2 += o[x] * o[x]; }
        float r = rsqrtf(sum16(s2) * (1.f / 128.f) + EPS);
        if (i < nvalid) {
          const float* gain = (MODE == 0) ? (p.in[13] + (l * 4 + sub) * 128 + eg * 8) : (p.in[21] + l * 128 + eg * 8);
          float res[8];
#pragma unroll
          for (int x = 0; x < 8; ++x) {
            float g = bf2f((u16)((x & 1) ? (gw[x >> 1] >> 16) : (gw[x >> 1] & 0xffff)));
            float gate = (MODE == 0) ? siluf_(g) : sigmoidf_(g);
            res[x] = o[x] * r * gain[x] * gate;
          }
          uint4 ov = make_uint4(pack2(res[0], res[1]), pack2(res[2], res[3]), pack2(res[4], res[5]), pack2(res[6], res[7]));
          const int ocol = ((MODE == 0) ? 0 : 1024) + sub * 128 + eg * 8;
          *(uint4*)(p.obuf + (size_t)grow * OLD + ocol) = ov;
        }
      } else {
        float y[8];
        const int chb = eg * 8;
        const float Dh = p.in[18][l * 8 + sub * 2 + (chb >> 6)];
        float s2 = 0.f;
#pragma unroll
        for (int x = 0; x < 8; ++x) {
          float g = bf2f((u16)((x & 1) ? (gw[x >> 1] >> 16) : (gw[x >> 1] & 0xffff)));
          float v = Of[i * OFS + chb + x] + bf2f(Xc[i * 128 + chb + x]) * Dh;
          v *= siluf_(g);
          y[x] = v; s2 += v * v;
        }
        s2 = sum16(s2);
        if (i < nvalid) {
          if (eg == 0) p.ssq[(size_t)grow * 4 + sub] = s2;
          uint4 ov = make_uint4(pack2(y[0], y[1]), pack2(y[2], y[3]), pack2(y[4], y[5]), pack2(y[6], y[7]));
          *(uint4*)(p.obuf + (size_t)grow * OLD + 512 + sub * 128 + chb) = ov;
        }
      }
    }
    __syncthreads();
  }

  if (light) {
    uint2* sl = (uint2*)(p.slocal + (size_t)(cid * (p.nseg - 1) + seg) * 16384) + tid;
#pragma unroll
    for (int t = 0; t < 8; ++t)
#pragma unroll
      for (int u = 0; u < NE; ++u)
        sl[(t * NE + u) * 256] = make_uint2(pack2(S[t][u][0], S[t][u][1]), pack2(S[t][u][2], S[t][u][3]));
    float* sd = p.segdec + (size_t)(cid * 7 + seg) * 128;
    if (MODE == 1) { if (tid < 2) sd[tid] = segacc[tid]; }
    if (MODE == 2) { if (tid < 128) sd[tid] = hg_tot; }
  } else if (last_seg) {
    asm volatile("" : "+v"(sbase));
#pragma unroll
    for (int t = 0; t < 8; ++t)
#pragma unroll
      for (int u = 0; u < NE; ++u) {
        if (MODE == 1) {
          *(f32x4*)(sout + sbase + u * 2048 + t * 16) = S[t][u];
        } else {
#pragma unroll
          for (int jj = 0; jj < 4; ++jj) sout[sbase + t * 2048 + jj * 128 + u * 16] = S[t][u][jj];
        }
      }
    if (MODE == 1) {
      float* co = p.out + (prompt ? p.o_conv_p : p.o_conv_s) + ((size_t)l * NB + bidx) * 3 * 1024;
#pragma unroll
      for (int k = 0; k < 2; ++k) {
        const int ci = tid + 256 * k;
        if (ci < 128 || (ci < 384 && pair == 0)) {
#pragma unroll
          for (int j = 0; j < 3; ++j) co[j * 1024 + ccidx[k]] = cprev[k][j];
        }
      }
    }
  }
}

__device__ void run_s5(const Params& p, int l, int seq, int gq, int seg, int pass, char* smem) {
  const int tid = tidq(), lane = tid & 63, w = tid >> 6;
  const int g = gq * 4 + w;
  const bool prompt = seq < 8;
  const int bidx = prompt ? seq : seq - 8;
  const int NB = prompt ? 8 : 128;
  const int row0 = prompt ? seq * 2048 : MPR + (seq - 8) * 8;
  const int sps = prompt ? p.cps * 2 : 1;
  const int sc_begin = prompt ? seg * sps : 0;
  const int sc_end = sc_begin + sps;
  const bool light = prompt && (pass == 1);
  const bool last_seg = !prompt || (seg == p.nseg - 1);
  float* base = (float*)(smem + w * 13568);
  float* hre = base;
  float* him = base + 544;
  float* cre = base + 1088;
  float* cim = base + 2176;
  float* ub = base + 3264;
  const int lg_ = l * 32 + g;
  if (!light) {
#pragma unroll
    for (int m = 0; m < 16; ++m) {
      cre[m * 68 + lane] = p.in[26][((size_t)lg_ * 16 + m) * 64 + lane];
      cim[m * 68 + lane] = p.in[27][((size_t)lg_ * 16 + m) * 64 + lane];
    }
  }
  const float dt = __expf(p.in[29][lg_]);
  const float are = p.in[22][lg_ * 64 + lane], aim = p.in[23][lg_ * 64 + lane];
  const float th = dt * aim;
  float sn, cs; sincos_red(th, sn, cs);
  float shalf, chalf; sincos_red(0.5f * th, shalf, chalf);
  const float em1 = expm1f(dt * are);
  const float mag = em1 + 1.f;
  const float abr = mag * cs, abi = mag * sn;
  const float nre = em1 * cs - 2.f * shalf * shalf, nim = abi;
  const float den = are * are + aim * aim;
  const float fre = (nre * are + nim * aim) / den, fim = (nim * are - nre * aim) / den;
  float bbr[16], bbi[16];
#pragma unroll
  for (int m = 0; m < 16; ++m) {
    float br = p.in[24][((size_t)lg_ * 64 + lane) * 16 + m], bi = p.in[25][((size_t)lg_ * 64 + lane) * 16 + m];
    bbr[m] = fre * br - fim * bi;
    bbi[m] = fre * bi + fim * br;
  }
  float hr = 0.f, hi = 0.f;
  if (!prompt) {
    hr = p.in[6][((size_t)(l * 128 + bidx) * 32 + g) * 64 + lane];
    hi = p.in[7][((size_t)(l * 128 + bidx) * 32 + g) * 64 + lane];
  } else if (pass == 2 && seg > 0) {
    const float len = (float)(sps * 8);
    const float pm = __expf(len * dt * are);
    float ps, pc; sincos_red(len * th, ps, pc);
    const float pr_ = pm * pc, pi_ = pm * ps;
    for (int r = 0; r < seg; ++r) {
      const float* hl = p.hlocal + ((size_t)((seq * 32 + g) * 7 + r)) * 128;
      float lr_ = hl[lane], li_ = hl[64 + lane];
      float nr = pr_ * hr - pi_ * hi + lr_;
      float ni = pr_ * hi + pi_ * hr + li_;
      hr = nr; hi = ni;
    }
  }
  const int oi = lane & 7, mg = lane >> 3, m0 = mg * 2;
  const float dm0 = p.in[28][lg_ * 16 + m0], dm1 = p.in[28][lg_ * 16 + m0 + 1];
  const int ti = lane >> 3, cp = lane & 7;
  const u16* ubase = p.pbuf + (size_t)(row0 + ti) * NP + C_SU + g * 16 + cp * 2;
  unsigned nxt = *(const unsigned*)(ubase + (size_t)sc_begin * 8 * NP);
  for (int sc = sc_begin; sc < sc_end; ++sc) {
    unsigned cur = nxt;
    if (sc + 1 < sc_end) nxt = *(const unsigned*)(ubase + (size_t)(sc + 1) * 8 * NP);
    ub[ti * 16 + cp * 2] = bf2f((u16)(cur & 0xffff));
    ub[ti * 16 + cp * 2 + 1] = bf2f((u16)(cur >> 16));
    __syncthreads();
#pragma unroll
    for (int i = 0; i < 8; ++i) {
      float bur = 0.f, bui = 0.f;
#pragma unroll
      for (int m4 = 0; m4 < 4; ++m4) {
        f32x4 u4 = *(const f32x4*)(ub + i * 16 + m4 * 4);
#pragma unroll
        for (int x = 0; x < 4; ++x) { bur += bbr[m4 * 4 + x] * u4[x]; bui += bbi[m4 * 4 + x] * u4[x]; }
      }
      float nr = abr * hr - abi * hi + bur;
      float ni = abr * hi + abi * hr + bui;
      hr = nr; hi = ni;
      if (!light) { hre[i * 68 + lane] = hr; him[i * 68 + lane] = hi; }
    }
    __syncthreads();
    if (!light) {
      float y0 = 0.f, y1 = 0.f;
#pragma unroll
      for (int p4 = 0; p4 < 16; ++p4) {
        f32x4 h4r = *(const f32x4*)(hre + oi * 68 + p4 * 4);
        f32x4 h4i = *(const f32x4*)(him + oi * 68 + p4 * 4);
        f32x4 c0r = *(const f32x4*)(cre + m0 * 68 + p4 * 4);
        f32x4 c0i = *(const f32x4*)(cim + m0 * 68 + p4 * 4);
        f32x4 c1r = *(const f32x4*)(cre + (m0 + 1) * 68 + p4 * 4);
        f32x4 c1i = *(const f32x4*)(cim + (m0 + 1) * 68 + p4 * 4);
#pragma unroll
        for (int x = 0; x < 4; ++x) {
          y0 += c0r[x] * h4r[x] - c0i[x] * h4i[x];
          y1 += c1r[x] * h4r[x] - c1i[x] * h4i[x];
        }
      }
      y0 += dm0 * ub[oi * 16 + m0];
      y1 += dm1 * ub[oi * 16 + m0 + 1];
      *(unsigned*)(p.zs5 + (size_t)(row0 + sc * 8 + oi) * ZLD + g * 16 + m0) = pack2(gelu_tanh(y0), gelu_tanh(y1));
      __syncthreads();
    }
  }
  if (light) {
    float* hl = p.hlocal + ((size_t)((seq * 32 + g) * 7 + seg)) * 128;
    hl[lane] = hr; hl[64 + lane] = hi;
  } else if (last_seg) {
    p.out[(prompt ? p.o_s5r_p : p.o_s5r_s) + ((size_t)(l * NB + bidx) * 32 + g) * 64 + lane] = hr;
    p.out[(prompt ? p.o_s5i_p : p.o_s5i_s) + ((size_t)(l * NB + bidx) * 32 + g) * 64 + lane] = hi;
  }
}

__device__ void phase_mixers(const Params& p, int l, int pass, char* smem, int visit) {
  int* s_item = (int*)(smem + 65536);
  unsigned* cnt = p.counters + l * 64 + (pass - 1) * 32 + visit * 16;
  const int nseg = p.nseg;
  const int ns1 = nseg - 1;
  const int n_chain = (pass == 1) ? 96 * ns1 : 96 * nseg;
  const int n_s5 = (pass == 1) ? 64 * ns1 : 64 * nseg;
  const int n_items = n_chain + n_s5 + ((pass == 1) ? 128 * 20 : 0);
  for (;;) {
    if (tidq() == 0) *s_item = (int)atomicAdd(cnt, 1u);
    __syncthreads();
    const int item = *s_item;
    __syncthreads();
    if (item >= n_items) break;
    int mode, seq, sub, seg = 0;
    const int per = (pass == 1) ? ns1 : nseg;
    if (item < n_chain) {
      const int c = item / per; seg = item % per;
      const int kind = c >> 5, r = c & 31;
      seq = r >> 2; sub = r & 3;
      mode = (kind == 0) ? 1 : ((kind == 1) ? 2 : 0);
    } else if (item < n_chain + n_s5) {
      const int k = item - n_chain;
      const int c = k / per; seg = k % per;
      mode = 3; seq = c >> 3; sub = c & 7;
    } else {
      int k = item - n_chain - n_s5; int b = k / 20; sub = k % 20; seq = 8 + b;
      if (sub < 4) mode = 1;
      else if (sub < 8) { mode = 0; sub -= 4; }
      else if (sub < 12) { mode = 2; sub -= 8; }
      else { mode = 3; sub -= 12; }
    }
    const int ps = (seq >= 8) ? 2 : pass;
    if (mode == 0) { if (EN(2) || ONLY == 20) run_chain<0>(p, l, seq, sub, seg, ps, smem); }
    else if (mode == 1) { if (EN(2) || ONLY == 21) run_chain<1>(p, l, seq, sub, seg, ps, smem); }
    else if (mode == 2) { if (EN(2) || ONLY == 22) run_chain<2>(p, l, seq, sub, seg, ps, smem); }
    else { if (EN(2) || ONLY == 23) run_s5(p, l, seq, sub, seg, ps, smem); }
    __syncthreads();
  }
}

DI bool tile_at(int i, int T, int& t) {
  const int bpx = gridDim.x >> 3;
  t = ((blockIdx.x & 7) + 8 * i) * bpx + (blockIdx.x >> 3);
  return t < T;
}
DI void tile_mn(int t, int nN, int& m0, int& n0) {
  const int per = 8 * nN;
  const int grp = t / per, r = t - grp * per;
  m0 = (grp * 8 + (r & 7)) * 128;
  n0 = (r >> 3) * 128;
}

__device__ void run_phase(const Params& p, int ph, char* smem, int visit) {
  constexpr int NMT = MTOK / 128;
  if (ph == 0) {
    if (EN(9)) phase_convert(p, smem);
    if (EN(0)) phase_rownorm(p, true, nullptr, nullptr, p.in[8], p.hb);
    return;
  }
  if (ph == NPHASE - 1) {
    if (EN(10)) phase_rownorm(p, false, p.tbuf, p.in[11] + 1 * DM, nullptr, nullptr);
    return;
  }
  const int l = (ph <= 9) ? 0 : 1, s0_ = (ph <= 9) ? ph : ph - 10;
  const int s = (s0_ <= 2) ? s0_ : s0_ - 1;
  switch (s) {
    case 0:
      if (!EN(0)) break;
      phase_rownorm(p, false, p.tbuf, p.in[11] + (l - 1) * DM, p.in[8] + l * DM, p.hb);
      break;
    case 1: if (EN(1)) {
      constexpr int NN = NP / 128;
      int t, m0, n0;
      for (int i = 0; tile_at(i, NMT * NN, t); ++i) {
        tile_mn(t, NN, m0, n0);
        gemm_tile<EPI_BF16>(p.hb, HLD, p.wt_in + (size_t)l * NIN * WLD1, WLD1, DM, m0, n0, p.pbuf, NP, nullptr, 0, smem);
      }
    } break;
    case 2: if (EN(2) || (ONLY >= 20 && ONLY <= 23)) phase_mixers(p, l, (s0_ == 2) ? 1 : 2, smem, visit); break;
    case 3: if (EN(3)) {
      constexpr int NG = 32, NGLU = 4;
      {
        const int lane = tidq() & 63, w = tidq() >> 6;
        for (int row = blockIdx.x * 4 + w; row < MTOK; row += gridDim.x * 4) {
          const float4 sq = *(const float4*)(p.ssq + (size_t)row * 4);
          const float ms = (lane < 32) ? (sq.x + sq.y) : (sq.z + sq.w);
          const float r = rsqrtf(ms * (1.f / 256.f) + EPS);
          u16* ptr = p.obuf + (size_t)row * OLD + 512 + lane * 8;
          uint4 v = *(const uint4*)ptr;
          const float* gn = p.in[19] + l * 512 + lane * 8;
          unsigned vw[4] = {v.x, v.y, v.z, v.w};
          unsigned ow[4];
#pragma unroll
          for (int x = 0; x < 4; ++x)
            ow[x] = pack2(bf2f((u16)(vw[x] & 0xffff)) * r * gn[2 * x], bf2f((u16)(vw[x] >> 16)) * r * gn[2 * x + 1]);
          *(uint4*)ptr = make_uint4(ow[0], ow[1], ow[2], ow[3]);
        }
      }
      int t, m0, n0;
      for (int i = 0; tile_at(i, NMT * (NG + NGLU), t); ++i) {
        if (t < NMT * NG) {
          tile_mn(t, NG, m0, n0);
          gemm_tile<EPI_SIG>(p.hb, HLD, p.wt_in + ((size_t)l * NIN + NP) * WLD1, WLD1, DM, m0, n0, p.pbuf, 4096, nullptr, 0, smem);
        } else {
          tile_mn(t - NMT * NG, NGLU, m0, n0);
          gemm_tile<EPI_GLU>(p.zs5, ZLD, p.wt_glu + (size_t)l * 512 * WLD5, WLD5, 512, m0, n0,
                             p.obuf + 1536, OLD, p.zs5, ZLD, smem);
        }
      }
    } break;
    case 4:
      if (EN(4)) {
        int t, m0, n0;
        for (int i = 0; tile_at(i, NMT * 8, t); ++i) { tile_mn(t, 8, m0, n0); merge_tile(p, l, m0, n0, smem); }
      }
      break;
    case 5:
      if (EN(5)) {
        int t, m0, n0;
        for (int i = 0; tile_at(i, NMT * 8, t); ++i) {
          tile_mn(t, 8, m0, n0);
          gemm_tile<EPI_F32>(p.hb, HLD, p.wt_out + (size_t)l * DM * WLD1, WLD1, DM, m0, n0, p.tbuf, DM, nullptr, 0, smem);
        }
      }
      break;
    case 6:
      if (EN(6)) phase_rownorm(p, false, p.tbuf, p.in[9] + l * DM, p.in[10] + l * DM, p.hb);
      break;
    case 7:
      if (EN(7)) {
        int t, m0, n0;
        for (int i = 0; tile_at(i, NMT * 32, t); ++i) {
          tile_mn(t, 32, m0, n0);
          gemm_tile<EPI_RELU2>(p.hb, HLD, p.wt_ff1 + (size_t)l * DFF * WLD1, WLD1, DM, m0, n0, p.pbuf, ULD, nullptr, 0, smem);
        }
      }
      break;
    case 8:
      if (EN(8)) {
        int t, m0, n0;
        for (int i = 0; tile_at(i, NMT * 8, t); ++i) {
          tile_mn(t, 8, m0, n0);
          gemm_tile<EPI_F32>(p.pbuf, ULD, p.wt_ff2 + (size_t)l * DM * WLD4, WLD4, DFF, m0, n0, p.tbuf, DM, nullptr, 0, smem);
        }
      }
      break;
  }
}

#ifndef DUP_S
#define DUP_S -1
#endif
#define XB_TMO      128
#define XB_XCNT(j)  (256  + 64 * (j))
#define XB_XSUB(j)  (1280 + 64 * (j))
#define XB_XGEN(j)  (2304 + 64 * (j))
#define XB_TOP      3328
#define XB_TOPGEN   3392
#define XCD_BAR_WORDS 3456
#define XB_SPIN_CAP (1u << 22)
#define LAS __attribute__((address_space(3)))
DI unsigned xb_ld(unsigned* p)              { return __hip_atomic_load(p, __ATOMIC_RELAXED, __HIP_MEMORY_SCOPE_AGENT); }
DI unsigned xb_add(unsigned* p, unsigned v) { return __hip_atomic_fetch_add(p, v, __ATOMIC_RELAXED, __HIP_MEMORY_SCOPE_AGENT); }
DI unsigned xb_xcc_id() { return (unsigned)__builtin_amdgcn_s_getreg((3 << 11) | 20) & 0xFu; }
#define XB_SPIN(cond, bar) do { unsigned _sp = 0; while (cond) { __builtin_amdgcn_s_sleep(1); \
    if ((++_sp & 255u) == 0u) { if (xb_ld(&(bar)[XB_TMO])) break; if (_sp > XB_SPIN_CAP) { atomicAdd(&(bar)[XB_TMO], 1u); break; } } } } while (0)
struct XcdBarrier { unsigned* bar; unsigned x; volatile LAS unsigned* st; };
DI XcdBarrier xcd_barrier_post(unsigned* bar, volatile LAS unsigned* st) {
  XcdBarrier b; b.bar = bar; b.x = xb_xcc_id(); b.st = st;
  if (threadIdx.x == 0) (void)xb_add(&bar[XB_XCNT(b.x)], 1u);
  return b;
}
DI void xcd_barrier_complete(unsigned* bar, unsigned x, unsigned& nloc, unsigned& nx) {
  const unsigned G = gridDim.x * gridDim.y * gridDim.z;
  unsigned sum, cnt, mine, sp = 0u;
  for (;;) {
    sum = 0u; cnt = 0u; mine = 0u;
#pragma unroll
    for (unsigned j = 0; j < 16; ++j) { const unsigned c = xb_ld(&bar[XB_XCNT(j)]); sum += c; cnt += (c > 0u) ? 1u : 0u; mine = (j == x) ? c : mine; }
    if (sum == G) break;
    __builtin_amdgcn_s_sleep(1);
    if ((++sp & 255u) == 0u) { if (xb_ld(&bar[XB_TMO])) break; if (sp > XB_SPIN_CAP) { atomicAdd(&bar[XB_TMO], 1u); break; } }
  }
  nloc = mine > 0u ? mine : 1u; nx = cnt > 0u ? cnt : 1u;
}
DI void xcd_barrier(const XcdBarrier& b) {
  asm volatile("s_waitcnt vmcnt(0)" ::: "memory");
  __syncthreads();
  if (threadIdx.x == 0) {
    unsigned* bar = b.bar;
    __builtin_amdgcn_s_waitcnt(0);
    unsigned nloc = b.st[0], nx = b.st[1];
    if (nloc == 0u) { xcd_barrier_complete(bar, b.x, nloc, nx); b.st[0] = nloc; b.st[1] = nx; }
    const unsigned old = xb_add(&bar[XB_XSUB(b.x)], 1u);
    const unsigned gen = old / nloc;
    if (old + 1u == (gen + 1u) * nloc) {
      __builtin_amdgcn_fence(__ATOMIC_RELEASE, "agent");
      asm volatile("s_waitcnt vmcnt(0)" ::: "memory");
      const unsigned og = xb_add(&bar[XB_TOP], 1u);
      const unsigned tg = og / nx;
      if (og + 1u == (tg + 1u) * nx) xb_add(&bar[XB_TOPGEN], 1u);
      else XB_SPIN(xb_ld(&bar[XB_TOPGEN]) == tg, bar);
      __builtin_amdgcn_fence(__ATOMIC_ACQUIRE, "agent");
      xb_add(&bar[XB_XGEN(b.x)], 1u);
      asm volatile("s_waitcnt vmcnt(0)" ::: "memory");
    } else {
      XB_SPIN(xb_ld(&bar[XB_XGEN(b.x)]) == gen, bar);
      __builtin_amdgcn_fence(__ATOMIC_ACQUIRE, "agent");
      asm volatile("s_waitcnt vmcnt(0)" ::: "memory");
    }
  }
  __syncthreads();
}

__global__ void __launch_bounds__(256, 2) mega_kernel(Params p, int ph_lo, int ph_hi) {
  __shared__ __attribute__((aligned(16))) char smem[65536 + 32];
  volatile LAS unsigned* st = (volatile LAS unsigned*)(&smem[65536 + 16]);
  if (threadIdx.x == 0) { st[0] = 0u; st[1] = 0u; }
  __syncthreads();
  const XcdBarrier xb = xcd_barrier_post(p.bar, st);
  for (int ph = ph_lo; ph < ph_hi; ++ph) {
    if (ph > ph_lo) {
      if (ph == ph_lo + 1) cg::this_grid().sync();
      else xcd_barrier(xb);
    }
    const int reps = (DUP_S >= 0 && ph == DUP_S) ? 2 : 1;
    for (int r = 0; r < reps; ++r) {
      if (r) xcd_barrier(xb);
#ifdef VAR_NOSTORE
      if (tidq() == 0) *(volatile int*)(smem + 65536 + 8) = r;
      __syncthreads();
#endif
      run_phase(p, ph, smem, r);
    }
  }
}

extern "C" void kernel_launch(void* const* d_in, const int* in_sizes, int n_in, void* d_out, int out_size,
                              void* d_ws, size_t ws_size, hipStream_t stream) {
  Params p{};
  for (int i = 0; i < 35; ++i) p.in[i] = (const float*)d_in[i];
  p.out = (float*)d_out;
  char* ws = (char*)d_ws;
  size_t off = 0;
  auto take = [&](size_t bytes) { char* r = ws + off; off += (bytes + 255) & ~(size_t)255; return r; };
  p.wt_in  = (u16*)take((size_t)2 * NIN * WLD1 * 2);
  p.wt_ff1 = (u16*)take((size_t)2 * DFF * WLD1 * 2);
  p.wt_ff2 = (u16*)take((size_t)2 * DM * WLD4 * 2);
  p.wt_br  = (u16*)take((size_t)2 * 4 * DM * WLD5 * 2);
  p.wt_out = (u16*)take((size_t)2 * DM * WLD1 * 2);
  p.wt_glu = (u16*)take((size_t)2 * 512 * WLD5 * 2);
  p.hb     = (u16*)take((size_t)MTOK * HLD * 2);
  p.pbuf   = (u16*)take((size_t)MTOK * NP * 2);
  p.obuf   = (u16*)take((size_t)MTOK * OLD * 2);
  p.zs5    = (u16*)take((size_t)MTOK * ZLD * 2);
  p.counters = (unsigned*)take(4096);
  p.bar = (unsigned*)take(16384);
  p.ssq = (float*)take((size_t)MTOK * 4 * 4);
  p.segdec = (float*)take((size_t)96 * 7 * 128 * 4);
  p.hlocal = (float*)take((size_t)8 * 32 * 7 * 128 * 4);
  p.nseg = 8;
  if (off + (size_t)96 * 7 * 32768 > ws_size) p.nseg = 4;
  p.cps = 128 / p.nseg;
  p.slocal = (u16*)take((size_t)96 * (p.nseg - 1) * 32768);
  p.tbuf = (float*)(p.pbuf + (size_t)MTOK * ULD);
  if (off > ws_size) { fprintf(stderr, "workspace too small: need %zu have %zu\n", off, ws_size); return; }
  size_t o = (size_t)MTOK * DM;
  p.o_ret_p = o;  o += (size_t)2 * 8 * 65536;
  p.o_ret_s = o;  o += (size_t)2 * 128 * 65536;
  p.o_ssd_p = o;  o += (size_t)2 * 8 * 65536;
  p.o_ssd_s = o;  o += (size_t)2 * 128 * 65536;
  p.o_conv_p = o; o += (size_t)2 * 8 * 3 * 1024;
  p.o_conv_s = o; o += (size_t)2 * 128 * 3 * 1024;
  p.o_hg_p = o;   o += (size_t)2 * 8 * 65536;
  p.o_hg_s = o;   o += (size_t)2 * 128 * 65536;
  p.o_s5r_p = o;  o += (size_t)2 * 8 * 2048;
  p.o_s5r_s = o;  o += (size_t)2 * 128 * 2048;
  p.o_s5i_p = o;  o += (size_t)2 * 8 * 2048;
  p.o_s5i_s = o;  o += (size_t)2 * 128 * 2048;

  static int grid_blocks = 0;
  if (!grid_blocks) {
    int dev = 0, cus = 0, per_cu = 0;
    hipGetDevice(&dev);
    hipDeviceGetAttribute(&cus, hipDeviceAttributeMultiprocessorCount, dev);
    hipOccupancyMaxActiveBlocksPerMultiprocessor(&per_cu, mega_kernel, 256, 0);
    if (per_cu > 2) per_cu = 2;
    if (per_cu < 1) per_cu = 1;
    grid_blocks = cus * per_cu;
  }
  hipMemsetAsync(p.counters, 0, 4096 + 16384, stream);
#if SINGLE_LAUNCH
  int lo = 0, hi = NPHASE;
  void* args[] = {&p, &lo, &hi};
  hipError_t e = hipLaunchCooperativeKernel((void*)mega_kernel, dim3(grid_blocks), dim3(256), args, 0, stream);
  if (e != hipSuccess) fprintf(stderr, "cooperative launch failed: %s (grid %d)\n", hipGetErrorString(e), grid_blocks);
#else
  for (int ph = 0; ph < NPHASE; ++ph)
    hipLaunchKernelGGL(mega_kernel, dim3(grid_blocks), dim3(256), 0, stream, p, ph, ph + 1);
#endif
}
```

```cpp
#include <hip/hip_runtime.h>
#include <hip/hip_cooperative_groups.h>
#include <cstdio>
#include <cstdint>
namespace cg = cooperative_groups;

#ifndef SINGLE_LAUNCH
#define SINGLE_LAUNCH 1
#endif
#ifndef ONLY
#define ONLY -1
#endif
#define EN(k) (ONLY < 0 || ONLY == (k))

typedef unsigned short u16;
using bf16x8 = __attribute__((ext_vector_type(8))) short;
using bf16x4 = __attribute__((ext_vector_type(4))) short;
using f32x4  = __attribute__((ext_vector_type(4))) float;
typedef unsigned u32x4 __attribute__((ext_vector_type(4)));
#define DI __device__ __forceinline__
#define MFMA16(a, b, c) __builtin_amdgcn_mfma_f32_16x16x32_bf16((a), (b), (c), 0, 0, 0)

constexpr int MTOK = 17408;
constexpr int MPR  = 16384;
constexpr int DM   = 1024;
constexpr int NP   = 6272;
constexpr int NIN  = 10368;
constexpr int DFF  = 4096;
constexpr int INC  = 10248;
constexpr int C_RQ = 0, C_RK = 512, C_RV = 1024, C_RG = 1536, C_SZ = 2048, C_SXBC = 2560;
constexpr int C_HQ = 3584, C_HF = 4096, C_HI = 4608, C_HG = 5120, C_SU = 5632, C_SDT = 6144;
constexpr float EPS = 1e-6f;
constexpr int HLD = 1024, WLD1 = 1024, ULD = 4096, WLD4 = 4096, OLD = 2048, ZLD = 512, WLD5 = 512;
constexpr int NITEMS = 160 + 128 * 20;
constexpr int NPHASE = 21;

struct Params {
  const float* in[35];
  float* out;
  u16 *wt_in, *wt_ff1, *wt_ff2, *wt_br, *wt_out, *wt_glu;
  u16 *hb, *pbuf, *obuf, *zs5;
  float* tbuf;
  unsigned* counters;
  unsigned* bar;
  float* ssq;
  u16* slocal;
  float* segdec;
  float* hlocal;
  int nseg, cps;
  size_t o_ret_p, o_ret_s, o_ssd_p, o_ssd_s, o_conv_p, o_conv_s, o_hg_p, o_hg_s, o_s5r_p, o_s5r_s, o_s5i_p, o_s5i_s;
};

DI int tidq() { int t = threadIdx.x; asm volatile("" : "+v"(t)); return t; }
typedef __bf16 bf16v2 __attribute__((ext_vector_type(2)));
typedef float f32v2 __attribute__((ext_vector_type(2)));
DI unsigned pack2(float a, float b) { f32v2 v = {a, b}; return __builtin_bit_cast(unsigned, __builtin_convertvector(v, bf16v2)); }
DI u16 f2bf(float f) { return (u16)(pack2(f, 0.f) & 0xffffu); }
DI float bf2f(u16 h) { return __uint_as_float(((unsigned)h) << 16); }
DI float sigmoidf_(float x) { return 1.f / (1.f + __expf(-x)); }
DI float siluf_(float x) { return x / (1.f + __expf(-x)); }
DI float softplusf_(float x) { return x > 20.f ? x : log1pf(__expf(x)); }
DI float gelu_tanh(float x) {
  float u = 0.7978845608028654f * (x + 0.044715f * x * x * x);
  float e = __expf(2.f * u);
  float th = 1.f - 2.f / (e + 1.f);
  return 0.5f * x * (1.f + th);
}
DI float wave_sum(float v) {
#pragma unroll
  for (int m = 32; m >= 1; m >>= 1) v += __shfl_xor(v, m);
  return v;
}
DI float sum16(float v) {
#pragma unroll
  for (int m = 8; m >= 1; m >>= 1) v += __shfl_xor(v, m);
  return v;
}
DI void sincos_red(float a, float& s, float& c) {
  float n = rintf(a * 0.15915494309189535f);
  float r = fmaf(-n, 6.28125f, a);
  r = fmaf(-n, 1.9353071795864769e-3f, r);
  s = __sinf(r); c = __cosf(r);
}

DI int map_win(int my) {
  if (my < 3584) return my;
  if (my < 6144) return my + 8;
  if (my < 6152) return my - 6144 + 3584;
  if (my < 6272) return -1;
  return my - 120;
}
DI void transpose_tile(const float* __restrict__ src, int src_ld, u16* __restrict__ dst, int dst_ld,
                       int k0, int n0, int mapmode, char* smem) {
  float* tile = (float*)smem;
  const int tid = tidq();
  {
    const int n = tid & 63;
    int sc = n0 + n;
    if (mapmode) sc = map_win(sc);
#pragma unroll
    for (int i = 0; i < 16; ++i) {
      int k = (tid >> 6) + 4 * i;
      float v = (sc >= 0) ? src[(size_t)(k0 + k) * src_ld + sc] : 0.f;
      tile[n * 65 + k] = v;
    }
  }
  __syncthreads();
  {
    const int n = tid >> 2, kc = (tid & 3) * 16;
    unsigned pk[8];
#pragma unroll
    for (int x = 0; x < 8; ++x) pk[x] = pack2(tile[n * 65 + kc + 2 * x], tile[n * 65 + kc + 2 * x + 1]);
    uint4* d = (uint4*)(dst + (size_t)(n0 + n) * dst_ld + k0 + kc);
    d[0] = make_uint4(pk[0], pk[1], pk[2], pk[3]);
    d[1] = make_uint4(pk[4], pk[5], pk[6], pk[7]);
  }
  __syncthreads();
}

__device__ void phase_convert(const Params& p, char* smem) {
  constexpr int PER = 5472;
  for (int t = blockIdx.x; t < 2 * PER; t += gridDim.x) {
    int l = t / PER, r = t % PER;
    if (r < 2592) {
      int nt = r / 16, kt = r % 16;
      transpose_tile(p.in[12] + (size_t)l * DM * INC, INC, p.wt_in + (size_t)l * NIN * WLD1, WLD1, kt * 64, nt * 64, 1, smem);
    } else if (r < 3616) {
      r -= 2592; int nt = r / 16, kt = r % 16;
      transpose_tile(p.in[33] + (size_t)l * DM * DFF, DFF, p.wt_ff1 + (size_t)l * DFF * WLD1, WLD1, kt * 64, nt * 64, 0, smem);
    } else if (r < 4640) {
      r -= 3616; int nt = r / 64, kt = r % 64;
      transpose_tile(p.in[34] + (size_t)l * DFF * DM, DM, p.wt_ff2 + (size_t)l * DM * WLD4, WLD4, kt * 64, nt * 64, 0, smem);
    } else if (r < 4896) {
      r -= 4640; int nt = r / 16, kt = r % 16;
      transpose_tile(p.in[32] + (size_t)l * DM * DM, DM, p.wt_out + (size_t)l * DM * WLD1, WLD1, kt * 64, nt * 64, 0, smem);
    } else if (r < 5408) {
      r -= 4896; int b = r / 128; r %= 128; int nt = r / 8, kt = r % 8;
      transpose_tile(p.in[31] + (size_t)(l * 4 + b) * 512 * DM, DM, p.wt_br + (size_t)(l * 4 + b) * DM * WLD5, WLD5, kt * 64, nt * 64, 0, smem);
    } else {
      r -= 5408; int nt = r / 8, kt = r % 8;
      transpose_tile(p.in[30] + (size_t)l * 512 * 512, 512, p.wt_glu + (size_t)l * 512 * WLD5, WLD5, kt * 64, nt * 64, 0, smem);
    }
  }
}

__device__ void phase_rownorm(const Params& p, bool from_input, const float* __restrict__ t, const float* __restrict__ gpost,
                              const float* __restrict__ gpre, u16* __restrict__ hout) {
  const int lane = tidq() & 63, w = tidq() >> 6;
  float* xbuf = p.out;
  for (int row = blockIdx.x * 4 + w; row < MTOK; row += gridDim.x * 4) {
    const float* xin = from_input ? (row < MPR ? p.in[0] + (size_t)row * DM : p.in[1] + (size_t)(row - MPR) * DM)
                                  : xbuf + (size_t)row * DM;
    float4 x[4];
#pragma unroll
    for (int k = 0; k < 4; ++k) x[k] = *(const float4*)(xin + lane * 4 + 256 * k);
    if (t) {
      float4 tv[4];
      float ss = 0.f;
#pragma unroll
      for (int k = 0; k < 4; ++k) {
        tv[k] = *(const float4*)(t + (size_t)row * DM + lane * 4 + 256 * k);
        ss += tv[k].x * tv[k].x + tv[k].y * tv[k].y + tv[k].z * tv[k].z + tv[k].w * tv[k].w;
      }
      ss = wave_sum(ss);
      float r = rsqrtf(ss * (1.f / DM) + EPS);
#pragma unroll
      for (int k = 0; k < 4; ++k) {
        float4 g = *(const float4*)(gpost + lane * 4 + 256 * k);
        x[k].x += tv[k].x * r * g.x; x[k].y += tv[k].y * r * g.y; x[k].z += tv[k].z * r * g.z; x[k].w += tv[k].w * r * g.w;
      }
    }
#pragma unroll
    for (int k = 0; k < 4; ++k) *(float4*)(xbuf + (size_t)row * DM + lane * 4 + 256 * k) = x[k];
    if (hout) {
      float ss = 0.f;
#pragma unroll
      for (int k = 0; k < 4; ++k) ss += x[k].x * x[k].x + x[k].y * x[k].y + x[k].z * x[k].z + x[k].w * x[k].w;
      ss = wave_sum(ss);
      float r = rsqrtf(ss * (1.f / DM) + EPS);
#pragma unroll
      for (int k = 0; k < 4; ++k) {
        float4 g = *(const float4*)(gpre + lane * 4 + 256 * k);
        uint2 o;
        o.x = pack2(x[k].x * r * g.x, x[k].y * r * g.y);
        o.y = pack2(x[k].z * r * g.z, x[k].w * r * g.w);
        *(uint2*)(hout + (size_t)row * HLD + lane * 4 + 256 * k) = o;
      }
    }
  }
}

DI int swz(int r, int c) { return r * 128 + ((c ^ ((r >> 1) & 7)) << 4); }

#define GEMM_COMPUTE(AS_) do { const char* as_ = (AS_); const char* bs_ = as_ + 16384; \
  _Pragma("unroll") for (int s_ = 0; s_ < 2; ++s_) { \
    bf16x8 af_[4], bfr_[4]; \
    _Pragma("unroll") for (int i_ = 0; i_ < 4; ++i_) af_[i_] = *(const bf16x8*)(as_ + swz(wm * 64 + i_ * 16 + r16, s_ * 4 + quad)); \
    _Pragma("unroll") for (int j_ = 0; j_ < 4; ++j_) bfr_[j_] = *(const bf16x8*)(bs_ + swz(wn * 64 + j_ * 16 + r16, s_ * 4 + quad)); \
    _Pragma("unroll") for (int i_ = 0; i_ < 4; ++i_) \
      _Pragma("unroll") for (int j_ = 0; j_ < 4; ++j_) acc[i_][j_] = MFMA16(bfr_[j_], af_[i_], acc[i_][j_]); \
  } } while (0)

struct Stage { u32x4 a0, a1, a2, a3, b0, b1, b2, b3; };
DI void gload(Stage& s, const u16* ag, const u16* bg, int lda, int ldb, int kt) {
  s.a0 = *(const u32x4*)(ag + (size_t)0 * 32 * lda + kt * 64);
  s.a1 = *(const u32x4*)(ag + (size_t)1 * 32 * lda + kt * 64);
  s.a2 = *(const u32x4*)(ag + (size_t)2 * 32 * lda + kt * 64);
  s.a3 = *(const u32x4*)(ag + (size_t)3 * 32 * lda + kt * 64);
  s.b0 = *(const u32x4*)(bg + (size_t)0 * 32 * ldb + kt * 64);
  s.b1 = *(const u32x4*)(bg + (size_t)1 * 32 * ldb + kt * 64);
  s.b2 = *(const u32x4*)(bg + (size_t)2 * 32 * ldb + kt * 64);
  s.b3 = *(const u32x4*)(bg + (size_t)3 * 32 * ldb + kt * 64);
}
DI void lwrite(const Stage& s, char* d, int lr, int lc) {
  *(u32x4*)(d + swz(lr, lc)) = s.a0;
  *(u32x4*)(d + swz(lr + 32, lc)) = s.a1;
  *(u32x4*)(d + swz(lr + 64, lc)) = s.a2;
  *(u32x4*)(d + swz(lr + 96, lc)) = s.a3;
  *(u32x4*)(d + 16384 + swz(lr, lc)) = s.b0;
  *(u32x4*)(d + 16384 + swz(lr + 32, lc)) = s.b1;
  *(u32x4*)(d + 16384 + swz(lr + 64, lc)) = s.b2;
  *(u32x4*)(d + 16384 + swz(lr + 96, lc)) = s.b3;
}

template <bool DEEP>
DI void gemm_kloop(f32x4 (&acc)[4][4], const u16* __restrict__ A, int lda, const u16* __restrict__ Bt, int ldb,
                   int K, int m0, int n0, char* smem) {
  const int tid = tidq(), lane = tid & 63, w = tid >> 6, wm = w >> 1, wn = w & 1, r16 = lane & 15, quad = lane >> 4;
  const int lr = tid >> 3, lc = tid & 7;
  const u16* ag = A + (size_t)(m0 + lr) * lda + lc * 8;
  const u16* bg = Bt + (size_t)(n0 + lr) * ldb + lc * 8;
  const int nk = K >> 6;
  Stage s0;
  gload(s0, ag, bg, lda, ldb, 0);
  if (DEEP) {
    Stage s1;
    gload(s1, ag, bg, lda, ldb, 1);
    lwrite(s0, smem, lr, lc);
    __syncthreads();
    for (int kt = 0; kt < nk; kt += 2) {
      if (kt + 2 < nk) gload(s0, ag, bg, lda, ldb, kt + 2);
      GEMM_COMPUTE(smem);
      lwrite(s1, smem + 32768, lr, lc);
      __syncthreads();
      if (kt + 3 < nk) gload(s1, ag, bg, lda, ldb, kt + 3);
      GEMM_COMPUTE(smem + 32768);
      if (kt + 2 < nk) lwrite(s0, smem, lr, lc);
      __syncthreads();
    }
  } else {
    lwrite(s0, smem, lr, lc);
    __syncthreads();
    for (int kt = 0; kt < nk; ++kt) {
      const bool more = (kt + 1 < nk);
      if (more) gload(s0, ag, bg, lda, ldb, kt + 1);
      GEMM_COMPUTE(smem + (kt & 1) * 32768);
      if (more) lwrite(s0, smem + ((kt + 1) & 1) * 32768, lr, lc);
      __syncthreads();
    }
  }
}

DI void zero_acc(f32x4 (&acc)[4][4]) {
#pragma unroll
  for (int i = 0; i < 4; ++i)
#pragma unroll
    for (int j = 0; j < 4; ++j) acc[i][j] = f32x4{0.f, 0.f, 0.f, 0.f};
}

enum { EPI_BF16 = 0, EPI_SIG = 1, EPI_RELU2 = 2, EPI_F32 = 3, EPI_GLU = 4 };

template <int EPI>
DI void gemm_tile(const u16* A, int lda, const u16* Bt, int ldb, int K, int m0, int n0,
                  void* outp, int ldc, const u16* aux, int ldaux, char* smem) {
  f32x4 acc[4][4];
  zero_acc(acc);
  gemm_kloop<true>(acc, A, lda, Bt, ldb, K, m0, n0, smem);
#ifdef VAR_NOSTORE
  if (*(volatile int*)(smem + 65536 + 8) == 1 && acc[0][0][0] != 12345.678f) return;
#endif
  const int lane = tidq() & 63, w = tidq() >> 6, wm = w >> 1, wn = w & 1, r16 = lane & 15, quad = lane >> 4;
#pragma unroll
  for (int i = 0; i < 4; ++i) {
    const int m = m0 + wm * 64 + i * 16 + r16;
#pragma unroll
    for (int j = 0; j < 4; ++j) {
      const int n = n0 + wn * 64 + j * 16 + quad * 4;
      f32x4 v = acc[i][j];
      if (EPI == EPI_F32) {
        *(float4*)((float*)outp + (size_t)m * ldc + n) = make_float4(v[0], v[1], v[2], v[3]);
      } else {
        if (EPI == EPI_SIG) {
#pragma unroll
          for (int x = 0; x < 4; ++x) v[x] = sigmoidf_(v[x]);
        } else if (EPI == EPI_RELU2) {
#pragma unroll
          for (int x = 0; x < 4; ++x) { float r = fmaxf(v[x], 0.f); v[x] = r * r; }
        } else if (EPI == EPI_GLU) {
          uint2 zz = *(const uint2*)(aux + (size_t)m * ldaux + n);
          v[0] = bf2f((u16)(zz.x & 0xffff)) * sigmoidf_(v[0]);
          v[1] = bf2f((u16)(zz.x >> 16)) * sigmoidf_(v[1]);
          v[2] = bf2f((u16)(zz.y & 0xffff)) * sigmoidf_(v[2]);
          v[3] = bf2f((u16)(zz.y >> 16)) * sigmoidf_(v[3]);
        }
        uint2 o; o.x = pack2(v[0], v[1]); o.y = pack2(v[2], v[3]);
        *(uint2*)((u16*)outp + (size_t)m * ldc + n) = o;
      }
    }
  }
}

DI void merge_tile(const Params& p, int l, int m0, int n0, char* smem) {
  f32x4 macc[4][4];
  zero_acc(macc);
  const int lane = tidq() & 63, w = tidq() >> 6, wm = w >> 1, wn = w & 1, r16 = lane & 15, quad = lane >> 4;
  const u16* gates = p.pbuf;
  for (int b = 0; b < 4; ++b) {
    f32x4 acc[4][4];
    zero_acc(acc);
    gemm_kloop<false>(acc, p.obuf + b * 512, OLD, p.wt_br + (size_t)(l * 4 + b) * DM * WLD5, WLD5, 512, m0, n0, smem);
#pragma unroll
    for (int i = 0; i < 4; ++i) {
      const int m = m0 + wm * 64 + i * 16 + r16;
#pragma unroll
      for (int j = 0; j < 4; ++j) {
        const int n = n0 + wn * 64 + j * 16 + quad * 4;
        uint2 gg = *(const uint2*)(gates + (size_t)m * 4096 + b * 1024 + n);
        macc[i][j][0] += bf2f((u16)(gg.x & 0xffff)) * acc[i][j][0];
        macc[i][j][1] += bf2f((u16)(gg.x >> 16)) * acc[i][j][1];
        macc[i][j][2] += bf2f((u16)(gg.y & 0xffff)) * acc[i][j][2];
        macc[i][j][3] += bf2f((u16)(gg.y >> 16)) * acc[i][j][3];
      }
    }
  }
#pragma unroll
  for (int i = 0; i < 4; ++i) {
    const int m = m0 + wm * 64 + i * 16 + r16;
#pragma unroll
    for (int j = 0; j < 4; ++j) {
      const int n = n0 + wn * 64 + j * 16 + quad * 4;
      uint2 o; o.x = pack2(macc[i][j][0], macc[i][j][1]); o.y = pack2(macc[i][j][2], macc[i][j][3]);
      *(uint2*)(p.hb + (size_t)m * HLD + n) = o;
    }
  }
}

constexpr int QS = 136;
constexpr int TS = 20;
constexpr int OFS = 260;

template <int MODE>
__device__ void run_chain(const Params& p, int l, int seq, int sub, int seg, int pass, char* smem) {
  constexpr int NE = 2;
  const int tid = tidq(), lane = tid & 63, w = tid >> 6, r16 = lane & 15, quad = lane >> 4;
  const bool prompt = seq < 8;
  const int bidx = prompt ? seq : seq - 8;
  const int NB = prompt ? 8 : 128;
  const int L = prompt ? 2048 : 8;
  const int row0 = prompt ? seq * 2048 : MPR + (seq - 8) * 8;
  const int pos0 = prompt ? 0 : 16384;
  const int cps = p.cps;
  const int ch_begin = prompt ? seg * cps : 0;
  const int ch_end = prompt ? ch_begin + cps : 1;
  const bool light = prompt && (pass == 1);
  const bool last_seg = !prompt || (seg == p.nseg - 1);
  const int cid = seq * 12 + MODE * 4 + sub;

  u16* Qa = (u16*)smem;
  u16* Ka = (u16*)(smem + 4352);
  u16* KuT = (u16*)(smem + 8704);
  u16* VaT = (u16*)(smem + 13824);
  u16* VuT = (MODE == 1) ? (u16*)(smem + 24064) : VaT;
  float* Of = (float*)(smem + 34304);
  u16* Raw = (u16*)(smem + 34304);
  u16* Xc = (u16*)(smem + 50944);
  float* tot = (float*)(smem + 55040);
  float* cdec = (float*)(smem + 59136);
  float* dtl = (float*)(smem + 59392);
  float* rsc = (float*)(smem + 59648);
  float* clast = (float*)(smem + 60160);
  float* segacc = (float*)(smem + 60176);

  const float* sin_ = nullptr;
  float* sout = nullptr;
  if (MODE == 0) {
    if (!prompt) sin_ = p.in[2] + (((size_t)l * 128 + bidx) * 4 + sub) * 16384;
    sout = p.out + (prompt ? p.o_ret_p : p.o_ret_s) + (((size_t)l * NB + bidx) * 4 + sub) * 16384;
  } else if (MODE == 2) {
    if (!prompt) sin_ = p.in[5] + (((size_t)l * 128 + bidx) * 4 + sub) * 16384;
    sout = p.out + (prompt ? p.o_hg_p : p.o_hg_s) + (((size_t)l * NB + bidx) * 4 + sub) * 16384;
  } else {
    if (!prompt) sin_ = p.in[3] + (((size_t)l * 128 + bidx) * 8 + sub * 2 + (w >> 1)) * 8192;
    sout = p.out + (prompt ? p.o_ssd_p : p.o_ssd_s) + (((size_t)l * NB + bidx) * 8 + sub * 2 + (w >> 1)) * 8192;
  }

  float lg = 0.f;
  if (MODE == 0) lg = log1pf(-exp2f(-5.f - (float)sub));

  int sbase = (MODE == 1) ? (((w & 1) * 32 + r16) * 128 + quad * 4) : (quad * 512 + w * 32 + r16);
  asm volatile("" : "+v"(sbase));
  f32x4 S[8][NE];
#pragma unroll
  for (int t = 0; t < 8; ++t)
#pragma unroll
    for (int u = 0; u < NE; ++u) {
      if (sin_) {
        if (MODE == 1) {
          S[t][u] = *(const f32x4*)(sin_ + sbase + u * 2048 + t * 16);
        } else {
#pragma unroll
          for (int jj = 0; jj < 4; ++jj) S[t][u][jj] = sin_[sbase + t * 2048 + jj * 128 + u * 16];
        }
      } else {
        S[t][u] = f32x4{0.f, 0.f, 0.f, 0.f};
      }
    }
  if (prompt && pass == 2) {
    for (int r = 0; r < seg; ++r) {
      const uint2* sl = (const uint2*)(p.slocal + (size_t)(cid * (p.nseg - 1) + r) * 16384) + tid;
      const float* sd = p.segdec + (size_t)(cid * 7 + r) * 128;
      float dsc = 1.f;
      if (MODE == 0) dsc = __expf(lg * (float)(16 * cps));
      if (MODE == 1) dsc = __expf(sd[w >> 1]);
#pragma unroll
      for (int t = 0; t < 8; ++t) {
        f32x4 dv = f32x4{dsc, dsc, dsc, dsc};
        if (MODE == 2) {
          f32x4 lv = *(const f32x4*)(sd + t * 16 + quad * 4);
          dv = f32x4{__expf(lv[0]), __expf(lv[1]), __expf(lv[2]), __expf(lv[3])};
        }
#pragma unroll
        for (int u = 0; u < NE; ++u) {
          uint2 pk = sl[(t * NE + u) * 256];
          S[t][u][0] = S[t][u][0] * dv[0] + bf2f((u16)(pk.x & 0xffff));
          S[t][u][1] = S[t][u][1] * dv[1] + bf2f((u16)(pk.x >> 16));
          S[t][u][2] = S[t][u][2] * dv[2] + bf2f((u16)(pk.y & 0xffff));
          S[t][u][3] = S[t][u][3] * dv[3] + bf2f((u16)(pk.y >> 16));
        }
      }
    }
  }

  float lbv = 0.f;
  float hg_tot = 0.f;
  float cprev[2][3];
  float cw[2][4], cb[2];
  int ccidx[2];
  float dt_bias = 0.f, dt_A = 0.f;
  float rinv = 0.f, rcD = 1.f, rsD = 0.f;
  const int gg = sub >> 1, pair = sub & 1;
  if (MODE == 0) {
    rinv = exp2f(-(float)(tid & 63) * (13.287712379549449f / 64.f));
    rsD = __sinf(rinv); rcD = __cosf(rinv);
  }
  if (MODE == 2) {
    if (l == 1) {
      float a0 = p.in[20][sub * 128 + (tid & 127)], a1 = p.in[20][512 + sub * 128 + (tid & 127)];
      float mx = fmaxf(a0, a1);
      float e0 = __expf(a0 - mx), e1 = __expf(a1 - mx);
      lbv = e1 / (e0 + e1);
    }
  }
  if (MODE == 1) {
    if (tid < 32) {
      const int hh = sub * 2 + (tid >> 4);
      dt_A = -__expf(p.in[16][l * 8 + hh]);
      dt_bias = p.in[17][l * 8 + hh];
    }
    if (tid < 2) segacc[tid] = 0.f;
#pragma unroll
    for (int k = 0; k < 2; ++k) {
      int ci = tid + 256 * k;
      int cc = 0;
      if (ci < 128) cc = gg * 256 + pair * 128 + ci;
      else if (ci < 256) cc = 512 + gg * 128 + (ci - 128);
      else cc = 768 + gg * 128 + (ci - 256);
      if (ci >= 384) cc = 0;
      ccidx[k] = cc;
#pragma unroll
      for (int j = 0; j < 4; ++j) cw[k][j] = p.in[14][((size_t)l * 4 + j) * 1024 + cc];
      cb[k] = p.in[15][l * 1024 + cc];
#pragma unroll
      for (int j = 0; j < 3; ++j) {
        float v = 0.f;
        if (!prompt) v = p.in[4][(((size_t)l * 128 + bidx) * 3 + j) * 1024 + cc];
        else if (ch_begin > 0) v = bf2f(p.pbuf[(size_t)(row0 + ch_begin * 16 - 3 + j) * NP + C_SXBC + cc]);
        cprev[k][j] = v;
      }
    }
  }

  const int lt = tid >> 4, lc = tid & 15;
  uint4 r0, r1, r2, g0;
  unsigned rdt = 0;
  const uint4 z4 = make_uint4(0, 0, 0, 0);
  r0 = r1 = r2 = g0 = z4;
  auto load_raw = [&](int ch) {
    const int t0 = ch * 16;
    const int nv = (L - t0 < 16) ? (L - t0) : 16;
    const u16* Pr = p.pbuf + (size_t)(row0 + t0 + lt) * NP;
    r0 = r1 = r2 = g0 = z4;
    rdt = 0;
    if (lt < nv) {
      if (MODE == 0) {
        r0 = *(const uint4*)(Pr + C_RQ + sub * 128 + lc * 8);
        r1 = *(const uint4*)(Pr + C_RK + sub * 128 + lc * 8);
        r2 = *(const uint4*)(Pr + C_RV + sub * 128 + lc * 8);
        g0 = *(const uint4*)(Pr + C_RG + sub * 128 + lc * 8);
      } else if (MODE == 2) {
        r0 = *(const uint4*)(Pr + C_HQ + sub * 128 + lc * 8);
        r1 = *(const uint4*)(Pr + C_HF + sub * 128 + lc * 8);
        r2 = *(const uint4*)(Pr + C_HI + sub * 128 + lc * 8);
        g0 = *(const uint4*)(Pr + C_HG + sub * 128 + lc * 8);
      } else {
        r0 = *(const uint4*)(Pr + C_SXBC + gg * 256 + pair * 128 + lc * 8);
        r1 = *(const uint4*)(Pr + C_SXBC + 512 + gg * 128 + lc * 8);
        r2 = *(const uint4*)(Pr + C_SXBC + 768 + gg * 128 + lc * 8);
        g0 = *(const uint4*)(Pr + C_SZ + gg * 256 + pair * 128 + lc * 8);
        if (lc < 2) rdt = Pr[C_SDT + sub * 2 + lc];
      }
    }
  };
  load_raw(ch_begin);

  for (int ch = ch_begin; ch < ch_end; ++ch) {
    const int t0 = ch * 16;
    const int nvalid = (L - t0 < 16) ? (L - t0) : 16;
    float sscale = 1.f;
    int tidv = threadIdx.x;
    asm volatile("" : "+v"(tidv));
    const int tid = tidv, lane = tid & 63, w = tid >> 6, r16 = lane & 15, quad = lane >> 4, lt = tid >> 4, lc = tid & 15;

    *(uint4*)(Raw + lt * 128 + lc * 8) = r0;
    *(uint4*)(Raw + 2048 + lt * 128 + lc * 8) = r1;
    *(uint4*)(Raw + 4096 + lt * 128 + lc * 8) = r2;
    if (MODE == 1) { if (lc < 2) Raw[6144 + lt * 2 + lc] = (u16)rdt; }
    const uint4 gc0 = g0;
    __syncthreads();
    if (ch + 1 < ch_end) load_raw(ch + 1);

    if (MODE == 0) {
      const int which = tid >> 7, pr = tid & 63, th = (tid >> 6) & 1;
      if (which == 1 || !light) {
        const u16* R = Raw + which * 2048;
        float sn, cs;
        sincos_red((float)(pos0 + t0 + th * 8) * rinv, sn, cs);
#pragma unroll
        for (int x = 0; x < 8; ++x) {
          const int t = th * 8 + x;
          float x1 = bf2f(R[t * 128 + pr]);
          float x2 = bf2f(R[t * 128 + pr + 64]);
          float y1 = x1 * cs - x2 * sn, y2 = x1 * sn + x2 * cs;
          if (which) {
            y1 *= 0.08838834764831845f; y2 *= 0.08838834764831845f;
            Ka[t * QS + pr] = f2bf(y1); Ka[t * QS + pr + 64] = f2bf(y2);
            float kd = __expf(lg * (float)(nvalid - 1 - t));
            KuT[pr * TS + t] = f2bf(y1 * kd);
            KuT[(pr + 64) * TS + t] = f2bf(y2 * kd);
          } else {
            Qa[t * QS + pr] = f2bf(y1); Qa[t * QS + pr + 64] = f2bf(y2);
          }
          float ncs = cs * rcD - sn * rsD;
          sn = sn * rcD + cs * rsD; cs = ncs;
        }
      }
      if (tid < 16) cdec[tid] = lg * (float)(tid + 1);
      sscale = __expf(lg * (float)nvalid);
    } else if (MODE == 2) {
      const int d = tid & 127, th = tid >> 7;
      float cl[8], kk[8], qv[8];
      float c = 0.f;
#pragma unroll
      for (int x = 0; x < 8; ++x) {
        const int t = th * 8 + x;
        kk[x] = 0.f; qv[x] = 0.f;
        if (t < nvalid) {
          float z = bf2f(Raw[2048 + t * 128 + d]);
          float sg = sigmoidf_(z);
          float f = lbv + (1.f - lbv) * sg;
          c += __logf(f);
          kk[x] = (1.f - lbv) * (1.f - sg);
          if (!light) qv[x] = siluf_(bf2f(Raw[t * 128 + d]));
        }
        cl[x] = c;
      }
      tot[th * 128 + d] = c;
      __syncthreads();
      const float c_lo = tot[d];
      const float c_all = c_lo + tot[128 + d];
      const float off = th ? c_lo : 0.f;
#pragma unroll
      for (int x = 0; x < 8; ++x) {
        const int t = th * 8 + x;
        const float ct = off + cl[x];
        if (!light) {
          Qa[t * QS + d] = f2bf(qv[x] * __expf(ct));
          Ka[t * QS + d] = f2bf(kk[x] * __expf(-ct));
        }
        KuT[d * TS + t] = f2bf(kk[x] * __expf(c_all - ct));
      }
      if (th == 0) { rsc[d] = __expf(c_all); hg_tot += c_all; }
    } else {
      if (tid < 32) {
        const int hl = tid >> 4, t = tid & 15;
        float dtv = 0.f, c = 0.f;
        if (t < nvalid) {
          dtv = softplusf_(bf2f(Raw[6144 + t * 2 + hl]) + dt_bias);
          c = dtv * dt_A;
        }
#pragma unroll
        for (int o = 1; o < 16; o <<= 1) {
          float v = __shfl_up(c, o, 16);
          if (t >= o) c += v;
        }
        cdec[hl * 16 + t] = c;
        dtl[hl * 16 + t] = dtv;
        if (t == 15) { clast[hl] = c; segacc[hl] += c; }
      }
      __syncthreads();
#pragma unroll
      for (int k = 0; k < 2; ++k) {
        const int ci = tid + 256 * k;
        if (ci < 256 || (ci < 384 && !light)) {
          const int hl = (ci < 128) ? (ci >> 6) : 0;
          const float cl = clast[hl];
          const u16* R = Raw + ((ci < 128) ? ci : ((ci < 256) ? (2048 + (ci - 128)) : (4096 + (ci - 256))));
#pragma unroll 4
          for (int t = 0; t < 16; ++t) {
            float v = 0.f;
            if (t < nvalid) {
              float raw = bf2f(R[t * 128]);
              float o = cb[k] + cprev[k][0] * cw[k][0] + cprev[k][1] * cw[k][1] + cprev[k][2] * cw[k][2] + raw * cw[k][3];
              cprev[k][0] = cprev[k][1]; cprev[k][1] = cprev[k][2]; cprev[k][2] = raw;
              v = siluf_(o);
            }
            if (ci < 128) {
              float dtv = dtl[hl * 16 + t];
              if (!light) { Xc[t * 128 + ci] = f2bf(v); VaT[ci * TS + t] = f2bf(v * dtv); }
              VuT[ci * TS + t] = f2bf(v * dtv * __expf(cl - cdec[hl * 16 + t]));
            } else if (ci < 256) {
              u16 a = f2bf(v);
              if (!light) Ka[t * QS + (ci - 128)] = a;
              KuT[(ci - 128) * TS + t] = a;
            } else {
              Qa[t * QS + (ci - 256)] = f2bf(v);
            }
          }
        }
      }
    }
    if (MODE != 1) {
      const int e = tid & 127, th = tid >> 7;
#pragma unroll
      for (int x = 0; x < 4; ++x) {
        const int t = th * 8 + 2 * x;
        unsigned lo = Raw[4096 + t * 128 + e], hi = Raw[4096 + (t + 1) * 128 + e];
        *(unsigned*)(VaT + e * TS + t) = lo | (hi << 16);
      }
    }
    __syncthreads();

    {
      const float* cd = cdec + ((MODE == 1) ? (w >> 1) * 16 : 0);
      bf16x8 attA;
      float rr[4];
      bf16x8 qf[4];
      if (!light) {
        f32x4 at = f32x4{0.f, 0.f, 0.f, 0.f};
#pragma unroll
        for (int s = 0; s < 4; ++s) {
          bf16x8 a = *(const bf16x8*)(Ka + r16 * QS + s * 32 + quad * 8);
          bf16x8 b = *(const bf16x8*)(Qa + r16 * QS + s * 32 + quad * 8);
          at = MFMA16(a, b, at);
        }
        float ci_ = (MODE != 2) ? cd[r16] : 0.f;
        float vv[4];
#pragma unroll
        for (int jj = 0; jj < 4; ++jj) {
          int j = quad * 4 + jj;
          float v = at[jj];
          if (MODE != 2) v *= __expf(fminf(ci_ - cd[j], 0.f));
          vv[jj] = (j <= r16) ? v : 0.f;
        }
        unsigned a01 = pack2(vv[0], vv[1]), a23 = pack2(vv[2], vv[3]);
        attA = __builtin_bit_cast(bf16x8, (u32x4){a01, a23, 0u, 0u});
#pragma unroll
        for (int jj = 0; jj < 4; ++jj) rr[jj] = (MODE != 2) ? __expf(cd[quad * 4 + jj]) : 1.f;
#pragma unroll
        for (int s = 0; s < 4; ++s) {
          bf16x4 lo = *(const bf16x4*)(Qa + r16 * QS + s * 32 + quad * 4);
          bf16x4 hi = *(const bf16x4*)(Qa + r16 * QS + s * 32 + 16 + quad * 4);
          qf[s] = bf16x8{lo[0], lo[1], lo[2], lo[3], hi[0], hi[1], hi[2], hi[3]};
        }
      }
      __syncthreads();
      if (!light) {
#pragma unroll
        for (int u = 0; u < NE; ++u) {
          const int e0 = (w * NE + u) * 16;
          bf16x4 v4 = *(const bf16x4*)(VaT + (e0 + r16) * TS + quad * 4);
          bf16x8 vb = bf16x8{v4[0], v4[1], v4[2], v4[3], 0, 0, 0, 0};
          f32x4 o1 = MFMA16(attA, vb, (f32x4{0.f, 0.f, 0.f, 0.f}));
          f32x4 o2 = f32x4{0.f, 0.f, 0.f, 0.f};
#pragma unroll
          for (int s = 0; s < 4; ++s) {
            u32x4 sp = {pack2(S[2 * s][u][0], S[2 * s][u][1]), pack2(S[2 * s][u][2], S[2 * s][u][3]),
                        pack2(S[2 * s + 1][u][0], S[2 * s + 1][u][1]), pack2(S[2 * s + 1][u][2], S[2 * s + 1][u][3])};
            o2 = MFMA16(qf[s], __builtin_bit_cast(bf16x8, sp), o2);
          }
#pragma unroll
          for (int jj = 0; jj < 4; ++jj) Of[(quad * 4 + jj) * OFS + e0 + r16] = o1[jj] + rr[jj] * o2[jj];
        }
      }
      float hs = 1.f;
      if (MODE == 0) hs = sscale;
      if (MODE == 1) hs = __expf(clast[w >> 1]);
#pragma unroll
      for (int u = 0; u < NE; ++u) {
        const int e0 = (w * NE + u) * 16;
        bf16x4 v4 = *(const bf16x4*)(VuT + (e0 + r16) * TS + quad * 4);
        bf16x8 vb = bf16x8{v4[0], v4[1], v4[2], v4[3], 0, 0, 0, 0};
#pragma unroll
        for (int t = 0; t < 8; ++t) {
          bf16x4 k4 = *(const bf16x4*)(KuT + (t * 16 + r16) * TS + quad * 4);
          bf16x8 ka = bf16x8{k4[0], k4[1], k4[2], k4[3], 0, 0, 0, 0};
          f32x4 sv = S[t][u];
          if (MODE == 2) {
            f32x4 r4 = *(const f32x4*)(rsc + t * 16 + quad * 4);
            sv[0] *= r4[0]; sv[1] *= r4[1]; sv[2] *= r4[2]; sv[3] *= r4[3];
          } else {
            sv[0] *= hs; sv[1] *= hs; sv[2] *= hs; sv[3] *= hs;
          }
          S[t][u] = MFMA16(ka, vb, sv);
        }
      }
    }
    __syncthreads();

    if (!light) {
      const int i = tid >> 4, eg = tid & 15;
      const int grow = row0 + t0 + i;
      unsigned gw[4] = {gc0.x, gc0.y, gc0.z, gc0.w};
      if (MODE == 0 || MODE == 2) {
        float o[8];
#pragma unroll
        for (int x = 0; x < 8; ++x) o[x] = Of[i * OFS + eg * 8 + x];
        float s1 = 0.f;
        float mu = 0.f;
        if (MODE == 0) {
#pragma unroll
          for (int x = 0; x < 8; ++x) s1 += o[x];
          mu = sum16(s1) * (1.f / 128.f);
        }
        float s2 = 0.f;
#pragma unroll
        for (int x = 0; x < 8; ++x) { o[x] -= mu; s2 += o[x] * o[x]; }
        float r = rsqrtf(sum16(s2) * (1.f / 128.f) + EPS);
        if (i < nvalid) {
          const float* gain = (MODE == 0) ? (p.in[13] + (l * 4 + sub) * 128 + eg * 8) : (p.in[21] + l * 128 + eg * 8);
          float res[8];
#pragma unroll
          for (int x = 0; x < 8; ++x) {
            float g = bf2f((u16)((x & 1) ? (gw[x >> 1] >> 16) : (gw[x >> 1] & 0xffff)));
            float gate = (MODE == 0) ? siluf_(g) : sigmoidf_(g);
            res[x] = o[x] * r * gain[x] * gate;
          }
          uint4 ov = make_uint4(pack2(res[0], res[1]), pack2(res[2], res[3]), pack2(res[4], res[5]), pack2(res[6], res[7]));
          const int ocol = ((MODE == 0) ? 0 : 1024) + sub * 128 + eg * 8;
          *(uint4*)(p.obuf + (size_t)grow * OLD + ocol) = ov;
        }
      } else {
        float y[8];
        const int chb = eg * 8;
        const float Dh = p.in[18][l * 8 + sub * 2 + (chb >> 6)];
        float s2 = 0.f;
#pragma unroll
        for (int x = 0; x < 8; ++x) {
          float g = bf2f((u16)((x & 1) ? (gw[x >> 1] >> 16) : (gw[x >> 1] & 0xffff)));
          float v = Of[i * OFS + chb + x] + bf2f(Xc[i * 128 + chb + x]) * Dh;
          v *= siluf_(g);
          y[x] = v; s2 += v * v;
        }
        s2 = sum16(s2);
        if (i < nvalid) {
          if (eg == 0) p.ssq[(size_t)grow * 4 + sub] = s2;
          uint4 ov = make_uint4(pack2(y[0], y[1]), pack2(y[2], y[3]), pack2(y[4], y[5]), pack2(y[6], y[7]));
          *(uint4*)(p.obuf + (size_t)grow * OLD + 512 + sub * 128 + chb) = ov;
        }
      }
    }
    __syncthreads();
  }

  if (light) {
    uint2* sl = (uint2*)(p.slocal + (size_t)(cid * (p.nseg - 1) + seg) * 16384) + tid;
#pragma unroll
    for (int t = 0; t < 8; ++t)
#pragma unroll
      for (int u = 0; u < NE; ++u)
        sl[(t * NE + u) * 256] = make_uint2(pack2(S[t][u][0], S[t][u][1]), pack2(S[t][u][2], S[t][u][3]));
    float* sd = p.segdec + (size_t)(cid * 7 + seg) * 128;
    if (MODE == 1) { if (tid < 2) sd[tid] = segacc[tid]; }
    if (MODE == 2) { if (tid < 128) sd[tid] = hg_tot; }
  } else if (last_seg) {
    asm volatile("" : "+v"(sbase));
#pragma unroll
    for (int t = 0; t < 8; ++t)
#pragma unroll
      for (int u = 0; u < NE; ++u) {
        if (MODE == 1) {
          *(f32x4*)(sout + sbase + u * 2048 + t * 16) = S[t][u];
        } else {
#pragma unroll
          for (int jj = 0; jj < 4; ++jj) sout[sbase + t * 2048 + jj * 128 + u * 16] = S[t][u][jj];
        }
      }
    if (MODE == 1) {
      float* co = p.out + (prompt ? p.o_conv_p : p.o_conv_s) + ((size_t)l * NB + bidx) * 3 * 1024;
#pragma unroll
      for (int k = 0; k < 2; ++k) {
        const int ci = tid + 256 * k;
        if (ci < 128 || (ci < 384 && pair == 0)) {
#pragma unroll
          for (int j = 0; j < 3; ++j) co[j * 1024 + ccidx[k]] = cprev[k][j];
        }
      }
    }
  }
}

__device__ void run_s5(const Params& p, int l, int seq, int gq, int seg, int pass, char* smem) {
  const int tid = tidq(), lane = tid & 63, w = tid >> 6, r16 = lane & 15, quad = lane >> 4;
  const int g = gq * 4 + w;
  const bool prompt = seq < 8;
  const int bidx = prompt ? seq : seq - 8;
  const int NB = prompt ? 8 : 128;
  const int row0 = prompt ? seq * 2048 : MPR + (seq - 8) * 8;
  const int nch = prompt ? p.cps : 1;
  const int ch_begin = prompt ? seg * nch : 0;
  const int ch_end = ch_begin + nch;
  const int nvalid = prompt ? 16 : 8;
  const bool light = prompt && (pass == 1);
  const bool last_seg = !prompt || (seg == p.nseg - 1);
  char* wb = smem + w * 5120;
  u16* Hs = (u16*)wb;
  u16* Us = (u16*)(wb + 4352);
  const int lg_ = l * 32 + g;

  const float dt = __expf(p.in[29][lg_]);
  float Ar[4][4], Ai[4][4];
  float fre[4], fim[4];
  float dtare[4], thv[4];
#pragma unroll
  for (int i = 0; i < 4; ++i) {
    const int pi = i * 16 + r16;
    const float are = p.in[22][lg_ * 64 + pi], aim = p.in[23][lg_ * 64 + pi];
    const float th = dt * aim;
    float sn, cs; sincos_red(th, sn, cs);
    float shalf, chalf; sincos_red(0.5f * th, shalf, chalf);
    const float em1 = expm1f(dt * are);
    const float mag = em1 + 1.f;
    const float abr = mag * cs, abi = mag * sn;
    const float nre = em1 * cs - 2.f * shalf * shalf, nim = abi;
    const float den = are * are + aim * aim;
    fre[i] = (nre * are + nim * aim) / den; fim[i] = (nim * are - nre * aim) / den;
    dtare[i] = dt * are; thv[i] = th;
    Ar[0][i] = abr; Ai[0][i] = abi;
    Ar[1][i] = abr * abr - abi * abi; Ai[1][i] = 2.f * abr * abi;
    Ar[2][i] = Ar[1][i] * abr - Ai[1][i] * abi; Ai[2][i] = Ar[1][i] * abi + Ai[1][i] * abr;
    Ar[3][i] = Ar[1][i] * Ar[1][i] - Ai[1][i] * Ai[1][i]; Ai[3][i] = 2.f * Ar[1][i] * Ai[1][i];
  }
  bf16x8 Bop[8];
#pragma unroll
  for (int nt = 0; nt < 8; ++nt) {
    const int i = nt & 3;
    u32x4 pk = {0u, 0u, 0u, 0u};
    if (quad < 2) {
      const size_t bo = ((size_t)lg_ * 64 + i * 16 + r16) * 16 + quad * 8;
      const float4 br0 = *(const float4*)(p.in[24] + bo), br1 = *(const float4*)(p.in[24] + bo + 4);
      const float4 bi0 = *(const float4*)(p.in[25] + bo), bi1 = *(const float4*)(p.in[25] + bo + 4);
      const float brv[8] = {br0.x, br0.y, br0.z, br0.w, br1.x, br1.y, br1.z, br1.w};
      const float biv[8] = {bi0.x, bi0.y, bi0.z, bi0.w, bi1.x, bi1.y, bi1.z, bi1.w};
      float v[8];
#pragma unroll
      for (int j = 0; j < 8; ++j)
        v[j] = (nt < 4) ? (fre[i] * brv[j] - fim[i] * biv[j]) : (fre[i] * biv[j] + fim[i] * brv[j]);
      pk = u32x4{pack2(v[0], v[1]), pack2(v[2], v[3]), pack2(v[4], v[5]), pack2(v[6], v[7])};
    }
    Bop[nt] = __builtin_bit_cast(bf16x8, pk);
  }
  bf16x8 Cop[4];
  float Dm[4] = {0.f, 0.f, 0.f, 0.f};
  if (!light) {
#pragma unroll
    for (int s = 0; s < 4; ++s) {
      const int n0 = 32 * s + quad * 8;
      const float* src = ((n0 >= 64) ? p.in[27] : p.in[26]) + ((size_t)lg_ * 16 + r16) * 64 + (n0 & 63);
      const float sg = (n0 >= 64) ? -1.f : 1.f;
      const float4 c0 = *(const float4*)src, c1 = *(const float4*)(src + 4);
      Cop[s] = __builtin_bit_cast(bf16x8, (u32x4{pack2(sg * c0.x, sg * c0.y), pack2(sg * c0.z, sg * c0.w),
                                                 pack2(sg * c1.x, sg * c1.y), pack2(sg * c1.z, sg * c1.w)}));
    }
#pragma unroll
    for (int jj = 0; jj < 4; ++jj) Dm[jj] = p.in[28][lg_ * 16 + quad * 4 + jj];
  }
  float hr[4], hi[4];
#pragma unroll
  for (int i = 0; i < 4; ++i) { hr[i] = 0.f; hi[i] = 0.f; }
  if (!prompt) {
#pragma unroll
    for (int i = 0; i < 4; ++i) {
      hr[i] = p.in[6][((size_t)(l * 128 + bidx) * 32 + g) * 64 + i * 16 + r16];
      hi[i] = p.in[7][((size_t)(l * 128 + bidx) * 32 + g) * 64 + i * 16 + r16];
    }
  } else if (pass == 2 && seg > 0) {
    const float len = (float)(nch * 16);
#pragma unroll
    for (int i = 0; i < 4; ++i) {
      const float pm = __expf(len * dtare[i]);
      float ps, pc; sincos_red(len * thv[i], ps, pc);
      const float pr_ = pm * pc, pi_ = pm * ps;
      for (int r = 0; r < seg; ++r) {
        const float* hl = p.hlocal + ((size_t)((seq * 32 + g) * 7 + r)) * 128;
        const float lr_ = hl[i * 16 + r16], li_ = hl[64 + i * 16 + r16];
        const float nr = pr_ * hr[i] - pi_ * hi[i] + lr_;
        const float ni = pr_ * hi[i] + pi_ * hr[i] + li_;
        hr[i] = nr; hi[i] = ni;
      }
    }
  }
  const int ut = lane >> 1, uh = lane & 1;
  const u16* ubase = p.pbuf + (size_t)(row0 + ut) * NP + C_SU + g * 16 + uh * 8;
  const uint4 z4 = make_uint4(0, 0, 0, 0);
  uint4 nxt = z4;
  if (lane < 32 && ut < nvalid) nxt = *(const uint4*)(ubase + (size_t)ch_begin * 16 * NP);
  for (int ch = ch_begin; ch < ch_end; ++ch) {
    const uint4 cur = nxt;
    nxt = z4;
    if (ch + 1 < ch_end && lane < 32) nxt = *(const uint4*)(ubase + (size_t)(ch + 1) * 16 * NP);
    if (lane < 32) *(uint4*)(Us + ut * 16 + uh * 8) = cur;
    __syncthreads();
    bf16x8 Uop = bf16x8{0, 0, 0, 0, 0, 0, 0, 0};
    if (quad < 2) Uop = *(const bf16x8*)(Us + r16 * 16 + quad * 8);
    f32x4 bu[8];
#pragma unroll
    for (int nt = 0; nt < 8; ++nt) bu[nt] = MFMA16(Uop, Bop[nt], (f32x4{0.f, 0.f, 0.f, 0.f}));
    float Er[4], Ei[4];
#pragma unroll
    for (int i = 0; i < 4; ++i) {
      float xr = 0.f, xi = 0.f;
#pragma unroll
      for (int jj = 0; jj < 4; ++jj) {
        const float nr = Ar[0][i] * xr - Ai[0][i] * xi + bu[i][jj];
        const float ni = Ar[0][i] * xi + Ai[0][i] * xr + bu[4 + i][jj];
        xr = nr; xi = ni;
        bu[i][jj] = xr; bu[4 + i][jj] = xi;
      }
      Er[i] = xr; Ei[i] = xi;
    }
    float cr[4], ci[4];
#pragma unroll
    for (int i = 0; i < 4; ++i) { cr[i] = hr[i]; ci[i] = hi[i]; }
#pragma unroll
    for (int k = 0; k < 4; ++k) {
#pragma unroll
      for (int i = 0; i < 4; ++i) {
        const float er = __shfl(Er[i], r16 + 16 * k), ei = __shfl(Ei[i], r16 + 16 * k);
        const float nr = Ar[3][i] * hr[i] - Ai[3][i] * hi[i] + er;
        const float ni = Ar[3][i] * hi[i] + Ai[3][i] * hr[i] + ei;
        if (k * 4 < nvalid) { hr[i] = nr; hi[i] = ni; }
        if (k < quad) { cr[i] = nr; ci[i] = ni; }
      }
    }
    if (!light) {
#pragma unroll
      for (int i = 0; i < 4; ++i)
#pragma unroll
        for (int jj = 0; jj < 4; ++jj) {
          const float vr = bu[i][jj] + Ar[jj][i] * cr[i] - Ai[jj][i] * ci[i];
          const float vi = bu[4 + i][jj] + Ar[jj][i] * ci[i] + Ai[jj][i] * cr[i];
          Hs[(quad * 4 + jj) * 136 + i * 16 + r16] = f2bf(vr);
          Hs[(quad * 4 + jj) * 136 + 64 + i * 16 + r16] = f2bf(vi);
        }
      __syncthreads();
      f32x4 ya = f32x4{0.f, 0.f, 0.f, 0.f};
#pragma unroll
      for (int s = 0; s < 4; ++s) {
        const bf16x8 bh = *(const bf16x8*)(Hs + r16 * 136 + s * 32 + quad * 8);
        ya = MFMA16(Cop[s], bh, ya);
      }
      const uint2 uu = *(const uint2*)(Us + r16 * 16 + quad * 4);
      const float u0 = bf2f((u16)(uu.x & 0xffff)), u1 = bf2f((u16)(uu.x >> 16));
      const float u2 = bf2f((u16)(uu.y & 0xffff)), u3 = bf2f((u16)(uu.y >> 16));
      const float z0 = gelu_tanh(ya[0] + Dm[0] * u0), z1 = gelu_tanh(ya[1] + Dm[1] * u1);
      const float z2 = gelu_tanh(ya[2] + Dm[2] * u2), z3 = gelu_tanh(ya[3] + Dm[3] * u3);
      if (r16 < nvalid)
        *(uint2*)(p.zs5 + (size_t)(row0 + ch * 16 + r16) * ZLD + g * 16 + quad * 4) = make_uint2(pack2(z0, z1), pack2(z2, z3));
    }
    __syncthreads();
  }
  if (light) {
    if (quad == 0) {
      float* hl = p.hlocal + ((size_t)((seq * 32 + g) * 7 + seg)) * 128;
#pragma unroll
      for (int i = 0; i < 4; ++i) { hl[i * 16 + r16] = hr[i]; hl[64 + i * 16 + r16] = hi[i]; }
    }
  } else if (last_seg) {
    if (quad == 0) {
      float* o_r = p.out + (prompt ? p.o_s5r_p : p.o_s5r_s) + ((size_t)(l * NB + bidx) * 32 + g) * 64;
      float* o_i = p.out + (prompt ? p.o_s5i_p : p.o_s5i_s) + ((size_t)(l * NB + bidx) * 32 + g) * 64;
#pragma unroll
      for (int i = 0; i < 4; ++i) { o_r[i * 16 + r16] = hr[i]; o_i[i * 16 + r16] = hi[i]; }
    }
  }
}

__device__ void phase_mixers(const Params& p, int l, int pass, char* smem, int visit) {
  int* s_item = (int*)(smem + 65536);
  unsigned* cnt = p.counters + l * 64 + (pass - 1) * 32 + visit * 16;
  const int nseg = p.nseg;
  const int ns1 = nseg - 1;
  const int n_chain = (pass == 1) ? 96 * ns1 : 96 * nseg;
  const int n_s5 = (pass == 1) ? 64 * ns1 : 64 * nseg;
  const int n_items = n_chain + n_s5 + ((pass == 1) ? 128 * 20 : 0);
  for (;;) {
    if (tidq() == 0) *s_item = (int)atomicAdd(cnt, 1u);
    __syncthreads();
    const int item = *s_item;
    __syncthreads();
    if (item >= n_items) break;
    int mode, seq, sub, seg = 0;
    const int per = (pass == 1) ? ns1 : nseg;
    if (item < n_chain) {
      const int c = item / per; seg = item % per;
      const int kind = c >> 5, r = c & 31;
      seq = r >> 2; sub = r & 3;
      mode = (kind == 0) ? 1 : ((kind == 1) ? 2 : 0);
    } else if (item < n_chain + n_s5) {
      const int k = item - n_chain;
      const int c = k / per; seg = k % per;
      mode = 3; seq = c >> 3; sub = c & 7;
    } else {
      int k = item - n_chain - n_s5; int b = k / 20; sub = k % 20; seq = 8 + b;
      if (sub < 4) mode = 1;
      else if (sub < 8) { mode = 0; sub -= 4; }
      else if (sub < 12) { mode = 2; sub -= 8; }
      else { mode = 3; sub -= 12; }
    }
    const int ps = (seq >= 8) ? 2 : pass;
    if (mode == 0) { if (EN(2) || ONLY == 20) run_chain<0>(p, l, seq, sub, seg, ps, smem); }
    else if (mode == 1) { if (EN(2) || ONLY == 21) run_chain<1>(p, l, seq, sub, seg, ps, smem); }
    else if (mode == 2) { if (EN(2) || ONLY == 22) run_chain<2>(p, l, seq, sub, seg, ps, smem); }
    else { if (EN(2) || ONLY == 23) run_s5(p, l, seq, sub, seg, ps, smem); }
    __syncthreads();
  }
}

DI bool tile_at(int i, int T, int& t) {
  const int bpx = gridDim.x >> 3;
  t = ((blockIdx.x & 7) + 8 * i) * bpx + (blockIdx.x >> 3);
  return t < T;
}
DI void tile_mn(int t, int nN, int& m0, int& n0) {
  const int per = 8 * nN;
  const int grp = t / per, r = t - grp * per;
  m0 = (grp * 8 + (r & 7)) * 128;
  n0 = (r >> 3) * 128;
}

__device__ void run_phase(const Params& p, int ph, char* smem, int visit) {
  constexpr int NMT = MTOK / 128;
  if (ph == 0) {
    if (EN(9)) phase_convert(p, smem);
    if (EN(0)) phase_rownorm(p, true, nullptr, nullptr, p.in[8], p.hb);
    return;
  }
  if (ph == NPHASE - 1) {
    if (EN(10)) phase_rownorm(p, false, p.tbuf, p.in[11] + 1 * DM, nullptr, nullptr);
    return;
  }
  const int l = (ph <= 9) ? 0 : 1, s0_ = (ph <= 9) ? ph : ph - 10;
  const int s = (s0_ <= 2) ? s0_ : s0_ - 1;
  switch (s) {
    case 0:
      if (!EN(0)) break;
      phase_rownorm(p, false, p.tbuf, p.in[11] + (l - 1) * DM, p.in[8] + l * DM, p.hb);
      break;
    case 1: if (EN(1)) {
      constexpr int NN = NP / 128;
      int t, m0, n0;
      for (int i = 0; tile_at(i, NMT * NN, t); ++i) {
        tile_mn(t, NN, m0, n0);
        gemm_tile<EPI_BF16>(p.hb, HLD, p.wt_in + (size_t)l * NIN * WLD1, WLD1, DM, m0, n0, p.pbuf, NP, nullptr, 0, smem);
      }
    } break;
    case 2: if (EN(2) || (ONLY >= 20 && ONLY <= 23)) phase_mixers(p, l, (s0_ == 2) ? 1 : 2, smem, visit); break;
    case 3: if (EN(3)) {
      constexpr int NG = 32, NGLU = 4;
      {
        const int lane = tidq() & 63, w = tidq() >> 6;
        for (int row = blockIdx.x * 4 + w; row < MTOK; row += gridDim.x * 4) {
          const float4 sq = *(const float4*)(p.ssq + (size_t)row * 4);
          const float ms = (lane < 32) ? (sq.x + sq.y) : (sq.z + sq.w);
          const float r = rsqrtf(ms * (1.f / 256.f) + EPS);
          u16* ptr = p.obuf + (size_t)row * OLD + 512 + lane * 8;
          uint4 v = *(const uint4*)ptr;
          const float* gn = p.in[19] + l * 512 + lane * 8;
          unsigned vw[4] = {v.x, v.y, v.z, v.w};
          unsigned ow[4];
#pragma unroll
          for (int x = 0; x < 4; ++x)
            ow[x] = pack2(bf2f((u16)(vw[x] & 0xffff)) * r * gn[2 * x], bf2f((u16)(vw[x] >> 16)) * r * gn[2 * x + 1]);
          *(uint4*)ptr = make_uint4(ow[0], ow[1], ow[2], ow[3]);
        }
      }
      int t, m0, n0;
      for (int i = 0; tile_at(i, NMT * (NG + NGLU), t); ++i) {
        if (t < NMT * NG) {
          tile_mn(t, NG, m0, n0);
          gemm_tile<EPI_SIG>(p.hb, HLD, p.wt_in + ((size_t)l * NIN + NP) * WLD1, WLD1, DM, m0, n0, p.pbuf, 4096, nullptr, 0, smem);
        } else {
          tile_mn(t - NMT * NG, NGLU, m0, n0);
          gemm_tile<EPI_GLU>(p.zs5, ZLD, p.wt_glu + (size_t)l * 512 * WLD5, WLD5, 512, m0, n0,
                             p.obuf + 1536, OLD, p.zs5, ZLD, smem);
        }
      }
    } break;
    case 4:
      if (EN(4)) {
        int t, m0, n0;
        for (int i = 0; tile_at(i, NMT * 8, t); ++i) { tile_mn(t, 8, m0, n0); merge_tile(p, l, m0, n0, smem); }
      }
      break;
    case 5:
      if (EN(5)) {
        int t, m0, n0;
        for (int i = 0; tile_at(i, NMT * 8, t); ++i) {
          tile_mn(t, 8, m0, n0);
          gemm_tile<EPI_F32>(p.hb, HLD, p.wt_out + (size_t)l * DM * WLD1, WLD1, DM, m0, n0, p.tbuf, DM, nullptr, 0, smem);
        }
      }
      break;
    case 6:
      if (EN(6)) phase_rownorm(p, false, p.tbuf, p.in[9] + l * DM, p.in[10] + l * DM, p.hb);
      break;
    case 7:
      if (EN(7)) {
        int t, m0, n0;
        for (int i = 0; tile_at(i, NMT * 32, t); ++i) {
          tile_mn(t, 32, m0, n0);
          gemm_tile<EPI_RELU2>(p.hb, HLD, p.wt_ff1 + (size_t)l * DFF * WLD1, WLD1, DM, m0, n0, p.pbuf, ULD, nullptr, 0, smem);
        }
      }
      break;
    case 8:
      if (EN(8)) {
        int t, m0, n0;
        for (int i = 0; tile_at(i, NMT * 8, t); ++i) {
          tile_mn(t, 8, m0, n0);
          gemm_tile<EPI_F32>(p.pbuf, ULD, p.wt_ff2 + (size_t)l * DM * WLD4, WLD4, DFF, m0, n0, p.tbuf, DM, nullptr, 0, smem);
        }
      }
      break;
  }
}

#ifndef DUP_S
#define DUP_S -1
#endif
#define XB_TMO      128
#define XB_XCNT(j)  (256  + 64 * (j))
#define XB_XSUB(j)  (1280 + 64 * (j))
#define XB_XGEN(j)  (2304 + 64 * (j))
#define XB_TOP      3328
#define XB_TOPGEN   3392
#define XCD_BAR_WORDS 3456
#define XB_SPIN_CAP (1u << 22)
#define LAS __attribute__((address_space(3)))
DI unsigned xb_ld(unsigned* p)              { return __hip_atomic_load(p, __ATOMIC_RELAXED, __HIP_MEMORY_SCOPE_AGENT); }
DI unsigned xb_add(unsigned* p, unsigned v) { return __hip_atomic_fetch_add(p, v, __ATOMIC_RELAXED, __HIP_MEMORY_SCOPE_AGENT); }
DI unsigned xb_xcc_id() { return (unsigned)__builtin_amdgcn_s_getreg((3 << 11) | 20) & 0xFu; }
#define XB_SPIN(cond, bar) do { unsigned _sp = 0; while (cond) { __builtin_amdgcn_s_sleep(1); \
    if ((++_sp & 255u) == 0u) { if (xb_ld(&(bar)[XB_TMO])) break; if (_sp > XB_SPIN_CAP) { atomicAdd(&(bar)[XB_TMO], 1u); break; } } } } while (0)
struct XcdBarrier { unsigned* bar; unsigned x; volatile LAS unsigned* st; };
DI XcdBarrier xcd_barrier_post(unsigned* bar, volatile LAS unsigned* st) {
  XcdBarrier b; b.bar = bar; b.x = xb_xcc_id(); b.st = st;
  if (threadIdx.x == 0) (void)xb_add(&bar[XB_XCNT(b.x)], 1u);
  return b;
}
DI void xcd_barrier_complete(unsigned* bar, unsigned x, unsigned& nloc, unsigned& nx) {
  const unsigned G = gridDim.x * gridDim.y * gridDim.z;
  unsigned sum, cnt, mine, sp = 0u;
  for (;;) {
    sum = 0u; cnt = 0u; mine = 0u;
#pragma unroll
    for (unsigned j = 0; j < 16; ++j) { const unsigned c = xb_ld(&bar[XB_XCNT(j)]); sum += c; cnt += (c > 0u) ? 1u : 0u; mine = (j == x) ? c : mine; }
    if (sum == G) break;
    __builtin_amdgcn_s_sleep(1);
    if ((++sp & 255u) == 0u) { if (xb_ld(&bar[XB_TMO])) break; if (sp > XB_SPIN_CAP) { atomicAdd(&bar[XB_TMO], 1u); break; } }
  }
  nloc = mine > 0u ? mine : 1u; nx = cnt > 0u ? cnt : 1u;
}
DI void xcd_barrier(const XcdBarrier& b) {
  asm volatile("s_waitcnt vmcnt(0)" ::: "memory");
  __syncthreads();
  if (threadIdx.x == 0) {
    unsigned* bar = b.bar;
    __builtin_amdgcn_s_waitcnt(0);
    unsigned nloc = b.st[0], nx = b.st[1];
    if (nloc == 0u) { xcd_barrier_complete(bar, b.x, nloc, nx); b.st[0] = nloc; b.st[1] = nx; }
    const unsigned old = xb_add(&bar[XB_XSUB(b.x)], 1u);
    const unsigned gen = old / nloc;
    if (old + 1u == (gen + 1u) * nloc) {
      __builtin_amdgcn_fence(__ATOMIC_RELEASE, "agent");
      asm volatile("s_waitcnt vmcnt(0)" ::: "memory");
      const unsigned og = xb_add(&bar[XB_TOP], 1u);
      const unsigned tg = og / nx;
      if (og + 1u == (tg + 1u) * nx) xb_add(&bar[XB_TOPGEN], 1u);
      else XB_SPIN(xb_ld(&bar[XB_TOPGEN]) == tg, bar);
      __builtin_amdgcn_fence(__ATOMIC_ACQUIRE, "agent");
      xb_add(&bar[XB_XGEN(b.x)], 1u);
      asm volatile("s_waitcnt vmcnt(0)" ::: "memory");
    } else {
      XB_SPIN(xb_ld(&bar[XB_XGEN(b.x)]) == gen, bar);
      __builtin_amdgcn_fence(__ATOMIC_ACQUIRE, "agent");
      asm volatile("s_waitcnt vmcnt(0)" ::: "memory");
    }
  }
  __syncthreads();
}

__global__ void __launch_bounds__(256, 2) mega_kernel(Params p, int ph_lo, int ph_hi) {
  __shared__ __attribute__((aligned(16))) char smem[65536 + 32];
  volatile LAS unsigned* st = (volatile LAS unsigned*)(&smem[65536 + 16]);
  if (threadIdx.x == 0) { st[0] = 0u; st[1] = 0u; }
  __syncthreads();
  const XcdBarrier xb = xcd_barrier_post(p.bar, st);
  for (int ph = ph_lo; ph < ph_hi; ++ph) {
    if (ph > ph_lo) xcd_barrier(xb);
    if (ph_hi < 0) cg::this_grid().sync();
    const int reps = (DUP_S >= 0 && ph == DUP_S) ? 2 : 1;
    for (int r = 0; r < reps; ++r) {
      if (r) xcd_barrier(xb);
#ifdef VAR_NOSTORE
      if (tidq() == 0) *(volatile int*)(smem + 65536 + 8) = r;
      __syncthreads();
#endif
      run_phase(p, ph, smem, r);
    }
  }
}

extern "C" void kernel_launch(void* const* d_in, const int* in_sizes, int n_in, void* d_out, int out_size,
                              void* d_ws, size_t ws_size, hipStream_t stream) {
  Params p{};
  for (int i = 0; i < 35; ++i) p.in[i] = (const float*)d_in[i];
  p.out = (float*)d_out;
  char* ws = (char*)d_ws;
  size_t off = 0;
  auto take = [&](size_t bytes) { char* r = ws + off; off += (bytes + 255) & ~(size_t)255; return r; };
  p.wt_in  = (u16*)take((size_t)2 * NIN * WLD1 * 2);
  p.wt_ff1 = (u16*)take((size_t)2 * DFF * WLD1 * 2);
  p.wt_ff2 = (u16*)take((size_t)2 * DM * WLD4 * 2);
  p.wt_br  = (u16*)take((size_t)2 * 4 * DM * WLD5 * 2);
  p.wt_out = (u16*)take((size_t)2 * DM * WLD1 * 2);
  p.wt_glu = (u16*)take((size_t)2 * 512 * WLD5 * 2);
  p.hb     = (u16*)take((size_t)MTOK * HLD * 2);
  p.pbuf   = (u16*)take((size_t)MTOK * NP * 2);
  p.obuf   = (u16*)take((size_t)MTOK * OLD * 2);
  p.zs5    = (u16*)take((size_t)MTOK * ZLD * 2);
  p.counters = (unsigned*)take(4096);
  p.bar = (unsigned*)take(16384);
  p.ssq = (float*)take((size_t)MTOK * 4 * 4);
  p.segdec = (float*)take((size_t)96 * 7 * 128 * 4);
  p.hlocal = (float*)take((size_t)8 * 32 * 7 * 128 * 4);
  p.nseg = 8;
  if (off + (size_t)96 * 7 * 32768 > ws_size) p.nseg = 4;
  p.cps = 128 / p.nseg;
  p.slocal = (u16*)take((size_t)96 * (p.nseg - 1) * 32768);
  p.tbuf = (float*)(p.pbuf + (size_t)MTOK * ULD);
  if (off > ws_size) { fprintf(stderr, "workspace too small: need %zu have %zu\n", off, ws_size); return; }
  size_t o = (size_t)MTOK * DM;
  p.o_ret_p = o;  o += (size_t)2 * 8 * 65536;
  p.o_ret_s = o;  o += (size_t)2 * 128 * 65536;
  p.o_ssd_p = o;  o += (size_t)2 * 8 * 65536;
  p.o_ssd_s = o;  o += (size_t)2 * 128 * 65536;
  p.o_conv_p = o; o += (size_t)2 * 8 * 3 * 1024;
  p.o_conv_s = o; o += (size_t)2 * 128 * 3 * 1024;
  p.o_hg_p = o;   o += (size_t)2 * 8 * 65536;
  p.o_hg_s = o;   o += (size_t)2 * 128 * 65536;
  p.o_s5r_p = o;  o += (size_t)2 * 8 * 2048;
  p.o_s5r_s = o;  o += (size_t)2 * 128 * 2048;
  p.o_s5i_p = o;  o += (size_t)2 * 8 * 2048;
  p.o_s5i_s = o;  o += (size_t)2 * 128 * 2048;

  static int grid_blocks = 0;
  if (!grid_blocks) {
    int dev = 0, cus = 0, per_cu = 0;
    hipGetDevice(&dev);
    hipDeviceGetAttribute(&cus, hipDeviceAttributeMultiprocessorCount, dev);
    hipOccupancyMaxActiveBlocksPerMultiprocessor(&per_cu, mega_kernel, 256, 0);
    if (per_cu > 2) per_cu = 2;
    if (per_cu < 1) per_cu = 1;
    grid_blocks = cus * per_cu;
  }
  hipMemsetAsync(p.counters, 0, 4096 + 16384, stream);
#if SINGLE_LAUNCH
  int lo = 0, hi = NPHASE;
  void* args[] = {&p, &lo, &hi};
  hipError_t e = hipLaunchCooperativeKernel((void*)mega_kernel, dim3(grid_blocks), dim3(256), args, 0, stream);
  if (e != hipSuccess) fprintf(stderr, "cooperative launch failed: %s (grid %d)\n", hipGetErrorString(e), grid_blocks);
#else
  for (int ph = 0; ph < NPHASE; ++ph)
    hipLaunchKernelGGL(mega_kernel, dim3(grid_blocks), dim3(256), 0, stream, p, ph, ph + 1);
#endif
}
```

```cpp
#include <hip/hip_runtime.h>
#include <hip/hip_cooperative_groups.h>
#include <cstdio>
#include <cstdint>
namespace cg = cooperative_groups;

#ifndef SINGLE_LAUNCH
#define SINGLE_LAUNCH 1
#endif
#ifndef ONLY
#define ONLY -1
#endif
#define EN(k) (ONLY < 0 || ONLY == (k))

typedef unsigned short u16;
using bf16x8 = __attribute__((ext_vector_type(8))) short;
using bf16x4 = __attribute__((ext_vector_type(4))) short;
using f32x4  = __attribute__((ext_vector_type(4))) float;
typedef unsigned u32x4 __attribute__((ext_vector_type(4)));
#define DI __device__ __forceinline__
#define MFMA16(a, b, c) __builtin_amdgcn_mfma_f32_16x16x32_bf16((a), (b), (c), 0, 0, 0)

constexpr int MTOK = 17408;
constexpr int MPR  = 16384;
constexpr int DM   = 1024;
constexpr int NP   = 6272;
constexpr int NIN  = 10368;
constexpr int DFF  = 4096;
constexpr int INC  = 10248;
constexpr int C_RQ = 0, C_RK = 512, C_RV = 1024, C_RG = 1536, C_SZ = 2048, C_SXBC = 2560;
constexpr int C_HQ = 3584, C_HF = 4096, C_HI = 4608, C_HG = 5120, C_SU = 5632, C_SDT = 6144;
constexpr float EPS = 1e-6f;
constexpr int HLD = 1024, WLD1 = 1024, ULD = 4096, WLD4 = 4096, OLD = 2048, ZLD = 512, WLD5 = 512;
constexpr int NITEMS = 160 + 128 * 20;
constexpr int NPHASE = 21;

struct Params {
  const float* in[35];
  float* out;
  u16 *wt_in, *wt_ff1, *wt_ff2, *wt_br, *wt_out, *wt_glu;
  u16 *hb, *pbuf, *obuf, *zs5;
  float* tbuf;
  unsigned* counters;
  unsigned* bar;
  float* ssq;
  u16* slocal;
  float* segdec;
  float* hlocal;
  int nseg, cps;
  size_t o_ret_p, o_ret_s, o_ssd_p, o_ssd_s, o_conv_p, o_conv_s, o_hg_p, o_hg_s, o_s5r_p, o_s5r_s, o_s5i_p, o_s5i_s;
};

DI int tidq() { int t = threadIdx.x; asm volatile("" : "+v"(t)); return t; }
typedef __bf16 bf16v2 __attribute__((ext_vector_type(2)));
typedef float f32v2 __attribute__((ext_vector_type(2)));
DI unsigned pack2(float a, float b) { f32v2 v = {a, b}; return __builtin_bit_cast(unsigned, __builtin_convertvector(v, bf16v2)); }
DI u16 f2bf(float f) { return (u16)(pack2(f, 0.f) & 0xffffu); }
DI float bf2f(u16 h) { return __uint_as_float(((unsigned)h) << 16); }
DI float sigmoidf_(float x) { return 1.f / (1.f + __expf(-x)); }
DI float siluf_(float x) { return x / (1.f + __expf(-x)); }
DI float softplusf_(float x) { return x > 20.f ? x : log1pf(__expf(x)); }
DI float gelu_tanh(float x) {
  float u = 0.7978845608028654f * (x + 0.044715f * x * x * x);
  float e = __expf(2.f * u);
  float th = 1.f - 2.f / (e + 1.f);
  return 0.5f * x * (1.f + th);
}
DI float wave_sum(float v) {
#pragma unroll
  for (int m = 32; m >= 1; m >>= 1) v += __shfl_xor(v, m);
  return v;
}
DI float sum16(float v) {
#pragma unroll
  for (int m = 8; m >= 1; m >>= 1) v += __shfl_xor(v, m);
  return v;
}
DI void sincos_red(float a, float& s, float& c) {
  float n = rintf(a * 0.15915494309189535f);
  float r = fmaf(-n, 6.28125f, a);
  r = fmaf(-n, 1.9353071795864769e-3f, r);
  s = __sinf(r); c = __cosf(r);
}

DI int map_win(int my) {
  if (my < 3584) return my;
  if (my < 6144) return my + 8;
  if (my < 6152) return my - 6144 + 3584;
  if (my < 6272) return -1;
  return my - 120;
}
DI void transpose_tile(const float* __restrict__ src, int src_ld, u16* __restrict__ dst, int dst_ld,
                       int k0, int n0, int mapmode, char* smem) {
  float* tile = (float*)smem;
  const int tid = tidq();
  {
    const int n = tid & 63;
    int sc = n0 + n;
    if (mapmode) sc = map_win(sc);
#pragma unroll
    for (int i = 0; i < 16; ++i) {
      int k = (tid >> 6) + 4 * i;
      float v = (sc >= 0) ? src[(size_t)(k0 + k) * src_ld + sc] : 0.f;
      tile[n * 65 + k] = v;
    }
  }
  __syncthreads();
  {
    const int n = tid >> 2, kc = (tid & 3) * 16;
    unsigned pk[8];
#pragma unroll
    for (int x = 0; x < 8; ++x) pk[x] = pack2(tile[n * 65 + kc + 2 * x], tile[n * 65 + kc + 2 * x + 1]);
    uint4* d = (uint4*)(dst + (size_t)(n0 + n) * dst_ld + k0 + kc);
    d[0] = make_uint4(pk[0], pk[1], pk[2], pk[3]);
    d[1] = make_uint4(pk[4], pk[5], pk[6], pk[7]);
  }
  __syncthreads();
}

__device__ void phase_convert(const Params& p, char* smem) {
  constexpr int PER = 5472;
  for (int t = blockIdx.x; t < 2 * PER; t += gridDim.x) {
    int l = t / PER, r = t % PER;
    if (r < 2592) {
      int nt = r / 16, kt = r % 16;
      transpose_tile(p.in[12] + (size_t)l * DM * INC, INC, p.wt_in + (size_t)l * NIN * WLD1, WLD1, kt * 64, nt * 64, 1, smem);
    } else if (r < 3616) {
      r -= 2592; int nt = r / 16, kt = r % 16;
      transpose_tile(p.in[33] + (size_t)l * DM * DFF, DFF, p.wt_ff1 + (size_t)l * DFF * WLD1, WLD1, kt * 64, nt * 64, 0, smem);
    } else if (r < 4640) {
      r -= 3616; int nt = r / 64, kt = r % 64;
      transpose_tile(p.in[34] + (size_t)l * DFF * DM, DM, p.wt_ff2 + (size_t)l * DM * WLD4, WLD4, kt * 64, nt * 64, 0, smem);
    } else if (r < 4896) {
      r -= 4640; int nt = r / 16, kt = r % 16;
      transpose_tile(p.in[32] + (size_t)l * DM * DM, DM, p.wt_out + (size_t)l * DM * WLD1, WLD1, kt * 64, nt * 64, 0, smem);
    } else if (r < 5408) {
      r -= 4896; int b = r / 128; r %= 128; int nt = r / 8, kt = r % 8;
      transpose_tile(p.in[31] + (size_t)(l * 4 + b) * 512 * DM, DM, p.wt_br + (size_t)(l * 4 + b) * DM * WLD5, WLD5, kt * 64, nt * 64, 0, smem);
    } else {
      r -= 5408; int nt = r / 8, kt = r % 8;
      transpose_tile(p.in[30] + (size_t)l * 512 * 512, 512, p.wt_glu + (size_t)l * 512 * WLD5, WLD5, kt * 64, nt * 64, 0, smem);
    }
  }
}

__device__ void phase_rownorm(const Params& p, bool from_input, const float* __restrict__ t, const float* __restrict__ gpost,
                              const float* __restrict__ gpre, u16* __restrict__ hout) {
  const int lane = tidq() & 63, w = tidq() >> 6;
  float* xbuf = p.out;
  for (int row = blockIdx.x * 4 + w; row < MTOK; row += gridDim.x * 4) {
    const float* xin = from_input ? (row < MPR ? p.in[0] + (size_t)row * DM : p.in[1] + (size_t)(row - MPR) * DM)
                                  : xbuf + (size_t)row * DM;
    float4 x[4];
#pragma unroll
    for (int k = 0; k < 4; ++k) x[k] = *(const float4*)(xin + lane * 4 + 256 * k);
    if (t) {
      float4 tv[4];
      float ss = 0.f;
#pragma unroll
      for (int k = 0; k < 4; ++k) {
        tv[k] = *(const float4*)(t + (size_t)row * DM + lane * 4 + 256 * k);
        ss += tv[k].x * tv[k].x + tv[k].y * tv[k].y + tv[k].z * tv[k].z + tv[k].w * tv[k].w;
      }
      ss = wave_sum(ss);
      float r = rsqrtf(ss * (1.f / DM) + EPS);
#pragma unroll
      for (int k = 0; k < 4; ++k) {
        float4 g = *(const float4*)(gpost + lane * 4 + 256 * k);
        x[k].x += tv[k].x * r * g.x; x[k].y += tv[k].y * r * g.y; x[k].z += tv[k].z * r * g.z; x[k].w += tv[k].w * r * g.w;
      }
    }
#pragma unroll
    for (int k = 0; k < 4; ++k) *(float4*)(xbuf + (size_t)row * DM + lane * 4 + 256 * k) = x[k];
    if (hout) {
      float ss = 0.f;
#pragma unroll
      for (int k = 0; k < 4; ++k) ss += x[k].x * x[k].x + x[k].y * x[k].y + x[k].z * x[k].z + x[k].w * x[k].w;
      ss = wave_sum(ss);
      float r = rsqrtf(ss * (1.f / DM) + EPS);
#pragma unroll
      for (int k = 0; k < 4; ++k) {
        float4 g = *(const float4*)(gpre + lane * 4 + 256 * k);
        uint2 o;
        o.x = pack2(x[k].x * r * g.x, x[k].y * r * g.y);
        o.y = pack2(x[k].z * r * g.z, x[k].w * r * g.w);
        *(uint2*)(hout + (size_t)row * HLD + lane * 4 + 256 * k) = o;
      }
    }
  }
}

DI int swz(int r, int c) { return r * 128 + ((c ^ ((r >> 1) & 7)) << 4); }

#define GEMM_COMPUTE(AS_) do { const char* as_ = (AS_); const char* bs_ = as_ + 16384; \
  _Pragma("unroll") for (int s_ = 0; s_ < 2; ++s_) { \
    bf16x8 af_[4], bfr_[4]; \
    _Pragma("unroll") for (int i_ = 0; i_ < 4; ++i_) af_[i_] = *(const bf16x8*)(as_ + swz(wm * 64 + i_ * 16 + r16, s_ * 4 + quad)); \
    _Pragma("unroll") for (int j_ = 0; j_ < 4; ++j_) bfr_[j_] = *(const bf16x8*)(bs_ + swz(wn * 64 + j_ * 16 + r16, s_ * 4 + quad)); \
    _Pragma("unroll") for (int i_ = 0; i_ < 4; ++i_) \
      _Pragma("unroll") for (int j_ = 0; j_ < 4; ++j_) acc[i_][j_] = MFMA16(bfr_[j_], af_[i_], acc[i_][j_]); \
  } } while (0)

struct Stage { u32x4 a0, a1, a2, a3, b0, b1, b2, b3; };
DI void gload(Stage& s, const u16* ag, const u16* bg, int lda, int ldb, int kt) {
  s.a0 = *(const u32x4*)(ag + (size_t)0 * 32 * lda + kt * 64);
  s.a1 = *(const u32x4*)(ag + (size_t)1 * 32 * lda + kt * 64);
  s.a2 = *(const u32x4*)(ag + (size_t)2 * 32 * lda + kt * 64);
  s.a3 = *(const u32x4*)(ag + (size_t)3 * 32 * lda + kt * 64);
  s.b0 = *(const u32x4*)(bg + (size_t)0 * 32 * ldb + kt * 64);
  s.b1 = *(const u32x4*)(bg + (size_t)1 * 32 * ldb + kt * 64);
  s.b2 = *(const u32x4*)(bg + (size_t)2 * 32 * ldb + kt * 64);
  s.b3 = *(const u32x4*)(bg + (size_t)3 * 32 * ldb + kt * 64);
}
DI void lwrite(const Stage& s, char* d, int lr, int lc) {
  *(u32x4*)(d + swz(lr, lc)) = s.a0;
  *(u32x4*)(d + swz(lr + 32, lc)) = s.a1;
  *(u32x4*)(d + swz(lr + 64, lc)) = s.a2;
  *(u32x4*)(d + swz(lr + 96, lc)) = s.a3;
  *(u32x4*)(d + 16384 + swz(lr, lc)) = s.b0;
  *(u32x4*)(d + 16384 + swz(lr + 32, lc)) = s.b1;
  *(u32x4*)(d + 16384 + swz(lr + 64, lc)) = s.b2;
  *(u32x4*)(d + 16384 + swz(lr + 96, lc)) = s.b3;
}

template <bool DEEP>
DI void gemm_kloop(f32x4 (&acc)[4][4], const u16* __restrict__ A, int lda, const u16* __restrict__ Bt, int ldb,
                   int K, int m0, int n0, char* smem) {
  const int tid = tidq(), lane = tid & 63, w = tid >> 6, wm = w >> 1, wn = w & 1, r16 = lane & 15, quad = lane >> 4;
  const int lr = tid >> 3, lc = tid & 7;
  const u16* ag = A + (size_t)(m0 + lr) * lda + lc * 8;
  const u16* bg = Bt + (size_t)(n0 + lr) * ldb + lc * 8;
  const int nk = K >> 6;
  Stage s0;
  gload(s0, ag, bg, lda, ldb, 0);
  if (DEEP) {
    Stage s1;
    gload(s1, ag, bg, lda, ldb, 1);
    lwrite(s0, smem, lr, lc);
    __syncthreads();
    for (int kt = 0; kt < nk; kt += 2) {
      if (kt + 2 < nk) gload(s0, ag, bg, lda, ldb, kt + 2);
      GEMM_COMPUTE(smem);
      lwrite(s1, smem + 32768, lr, lc);
      __syncthreads();
      if (kt + 3 < nk) gload(s1, ag, bg, lda, ldb, kt + 3);
      GEMM_COMPUTE(smem + 32768);
      if (kt + 2 < nk) lwrite(s0, smem, lr, lc);
      __syncthreads();
    }
  } else {
    lwrite(s0, smem, lr, lc);
    __syncthreads();
    for (int kt = 0; kt < nk; ++kt) {
      const bool more = (kt + 1 < nk);
      if (more) gload(s0, ag, bg, lda, ldb, kt + 1);
      GEMM_COMPUTE(smem + (kt & 1) * 32768);
      if (more) lwrite(s0, smem + ((kt + 1) & 1) * 32768, lr, lc);
      __syncthreads();
    }
  }
}

DI void zero_acc(f32x4 (&acc)[4][4]) {
#pragma unroll
  for (int i = 0; i < 4; ++i)
#pragma unroll
    for (int j = 0; j < 4; ++j) acc[i][j] = f32x4{0.f, 0.f, 0.f, 0.f};
}

enum { EPI_BF16 = 0, EPI_SIG = 1, EPI_RELU2 = 2, EPI_F32 = 3, EPI_GLU = 4 };

template <int EPI>
DI void gemm_epilogue(f32x4 (&acc)[4][4], int m0, int n0, void* outp, int ldc, const u16* aux, int ldaux) {
  const int lane = tidq() & 63, w = tidq() >> 6, wm = w >> 1, wn = w & 1, r16 = lane & 15, quad = lane >> 4;
#pragma unroll
  for (int i = 0; i < 4; ++i) {
    const int m = m0 + wm * 64 + i * 16 + r16;
#pragma unroll
    for (int j = 0; j < 4; ++j) {
      const int n = n0 + wn * 64 + j * 16 + quad * 4;
      f32x4 v = acc[i][j];
      if (EPI == EPI_F32) {
        *(float4*)((float*)outp + (size_t)m * ldc + n) = make_float4(v[0], v[1], v[2], v[3]);
      } else {
        if (EPI == EPI_SIG) {
#pragma unroll
          for (int x = 0; x < 4; ++x) v[x] = sigmoidf_(v[x]);
        } else if (EPI == EPI_RELU2) {
#pragma unroll
          for (int x = 0; x < 4; ++x) { float r = fmaxf(v[x], 0.f); v[x] = r * r; }
        } else if (EPI == EPI_GLU) {
          uint2 zz = *(const uint2*)(aux + (size_t)m * ldaux + n);
          v[0] = bf2f((u16)(zz.x & 0xffff)) * sigmoidf_(v[0]);
          v[1] = bf2f((u16)(zz.x >> 16)) * sigmoidf_(v[1]);
          v[2] = bf2f((u16)(zz.y & 0xffff)) * sigmoidf_(v[2]);
          v[3] = bf2f((u16)(zz.y >> 16)) * sigmoidf_(v[3]);
        }
        uint2 o; o.x = pack2(v[0], v[1]); o.y = pack2(v[2], v[3]);
        *(uint2*)((u16*)outp + (size_t)m * ldc + n) = o;
      }
      acc[i][j] = f32x4{0.f, 0.f, 0.f, 0.f};
    }
  }
}

DI bool tile_at(int i, int T, int& t);
DI void tile_mn(int t, int nN, int& m0, int& n0);

template <int EPI>
DI void gemm_stream(const u16* __restrict__ A, int lda, const u16* __restrict__ Bt, int ldb, int K, int nN, int T,
                    void* outp, int ldc, const u16* aux, int ldaux, char* smem) {
  const int tid = tidq(), lane = tid & 63, w = tid >> 6, wm = w >> 1, wn = w & 1, r16 = lane & 15, quad = lane >> 4;
  const int lr = tid >> 3, lc = tid & 7;
  asm volatile("" : "+s"(lda), "+s"(ldb), "+s"(K));
  const int nk = K >> 6;
  int t, m0, n0, m1 = 0, n1 = 0;
  if (!tile_at(0, T, t)) return;
  tile_mn(t, nN, m0, n0);
  const size_t aoff = (size_t)lr * lda + lc * 8, boff = (size_t)lr * ldb + lc * 8;
  const u16* ag = A + (size_t)m0 * lda + aoff;
  const u16* bg = Bt + (size_t)n0 * ldb + boff;
  f32x4 acc[4][4];
  zero_acc(acc);
  Stage s0, s1;
  gload(s0, ag, bg, lda, ldb, 0);
  gload(s1, ag, bg, lda, ldb, 1);
  lwrite(s0, smem, lr, lc);
  __syncthreads();
  for (int i = 0;; ++i) {
    const bool has_next = tile_at(i + 1, T, t);
    if (has_next) tile_mn(t, nN, m1, n1);
    const u16* agn = A + (size_t)m1 * lda + aoff;
    const u16* bgn = Bt + (size_t)n1 * ldb + boff;
    for (int kt = 0; kt < nk; kt += 2) {
      if (kt + 2 < nk) gload(s0, ag, bg, lda, ldb, kt + 2);
      else if (has_next) gload(s0, agn, bgn, lda, ldb, 0);
      GEMM_COMPUTE(smem);
      lwrite(s1, smem + 32768, lr, lc);
      __syncthreads();
      if (kt + 2 < nk) gload(s1, ag, bg, lda, ldb, kt + 3);
      else if (has_next) gload(s1, agn, bgn, lda, ldb, 1);
      GEMM_COMPUTE(smem + 32768);
      if (kt + 2 < nk || has_next) lwrite(s0, smem, lr, lc);
      __syncthreads();
    }
    gemm_epilogue<EPI>(acc, m0, n0, outp, ldc, aux, ldaux);
    if (!has_next) break;
    m0 = m1; n0 = n1; ag = agn; bg = bgn;
  }
}

DI void merge_tile(const Params& p, int l, int m0, int n0, char* smem) {
  f32x4 macc[4][4];
  zero_acc(macc);
  const int lane = tidq() & 63, w = tidq() >> 6, wm = w >> 1, wn = w & 1, r16 = lane & 15, quad = lane >> 4;
  const u16* gates = p.pbuf;
  for (int b = 0; b < 4; ++b) {
    f32x4 acc[4][4];
    zero_acc(acc);
    gemm_kloop<false>(acc, p.obuf + b * 512, OLD, p.wt_br + (size_t)(l * 4 + b) * DM * WLD5, WLD5, 512, m0, n0, smem);
#pragma unroll
    for (int i = 0; i < 4; ++i) {
      const int m = m0 + wm * 64 + i * 16 + r16;
#pragma unroll
      for (int j = 0; j < 4; ++j) {
        const int n = n0 + wn * 64 + j * 16 + quad * 4;
        uint2 gg = *(const uint2*)(gates + (size_t)m * 4096 + b * 1024 + n);
        macc[i][j][0] += bf2f((u16)(gg.x & 0xffff)) * acc[i][j][0];
        macc[i][j][1] += bf2f((u16)(gg.x >> 16)) * acc[i][j][1];
        macc[i][j][2] += bf2f((u16)(gg.y & 0xffff)) * acc[i][j][2];
        macc[i][j][3] += bf2f((u16)(gg.y >> 16)) * acc[i][j][3];
      }
    }
  }
#pragma unroll
  for (int i = 0; i < 4; ++i) {
    const int m = m0 + wm * 64 + i * 16 + r16;
#pragma unroll
    for (int j = 0; j < 4; ++j) {
      const int n = n0 + wn * 64 + j * 16 + quad * 4;
      uint2 o; o.x = pack2(macc[i][j][0], macc[i][j][1]); o.y = pack2(macc[i][j][2], macc[i][j][3]);
      *(uint2*)(p.hb + (size_t)m * HLD + n) = o;
    }
  }
}

constexpr int QS = 136;
constexpr int TS = 20;
constexpr int OFS = 260;

template <int MODE>
__device__ void run_chain(const Params& p, int l, int seq, int sub, int seg, int pass, char* smem) {
  constexpr int NE = 2;
  const int tid = tidq(), lane = tid & 63, w = tid >> 6, r16 = lane & 15, quad = lane >> 4;
  const bool prompt = seq < 8;
  const int bidx = prompt ? seq : seq - 8;
  const int NB = prompt ? 8 : 128;
  const int L = prompt ? 2048 : 8;
  const int row0 = prompt ? seq * 2048 : MPR + (seq - 8) * 8;
  const int pos0 = prompt ? 0 : 16384;
  const int cps = p.cps;
  const int ch_begin = prompt ? seg * cps : 0;
  const int ch_end = prompt ? ch_begin + cps : 1;
  const bool light = prompt && (pass == 1);
  const bool last_seg = !prompt || (seg == p.nseg - 1);
  const int cid = seq * 12 + MODE * 4 + sub;

  u16* Qa = (u16*)smem;
  u16* Ka = (u16*)(smem + 4352);
  u16* KuT = (u16*)(smem + 8704);
  u16* VaT = (u16*)(smem + 13824);
  u16* VuT = (MODE == 1) ? (u16*)(smem + 24064) : VaT;
  float* Of = (float*)(smem + 34304);
  u16* Raw = (u16*)(smem + 34304);
  u16* Xc = (u16*)(smem + 50944);
  float* tot = (float*)(smem + 55040);
  float* cdec = (float*)(smem + 59136);
  float* dtl = (float*)(smem + 59392);
  float* rsc = (float*)(smem + 59648);
  float* clast = (float*)(smem + 60160);
  float* segacc = (float*)(smem + 60176);

  const float* sin_ = nullptr;
  float* sout = nullptr;
  if (MODE == 0) {
    if (!prompt) sin_ = p.in[2] + (((size_t)l * 128 + bidx) * 4 + sub) * 16384;
    sout = p.out + (prompt ? p.o_ret_p : p.o_ret_s) + (((size_t)l * NB + bidx) * 4 + sub) * 16384;
  } else if (MODE == 2) {
    if (!prompt) sin_ = p.in[5] + (((size_t)l * 128 + bidx) * 4 + sub) * 16384;
    sout = p.out + (prompt ? p.o_hg_p : p.o_hg_s) + (((size_t)l * NB + bidx) * 4 + sub) * 16384;
  } else {
    if (!prompt) sin_ = p.in[3] + (((size_t)l * 128 + bidx) * 8 + sub * 2 + (w >> 1)) * 8192;
    sout = p.out + (prompt ? p.o_ssd_p : p.o_ssd_s) + (((size_t)l * NB + bidx) * 8 + sub * 2 + (w >> 1)) * 8192;
  }

  float lg = 0.f;
  if (MODE == 0) lg = log1pf(-exp2f(-5.f - (float)sub));

  int sbase = (MODE == 1) ? (((w & 1) * 32 + r16) * 128 + quad * 4) : (quad * 512 + w * 32 + r16);
  asm volatile("" : "+v"(sbase));
  f32x4 S[8][NE];
#pragma unroll
  for (int t = 0; t < 8; ++t)
#pragma unroll
    for (int u = 0; u < NE; ++u) {
      if (sin_) {
        if (MODE == 1) {
          S[t][u] = *(const f32x4*)(sin_ + sbase + u * 2048 + t * 16);
        } else {
#pragma unroll
          for (int jj = 0; jj < 4; ++jj) S[t][u][jj] = sin_[sbase + t * 2048 + jj * 128 + u * 16];
        }
      } else {
        S[t][u] = f32x4{0.f, 0.f, 0.f, 0.f};
      }
    }
  if (prompt && pass == 2) {
    for (int r = 0; r < seg; ++r) {
      const uint2* sl = (const uint2*)(p.slocal + (size_t)(cid * (p.nseg - 1) + r) * 16384) + tid;
      const float* sd = p.segdec + (size_t)(cid * 7 + r) * 128;
      float dsc = 1.f;
      if (MODE == 0) dsc = __expf(lg * (float)(16 * cps));
      if (MODE == 1) dsc = __expf(sd[w >> 1]);
#pragma unroll
      for (int t = 0; t < 8; ++t) {
        f32x4 dv = f32x4{dsc, dsc, dsc, dsc};
        if (MODE == 2) {
          f32x4 lv = *(const f32x4*)(sd + t * 16 + quad * 4);
          dv = f32x4{__expf(lv[0]), __expf(lv[1]), __expf(lv[2]), __expf(lv[3])};
        }
#pragma unroll
        for (int u = 0; u < NE; ++u) {
          uint2 pk = sl[(t * NE + u) * 256];
          S[t][u][0] = S[t][u][0] * dv[0] + bf2f((u16)(pk.x & 0xffff));
          S[t][u][1] = S[t][u][1] * dv[1] + bf2f((u16)(pk.x >> 16));
          S[t][u][2] = S[t][u][2] * dv[2] + bf2f((u16)(pk.y & 0xffff));
          S[t][u][3] = S[t][u][3] * dv[3] + bf2f((u16)(pk.y >> 16));
        }
      }
    }
  }

  float lbv = 0.f;
  float hg_tot = 0.f;
  float cprev[2][3];
  float cw[2][4], cb[2];
  int ccidx[2];
  float dt_bias = 0.f, dt_A = 0.f;
  float rinv = 0.f, rcD = 1.f, rsD = 0.f;
  const int gg = sub >> 1, pair = sub & 1;
  if (MODE == 0) {
    rinv = exp2f(-(float)(tid & 63) * (13.287712379549449f / 64.f));
    rsD = __sinf(rinv); rcD = __cosf(rinv);
  }
  if (MODE == 2) {
    if (l == 1) {
      float a0 = p.in[20][sub * 128 + (tid & 127)], a1 = p.in[20][512 + sub * 128 + (tid & 127)];
      float mx = fmaxf(a0, a1);
      float e0 = __expf(a0 - mx), e1 = __expf(a1 - mx);
      lbv = e1 / (e0 + e1);
    }
  }
  if (MODE == 1) {
    if (tid < 32) {
      const int hh = sub * 2 + (tid >> 4);
      dt_A = -__expf(p.in[16][l * 8 + hh]);
      dt_bias = p.in[17][l * 8 + hh];
    }
    if (tid < 2) segacc[tid] = 0.f;
#pragma unroll
    for (int k = 0; k < 2; ++k) {
      int ci = tid + 256 * k;
      int cc = 0;
      if (ci < 128) cc = gg * 256 + pair * 128 + ci;
      else if (ci < 256) cc = 512 + gg * 128 + (ci - 128);
      else cc = 768 + gg * 128 + (ci - 256);
      if (ci >= 384) cc = 0;
      ccidx[k] = cc;
#pragma unroll
      for (int j = 0; j < 4; ++j) cw[k][j] = p.in[14][((size_t)l * 4 + j) * 1024 + cc];
      cb[k] = p.in[15][l * 1024 + cc];
#pragma unroll
      for (int j = 0; j < 3; ++j) {
        float v = 0.f;
        if (!prompt) v = p.in[4][(((size_t)l * 128 + bidx) * 3 + j) * 1024 + cc];
        else if (ch_begin > 0) v = bf2f(p.pbuf[(size_t)(row0 + ch_begin * 16 - 3 + j) * NP + C_SXBC + cc]);
        cprev[k][j] = v;
      }
    }
  }

  const int lt = tid >> 4, lc = tid & 15;
  uint4 r0, r1, r2, g0;
  unsigned rdt = 0;
  const uint4 z4 = make_uint4(0, 0, 0, 0);
  r0 = r1 = r2 = g0 = z4;
  auto load_raw = [&](int ch) {
    const int t0 = ch * 16;
    const int nv = (L - t0 < 16) ? (L - t0) : 16;
    const u16* Pr = p.pbuf + (size_t)(row0 + t0 + lt) * NP;
    r0 = r1 = r2 = g0 = z4;
    rdt = 0;
    if (lt < nv) {
      if (MODE == 0) {
        r0 = *(const uint4*)(Pr + C_RQ + sub * 128 + lc * 8);
        r1 = *(const uint4*)(Pr + C_RK + sub * 128 + lc * 8);
        r2 = *(const uint4*)(Pr + C_RV + sub * 128 + lc * 8);
        g0 = *(const uint4*)(Pr + C_RG + sub * 128 + lc * 8);
      } else if (MODE == 2) {
        r0 = *(const uint4*)(Pr + C_HQ + sub * 128 + lc * 8);
        r1 = *(const uint4*)(Pr + C_HF + sub * 128 + lc * 8);
        r2 = *(const uint4*)(Pr + C_HI + sub * 128 + lc * 8);
        g0 = *(const uint4*)(Pr + C_HG + sub * 128 + lc * 8);
      } else {
        r0 = *(const uint4*)(Pr + C_SXBC + gg * 256 + pair * 128 + lc * 8);
        r1 = *(const uint4*)(Pr + C_SXBC + 512 + gg * 128 + lc * 8);
        r2 = *(const uint4*)(Pr + C_SXBC + 768 + gg * 128 + lc * 8);
        g0 = *(const uint4*)(Pr + C_SZ + gg * 256 + pair * 128 + lc * 8);
        if (lc < 2) rdt = Pr[C_SDT + sub * 2 + lc];
      }
    }
  };
  load_raw(ch_begin);

  for (int ch = ch_begin; ch < ch_end; ++ch) {
    const int t0 = ch * 16;
    const int nvalid = (L - t0 < 16) ? (L - t0) : 16;
    float sscale = 1.f;
    int tidv = threadIdx.x;
    asm volatile("" : "+v"(tidv));
    const int tid = tidv, lane = tid & 63, w = tid >> 6, r16 = lane & 15, quad = lane >> 4, lt = tid >> 4, lc = tid & 15;

    *(uint4*)(Raw + lt * 128 + lc * 8) = r0;
    *(uint4*)(Raw + 2048 + lt * 128 + lc * 8) = r1;
    *(uint4*)(Raw + 4096 + lt * 128 + lc * 8) = r2;
    if (MODE == 1) { if (lc < 2) Raw[6144 + lt * 2 + lc] = (u16)rdt; }
    const uint4 gc0 = g0;
    __syncthreads();
    if (ch + 1 < ch_end) load_raw(ch + 1);

    if (MODE == 0) {
      const int which = tid >> 7, pr = tid & 63, th = (tid >> 6) & 1;
      if (which == 1 || !light) {
        const u16* R = Raw + which * 2048;
        float sn, cs;
        sincos_red((float)(pos0 + t0 + th * 8) * rinv, sn, cs);
#pragma unroll
        for (int x = 0; x < 8; ++x) {
          const int t = th * 8 + x;
          float x1 = bf2f(R[t * 128 + pr]);
          float x2 = bf2f(R[t * 128 + pr + 64]);
          float y1 = x1 * cs - x2 * sn, y2 = x1 * sn + x2 * cs;
          if (which) {
            y1 *= 0.08838834764831845f; y2 *= 0.08838834764831845f;
            Ka[t * QS + pr] = f2bf(y1); Ka[t * QS + pr + 64] = f2bf(y2);
            float kd = __expf(lg * (float)(nvalid - 1 - t));
            KuT[pr * TS + t] = f2bf(y1 * kd);
            KuT[(pr + 64) * TS + t] = f2bf(y2 * kd);
          } else {
            Qa[t * QS + pr] = f2bf(y1); Qa[t * QS + pr + 64] = f2bf(y2);
          }
          float ncs = cs * rcD - sn * rsD;
          sn = sn * rcD + cs * rsD; cs = ncs;
        }
      }
      if (tid < 16) cdec[tid] = lg * (float)(tid + 1);
      sscale = __expf(lg * (float)nvalid);
    } else if (MODE == 2) {
      const int d = tid & 127, th = tid >> 7;
      float cl[8], kk[8], qv[8];
      float c = 0.f;
#pragma unroll
      for (int x = 0; x < 8; ++x) {
        const int t = th * 8 + x;
        kk[x] = 0.f; qv[x] = 0.f;
        if (t < nvalid) {
          float z = bf2f(Raw[2048 + t * 128 + d]);
          float sg = sigmoidf_(z);
          float f = lbv + (1.f - lbv) * sg;
          c += __logf(f);
          kk[x] = (1.f - lbv) * (1.f - sg);
          if (!light) qv[x] = siluf_(bf2f(Raw[t * 128 + d]));
        }
        cl[x] = c;
      }
      tot[th * 128 + d] = c;
      __syncthreads();
      const float c_lo = tot[d];
      const float c_all = c_lo + tot[128 + d];
      const float off = th ? c_lo : 0.f;
#pragma unroll
      for (int x = 0; x < 8; ++x) {
        const int t = th * 8 + x;
        const float ct = off + cl[x];
        if (!light) {
          Qa[t * QS + d] = f2bf(qv[x] * __expf(ct));
          Ka[t * QS + d] = f2bf(kk[x] * __expf(-ct));
        }
        KuT[d * TS + t] = f2bf(kk[x] * __expf(c_all - ct));
      }
      if (th == 0) { rsc[d] = __expf(c_all); hg_tot += c_all; }
    } else {
      if (tid < 32) {
        const int hl = tid >> 4, t = tid & 15;
        float dtv = 0.f, c = 0.f;
        if (t < nvalid) {
          dtv = softplusf_(bf2f(Raw[6144 + t * 2 + hl]) + dt_bias);
          c = dtv * dt_A;
        }
#pragma unroll
        for (int o = 1; o < 16; o <<= 1) {
          float v = __shfl_up(c, o, 16);
          if (t >= o) c += v;
        }
        cdec[hl * 16 + t] = c;
        dtl[hl * 16 + t] = dtv;
        if (t == 15) { clast[hl] = c; segacc[hl] += c; }
      }
      __syncthreads();
#pragma unroll
      for (int k = 0; k < 2; ++k) {
        const int ci = tid + 256 * k;
        if (ci < 256 || (ci < 384 && !light)) {
          const int hl = (ci < 128) ? (ci >> 6) : 0;
          const float cl = clast[hl];
          const u16* R = Raw + ((ci < 128) ? ci : ((ci < 256) ? (2048 + (ci - 128)) : (4096 + (ci - 256))));
#pragma unroll 4
          for (int t = 0; t < 16; ++t) {
            float v = 0.f;
            if (t < nvalid) {
              float raw = bf2f(R[t * 128]);
              float o = cb[k] + cprev[k][0] * cw[k][0] + cprev[k][1] * cw[k][1] + cprev[k][2] * cw[k][2] + raw * cw[k][3];
              cprev[k][0] = cprev[k][1]; cprev[k][1] = cprev[k][2]; cprev[k][2] = raw;
              v = siluf_(o);
            }
            if (ci < 128) {
              float dtv = dtl[hl * 16 + t];
              if (!light) { Xc[t * 128 + ci] = f2bf(v); VaT[ci * TS + t] = f2bf(v * dtv); }
              VuT[ci * TS + t] = f2bf(v * dtv * __expf(cl - cdec[hl * 16 + t]));
            } else if (ci < 256) {
              u16 a = f2bf(v);
              if (!light) Ka[t * QS + (ci - 128)] = a;
              KuT[(ci - 128) * TS + t] = a;
            } else {
              Qa[t * QS + (ci - 256)] = f2bf(v);
            }
          }
        }
      }
    }
    if (MODE != 1) {
      const int e = tid & 127, th = tid >> 7;
#pragma unroll
      for (int x = 0; x < 4; ++x) {
        const int t = th * 8 + 2 * x;
        unsigned lo = Raw[4096 + t * 128 + e], hi = Raw[4096 + (t + 1) * 128 + e];
        *(unsigned*)(VaT + e * TS + t) = lo | (hi << 16);
      }
    }
    __syncthreads();

    {
      const float* cd = cdec + ((MODE == 1) ? (w >> 1) * 16 : 0);
      bf16x8 attA;
      float rr[4];
      bf16x8 qf[4];
      if (!light) {
        f32x4 at = f32x4{0.f, 0.f, 0.f, 0.f};
#pragma unroll
        for (int s = 0; s < 4; ++s) {
          bf16x8 a = *(const bf16x8*)(Ka + r16 * QS + s * 32 + quad * 8);
          bf16x8 b = *(const bf16x8*)(Qa + r16 * QS + s * 32 + quad * 8);
          at = MFMA16(a, b, at);
        }
        float ci_ = (MODE != 2) ? cd[r16] : 0.f;
        float vv[4];
#pragma unroll
        for (int jj = 0; jj < 4; ++jj) {
          int j = quad * 4 + jj;
          float v = at[jj];
          if (MODE != 2) v *= __expf(fminf(ci_ - cd[j], 0.f));
          vv[jj] = (j <= r16) ? v : 0.f;
        }
        unsigned a01 = pack2(vv[0], vv[1]), a23 = pack2(vv[2], vv[3]);
        attA = __builtin_bit_cast(bf16x8, (u32x4){a01, a23, 0u, 0u});
#pragma unroll
        for (int jj = 0; jj < 4; ++jj) rr[jj] = (MODE != 2) ? __expf(cd[quad * 4 + jj]) : 1.f;
#pragma unroll
        for (int s = 0; s < 4; ++s) {
          bf16x4 lo = *(const bf16x4*)(Qa + r16 * QS + s * 32 + quad * 4);
          bf16x4 hi = *(const bf16x4*)(Qa + r16 * QS + s * 32 + 16 + quad * 4);
          qf[s] = bf16x8{lo[0], lo[1], lo[2], lo[3], hi[0], hi[1], hi[2], hi[3]};
        }
      }
      __syncthreads();
      if (!light) {
#pragma unroll
        for (int u = 0; u < NE; ++u) {
          const int e0 = (w * NE + u) * 16;
          bf16x4 v4 = *(const bf16x4*)(VaT + (e0 + r16) * TS + quad * 4);
          bf16x8 vb = bf16x8{v4[0], v4[1], v4[2], v4[3], 0, 0, 0, 0};
          f32x4 o1 = MFMA16(attA, vb, (f32x4{0.f, 0.f, 0.f, 0.f}));
          f32x4 o2 = f32x4{0.f, 0.f, 0.f, 0.f};
#pragma unroll
          for (int s = 0; s < 4; ++s) {
            u32x4 sp = {pack2(S[2 * s][u][0], S[2 * s][u][1]), pack2(S[2 * s][u][2], S[2 * s][u][3]),
                        pack2(S[2 * s + 1][u][0], S[2 * s + 1][u][1]), pack2(S[2 * s + 1][u][2], S[2 * s + 1][u][3])};
            o2 = MFMA16(qf[s], __builtin_bit_cast(bf16x8, sp), o2);
          }
#pragma unroll
          for (int jj = 0; jj < 4; ++jj) Of[(quad * 4 + jj) * OFS + e0 + r16] = o1[jj] + rr[jj] * o2[jj];
        }
      }
      float hs = 1.f;
      if (MODE == 0) hs = sscale;
      if (MODE == 1) hs = __expf(clast[w >> 1]);
#pragma unroll
      for (int u = 0; u < NE; ++u) {
        const int e0 = (w * NE + u) * 16;
        bf16x4 v4 = *(const bf16x4*)(VuT + (e0 + r16) * TS + quad * 4);
        bf16x8 vb = bf16x8{v4[0], v4[1], v4[2], v4[3], 0, 0, 0, 0};
#pragma unroll
        for (int t = 0; t < 8; ++t) {
          bf16x4 k4 = *(const bf16x4*)(KuT + (t * 16 + r16) * TS + quad * 4);
          bf16x8 ka = bf16x8{k4[0], k4[1], k4[2], k4[3], 0, 0, 0, 0};
          f32x4 sv = S[t][u];
          if (MODE == 2) {
            f32x4 r4 = *(const f32x4*)(rsc + t * 16 + quad * 4);
            sv[0] *= r4[0]; sv[1] *= r4[1]; sv[2] *= r4[2]; sv[3] *= r4[3];
          } else {
            sv[0] *= hs; sv[1] *= hs; sv[2] *= hs; sv[3] *= hs;
          }
          S[t][u] = MFMA16(ka, vb, sv);
        }
      }
    }
    __syncthreads();

    if (!light) {
      const int i = tid >> 4, eg = tid & 15;
      const int grow = row0 + t0 + i;
      unsigned gw[4] = {gc0.x, gc0.y, gc0.z, gc0.w};
      if (MODE == 0 || MODE == 2) {
        float o[8];
#pragma unroll
        for (int x = 0; x < 8; ++x) o[x] = Of[i * OFS + eg * 8 + x];
        float s1 = 0.f;
        float mu = 0.f;
        if (MODE == 0) {
#pragma unroll
          for (int x = 0; x < 8; ++x) s1 += o[x];
          mu = sum16(s1) * (1.f / 128.f);
        }
        float s2 = 0.f;
#pragma unroll
        for (int x = 0; x < 8; ++x) { o[x] -= mu; s2 += o[x] * o[x]; }
        float r = rsqrtf(sum16(s2) * (1.f / 128.f) + EPS);
        if (i < nvalid) {
          const float* gain = (MODE == 0) ? (p.in[13] + (l * 4 + sub) * 128 + eg * 8) : (p.in[21] + l * 128 + eg * 8);
          float res[8];
#pragma unroll
          for (int x = 0; x < 8; ++x) {
            float g = bf2f((u16)((x & 1) ? (gw[x >> 1] >> 16) : (gw[x >> 1] & 0xffff)));
            float gate = (MODE == 0) ? siluf_(g) : sigmoidf_(g);
            res[x] = o[x] * r * gain[x] * gate;
          }
          uint4 ov = make_uint4(pack2(res[0], res[1]), pack2(res[2], res[3]), pack2(res[4], res[5]), pack2(res[6], res[7]));
          const int ocol = ((MODE == 0) ? 0 : 1024) + sub * 128 + eg * 8;
          *(uint4*)(p.obuf + (size_t)grow * OLD + ocol) = ov;
        }
      } else {
        float y[8];
        const int chb = eg * 8;
        const float Dh = p.in[18][l * 8 + sub * 2 + (chb >> 6)];
        float s2 = 0.f;
#pragma unroll
        for (int x = 0; x < 8; ++x) {
          float g = bf2f((u16)((x & 1) ? (gw[x >> 1] >> 16) : (gw[x >> 1] & 0xffff)));
          float v = Of[i * OFS + chb + x] + bf2f(Xc[i * 128 + chb + x]) * Dh;
          v *= siluf_(g);
          y[x] = v; s2 += v * v;
        }
        s2 = sum16(s2);
        if (i < nvalid) {
          if (eg == 0) p.ssq[(size_t)grow * 4 + sub] = s2;
          uint4 ov = make_uint4(pack2(y[0], y[1]), pack2(y[2], y[3]), pack2(y[4], y[5]), pack2(y[6], y[7]));
          *(uint4*)(p.obuf + (size_t)grow * OLD + 512 + sub * 128 + chb) = ov;
        }
      }
    }
    __syncthreads();
  }

  if (light) {
    uint2* sl = (uint2*)(p.slocal + (size_t)(cid * (p.nseg - 1) + seg) * 16384) + tid;
#pragma unroll
    for (int t = 0; t < 8; ++t)
#pragma unroll
      for (int u = 0; u < NE; ++u)
        sl[(t * NE + u) * 256] = make_uint2(pack2(S[t][u][0], S[t][u][1]), pack2(S[t][u][2], S[t][u][3]));
    float* sd = p.segdec + (size_t)(cid * 7 + seg) * 128;
    if (MODE == 1) { if (tid < 2) sd[tid] = segacc[tid]; }
    if (MODE == 2) { if (tid < 128) sd[tid] = hg_tot; }
  } else if (last_seg) {
    asm volatile("" : "+v"(sbase));
#pragma unroll
    for (int t = 0; t < 8; ++t)
#pragma unroll
      for (int u = 0; u < NE; ++u) {
        if (MODE == 1) {
          *(f32x4*)(sout + sbase + u * 2048 + t * 16) = S[t][u];
        } else {
#pragma unroll
          for (int jj = 0; jj < 4; ++jj) sout[sbase + t * 2048 + jj * 128 + u * 16] = S[t][u][jj];
        }
      }
    if (MODE == 1) {
      float* co = p.out + (prompt ? p.o_conv_p : p.o_conv_s) + ((size_t)l * NB + bidx) * 3 * 1024;
#pragma unroll
      for (int k = 0; k < 2; ++k) {
        const int ci = tid + 256 * k;
        if (ci < 128 || (ci < 384 && pair == 0)) {
#pragma unroll
          for (int j = 0; j < 3; ++j) co[j * 1024 + ccidx[k]] = cprev[k][j];
        }
      }
    }
  }
}

__device__ void run_s5(const Params& p, int l, int seq, int gq, int seg, int pass, char* smem) {
  const int tid = tidq(), lane = tid & 63, w = tid >> 6, r16 = lane & 15, quad = lane >> 4;
  const int g = gq * 4 + w;
  const bool prompt = seq < 8;
  const int bidx = prompt ? seq : seq - 8;
  const int NB = prompt ? 8 : 128;
  const int row0 = prompt ? seq * 2048 : MPR + (seq - 8) * 8;
  const int nch = prompt ? p.cps : 1;
  const int ch_begin = prompt ? seg * nch : 0;
  const int ch_end = ch_begin + nch;
  const int nvalid = prompt ? 16 : 8;
  const bool light = prompt && (pass == 1);
  const bool last_seg = !prompt || (seg == p.nseg - 1);
  char* wb = smem + w * 5120;
  u16* Hs = (u16*)wb;
  u16* Us = (u16*)(wb + 4352);
  const int lg_ = l * 32 + g;

  const float dt = __expf(p.in[29][lg_]);
  float Ar[4][4], Ai[4][4];
  float fre[4], fim[4];
  float dtare[4], thv[4];
#pragma unroll
  for (int i = 0; i < 4; ++i) {
    const int pi = i * 16 + r16;
    const float are = p.in[22][lg_ * 64 + pi], aim = p.in[23][lg_ * 64 + pi];
    const float th = dt * aim;
    float sn, cs; sincos_red(th, sn, cs);
    float shalf, chalf; sincos_red(0.5f * th, shalf, chalf);
    const float em1 = expm1f(dt * are);
    const float mag = em1 + 1.f;
    const float abr = mag * cs, abi = mag * sn;
    const float nre = em1 * cs - 2.f * shalf * shalf, nim = abi;
    const float den = are * are + aim * aim;
    fre[i] = (nre * are + nim * aim) / den; fim[i] = (nim * are - nre * aim) / den;
    dtare[i] = dt * are; thv[i] = th;
    Ar[0][i] = abr; Ai[0][i] = abi;
    Ar[1][i] = abr * abr - abi * abi; Ai[1][i] = 2.f * abr * abi;
    Ar[2][i] = Ar[1][i] * abr - Ai[1][i] * abi; Ai[2][i] = Ar[1][i] * abi + Ai[1][i] * abr;
    Ar[3][i] = Ar[1][i] * Ar[1][i] - Ai[1][i] * Ai[1][i]; Ai[3][i] = 2.f * Ar[1][i] * Ai[1][i];
  }
  bf16x8 Bop[8];
#pragma unroll
  for (int nt = 0; nt < 8; ++nt) {
    const int i = nt & 3;
    u32x4 pk = {0u, 0u, 0u, 0u};
    if (quad < 2) {
      const size_t bo = ((size_t)lg_ * 64 + i * 16 + r16) * 16 + quad * 8;
      const float4 br0 = *(const float4*)(p.in[24] + bo), br1 = *(const float4*)(p.in[24] + bo + 4);
      const float4 bi0 = *(const float4*)(p.in[25] + bo), bi1 = *(const float4*)(p.in[25] + bo + 4);
      const float brv[8] = {br0.x, br0.y, br0.z, br0.w, br1.x, br1.y, br1.z, br1.w};
      const float biv[8] = {bi0.x, bi0.y, bi0.z, bi0.w, bi1.x, bi1.y, bi1.z, bi1.w};
      float v[8];
#pragma unroll
      for (int j = 0; j < 8; ++j)
        v[j] = (nt < 4) ? (fre[i] * brv[j] - fim[i] * biv[j]) : (fre[i] * biv[j] + fim[i] * brv[j]);
      pk = u32x4{pack2(v[0], v[1]), pack2(v[2], v[3]), pack2(v[4], v[5]), pack2(v[6], v[7])};
    }
    Bop[nt] = __builtin_bit_cast(bf16x8, pk);
  }
  bf16x8 Cop[4];
  float Dm[4] = {0.f, 0.f, 0.f, 0.f};
  if (!light) {
#pragma unroll
    for (int s = 0; s < 4; ++s) {
      const int n0 = 32 * s + quad * 8;
      const float* src = ((n0 >= 64) ? p.in[27] : p.in[26]) + ((size_t)lg_ * 16 + r16) * 64 + (n0 & 63);
      const float sg = (n0 >= 64) ? -1.f : 1.f;
      const float4 c0 = *(const float4*)src, c1 = *(const float4*)(src + 4);
      Cop[s] = __builtin_bit_cast(bf16x8, (u32x4{pack2(sg * c0.x, sg * c0.y), pack2(sg * c0.z, sg * c0.w),
                                                 pack2(sg * c1.x, sg * c1.y), pack2(sg * c1.z, sg * c1.w)}));
    }
#pragma unroll
    for (int jj = 0; jj < 4; ++jj) Dm[jj] = p.in[28][lg_ * 16 + quad * 4 + jj];
  }
  float hr[4], hi[4];
#pragma unroll
  for (int i = 0; i < 4; ++i) { hr[i] = 0.f; hi[i] = 0.f; }
  if (!prompt) {
#pragma unroll
    for (int i = 0; i < 4; ++i) {
      hr[i] = p.in[6][((size_t)(l * 128 + bidx) * 32 + g) * 64 + i * 16 + r16];
      hi[i] = p.in[7][((size_t)(l * 128 + bidx) * 32 + g) * 64 + i * 16 + r16];
    }
  } else if (pass == 2 && seg > 0) {
    const float len = (float)(nch * 16);
#pragma unroll
    for (int i = 0; i < 4; ++i) {
      const float pm = __expf(len * dtare[i]);
      float ps, pc; sincos_red(len * thv[i], ps, pc);
      const float pr_ = pm * pc, pi_ = pm * ps;
      for (int r = 0; r < seg; ++r) {
        const float* hl = p.hlocal + ((size_t)((seq * 32 + g) * 7 + r)) * 128;
        const float lr_ = hl[i * 16 + r16], li_ = hl[64 + i * 16 + r16];
        const float nr = pr_ * hr[i] - pi_ * hi[i] + lr_;
        const float ni = pr_ * hi[i] + pi_ * hr[i] + li_;
        hr[i] = nr; hi[i] = ni;
      }
    }
  }
  const int ut = lane >> 1, uh = lane & 1;
  const u16* ubase = p.pbuf + (size_t)(row0 + ut) * NP + C_SU + g * 16 + uh * 8;
  const uint4 z4 = make_uint4(0, 0, 0, 0);
  uint4 nxt = z4;
  if (lane < 32 && ut < nvalid) nxt = *(const uint4*)(ubase + (size_t)ch_begin * 16 * NP);
  for (int ch = ch_begin; ch < ch_end; ++ch) {
    const uint4 cur = nxt;
    nxt = z4;
    if (ch + 1 < ch_end && lane < 32) nxt = *(const uint4*)(ubase + (size_t)(ch + 1) * 16 * NP);
    if (lane < 32) *(uint4*)(Us + ut * 16 + uh * 8) = cur;
    __syncthreads();
    bf16x8 Uop = bf16x8{0, 0, 0, 0, 0, 0, 0, 0};
    if (quad < 2) Uop = *(const bf16x8*)(Us + r16 * 16 + quad * 8);
    f32x4 bu[8];
#pragma unroll
    for (int nt = 0; nt < 8; ++nt) bu[nt] = MFMA16(Uop, Bop[nt], (f32x4{0.f, 0.f, 0.f, 0.f}));
    float Er[4], Ei[4];
#pragma unroll
    for (int i = 0; i < 4; ++i) {
      float xr = 0.f, xi = 0.f;
#pragma unroll
      for (int jj = 0; jj < 4; ++jj) {
        const float nr = Ar[0][i] * xr - Ai[0][i] * xi + bu[i][jj];
        const float ni = Ar[0][i] * xi + Ai[0][i] * xr + bu[4 + i][jj];
        xr = nr; xi = ni;
        bu[i][jj] = xr; bu[4 + i][jj] = xi;
      }
      Er[i] = xr; Ei[i] = xi;
    }
    float cr[4], ci[4];
#pragma unroll
    for (int i = 0; i < 4; ++i) { cr[i] = hr[i]; ci[i] = hi[i]; }
#pragma unroll
    for (int k = 0; k < 4; ++k) {
#pragma unroll
      for (int i = 0; i < 4; ++i) {
        const float er = __shfl(Er[i], r16 + 16 * k), ei = __shfl(Ei[i], r16 + 16 * k);
        const float nr = Ar[3][i] * hr[i] - Ai[3][i] * hi[i] + er;
        const float ni = Ar[3][i] * hi[i] + Ai[3][i] * hr[i] + ei;
        if (k * 4 < nvalid) { hr[i] = nr; hi[i] = ni; }
        if (k < quad) { cr[i] = nr; ci[i] = ni; }
      }
    }
    if (!light) {
#pragma unroll
      for (int i = 0; i < 4; ++i)
#pragma unroll
        for (int jj = 0; jj < 4; ++jj) {
          const float vr = bu[i][jj] + Ar[jj][i] * cr[i] - Ai[jj][i] * ci[i];
          const float vi = bu[4 + i][jj] + Ar[jj][i] * ci[i] + Ai[jj][i] * cr[i];
          Hs[(quad * 4 + jj) * 136 + i * 16 + r16] = f2bf(vr);
          Hs[(quad * 4 + jj) * 136 + 64 + i * 16 + r16] = f2bf(vi);
        }
      __syncthreads();
      f32x4 ya = f32x4{0.f, 0.f, 0.f, 0.f};
#pragma unroll
      for (int s = 0; s < 4; ++s) {
        const bf16x8 bh = *(const bf16x8*)(Hs + r16 * 136 + s * 32 + quad * 8);
        ya = MFMA16(Cop[s], bh, ya);
      }
      const uint2 uu = *(const uint2*)(Us + r16 * 16 + quad * 4);
      const float u0 = bf2f((u16)(uu.x & 0xffff)), u1 = bf2f((u16)(uu.x >> 16));
      const float u2 = bf2f((u16)(uu.y & 0xffff)), u3 = bf2f((u16)(uu.y >> 16));
      const float z0 = gelu_tanh(ya[0] + Dm[0] * u0), z1 = gelu_tanh(ya[1] + Dm[1] * u1);
      const float z2 = gelu_tanh(ya[2] + Dm[2] * u2), z3 = gelu_tanh(ya[3] + Dm[3] * u3);
      if (r16 < nvalid)
        *(uint2*)(p.zs5 + (size_t)(row0 + ch * 16 + r16) * ZLD + g * 16 + quad * 4) = make_uint2(pack2(z0, z1), pack2(z2, z3));
    }
    __syncthreads();
  }
  if (light) {
    if (quad == 0) {
      float* hl = p.hlocal + ((size_t)((seq * 32 + g) * 7 + seg)) * 128;
#pragma unroll
      for (int i = 0; i < 4; ++i) { hl[i * 16 + r16] = hr[i]; hl[64 + i * 16 + r16] = hi[i]; }
    }
  } else if (last_seg) {
    if (quad == 0) {
      float* o_r = p.out + (prompt ? p.o_s5r_p : p.o_s5r_s) + ((size_t)(l * NB + bidx) * 32 + g) * 64;
      float* o_i = p.out + (prompt ? p.o_s5i_p : p.o_s5i_s) + ((size_t)(l * NB + bidx) * 32 + g) * 64;
#pragma unroll
      for (int i = 0; i < 4; ++i) { o_r[i * 16 + r16] = hr[i]; o_i[i * 16 + r16] = hi[i]; }
    }
  }
}

__device__ void phase_mixers(const Params& p, int l, int pass, char* smem, int visit) {
  int* s_item = (int*)(smem + 65536);
  unsigned* cnt = p.counters + l * 64 + (pass - 1) * 32 + visit * 16;
  const int nseg = p.nseg;
  const int ns1 = nseg - 1;
  const int n_chain = (pass == 1) ? 96 * ns1 : 96 * nseg;
  const int n_s5 = (pass == 1) ? 64 * ns1 : 64 * nseg;
  const int n_items = n_chain + n_s5 + ((pass == 1) ? 128 * 20 : 0);
  for (;;) {
    if (tidq() == 0) *s_item = (int)atomicAdd(cnt, 1u);
    __syncthreads();
    const int item = *s_item;
    __syncthreads();
    if (item >= n_items) break;
    int mode, seq, sub, seg = 0;
    const int per = (pass == 1) ? ns1 : nseg;
    if (item < n_chain) {
      const int c = item / per; seg = item % per;
      const int kind = c >> 5, r = c & 31;
      seq = r >> 2; sub = r & 3;
      mode = (kind == 0) ? 1 : ((kind == 1) ? 2 : 0);
    } else if (item < n_chain + n_s5) {
      const int k = item - n_chain;
      const int c = k / per; seg = k % per;
      mode = 3; seq = c >> 3; sub = c & 7;
    } else {
      int k = item - n_chain - n_s5; int b = k / 20; sub = k % 20; seq = 8 + b;
      if (sub < 4) mode = 1;
      else if (sub < 8) { mode = 0; sub -= 4; }
      else if (sub < 12) { mode = 2; sub -= 8; }
      else { mode = 3; sub -= 12; }
    }
    const int ps = (seq >= 8) ? 2 : pass;
    if (mode == 0) { if (EN(2) || ONLY == 20) run_chain<0>(p, l, seq, sub, seg, ps, smem); }
    else if (mode == 1) { if (EN(2) || ONLY == 21) run_chain<1>(p, l, seq, sub, seg, ps, smem); }
    else if (mode == 2) { if (EN(2) || ONLY == 22) run_chain<2>(p, l, seq, sub, seg, ps, smem); }
    else { if (EN(2) || ONLY == 23) run_s5(p, l, seq, sub, seg, ps, smem); }
    __syncthreads();
  }
}

DI bool tile_at(int i, int T, int& t) {
  const int bpx = gridDim.x >> 3;
  t = ((blockIdx.x & 7) + 8 * i) * bpx + (blockIdx.x >> 3);
  return t < T;
}
DI void tile_mn(int t, int nN, int& m0, int& n0) {
  const int per = 8 * nN;
  const int grp = t / per, r = t - grp * per;
  m0 = (grp * 8 + (r & 7)) * 128;
  n0 = (r >> 3) * 128;
}

__device__ void run_phase(const Params& p, int ph, char* smem, int visit) {
  constexpr int NMT = MTOK / 128;
  if (ph == 0) {
    if (EN(9)) phase_convert(p, smem);
    if (EN(0)) phase_rownorm(p, true, nullptr, nullptr, p.in[8], p.hb);
    return;
  }
  if (ph == NPHASE - 1) {
    if (EN(10)) phase_rownorm(p, false, p.tbuf, p.in[11] + 1 * DM, nullptr, nullptr);
    return;
  }
  const int l = (ph <= 9) ? 0 : 1, s0_ = (ph <= 9) ? ph : ph - 10;
  const int s = (s0_ <= 2) ? s0_ : s0_ - 1;
  switch (s) {
    case 0:
      if (!EN(0)) break;
      phase_rownorm(p, false, p.tbuf, p.in[11] + (l - 1) * DM, p.in[8] + l * DM, p.hb);
      break;
    case 1: if (EN(1)) {
      constexpr int NN = NP / 128;
      gemm_stream<EPI_BF16>(p.hb, HLD, p.wt_in + (size_t)l * NIN * WLD1, WLD1, DM, NN, NMT * NN, p.pbuf, NP, nullptr, 0, smem);
    } break;
    case 2: if (EN(2) || (ONLY >= 20 && ONLY <= 23)) phase_mixers(p, l, (s0_ == 2) ? 1 : 2, smem, visit); break;
    case 3: if (EN(3)) {
      constexpr int NG = 32, NGLU = 4;
      {
        const int lane = tidq() & 63, w = tidq() >> 6;
        for (int row = blockIdx.x * 4 + w; row < MTOK; row += gridDim.x * 4) {
          const float4 sq = *(const float4*)(p.ssq + (size_t)row * 4);
          const float ms = (lane < 32) ? (sq.x + sq.y) : (sq.z + sq.w);
          const float r = rsqrtf(ms * (1.f / 256.f) + EPS);
          u16* ptr = p.obuf + (size_t)row * OLD + 512 + lane * 8;
          uint4 v = *(const uint4*)ptr;
          const float* gn = p.in[19] + l * 512 + lane * 8;
          unsigned vw[4] = {v.x, v.y, v.z, v.w};
          unsigned ow[4];
#pragma unroll
          for (int x = 0; x < 4; ++x)
            ow[x] = pack2(bf2f((u16)(vw[x] & 0xffff)) * r * gn[2 * x], bf2f((u16)(vw[x] >> 16)) * r * gn[2 * x + 1]);
          *(uint4*)ptr = make_uint4(ow[0], ow[1], ow[2], ow[3]);
        }
      }
      gemm_stream<EPI_SIG>(p.hb, HLD, p.wt_in + ((size_t)l * NIN + NP) * WLD1, WLD1, DM, NG, NMT * NG, p.pbuf, 4096, nullptr, 0, smem);
      gemm_stream<EPI_GLU>(p.zs5, ZLD, p.wt_glu + (size_t)l * 512 * WLD5, WLD5, 512, NGLU, NMT * NGLU,
                           p.obuf + 1536, OLD, p.zs5, ZLD, smem);
    } break;
    case 4:
      if (EN(4)) {
        int t, m0, n0;
        for (int i = 0; tile_at(i, NMT * 8, t); ++i) { tile_mn(t, 8, m0, n0); merge_tile(p, l, m0, n0, smem); }
      }
      break;
    case 5:
      if (EN(5)) {
        gemm_stream<EPI_F32>(p.hb, HLD, p.wt_out + (size_t)l * DM * WLD1, WLD1, DM, 8, NMT * 8, p.tbuf, DM, nullptr, 0, smem);
      }
      break;
    case 6:
      if (EN(6)) phase_rownorm(p, false, p.tbuf, p.in[9] + l * DM, p.in[10] + l * DM, p.hb);
      break;
    case 7:
      if (EN(7)) {
        gemm_stream<EPI_RELU2>(p.hb, HLD, p.wt_ff1 + (size_t)l * DFF * WLD1, WLD1, DM, 32, NMT * 32, p.pbuf, ULD, nullptr, 0, smem);
      }
      break;
    case 8:
      if (EN(8)) {
        gemm_stream<EPI_F32>(p.pbuf, ULD, p.wt_ff2 + (size_t)l * DM * WLD4, WLD4, DFF, 8, NMT * 8, p.tbuf, DM, nullptr, 0, smem);
      }
      break;
  }
}

#ifndef DUP_S
#define DUP_S -1
#endif
#define XB_TMO      128
#define XB_XCNT(j)  (256  + 64 * (j))
#define XB_XSUB(j)  (1280 + 64 * (j))
#define XB_XGEN(j)  (2304 + 64 * (j))
#define XB_TOP      3328
#define XB_TOPGEN   3392
#define XCD_BAR_WORDS 3456
#define XB_SPIN_CAP (1u << 22)
#define LAS __attribute__((address_space(3)))
DI unsigned xb_ld(unsigned* p)              { return __hip_atomic_load(p, __ATOMIC_RELAXED, __HIP_MEMORY_SCOPE_AGENT); }
DI unsigned xb_add(unsigned* p, unsigned v) { return __hip_atomic_fetch_add(p, v, __ATOMIC_RELAXED, __HIP_MEMORY_SCOPE_AGENT); }
DI unsigned xb_xcc_id() { return (unsigned)__builtin_amdgcn_s_getreg((3 << 11) | 20) & 0xFu; }
#define XB_SPIN(cond, bar) do { unsigned _sp = 0; while (cond) { __builtin_amdgcn_s_sleep(1); \
    if ((++_sp & 255u) == 0u) { if (xb_ld(&(bar)[XB_TMO])) break; if (_sp > XB_SPIN_CAP) { atomicAdd(&(bar)[XB_TMO], 1u); break; } } } } while (0)
struct XcdBarrier { unsigned* bar; unsigned x; volatile LAS unsigned* st; };
DI XcdBarrier xcd_barrier_post(unsigned* bar, volatile LAS unsigned* st) {
  XcdBarrier b; b.bar = bar; b.x = xb_xcc_id(); b.st = st;
  if (threadIdx.x == 0) (void)xb_add(&bar[XB_XCNT(b.x)], 1u);
  return b;
}
DI void xcd_barrier_complete(unsigned* bar, unsigned x, unsigned& nloc, unsigned& nx) {
  const unsigned G = gridDim.x * gridDim.y * gridDim.z;
  unsigned sum, cnt, mine, sp = 0u;
  for (;;) {
    sum = 0u; cnt = 0u; mine = 0u;
#pragma unroll
    for (unsigned j = 0; j < 16; ++j) { const unsigned c = xb_ld(&bar[XB_XCNT(j)]); sum += c; cnt += (c > 0u) ? 1u : 0u; mine = (j == x) ? c : mine; }
    if (sum == G) break;
    __builtin_amdgcn_s_sleep(1);
    if ((++sp & 255u) == 0u) { if (xb_ld(&bar[XB_TMO])) break; if (sp > XB_SPIN_CAP) { atomicAdd(&bar[XB_TMO], 1u); break; } }
  }
  nloc = mine > 0u ? mine : 1u; nx = cnt > 0u ? cnt : 1u;
}
DI void xcd_barrier(const XcdBarrier& b) {
  asm volatile("s_waitcnt vmcnt(0)" ::: "memory");
  __syncthreads();
  if (threadIdx.x == 0) {
    unsigned* bar = b.bar;
    __builtin_amdgcn_s_waitcnt(0);
    unsigned nloc = b.st[0], nx = b.st[1];
    if (nloc == 0u) { xcd_barrier_complete(bar, b.x, nloc, nx); b.st[0] = nloc; b.st[1] = nx; }
    const unsigned old = xb_add(&bar[XB_XSUB(b.x)], 1u);
    const unsigned gen = old / nloc;
    if (old + 1u == (gen + 1u) * nloc) {
      __builtin_amdgcn_fence(__ATOMIC_RELEASE, "agent");
      asm volatile("s_waitcnt vmcnt(0)" ::: "memory");
      const unsigned og = xb_add(&bar[XB_TOP], 1u);
      const unsigned tg = og / nx;
      if (og + 1u == (tg + 1u) * nx) xb_add(&bar[XB_TOPGEN], 1u);
      else XB_SPIN(xb_ld(&bar[XB_TOPGEN]) == tg, bar);
      __builtin_amdgcn_fence(__ATOMIC_ACQUIRE, "agent");
      xb_add(&bar[XB_XGEN(b.x)], 1u);
      asm volatile("s_waitcnt vmcnt(0)" ::: "memory");
    } else {
      XB_SPIN(xb_ld(&bar[XB_XGEN(b.x)]) == gen, bar);
      __builtin_amdgcn_fence(__ATOMIC_ACQUIRE, "agent");
      asm volatile("s_waitcnt vmcnt(0)" ::: "memory");
    }
  }
  __syncthreads();
}

__global__ void __launch_bounds__(256, 2) mega_kernel(Params p, int ph_lo, int ph_hi) {
  __shared__ __attribute__((aligned(16))) char smem[65536 + 32];
  volatile LAS unsigned* st = (volatile LAS unsigned*)(&smem[65536 + 16]);
  if (threadIdx.x == 0) { st[0] = 0u; st[1] = 0u; }
  __syncthreads();
  const XcdBarrier xb = xcd_barrier_post(p.bar, st);
  for (int ph = ph_lo; ph < ph_hi; ++ph) {
    if (ph > ph_lo) xcd_barrier(xb);
    if (ph_hi < 0) cg::this_grid().sync();
    const int reps = (DUP_S >= 0 && ph == DUP_S) ? 2 : 1;
    for (int r = 0; r < reps; ++r) {
      if (r) xcd_barrier(xb);
#ifdef VAR_NOSTORE
      if (tidq() == 0) *(volatile int*)(smem + 65536 + 8) = r;
      __syncthreads();
#endif
      run_phase(p, ph, smem, r);
    }
  }
}

extern "C" void kernel_launch(void* const* d_in, const int* in_sizes, int n_in, void* d_out, int out_size,
                              void* d_ws, size_t ws_size, hipStream_t stream) {
  Params p{};
  for (int i = 0; i < 35; ++i) p.in[i] = (const float*)d_in[i];
  p.out = (float*)d_out;
  char* ws = (char*)d_ws;
  size_t off = 0;
  auto take = [&](size_t bytes) { char* r = ws + off; off += (bytes + 255) & ~(size_t)255; return r; };
  p.wt_in  = (u16*)take((size_t)2 * NIN * WLD1 * 2);
  p.wt_ff1 = (u16*)take((size_t)2 * DFF * WLD1 * 2);
  p.wt_ff2 = (u16*)take((size_t)2 * DM * WLD4 * 2);
  p.wt_br  = (u16*)take((size_t)2 * 4 * DM * WLD5 * 2);
  p.wt_out = (u16*)take((size_t)2 * DM * WLD1 * 2);
  p.wt_glu = (u16*)take((size_t)2 * 512 * WLD5 * 2);
  p.hb     = (u16*)take((size_t)MTOK * HLD * 2);
  p.pbuf   = (u16*)take((size_t)MTOK * NP * 2);
  p.obuf   = (u16*)take((size_t)MTOK * OLD * 2);
  p.zs5    = (u16*)take((size_t)MTOK * ZLD * 2);
  p.counters = (unsigned*)take(4096);
  p.bar = (unsigned*)take(16384);
  p.ssq = (float*)take((size_t)MTOK * 4 * 4);
  p.segdec = (float*)take((size_t)96 * 7 * 128 * 4);
  p.hlocal = (float*)take((size_t)8 * 32 * 7 * 128 * 4);
  p.nseg = 8;
  if (off + (size_t)96 * 7 * 32768 > ws_size) p.nseg = 4;
  p.cps = 128 / p.nseg;
  p.slocal = (u16*)take((size_t)96 * (p.nseg - 1) * 32768);
  p.tbuf = (float*)(p.pbuf + (size_t)MTOK * ULD);
  if (off > ws_size) { fprintf(stderr, "workspace too small: need %zu have %zu\n", off, ws_size); return; }
  size_t o = (size_t)MTOK * DM;
  p.o_ret_p = o;  o += (size_t)2 * 8 * 65536;
  p.o_ret_s = o;  o += (size_t)2 * 128 * 65536;
  p.o_ssd_p = o;  o += (size_t)2 * 8 * 65536;
  p.o_ssd_s = o;  o += (size_t)2 * 128 * 65536;
  p.o_conv_p = o; o += (size_t)2 * 8 * 3 * 1024;
  p.o_conv_s = o; o += (size_t)2 * 128 * 3 * 1024;
  p.o_hg_p = o;   o += (size_t)2 * 8 * 65536;
  p.o_hg_s = o;   o += (size_t)2 * 128 * 65536;
  p.o_s5r_p = o;  o += (size_t)2 * 8 * 2048;
  p.o_s5r_s = o;  o += (size_t)2 * 128 * 2048;
  p.o_s5i_p = o;  o += (size_t)2 * 8 * 2048;
  p.o_s5i_s = o;  o += (size_t)2 * 128 * 2048;

  static int grid_blocks = 0;
  if (!grid_blocks) {
    int dev = 0, cus = 0, per_cu = 0;
    hipGetDevice(&dev);
    hipDeviceGetAttribute(&cus, hipDeviceAttributeMultiprocessorCount, dev);
    hipOccupancyMaxActiveBlocksPerMultiprocessor(&per_cu, mega_kernel, 256, 0);
    if (per_cu > 2) per_cu = 2;
    if (per_cu < 1) per_cu = 1;
    grid_blocks = cus * per_cu;
  }
  hipMemsetAsync(p.counters, 0, 4096 + 16384, stream);
#if SINGLE_LAUNCH
  int lo = 0, hi = NPHASE;
  void* args[] = {&p, &lo, &hi};
  hipError_t e = hipLaunchCooperativeKernel((void*)mega_kernel, dim3(grid_blocks), dim3(256), args, 0, stream);
  if (e != hipSuccess) fprintf(stderr, "cooperative launch failed: %s (grid %d)\n", hipGetErrorString(e), grid_blocks);
#else
  for (int ph = 0; ph < NPHASE; ++ph)
    hipLaunchKernelGGL(mega_kernel, dim3(grid_blocks), dim3(256), 0, stream, p, ph, ph + 1);
#endif
}
```

```cpp
#include <hip/hip_runtime.h>
#include <hip/hip_cooperative_groups.h>
#include <cstdio>
#include <cstdint>
namespace cg = cooperative_groups;

#ifndef SINGLE_LAUNCH
#define SINGLE_LAUNCH 1
#endif
#ifndef ONLY
#define ONLY -1
#endif
#define EN(k) (ONLY < 0 || ONLY == (k))

typedef unsigned short u16;
using bf16x8 = __attribute__((ext_vector_type(8))) short;
using bf16x4 = __attribute__((ext_vector_type(4))) short;
using f32x4  = __attribute__((ext_vector_type(4))) float;
typedef unsigned u32x4 __attribute__((ext_vector_type(4)));
#define DI __device__ __forceinline__
#define MFMA16(a, b, c) __builtin_amdgcn_mfma_f32_16x16x32_bf16((a), (b), (c), 0, 0, 0)

constexpr int MTOK = 17408;
constexpr int MPR  = 16384;
constexpr int DM   = 1024;
constexpr int NP   = 6272;
constexpr int NIN  = 10368;
constexpr int DFF  = 4096;
constexpr int INC  = 10248;
constexpr int C_RQ = 0, C_RK = 512, C_RV = 1024, C_RG = 1536, C_SZ = 2048, C_SXBC = 2560;
constexpr int C_HQ = 3584, C_HF = 4096, C_HI = 4608, C_HG = 5120, C_SU = 5632, C_SDT = 6144;
constexpr float EPS = 1e-6f;
constexpr int HLD = 1024, WLD1 = 1024, ULD = 4096, WLD4 = 4096, OLD = 2048, ZLD = 512, WLD5 = 512;
constexpr int NITEMS = 160 + 128 * 20;
constexpr int NPHASE = 21;

struct Params {
  const float* in[35];
  float* out;
  u16 *wt_in, *wt_ff1, *wt_ff2, *wt_br, *wt_out, *wt_glu;
  u16 *hb, *pbuf, *obuf, *zs5;
  float* tbuf;
  unsigned* counters;
  unsigned* bar;
  float* ssq;
  u16* slocal;
  float* segdec;
  float* hlocal;
  int nseg, cps;
  size_t o_ret_p, o_ret_s, o_ssd_p, o_ssd_s, o_conv_p, o_conv_s, o_hg_p, o_hg_s, o_s5r_p, o_s5r_s, o_s5i_p, o_s5i_s;
};

DI int tidq() { int t = threadIdx.x; asm volatile("" : "+v"(t)); return t; }
typedef __bf16 bf16v2 __attribute__((ext_vector_type(2)));
typedef float f32v2 __attribute__((ext_vector_type(2)));
DI unsigned pack2(float a, float b) { f32v2 v = {a, b}; return __builtin_bit_cast(unsigned, __builtin_convertvector(v, bf16v2)); }
DI u16 f2bf(float f) { return (u16)(pack2(f, 0.f) & 0xffffu); }
DI float bf2f(u16 h) { return __uint_as_float(((unsigned)h) << 16); }
DI float sigmoidf_(float x) { return 1.f / (1.f + __expf(-x)); }
DI float siluf_(float x) { return x / (1.f + __expf(-x)); }
DI float softplusf_(float x) { return x > 20.f ? x : log1pf(__expf(x)); }
DI float gelu_tanh(float x) {
  float u = 0.7978845608028654f * (x + 0.044715f * x * x * x);
  float e = __expf(2.f * u);
  float th = 1.f - 2.f / (e + 1.f);
  return 0.5f * x * (1.f + th);
}
DI float wave_sum(float v) {
#pragma unroll
  for (int m = 32; m >= 1; m >>= 1) v += __shfl_xor(v, m);
  return v;
}
DI float sum16(float v) {
#pragma unroll
  for (int m = 8; m >= 1; m >>= 1) v += __shfl_xor(v, m);
  return v;
}
DI void sincos_red(float a, float& s, float& c) {
  float n = rintf(a * 0.15915494309189535f);
  float r = fmaf(-n, 6.28125f, a);
  r = fmaf(-n, 1.9353071795864769e-3f, r);
  s = __sinf(r); c = __cosf(r);
}

DI int map_win(int my) {
  if (my < 3584) return my;
  if (my < 6144) return my + 8;
  if (my < 6152) return my - 6144 + 3584;
  if (my < 6272) return -1;
  return my - 120;
}
DI void transpose_tile(const float* __restrict__ src, int src_ld, u16* __restrict__ dst, int dst_ld,
                       int k0, int n0, int mapmode, char* smem) {
  float* tile = (float*)smem;
  const int tid = tidq();
  {
    const int n = tid & 63;
    int sc = n0 + n;
    if (mapmode) sc = map_win(sc);
    const float* sp = src + (size_t)(k0 + (tid >> 6)) * src_ld + (sc >= 0 ? sc : 0);
    float v[32];
#pragma unroll
    for (int i = 0; i < 32; ++i) v[i] = sp[(size_t)(4 * i) * src_ld];
#pragma unroll
    for (int i = 0; i < 32; ++i) tile[n * 129 + (tid >> 6) + 4 * i] = (sc >= 0) ? v[i] : 0.f;
  }
  __syncthreads();
  {
    const int n = tid >> 2, kc = (tid & 3) * 32;
    unsigned pk[16];
#pragma unroll
    for (int x = 0; x < 16; ++x) pk[x] = pack2(tile[n * 129 + kc + 2 * x], tile[n * 129 + kc + 2 * x + 1]);
    uint4* d = (uint4*)(dst + (size_t)(n0 + n) * dst_ld + k0 + kc);
    d[0] = make_uint4(pk[0], pk[1], pk[2], pk[3]);
    d[1] = make_uint4(pk[4], pk[5], pk[6], pk[7]);
    d[2] = make_uint4(pk[8], pk[9], pk[10], pk[11]);
    d[3] = make_uint4(pk[12], pk[13], pk[14], pk[15]);
  }
  __syncthreads();
}

__device__ void phase_convert(const Params& p, char* smem) {
  constexpr int PER = 2736;
  for (int t = blockIdx.x; t < 2 * PER; t += gridDim.x) {
    int l = t / PER, r = t % PER;
    if (r < 1296) {
      int nt = r / 8, kt = r % 8;
      transpose_tile(p.in[12] + (size_t)l * DM * INC, INC, p.wt_in + (size_t)l * NIN * WLD1, WLD1, kt * 128, nt * 64, 1, smem);
    } else if (r < 1808) {
      r -= 1296; int nt = r / 8, kt = r % 8;
      transpose_tile(p.in[33] + (size_t)l * DM * DFF, DFF, p.wt_ff1 + (size_t)l * DFF * WLD1, WLD1, kt * 128, nt * 64, 0, smem);
    } else if (r < 2320) {
      r -= 1808; int nt = r / 32, kt = r % 32;
      transpose_tile(p.in[34] + (size_t)l * DFF * DM, DM, p.wt_ff2 + (size_t)l * DM * WLD4, WLD4, kt * 128, nt * 64, 0, smem);
    } else if (r < 2448) {
      r -= 2320; int nt = r / 8, kt = r % 8;
      transpose_tile(p.in[32] + (size_t)l * DM * DM, DM, p.wt_out + (size_t)l * DM * WLD1, WLD1, kt * 128, nt * 64, 0, smem);
    } else if (r < 2704) {
      r -= 2448; int b = r / 64; r %= 64; int nt = r / 4, kt = r % 4;
      transpose_tile(p.in[31] + (size_t)(l * 4 + b) * 512 * DM, DM, p.wt_br + (size_t)(l * 4 + b) * DM * WLD5, WLD5, kt * 128, nt * 64, 0, smem);
    } else {
      r -= 2704; int nt = r / 4, kt = r % 4;
      transpose_tile(p.in[30] + (size_t)l * 512 * 512, 512, p.wt_glu + (size_t)l * 512 * WLD5, WLD5, kt * 128, nt * 64, 0, smem);
    }
  }
}

__device__ void phase_rownorm(const Params& p, bool from_input, const float* __restrict__ t, const float* __restrict__ gpost,
                              const float* __restrict__ gpre, u16* __restrict__ hout) {
  const int lane = tidq() & 63, w = tidq() >> 6;
  float* xbuf = p.out;
  for (int row = blockIdx.x * 4 + w; row < MTOK; row += gridDim.x * 4) {
    const float* xin = from_input ? (row < MPR ? p.in[0] + (size_t)row * DM : p.in[1] + (size_t)(row - MPR) * DM)
                                  : xbuf + (size_t)row * DM;
    float4 x[4];
#pragma unroll
    for (int k = 0; k < 4; ++k) x[k] = *(const float4*)(xin + lane * 4 + 256 * k);
    if (t) {
      float4 tv[4];
      float ss = 0.f;
#pragma unroll
      for (int k = 0; k < 4; ++k) {
        tv[k] = *(const float4*)(t + (size_t)row * DM + lane * 4 + 256 * k);
        ss += tv[k].x * tv[k].x + tv[k].y * tv[k].y + tv[k].z * tv[k].z + tv[k].w * tv[k].w;
      }
      ss = wave_sum(ss);
      float r = rsqrtf(ss * (1.f / DM) + EPS);
#pragma unroll
      for (int k = 0; k < 4; ++k) {
        float4 g = *(const float4*)(gpost + lane * 4 + 256 * k);
        x[k].x += tv[k].x * r * g.x; x[k].y += tv[k].y * r * g.y; x[k].z += tv[k].z * r * g.z; x[k].w += tv[k].w * r * g.w;
      }
    }
#pragma unroll
    for (int k = 0; k < 4; ++k) *(float4*)(xbuf + (size_t)row * DM + lane * 4 + 256 * k) = x[k];
    if (hout) {
      float ss = 0.f;
#pragma unroll
      for (int k = 0; k < 4; ++k) ss += x[k].x * x[k].x + x[k].y * x[k].y + x[k].z * x[k].z + x[k].w * x[k].w;
      ss = wave_sum(ss);
      float r = rsqrtf(ss * (1.f / DM) + EPS);
#pragma unroll
      for (int k = 0; k < 4; ++k) {
        float4 g = *(const float4*)(gpre + lane * 4 + 256 * k);
        uint2 o;
        o.x = pack2(x[k].x * r * g.x, x[k].y * r * g.y);
        o.y = pack2(x[k].z * r * g.z, x[k].w * r * g.w);
        *(uint2*)(hout + (size_t)row * HLD + lane * 4 + 256 * k) = o;
      }
    }
  }
}

DI int swz(int r, int c) { return r * 128 + ((c ^ ((r >> 1) & 7)) << 4); }

#define GEMM_COMPUTE(AS_) do { const char* as_ = (AS_); const char* bs_ = as_ + 16384; \
  _Pragma("unroll") for (int s_ = 0; s_ < 2; ++s_) { \
    bf16x8 af_[4], bfr_[4]; \
    _Pragma("unroll") for (int i_ = 0; i_ < 4; ++i_) af_[i_] = *(const bf16x8*)(as_ + swz(wm * 64 + i_ * 16 + r16, s_ * 4 + quad)); \
    _Pragma("unroll") for (int j_ = 0; j_ < 4; ++j_) bfr_[j_] = *(const bf16x8*)(bs_ + swz(wn * 64 + j_ * 16 + r16, s_ * 4 + quad)); \
    _Pragma("unroll") for (int i_ = 0; i_ < 4; ++i_) \
      _Pragma("unroll") for (int j_ = 0; j_ < 4; ++j_) acc[i_][j_] = MFMA16(bfr_[j_], af_[i_], acc[i_][j_]); \
  } } while (0)

struct Stage { u32x4 a0, a1, a2, a3, b0, b1, b2, b3; };
DI void gload(Stage& s, const u16* ag, const u16* bg, int lda, int ldb, int kt) {
  s.a0 = *(const u32x4*)(ag + (size_t)0 * 32 * lda + kt * 64);
  s.a1 = *(const u32x4*)(ag + (size_t)1 * 32 * lda + kt * 64);
  s.a2 = *(const u32x4*)(ag + (size_t)2 * 32 * lda + kt * 64);
  s.a3 = *(const u32x4*)(ag + (size_t)3 * 32 * lda + kt * 64);
  s.b0 = *(const u32x4*)(bg + (size_t)0 * 32 * ldb + kt * 64);
  s.b1 = *(const u32x4*)(bg + (size_t)1 * 32 * ldb + kt * 64);
  s.b2 = *(const u32x4*)(bg + (size_t)2 * 32 * ldb + kt * 64);
  s.b3 = *(const u32x4*)(bg + (size_t)3 * 32 * ldb + kt * 64);
}
DI void lwrite(const Stage& s, char* d, int lr, int lc) {
  *(u32x4*)(d + swz(lr, lc)) = s.a0;
  *(u32x4*)(d + swz(lr + 32, lc)) = s.a1;
  *(u32x4*)(d + swz(lr + 64, lc)) = s.a2;
  *(u32x4*)(d + swz(lr + 96, lc)) = s.a3;
  *(u32x4*)(d + 16384 + swz(lr, lc)) = s.b0;
  *(u32x4*)(d + 16384 + swz(lr + 32, lc)) = s.b1;
  *(u32x4*)(d + 16384 + swz(lr + 64, lc)) = s.b2;
  *(u32x4*)(d + 16384 + swz(lr + 96, lc)) = s.b3;
}

template <bool DEEP>
DI void gemm_kloop(f32x4 (&acc)[4][4], const u16* __restrict__ A, int lda, const u16* __restrict__ Bt, int ldb,
                   int K, int m0, int n0, char* smem) {
  const int tid = tidq(), lane = tid & 63, w = tid >> 6, wm = w >> 1, wn = w & 1, r16 = lane & 15, quad = lane >> 4;
  const int lr = tid >> 3, lc = tid & 7;
  const u16* ag = A + (size_t)(m0 + lr) * lda + lc * 8;
  const u16* bg = Bt + (size_t)(n0 + lr) * ldb + lc * 8;
  const int nk = K >> 6;
  Stage s0;
  gload(s0, ag, bg, lda, ldb, 0);
  if (DEEP) {
    Stage s1;
    gload(s1, ag, bg, lda, ldb, 1);
    lwrite(s0, smem, lr, lc);
    __syncthreads();
    for (int kt = 0; kt < nk; kt += 2) {
      if (kt + 2 < nk) gload(s0, ag, bg, lda, ldb, kt + 2);
      GEMM_COMPUTE(smem);
      lwrite(s1, smem + 32768, lr, lc);
      __syncthreads();
      if (kt + 3 < nk) gload(s1, ag, bg, lda, ldb, kt + 3);
      GEMM_COMPUTE(smem + 32768);
      if (kt + 2 < nk) lwrite(s0, smem, lr, lc);
      __syncthreads();
    }
  } else {
    lwrite(s0, smem, lr, lc);
    __syncthreads();
    for (int kt = 0; kt < nk; ++kt) {
      const bool more = (kt + 1 < nk);
      if (more) gload(s0, ag, bg, lda, ldb, kt + 1);
      GEMM_COMPUTE(smem + (kt & 1) * 32768);
      if (more) lwrite(s0, smem + ((kt + 1) & 1) * 32768, lr, lc);
      __syncthreads();
    }
  }
}

DI void zero_acc(f32x4 (&acc)[4][4]) {
#pragma unroll
  for (int i = 0; i < 4; ++i)
#pragma unroll
    for (int j = 0; j < 4; ++j) acc[i][j] = f32x4{0.f, 0.f, 0.f, 0.f};
}

enum { EPI_BF16 = 0, EPI_SIG = 1, EPI_RELU2 = 2, EPI_F32 = 3, EPI_GLU = 4 };

template <int EPI>
DI void gemm_epilogue(f32x4 (&acc)[4][4], int m0, int n0, void* outp, int ldc, const u16* aux, int ldaux) {
  const int lane = tidq() & 63, w = tidq() >> 6, wm = w >> 1, wn = w & 1, r16 = lane & 15, quad = lane >> 4;
#pragma unroll
  for (int i = 0; i < 4; ++i) {
    const int m = m0 + wm * 64 + i * 16 + r16;
#pragma unroll
    for (int j = 0; j < 4; ++j) {
      const int n = n0 + wn * 64 + j * 16 + quad * 4;
      f32x4 v = acc[i][j];
      if (EPI == EPI_F32) {
        *(float4*)((float*)outp + (size_t)m * ldc + n) = make_float4(v[0], v[1], v[2], v[3]);
      } else {
        if (EPI == EPI_SIG) {
#pragma unroll
          for (int x = 0; x < 4; ++x) v[x] = sigmoidf_(v[x]);
        } else if (EPI == EPI_RELU2) {
#pragma unroll
          for (int x = 0; x < 4; ++x) { float r = fmaxf(v[x], 0.f); v[x] = r * r; }
        } else if (EPI == EPI_GLU) {
          uint2 zz = *(const uint2*)(aux + (size_t)m * ldaux + n);
          v[0] = bf2f((u16)(zz.x & 0xffff)) * sigmoidf_(v[0]);
          v[1] = bf2f((u16)(zz.x >> 16)) * sigmoidf_(v[1]);
          v[2] = bf2f((u16)(zz.y & 0xffff)) * sigmoidf_(v[2]);
          v[3] = bf2f((u16)(zz.y >> 16)) * sigmoidf_(v[3]);
        }
        uint2 o; o.x = pack2(v[0], v[1]); o.y = pack2(v[2], v[3]);
        *(uint2*)((u16*)outp + (size_t)m * ldc + n) = o;
      }
      acc[i][j] = f32x4{0.f, 0.f, 0.f, 0.f};
    }
  }
}

DI bool tile_at(int i, int T, int& t);
DI void tile_mn(int t, int nN, int& m0, int& n0);

template <int EPI>
DI void gemm_stream(const u16* __restrict__ A, int lda, const u16* __restrict__ Bt, int ldb, int K, int nN, int T,
                    void* outp, int ldc, const u16* aux, int ldaux, char* smem) {
  const int tid = tidq(), lane = tid & 63, w = tid >> 6, wm = w >> 1, wn = w & 1, r16 = lane & 15, quad = lane >> 4;
  const int lr = tid >> 3, lc = tid & 7;
  asm volatile("" : "+s"(lda), "+s"(ldb), "+s"(K));
  const int nk = K >> 6;
  int t, m0, n0, m1 = 0, n1 = 0;
  if (!tile_at(0, T, t)) return;
  tile_mn(t, nN, m0, n0);
  const size_t aoff = (size_t)lr * lda + lc * 8, boff = (size_t)lr * ldb + lc * 8;
  const u16* ag = A + (size_t)m0 * lda + aoff;
  const u16* bg = Bt + (size_t)n0 * ldb + boff;
  f32x4 acc[4][4];
  zero_acc(acc);
  Stage s0, s1;
  gload(s0, ag, bg, lda, ldb, 0);
  gload(s1, ag, bg, lda, ldb, 1);
  lwrite(s0, smem, lr, lc);
  __syncthreads();
  for (int i = 0;; ++i) {
    const bool has_next = tile_at(i + 1, T, t);
    if (has_next) tile_mn(t, nN, m1, n1);
    const u16* agn = A + (size_t)m1 * lda + aoff;
    const u16* bgn = Bt + (size_t)n1 * ldb + boff;
    for (int kt = 0; kt < nk; kt += 2) {
      if (kt + 2 < nk) gload(s0, ag, bg, lda, ldb, kt + 2);
      else if (has_next) gload(s0, agn, bgn, lda, ldb, 0);
      GEMM_COMPUTE(smem);
      lwrite(s1, smem + 32768, lr, lc);
      __syncthreads();
      if (kt + 2 < nk) gload(s1, ag, bg, lda, ldb, kt + 3);
      else if (has_next) gload(s1, agn, bgn, lda, ldb, 1);
      GEMM_COMPUTE(smem + 32768);
      if (kt + 2 < nk || has_next) lwrite(s0, smem, lr, lc);
      __syncthreads();
    }
    gemm_epilogue<EPI>(acc, m0, n0, outp, ldc, aux, ldaux);
    if (!has_next) break;
    m0 = m1; n0 = n1; ag = agn; bg = bgn;
  }
}

DI void merge_tile(const Params& p, int l, int m0, int n0, char* smem) {
  f32x4 macc[4][4];
  zero_acc(macc);
  const int lane = tidq() & 63, w = tidq() >> 6, wm = w >> 1, wn = w & 1, r16 = lane & 15, quad = lane >> 4;
  const u16* gates = p.pbuf;
  for (int b = 0; b < 4; ++b) {
    f32x4 acc[4][4];
    zero_acc(acc);
    gemm_kloop<false>(acc, p.obuf + b * 512, OLD, p.wt_br + (size_t)(l * 4 + b) * DM * WLD5, WLD5, 512, m0, n0, smem);
#pragma unroll
    for (int i = 0; i < 4; ++i) {
      const int m = m0 + wm * 64 + i * 16 + r16;
#pragma unroll
      for (int j = 0; j < 4; ++j) {
        const int n = n0 + wn * 64 + j * 16 + quad * 4;
        uint2 gg = *(const uint2*)(gates + (size_t)m * 4096 + b * 1024 + n);
        macc[i][j][0] += bf2f((u16)(gg.x & 0xffff)) * acc[i][j][0];
        macc[i][j][1] += bf2f((u16)(gg.x >> 16)) * acc[i][j][1];
        macc[i][j][2] += bf2f((u16)(gg.y & 0xffff)) * acc[i][j][2];
        macc[i][j][3] += bf2f((u16)(gg.y >> 16)) * acc[i][j][3];
      }
    }
  }
#pragma unroll
  for (int i = 0; i < 4; ++i) {
    const int m = m0 + wm * 64 + i * 16 + r16;
#pragma unroll
    for (int j = 0; j < 4; ++j) {
      const int n = n0 + wn * 64 + j * 16 + quad * 4;
      uint2 o; o.x = pack2(macc[i][j][0], macc[i][j][1]); o.y = pack2(macc[i][j][2], macc[i][j][3]);
      *(uint2*)(p.hb + (size_t)m * HLD + n) = o;
    }
  }
}

constexpr int QS = 136;
constexpr int TS = 20;
constexpr int OFS = 260;

template <int MODE>
__device__ void run_chain(const Params& p, int l, int seq, int sub, int seg, int pass, char* smem) {
  constexpr int NE = 2;
  const int tid = tidq(), lane = tid & 63, w = tid >> 6, r16 = lane & 15, quad = lane >> 4;
  const bool prompt = seq < 8;
  const int bidx = prompt ? seq : seq - 8;
  const int NB = prompt ? 8 : 128;
  const int L = prompt ? 2048 : 8;
  const int row0 = prompt ? seq * 2048 : MPR + (seq - 8) * 8;
  const int pos0 = prompt ? 0 : 16384;
  const int cps = p.cps;
  const int ch_begin = prompt ? seg * cps : 0;
  const int ch_end = prompt ? ch_begin + cps : 1;
  const bool light = prompt && (pass == 1);
  const bool last_seg = !prompt || (seg == p.nseg - 1);
  const int cid = seq * 12 + MODE * 4 + sub;

  u16* Qa = (u16*)smem;
  u16* Ka = (u16*)(smem + 4352);
  u16* KuT = (u16*)(smem + 8704);
  u16* VaT = (u16*)(smem + 13824);
  u16* VuT = (MODE == 1) ? (u16*)(smem + 24064) : VaT;
  float* Of = (float*)(smem + 34304);
  u16* Raw = (u16*)(smem + 34304);
  u16* Xc = (u16*)(smem + 50944);
  float* tot = (float*)(smem + 55040);
  float* cdec = (float*)(smem + 59136);
  float* dtl = (float*)(smem + 59392);
  float* rsc = (float*)(smem + 59648);
  float* clast = (float*)(smem + 60160);
  float* segacc = (float*)(smem + 60176);

  const float* sin_ = nullptr;
  float* sout = nullptr;
  if (MODE == 0) {
    if (!prompt) sin_ = p.in[2] + (((size_t)l * 128 + bidx) * 4 + sub) * 16384;
    sout = p.out + (prompt ? p.o_ret_p : p.o_ret_s) + (((size_t)l * NB + bidx) * 4 + sub) * 16384;
  } else if (MODE == 2) {
    if (!prompt) sin_ = p.in[5] + (((size_t)l * 128 + bidx) * 4 + sub) * 16384;
    sout = p.out + (prompt ? p.o_hg_p : p.o_hg_s) + (((size_t)l * NB + bidx) * 4 + sub) * 16384;
  } else {
    if (!prompt) sin_ = p.in[3] + (((size_t)l * 128 + bidx) * 8 + sub * 2 + (w >> 1)) * 8192;
    sout = p.out + (prompt ? p.o_ssd_p : p.o_ssd_s) + (((size_t)l * NB + bidx) * 8 + sub * 2 + (w >> 1)) * 8192;
  }

  float lg = 0.f;
  if (MODE == 0) lg = log1pf(-exp2f(-5.f - (float)sub));

  int sbase = (MODE == 1) ? (((w & 1) * 32 + r16) * 128 + quad * 4) : (quad * 512 + w * 32 + r16);
  asm volatile("" : "+v"(sbase));
  f32x4 S[8][NE];
#pragma unroll
  for (int t = 0; t < 8; ++t)
#pragma unroll
    for (int u = 0; u < NE; ++u) {
      if (sin_) {
        if (MODE == 1) {
          S[t][u] = *(const f32x4*)(sin_ + sbase + u * 2048 + t * 16);
        } else {
#pragma unroll
          for (int jj = 0; jj < 4; ++jj) S[t][u][jj] = sin_[sbase + t * 2048 + jj * 128 + u * 16];
        }
      } else {
        S[t][u] = f32x4{0.f, 0.f, 0.f, 0.f};
      }
    }
  if (prompt && pass == 2) {
    for (int r = 0; r < seg; ++r) {
      const uint2* sl = (const uint2*)(p.slocal + (size_t)(cid * (p.nseg - 1) + r) * 16384) + tid;
      const float* sd = p.segdec + (size_t)(cid * 7 + r) * 128;
      float dsc = 1.f;
      if (MODE == 0) dsc = __expf(lg * (float)(16 * cps));
      if (MODE == 1) dsc = __expf(sd[w >> 1]);
#pragma unroll
      for (int t = 0; t < 8; ++t) {
        f32x4 dv = f32x4{dsc, dsc, dsc, dsc};
        if (MODE == 2) {
          f32x4 lv = *(const f32x4*)(sd + t * 16 + quad * 4);
          dv = f32x4{__expf(lv[0]), __expf(lv[1]), __expf(lv[2]), __expf(lv[3])};
        }
#pragma unroll
        for (int u = 0; u < NE; ++u) {
          uint2 pk = sl[(t * NE + u) * 256];
          S[t][u][0] = S[t][u][0] * dv[0] + bf2f((u16)(pk.x & 0xffff));
          S[t][u][1] = S[t][u][1] * dv[1] + bf2f((u16)(pk.x >> 16));
          S[t][u][2] = S[t][u][2] * dv[2] + bf2f((u16)(pk.y & 0xffff));
          S[t][u][3] = S[t][u][3] * dv[3] + bf2f((u16)(pk.y >> 16));
        }
      }
    }
  }

  float lbv = 0.f;
  float hg_tot = 0.f;
  float cprev[2][3];
  float cw[2][4], cb[2];
  int ccidx[2];
  float dt_bias = 0.f, dt_A = 0.f;
  float rinv = 0.f, rcD = 1.f, rsD = 0.f;
  const int gg = sub >> 1, pair = sub & 1;
  if (MODE == 0) {
    rinv = exp2f(-(float)(tid & 63) * (13.287712379549449f / 64.f));
    rsD = __sinf(rinv); rcD = __cosf(rinv);
  }
  if (MODE == 2) {
    if (l == 1) {
      float a0 = p.in[20][sub * 128 + (tid & 127)], a1 = p.in[20][512 + sub * 128 + (tid & 127)];
      float mx = fmaxf(a0, a1);
      float e0 = __expf(a0 - mx), e1 = __expf(a1 - mx);
      lbv = e1 / (e0 + e1);
    }
  }
  if (MODE == 1) {
    if (tid < 32) {
      const int hh = sub * 2 + (tid >> 4);
      dt_A = -__expf(p.in[16][l * 8 + hh]);
      dt_bias = p.in[17][l * 8 + hh];
    }
    if (tid < 2) segacc[tid] = 0.f;
#pragma unroll
    for (int k = 0; k < 2; ++k) {
      int ci = tid + 256 * k;
      int cc = 0;
      if (ci < 128) cc = gg * 256 + pair * 128 + ci;
      else if (ci < 256) cc = 512 + gg * 128 + (ci - 128);
      else cc = 768 + gg * 128 + (ci - 256);
      if (ci >= 384) cc = 0;
      ccidx[k] = cc;
#pragma unroll
      for (int j = 0; j < 4; ++j) cw[k][j] = p.in[14][((size_t)l * 4 + j) * 1024 + cc];
      cb[k] = p.in[15][l * 1024 + cc];
#pragma unroll
      for (int j = 0; j < 3; ++j) {
        float v = 0.f;
        if (!prompt) v = p.in[4][(((size_t)l * 128 + bidx) * 3 + j) * 1024 + cc];
        else if (ch_begin > 0) v = bf2f(p.pbuf[(size_t)(row0 + ch_begin * 16 - 3 + j) * NP + C_SXBC + cc]);
        cprev[k][j] = v;
      }
    }
  }

  float fgain[8];
  {
    const int eg_ = tid & 15;
#pragma unroll
    for (int x = 0; x < 8; ++x) {
      if (MODE == 0) fgain[x] = p.in[13][(l * 4 + sub) * 128 + eg_ * 8 + x];
      else if (MODE == 2) fgain[x] = p.in[21][l * 128 + eg_ * 8 + x];
      else fgain[x] = p.in[18][l * 8 + sub * 2 + ((eg_ * 8) >> 6)];
    }
  }
  const int lt = tid >> 4, lc = tid & 15;
  uint4 r0, r1, r2, g0;
  unsigned rdt = 0;
  const uint4 z4 = make_uint4(0, 0, 0, 0);
  r0 = r1 = r2 = g0 = z4;
  auto load_raw = [&](int ch) {
    const int t0 = ch * 16;
    const int nv = (L - t0 < 16) ? (L - t0) : 16;
    const u16* Pr = p.pbuf + (size_t)(row0 + t0 + lt) * NP;
    r0 = r1 = r2 = g0 = z4;
    rdt = 0;
    if (lt < nv) {
      if (MODE == 0) {
        r0 = *(const uint4*)(Pr + C_RQ + sub * 128 + lc * 8);
        r1 = *(const uint4*)(Pr + C_RK + sub * 128 + lc * 8);
        r2 = *(const uint4*)(Pr + C_RV + sub * 128 + lc * 8);
        g0 = *(const uint4*)(Pr + C_RG + sub * 128 + lc * 8);
      } else if (MODE == 2) {
        r0 = *(const uint4*)(Pr + C_HQ + sub * 128 + lc * 8);
        r1 = *(const uint4*)(Pr + C_HF + sub * 128 + lc * 8);
        r2 = *(const uint4*)(Pr + C_HI + sub * 128 + lc * 8);
        g0 = *(const uint4*)(Pr + C_HG + sub * 128 + lc * 8);
      } else {
        r0 = *(const uint4*)(Pr + C_SXBC + gg * 256 + pair * 128 + lc * 8);
        r1 = *(const uint4*)(Pr + C_SXBC + 512 + gg * 128 + lc * 8);
        r2 = *(const uint4*)(Pr + C_SXBC + 768 + gg * 128 + lc * 8);
        g0 = *(const uint4*)(Pr + C_SZ + gg * 256 + pair * 128 + lc * 8);
        if (lc < 2) rdt = Pr[C_SDT + sub * 2 + lc];
      }
    }
  };
  load_raw(ch_begin);

  for (int ch = ch_begin; ch < ch_end; ++ch) {
    const int t0 = ch * 16;
    const int nvalid = (L - t0 < 16) ? (L - t0) : 16;
    float sscale = 1.f;
    int tidv = threadIdx.x;
    asm volatile("" : "+v"(tidv));
    const int tid = tidv, lane = tid & 63, w = tid >> 6, r16 = lane & 15, quad = lane >> 4, lt = tid >> 4, lc = tid & 15;

    *(uint4*)(Raw + lt * 128 + lc * 8) = r0;
    *(uint4*)(Raw + 2048 + lt * 128 + lc * 8) = r1;
    *(uint4*)(Raw + 4096 + lt * 128 + lc * 8) = r2;
    if (MODE == 1) { if (lc < 2) Raw[6144 + lt * 2 + lc] = (u16)rdt; }
    const uint4 gc0 = g0;
    __syncthreads();
    if (ch + 1 < ch_end) load_raw(ch + 1);

    if (MODE == 0) {
      const int which = tid >> 7, pr = tid & 63, th = (tid >> 6) & 1;
      if (which == 1 || !light) {
        const u16* R = Raw + which * 2048;
        float sn, cs;
        sincos_red((float)(pos0 + t0 + th * 8) * rinv, sn, cs);
#pragma unroll
        for (int x = 0; x < 8; ++x) {
          const int t = th * 8 + x;
          float x1 = bf2f(R[t * 128 + pr]);
          float x2 = bf2f(R[t * 128 + pr + 64]);
          float y1 = x1 * cs - x2 * sn, y2 = x1 * sn + x2 * cs;
          if (which) {
            y1 *= 0.08838834764831845f; y2 *= 0.08838834764831845f;
            Ka[t * QS + pr] = f2bf(y1); Ka[t * QS + pr + 64] = f2bf(y2);
            float kd = __expf(lg * (float)(nvalid - 1 - t));
            KuT[pr * TS + t] = f2bf(y1 * kd);
            KuT[(pr + 64) * TS + t] = f2bf(y2 * kd);
          } else {
            Qa[t * QS + pr] = f2bf(y1); Qa[t * QS + pr + 64] = f2bf(y2);
          }
          float ncs = cs * rcD - sn * rsD;
          sn = sn * rcD + cs * rsD; cs = ncs;
        }
      }
      if (tid < 16) cdec[tid] = lg * (float)(tid + 1);
      sscale = __expf(lg * (float)nvalid);
    } else if (MODE == 2) {
      const int d = tid & 127, th = tid >> 7;
      float cl[8], kk[8], qv[8];
      float c = 0.f;
#pragma unroll
      for (int x = 0; x < 8; ++x) {
        const int t = th * 8 + x;
        kk[x] = 0.f; qv[x] = 0.f;
        if (t < nvalid) {
          float z = bf2f(Raw[2048 + t * 128 + d]);
          float sg = sigmoidf_(z);
          float f = lbv + (1.f - lbv) * sg;
          c += __logf(f);
          kk[x] = (1.f - lbv) * (1.f - sg);
          if (!light) qv[x] = siluf_(bf2f(Raw[t * 128 + d]));
        }
        cl[x] = c;
      }
      tot[th * 128 + d] = c;
      __syncthreads();
      const float c_lo = tot[d];
      const float c_all = c_lo + tot[128 + d];
      const float off = th ? c_lo : 0.f;
      const float e_all = __expf(c_all);
#pragma unroll
      for (int x = 0; x < 8; ++x) {
        const int t = th * 8 + x;
        const float ct = off + cl[x];
        const float ein = __expf(-ct);
        if (!light) {
          Qa[t * QS + d] = f2bf(qv[x] * __frcp_rn(ein));
          Ka[t * QS + d] = f2bf(kk[x] * ein);
        }
        KuT[d * TS + t] = f2bf(kk[x] * ein * e_all);
      }
      if (th == 0) { rsc[d] = e_all; hg_tot += c_all; }
    } else {
      if (tid < 32) {
        const int hl = tid >> 4, t = tid & 15;
        float dtv = 0.f, c = 0.f;
        if (t < nvalid) {
          dtv = softplusf_(bf2f(Raw[6144 + t * 2 + hl]) + dt_bias);
          c = dtv * dt_A;
        }
#pragma unroll
        for (int o = 1; o < 16; o <<= 1) {
          float v = __shfl_up(c, o, 16);
          if (t >= o) c += v;
        }
        cdec[hl * 16 + t] = c;
        dtl[hl * 16 + t] = dtv;
        if (t == 15) { clast[hl] = c; segacc[hl] += c; }
      }
      __syncthreads();
#pragma unroll
      for (int k = 0; k < 2; ++k) {
        const int ci = tid + 256 * k;
        if (ci < 256 || (ci < 384 && !light)) {
          const int hl = (ci < 128) ? (ci >> 6) : 0;
          const float cl = clast[hl];
          const u16* R = Raw + ((ci < 128) ? ci : ((ci < 256) ? (2048 + (ci - 128)) : (4096 + (ci - 256))));
#pragma unroll 4
          for (int t = 0; t < 16; ++t) {
            float v = 0.f;
            if (t < nvalid) {
              float raw = bf2f(R[t * 128]);
              float o = cb[k] + cprev[k][0] * cw[k][0] + cprev[k][1] * cw[k][1] + cprev[k][2] * cw[k][2] + raw * cw[k][3];
              cprev[k][0] = cprev[k][1]; cprev[k][1] = cprev[k][2]; cprev[k][2] = raw;
              v = siluf_(o);
            }
            if (ci < 128) {
              float dtv = dtl[hl * 16 + t];
              if (!light) { Xc[t * 128 + ci] = f2bf(v); VaT[ci * TS + t] = f2bf(v * dtv); }
              VuT[ci * TS + t] = f2bf(v * dtv * __expf(cl - cdec[hl * 16 + t]));
            } else if (ci < 256) {
              u16 a = f2bf(v);
              if (!light) Ka[t * QS + (ci - 128)] = a;
              KuT[(ci - 128) * TS + t] = a;
            } else {
              Qa[t * QS + (ci - 256)] = f2bf(v);
            }
          }
        }
      }
    }
    if (MODE != 1) {
      const int e = tid & 127, th = tid >> 7;
#pragma unroll
      for (int x = 0; x < 4; ++x) {
        const int t = th * 8 + 2 * x;
        unsigned lo = Raw[4096 + t * 128 + e], hi = Raw[4096 + (t + 1) * 128 + e];
        *(unsigned*)(VaT + e * TS + t) = lo | (hi << 16);
      }
    }
    __syncthreads();

    {
      const float* cd = cdec + ((MODE == 1) ? (w >> 1) * 16 : 0);
      bf16x8 attA;
      float rr[4];
      bf16x8 qf[4];
      if (!light) {
        f32x4 at = f32x4{0.f, 0.f, 0.f, 0.f};
#pragma unroll
        for (int s = 0; s < 4; ++s) {
          bf16x8 a = *(const bf16x8*)(Ka + r16 * QS + s * 32 + quad * 8);
          bf16x8 b = *(const bf16x8*)(Qa + r16 * QS + s * 32 + quad * 8);
          at = MFMA16(a, b, at);
        }
        float ci_ = (MODE != 2) ? cd[r16] : 0.f;
        float vv[4];
#pragma unroll
        for (int jj = 0; jj < 4; ++jj) {
          int j = quad * 4 + jj;
          float v = at[jj];
          if (MODE != 2) v *= __expf(fminf(ci_ - cd[j], 0.f));
          vv[jj] = (j <= r16) ? v : 0.f;
        }
        unsigned a01 = pack2(vv[0], vv[1]), a23 = pack2(vv[2], vv[3]);
        attA = __builtin_bit_cast(bf16x8, (u32x4){a01, a23, 0u, 0u});
#pragma unroll
        for (int jj = 0; jj < 4; ++jj) rr[jj] = (MODE != 2) ? __expf(cd[quad * 4 + jj]) : 1.f;
#pragma unroll
        for (int s = 0; s < 4; ++s) {
          bf16x4 lo = *(const bf16x4*)(Qa + r16 * QS + s * 32 + quad * 4);
          bf16x4 hi = *(const bf16x4*)(Qa + r16 * QS + s * 32 + 16 + quad * 4);
          qf[s] = bf16x8{lo[0], lo[1], lo[2], lo[3], hi[0], hi[1], hi[2], hi[3]};
        }
      }
      __syncthreads();
      if (!light) {
#pragma unroll
        for (int u = 0; u < NE; ++u) {
          const int e0 = (w * NE + u) * 16;
          bf16x4 v4 = *(const bf16x4*)(VaT + (e0 + r16) * TS + quad * 4);
          bf16x8 vb = bf16x8{v4[0], v4[1], v4[2], v4[3], 0, 0, 0, 0};
          f32x4 o1 = MFMA16(attA, vb, (f32x4{0.f, 0.f, 0.f, 0.f}));
          f32x4 o2 = f32x4{0.f, 0.f, 0.f, 0.f};
#pragma unroll
          for (int s = 0; s < 4; ++s) {
            u32x4 sp = {pack2(S[2 * s][u][0], S[2 * s][u][1]), pack2(S[2 * s][u][2], S[2 * s][u][3]),
                        pack2(S[2 * s + 1][u][0], S[2 * s + 1][u][1]), pack2(S[2 * s + 1][u][2], S[2 * s + 1][u][3])};
            o2 = MFMA16(qf[s], __builtin_bit_cast(bf16x8, sp), o2);
          }
#pragma unroll
          for (int jj = 0; jj < 4; ++jj) Of[(quad * 4 + jj) * OFS + e0 + r16] = o1[jj] + rr[jj] * o2[jj];
        }
      }
      float hs = 1.f;
      if (MODE == 0) hs = sscale;
      if (MODE == 1) hs = __expf(clast[w >> 1]);
#pragma unroll
      for (int u = 0; u < NE; ++u) {
        const int e0 = (w * NE + u) * 16;
        bf16x4 v4 = *(const bf16x4*)(VuT + (e0 + r16) * TS + quad * 4);
        bf16x8 vb = bf16x8{v4[0], v4[1], v4[2], v4[3], 0, 0, 0, 0};
#pragma unroll
        for (int t = 0; t < 8; ++t) {
          bf16x4 k4 = *(const bf16x4*)(KuT + (t * 16 + r16) * TS + quad * 4);
          bf16x8 ka = bf16x8{k4[0], k4[1], k4[2], k4[3], 0, 0, 0, 0};
          f32x4 sv = S[t][u];
          if (MODE == 2) {
            f32x4 r4 = *(const f32x4*)(rsc + t * 16 + quad * 4);
            sv[0] *= r4[0]; sv[1] *= r4[1]; sv[2] *= r4[2]; sv[3] *= r4[3];
          } else {
            sv[0] *= hs; sv[1] *= hs; sv[2] *= hs; sv[3] *= hs;
          }
          S[t][u] = MFMA16(ka, vb, sv);
        }
      }
    }
    __syncthreads();

    if (!light) {
      const int i = tid >> 4, eg = tid & 15;
      const int grow = row0 + t0 + i;
      unsigned gw[4] = {gc0.x, gc0.y, gc0.z, gc0.w};
      if (MODE == 0 || MODE == 2) {
        float o[8];
#pragma unroll
        for (int x = 0; x < 8; ++x) o[x] = Of[i * OFS + eg * 8 + x];
        float s1 = 0.f;
        float mu = 0.f;
        if (MODE == 0) {
#pragma unroll
          for (int x = 0; x < 8; ++x) s1 += o[x];
          mu = sum16(s1) * (1.f / 128.f);
        }
        float s2 = 0.f;
#pragma unroll
        for (int x = 0; x < 8; ++x) { o[x] -= mu; s2 += o[x] * o[x]; }
        float r = rsqrtf(sum16(s2) * (1.f / 128.f) + EPS);
        if (i < nvalid) {
          float res[8];
#pragma unroll
          for (int x = 0; x < 8; ++x) {
            float g = bf2f((u16)((x & 1) ? (gw[x >> 1] >> 16) : (gw[x >> 1] & 0xffff)));
            float gate = (MODE == 0) ? siluf_(g) : sigmoidf_(g);
            res[x] = o[x] * r * fgain[x] * gate;
          }
          uint4 ov = make_uint4(pack2(res[0], res[1]), pack2(res[2], res[3]), pack2(res[4], res[5]), pack2(res[6], res[7]));
          const int ocol = ((MODE == 0) ? 0 : 1024) + sub * 128 + eg * 8;
          *(uint4*)(p.obuf + (size_t)grow * OLD + ocol) = ov;
        }
      } else {
        float y[8];
        const int chb = eg * 8;
        const float Dh = fgain[0];
        float s2 = 0.f;
#pragma unroll
        for (int x = 0; x < 8; ++x) {
          float g = bf2f((u16)((x & 1) ? (gw[x >> 1] >> 16) : (gw[x >> 1] & 0xffff)));
          float v = Of[i * OFS + chb + x] + bf2f(Xc[i * 128 + chb + x]) * Dh;
          v *= siluf_(g);
          y[x] = v; s2 += v * v;
        }
        s2 = sum16(s2);
        if (i < nvalid) {
          if (eg == 0) p.ssq[(size_t)grow * 4 + sub] = s2;
          uint4 ov = make_uint4(pack2(y[0], y[1]), pack2(y[2], y[3]), pack2(y[4], y[5]), pack2(y[6], y[7]));
          *(uint4*)(p.obuf + (size_t)grow * OLD + 512 + sub * 128 + chb) = ov;
        }
      }
    }
    __syncthreads();
  }

  if (light) {
    uint2* sl = (uint2*)(p.slocal + (size_t)(cid * (p.nseg - 1) + seg) * 16384) + tid;
#pragma unroll
    for (int t = 0; t < 8; ++t)
#pragma unroll
      for (int u = 0; u < NE; ++u)
        sl[(t * NE + u) * 256] = make_uint2(pack2(S[t][u][0], S[t][u][1]), pack2(S[t][u][2], S[t][u][3]));
    float* sd = p.segdec + (size_t)(cid * 7 + seg) * 128;
    if (MODE == 1) { if (tid < 2) sd[tid] = segacc[tid]; }
    if (MODE == 2) { if (tid < 128) sd[tid] = hg_tot; }
  } else if (last_seg) {
    asm volatile("" : "+v"(sbase));
#pragma unroll
    for (int t = 0; t < 8; ++t)
#pragma unroll
      for (int u = 0; u < NE; ++u) {
        if (MODE == 1) {
          *(f32x4*)(sout + sbase + u * 2048 + t * 16) = S[t][u];
        } else {
#pragma unroll
          for (int jj = 0; jj < 4; ++jj) sout[sbase + t * 2048 + jj * 128 + u * 16] = S[t][u][jj];
        }
      }
    if (MODE == 1) {
      float* co = p.out + (prompt ? p.o_conv_p : p.o_conv_s) + ((size_t)l * NB + bidx) * 3 * 1024;
#pragma unroll
      for (int k = 0; k < 2; ++k) {
        const int ci = tid + 256 * k;
        if (ci < 128 || (ci < 384 && pair == 0)) {
#pragma unroll
          for (int j = 0; j < 3; ++j) co[j * 1024 + ccidx[k]] = cprev[k][j];
        }
      }
    }
  }
}

__device__ void run_s5(const Params& p, int l, int seq, int gq, int seg, int pass, char* smem) {
  const int tid = tidq(), lane = tid & 63, w = tid >> 6, r16 = lane & 15, quad = lane >> 4;
  const int g = gq * 4 + w;
  const bool prompt = seq < 8;
  const int bidx = prompt ? seq : seq - 8;
  const int NB = prompt ? 8 : 128;
  const int row0 = prompt ? seq * 2048 : MPR + (seq - 8) * 8;
  const int nch = prompt ? p.cps : 1;
  const int ch_begin = prompt ? seg * nch : 0;
  const int ch_end = ch_begin + nch;
  const int nvalid = prompt ? 16 : 8;
  const bool light = prompt && (pass == 1);
  const bool last_seg = !prompt || (seg == p.nseg - 1);
  char* wb = smem + w * 5120;
  u16* Hs = (u16*)wb;
  u16* Us = (u16*)(wb + 4352);
  const int lg_ = l * 32 + g;

  const float dt = __expf(p.in[29][lg_]);
  float Ar[4][4], Ai[4][4];
  float fre[4], fim[4];
  float dtare[4], thv[4];
#pragma unroll
  for (int i = 0; i < 4; ++i) {
    const int pi = i * 16 + r16;
    const float are = p.in[22][lg_ * 64 + pi], aim = p.in[23][lg_ * 64 + pi];
    const float th = dt * aim;
    float sn, cs; sincos_red(th, sn, cs);
    float shalf, chalf; sincos_red(0.5f * th, shalf, chalf);
    const float em1 = expm1f(dt * are);
    const float mag = em1 + 1.f;
    const float abr = mag * cs, abi = mag * sn;
    const float nre = em1 * cs - 2.f * shalf * shalf, nim = abi;
    const float den = are * are + aim * aim;
    fre[i] = (nre * are + nim * aim) / den; fim[i] = (nim * are - nre * aim) / den;
    dtare[i] = dt * are; thv[i] = th;
    Ar[0][i] = abr; Ai[0][i] = abi;
    Ar[1][i] = abr * abr - abi * abi; Ai[1][i] = 2.f * abr * abi;
    Ar[2][i] = Ar[1][i] * abr - Ai[1][i] * abi; Ai[2][i] = Ar[1][i] * abi + Ai[1][i] * abr;
    Ar[3][i] = Ar[1][i] * Ar[1][i] - Ai[1][i] * Ai[1][i]; Ai[3][i] = 2.f * Ar[1][i] * Ai[1][i];
  }
  bf16x8 Bop[8];
#pragma unroll
  for (int nt = 0; nt < 8; ++nt) {
    const int i = nt & 3;
    u32x4 pk = {0u, 0u, 0u, 0u};
    if (quad < 2) {
      const size_t bo = ((size_t)lg_ * 64 + i * 16 + r16) * 16 + quad * 8;
      const float4 br0 = *(const float4*)(p.in[24] + bo), br1 = *(const float4*)(p.in[24] + bo + 4);
      const float4 bi0 = *(const float4*)(p.in[25] + bo), bi1 = *(const float4*)(p.in[25] + bo + 4);
      const float brv[8] = {br0.x, br0.y, br0.z, br0.w, br1.x, br1.y, br1.z, br1.w};
      const float biv[8] = {bi0.x, bi0.y, bi0.z, bi0.w, bi1.x, bi1.y, bi1.z, bi1.w};
      float v[8];
#pragma unroll
      for (int j = 0; j < 8; ++j)
        v[j] = (nt < 4) ? (fre[i] * brv[j] - fim[i] * biv[j]) : (fre[i] * biv[j] + fim[i] * brv[j]);
      pk = u32x4{pack2(v[0], v[1]), pack2(v[2], v[3]), pack2(v[4], v[5]), pack2(v[6], v[7])};
    }
    Bop[nt] = __builtin_bit_cast(bf16x8, pk);
  }
  bf16x8 Cop[4];
  float Dm[4] = {0.f, 0.f, 0.f, 0.f};
  if (!light) {
#pragma unroll
    for (int s = 0; s < 4; ++s) {
      const int n0 = 32 * s + quad * 8;
      const float* src = ((n0 >= 64) ? p.in[27] : p.in[26]) + ((size_t)lg_ * 16 + r16) * 64 + (n0 & 63);
      const float sg = (n0 >= 64) ? -1.f : 1.f;
      const float4 c0 = *(const float4*)src, c1 = *(const float4*)(src + 4);
      Cop[s] = __builtin_bit_cast(bf16x8, (u32x4{pack2(sg * c0.x, sg * c0.y), pack2(sg * c0.z, sg * c0.w),
                                                 pack2(sg * c1.x, sg * c1.y), pack2(sg * c1.z, sg * c1.w)}));
    }
#pragma unroll
    for (int jj = 0; jj < 4; ++jj) Dm[jj] = p.in[28][lg_ * 16 + quad * 4 + jj];
  }
  float hr[4], hi[4];
#pragma unroll
  for (int i = 0; i < 4; ++i) { hr[i] = 0.f; hi[i] = 0.f; }
  if (!prompt) {
#pragma unroll
    for (int i = 0; i < 4; ++i) {
      hr[i] = p.in[6][((size_t)(l * 128 + bidx) * 32 + g) * 64 + i * 16 + r16];
      hi[i] = p.in[7][((size_t)(l * 128 + bidx) * 32 + g) * 64 + i * 16 + r16];
    }
  } else if (pass == 2 && seg > 0) {
    const float len = (float)(nch * 16);
#pragma unroll
    for (int i = 0; i < 4; ++i) {
      const float pm = __expf(len * dtare[i]);
      float ps, pc; sincos_red(len * thv[i], ps, pc);
      const float pr_ = pm * pc, pi_ = pm * ps;
      for (int r = 0; r < seg; ++r) {
        const float* hl = p.hlocal + ((size_t)((seq * 32 + g) * 7 + r)) * 128;
        const float lr_ = hl[i * 16 + r16], li_ = hl[64 + i * 16 + r16];
        const float nr = pr_ * hr[i] - pi_ * hi[i] + lr_;
        const float ni = pr_ * hi[i] + pi_ * hr[i] + li_;
        hr[i] = nr; hi[i] = ni;
      }
    }
  }
  const int ut = lane >> 1, uh = lane & 1;
  const u16* ubase = p.pbuf + (size_t)(row0 + ut) * NP + C_SU + g * 16 + uh * 8;
  const uint4 z4 = make_uint4(0, 0, 0, 0);
  uint4 nxt = z4;
  if (lane < 32 && ut < nvalid) nxt = *(const uint4*)(ubase + (size_t)ch_begin * 16 * NP);
  for (int ch = ch_begin; ch < ch_end; ++ch) {
    const uint4 cur = nxt;
    nxt = z4;
    if (ch + 1 < ch_end && lane < 32) nxt = *(const uint4*)(ubase + (size_t)(ch + 1) * 16 * NP);
    if (lane < 32) *(uint4*)(Us + ut * 16 + uh * 8) = cur;
    __syncthreads();
    bf16x8 Uop = bf16x8{0, 0, 0, 0, 0, 0, 0, 0};
    if (quad < 2) Uop = *(const bf16x8*)(Us + r16 * 16 + quad * 8);
    f32x4 bu[8];
#pragma unroll
    for (int nt = 0; nt < 8; ++nt) bu[nt] = MFMA16(Uop, Bop[nt], (f32x4{0.f, 0.f, 0.f, 0.f}));
    float Er[4], Ei[4];
#pragma unroll
    for (int i = 0; i < 4; ++i) {
      float xr = 0.f, xi = 0.f;
#pragma unroll
      for (int jj = 0; jj < 4; ++jj) {
        const float nr = Ar[0][i] * xr - Ai[0][i] * xi + bu[i][jj];
        const float ni = Ar[0][i] * xi + Ai[0][i] * xr + bu[4 + i][jj];
        xr = nr; xi = ni;
        bu[i][jj] = xr; bu[4 + i][jj] = xi;
      }
      Er[i] = xr; Ei[i] = xi;
    }
    float cr[4], ci[4];
#pragma unroll
    for (int i = 0; i < 4; ++i) { cr[i] = hr[i]; ci[i] = hi[i]; }
#pragma unroll
    for (int k = 0; k < 4; ++k) {
#pragma unroll
      for (int i = 0; i < 4; ++i) {
        const float er = __shfl(Er[i], r16 + 16 * k), ei = __shfl(Ei[i], r16 + 16 * k);
        const float nr = Ar[3][i] * hr[i] - Ai[3][i] * hi[i] + er;
        const float ni = Ar[3][i] * hi[i] + Ai[3][i] * hr[i] + ei;
        if (k * 4 < nvalid) { hr[i] = nr; hi[i] = ni; }
        if (k < quad) { cr[i] = nr; ci[i] = ni; }
      }
    }
    if (!light) {
#pragma unroll
      for (int i = 0; i < 4; ++i)
#pragma unroll
        for (int jj = 0; jj < 4; ++jj) {
          const float vr = bu[i][jj] + Ar[jj][i] * cr[i] - Ai[jj][i] * ci[i];
          const float vi = bu[4 + i][jj] + Ar[jj][i] * ci[i] + Ai[jj][i] * cr[i];
          Hs[(quad * 4 + jj) * 136 + i * 16 + r16] = f2bf(vr);
          Hs[(quad * 4 + jj) * 136 + 64 + i * 16 + r16] = f2bf(vi);
        }
      __syncthreads();
      f32x4 ya = f32x4{0.f, 0.f, 0.f, 0.f};
#pragma unroll
      for (int s = 0; s < 4; ++s) {
        const bf16x8 bh = *(const bf16x8*)(Hs + r16 * 136 + s * 32 + quad * 8);
        ya = MFMA16(Cop[s], bh, ya);
      }
      const uint2 uu = *(const uint2*)(Us + r16 * 16 + quad * 4);
      const float u0 = bf2f((u16)(uu.x & 0xffff)), u1 = bf2f((u16)(uu.x >> 16));
      const float u2 = bf2f((u16)(uu.y & 0xffff)), u3 = bf2f((u16)(uu.y >> 16));
      const float z0 = gelu_tanh(ya[0] + Dm[0] * u0), z1 = gelu_tanh(ya[1] + Dm[1] * u1);
      const float z2 = gelu_tanh(ya[2] + Dm[2] * u2), z3 = gelu_tanh(ya[3] + Dm[3] * u3);
      if (r16 < nvalid)
        *(uint2*)(p.zs5 + (size_t)(row0 + ch * 16 + r16) * ZLD + g * 16 + quad * 4) = make_uint2(pack2(z0, z1), pack2(z2, z3));
    }
    __syncthreads();
  }
  if (light) {
    if (quad == 0) {
      float* hl = p.hlocal + ((size_t)((seq * 32 + g) * 7 + seg)) * 128;
#pragma unroll
      for (int i = 0; i < 4; ++i) { hl[i * 16 + r16] = hr[i]; hl[64 + i * 16 + r16] = hi[i]; }
    }
  } else if (last_seg) {
    if (quad == 0) {
      float* o_r = p.out + (prompt ? p.o_s5r_p : p.o_s5r_s) + ((size_t)(l * NB + bidx) * 32 + g) * 64;
      float* o_i = p.out + (prompt ? p.o_s5i_p : p.o_s5i_s) + ((size_t)(l * NB + bidx) * 32 + g) * 64;
#pragma unroll
      for (int i = 0; i < 4; ++i) { o_r[i * 16 + r16] = hr[i]; o_i[i * 16 + r16] = hi[i]; }
    }
  }
}

__device__ void phase_mixers(const Params& p, int l, int pass, char* smem, int visit) {
  int* s_item = (int*)(smem + 65536);
  unsigned* cnt = p.counters + l * 64 + (pass - 1) * 32 + visit * 16;
  const int nseg = p.nseg;
  const int ns1 = nseg - 1;
  const int n_chain = (pass == 1) ? 96 * ns1 : 96 * nseg;
  const int n_s5 = (pass == 1) ? 64 * ns1 : 64 * nseg;
  const int n_items = n_chain + n_s5 + ((pass == 1) ? 128 * 20 : 0);
  for (;;) {
    if (tidq() == 0) *s_item = (int)atomicAdd(cnt, 1u);
    __syncthreads();
    const int item = *s_item;
    __syncthreads();
    if (item >= n_items) break;
    int mode, seq, sub, seg = 0;
    const int per = (pass == 1) ? ns1 : nseg;
    if (item < n_chain) {
      const int c = item / per; seg = item % per;
      const int kind = c >> 5, r = c & 31;
      seq = r >> 2; sub = r & 3;
      mode = (kind == 0) ? 1 : ((kind == 1) ? 2 : 0);
    } else if (item < n_chain + n_s5) {
      const int k = item - n_chain;
      const int c = k / per; seg = k % per;
      mode = 3; seq = c >> 3; sub = c & 7;
    } else {
      int k = item - n_chain - n_s5; int b = k / 20; sub = k % 20; seq = 8 + b;
      if (sub < 4) mode = 1;
      else if (sub < 8) { mode = 0; sub -= 4; }
      else if (sub < 12) { mode = 2; sub -= 8; }
      else { mode = 3; sub -= 12; }
    }
    const int ps = (seq >= 8) ? 2 : pass;
    if (mode == 0) { if (EN(2) || ONLY == 20) run_chain<0>(p, l, seq, sub, seg, ps, smem); }
    else if (mode == 1) { if (EN(2) || ONLY == 21) run_chain<1>(p, l, seq, sub, seg, ps, smem); }
    else if (mode == 2) { if (EN(2) || ONLY == 22) run_chain<2>(p, l, seq, sub, seg, ps, smem); }
    else { if (EN(2) || ONLY == 23) run_s5(p, l, seq, sub, seg, ps, smem); }
    __syncthreads();
  }
}

DI bool tile_at(int i, int T, int& t) {
  const int bpx = gridDim.x >> 3;
  t = ((blockIdx.x & 7) + 8 * i) * bpx + (blockIdx.x >> 3);
  return t < T;
}
DI void tile_mn(int t, int nN, int& m0, int& n0) {
  const int per = 8 * nN;
  const int grp = t / per, r = t - grp * per;
  m0 = (grp * 8 + (r & 7)) * 128;
  n0 = (r >> 3) * 128;
}

__device__ void run_phase(const Params& p, int ph, char* smem, int visit) {
  constexpr int NMT = MTOK / 128;
  if (ph == 0) {
    if (EN(9)) phase_convert(p, smem);
    if (EN(0)) phase_rownorm(p, true, nullptr, nullptr, p.in[8], p.hb);
    return;
  }
  if (ph == NPHASE - 1) {
    if (EN(10)) phase_rownorm(p, false, p.tbuf, p.in[11] + 1 * DM, nullptr, nullptr);
    return;
  }
  const int l = (ph <= 9) ? 0 : 1, s0_ = (ph <= 9) ? ph : ph - 10;
  const int s = (s0_ <= 2) ? s0_ : s0_ - 1;
  switch (s) {
    case 0:
      if (!EN(0)) break;
      phase_rownorm(p, false, p.tbuf, p.in[11] + (l - 1) * DM, p.in[8] + l * DM, p.hb);
      break;
    case 1: if (EN(1)) {
      constexpr int NN = NP / 128;
      gemm_stream<EPI_BF16>(p.hb, HLD, p.wt_in + (size_t)l * NIN * WLD1, WLD1, DM, NN, NMT * NN, p.pbuf, NP, nullptr, 0, smem);
    } break;
    case 2: if (EN(2) || (ONLY >= 20 && ONLY <= 23)) phase_mixers(p, l, (s0_ == 2) ? 1 : 2, smem, visit); break;
    case 3: if (EN(3)) {
      constexpr int NG = 32, NGLU = 4;
      {
        const int lane = tidq() & 63, w = tidq() >> 6;
        for (int row = blockIdx.x * 4 + w; row < MTOK; row += gridDim.x * 4) {
          const float4 sq = *(const float4*)(p.ssq + (size_t)row * 4);
          const float ms = (lane < 32) ? (sq.x + sq.y) : (sq.z + sq.w);
          const float r = rsqrtf(ms * (1.f / 256.f) + EPS);
          u16* ptr = p.obuf + (size_t)row * OLD + 512 + lane * 8;
          uint4 v = *(const uint4*)ptr;
          const float* gn = p.in[19] + l * 512 + lane * 8;
          unsigned vw[4] = {v.x, v.y, v.z, v.w};
          unsigned ow[4];
#pragma unroll
          for (int x = 0; x < 4; ++x)
            ow[x] = pack2(bf2f((u16)(vw[x] & 0xffff)) * r * gn[2 * x], bf2f((u16)(vw[x] >> 16)) * r * gn[2 * x + 1]);
          *(uint4*)ptr = make_uint4(ow[0], ow[1], ow[2], ow[3]);
        }
      }
      gemm_stream<EPI_SIG>(p.hb, HLD, p.wt_in + ((size_t)l * NIN + NP) * WLD1, WLD1, DM, NG, NMT * NG, p.pbuf, 4096, nullptr, 0, smem);
      gemm_stream<EPI_GLU>(p.zs5, ZLD, p.wt_glu + (size_t)l * 512 * WLD5, WLD5, 512, NGLU, NMT * NGLU,
                           p.obuf + 1536, OLD, p.zs5, ZLD, smem);
    } break;
    case 4:
      if (EN(4)) {
        int t, m0, n0;
        for (int i = 0; tile_at(i, NMT * 8, t); ++i) { tile_mn(t, 8, m0, n0); merge_tile(p, l, m0, n0, smem); }
      }
      break;
    case 5:
      if (EN(5)) {
        gemm_stream<EPI_F32>(p.hb, HLD, p.wt_out + (size_t)l * DM * WLD1, WLD1, DM, 8, NMT * 8, p.tbuf, DM, nullptr, 0, smem);
      }
      break;
    case 6:
      if (EN(6)) phase_rownorm(p, false, p.tbuf, p.in[9] + l * DM, p.in[10] + l * DM, p.hb);
      break;
    case 7:
      if (EN(7)) {
        gemm_stream<EPI_RELU2>(p.hb, HLD, p.wt_ff1 + (size_t)l * DFF * WLD1, WLD1, DM, 32, NMT * 32, p.pbuf, ULD, nullptr, 0, smem);
      }
      break;
    case 8:
      if (EN(8)) {
        gemm_stream<EPI_F32>(p.pbuf, ULD, p.wt_ff2 + (size_t)l * DM * WLD4, WLD4, DFF, 8, NMT * 8, p.tbuf, DM, nullptr, 0, smem);
      }
      break;
  }
}

#ifndef DUP_S
#define DUP_S -1
#endif
#define XB_TMO      128
#define XB_XCNT(j)  (256  + 64 * (j))
#define XB_XSUB(j)  (1280 + 64 * (j))
#define XB_XGEN(j)  (2304 + 64 * (j))
#define XB_TOP      3328
#define XB_TOPGEN   3392
#define XCD_BAR_WORDS 3456
#define XB_SPIN_CAP (1u << 22)
#define LAS __attribute__((address_space(3)))
DI unsigned xb_ld(unsigned* p)              { return __hip_atomic_load(p, __ATOMIC_RELAXED, __HIP_MEMORY_SCOPE_AGENT); }
DI unsigned xb_add(unsigned* p, unsigned v) { return __hip_atomic_fetch_add(p, v, __ATOMIC_RELAXED, __HIP_MEMORY_SCOPE_AGENT); }
DI unsigned xb_xcc_id() { return (unsigned)__builtin_amdgcn_s_getreg((3 << 11) | 20) & 0xFu; }
#define XB_SPIN(cond, bar) do { unsigned _sp = 0; while (cond) { __builtin_amdgcn_s_sleep(1); \
    if ((++_sp & 255u) == 0u) { if (xb_ld(&(bar)[XB_TMO])) break; if (_sp > XB_SPIN_CAP) { atomicAdd(&(bar)[XB_TMO], 1u); break; } } } } while (0)
struct XcdBarrier { unsigned* bar; unsigned x; volatile LAS unsigned* st; };
DI XcdBarrier xcd_barrier_post(unsigned* bar, volatile LAS unsigned* st) {
  XcdBarrier b; b.bar = bar; b.x = xb_xcc_id(); b.st = st;
  if (threadIdx.x == 0) (void)xb_add(&bar[XB_XCNT(b.x)], 1u);
  return b;
}
DI void xcd_barrier_complete(unsigned* bar, unsigned x, unsigned& nloc, unsigned& nx) {
  const unsigned G = gridDim.x * gridDim.y * gridDim.z;
  unsigned sum, cnt, mine, sp = 0u;
  for (;;) {
    sum = 0u; cnt = 0u; mine = 0u;
#pragma unroll
    for (unsigned j = 0; j < 16; ++j) { const unsigned c = xb_ld(&bar[XB_XCNT(j)]); sum += c; cnt += (c > 0u) ? 1u : 0u; mine = (j == x) ? c : mine; }
    if (sum == G) break;
    __builtin_amdgcn_s_sleep(1);
    if ((++sp & 255u) == 0u) { if (xb_ld(&bar[XB_TMO])) break; if (sp > XB_SPIN_CAP) { atomicAdd(&bar[XB_TMO], 1u); break; } }
  }
  nloc = mine > 0u ? mine : 1u; nx = cnt > 0u ? cnt : 1u;
}
DI void xcd_barrier(const XcdBarrier& b) {
  asm volatile("s_waitcnt vmcnt(0)" ::: "memory");
  __syncthreads();
  if (threadIdx.x == 0) {
    unsigned* bar = b.bar;
    __builtin_amdgcn_s_waitcnt(0);
    unsigned nloc = b.st[0], nx = b.st[1];
    if (nloc == 0u) { xcd_barrier_complete(bar, b.x, nloc, nx); b.st[0] = nloc; b.st[1] = nx; }
    const unsigned old = xb_add(&bar[XB_XSUB(b.x)], 1u);
    const unsigned gen = old / nloc;
    if (old + 1u == (gen + 1u) * nloc) {
      __builtin_amdgcn_fence(__ATOMIC_RELEASE, "agent");
      asm volatile("s_waitcnt vmcnt(0)" ::: "memory");
      const unsigned og = xb_add(&bar[XB_TOP], 1u);
      const unsigned tg = og / nx;
      if (og + 1u == (tg + 1u) * nx) xb_add(&bar[XB_TOPGEN], 1u);
      else XB_SPIN(xb_ld(&bar[XB_TOPGEN]) == tg, bar);
      __builtin_amdgcn_fence(__ATOMIC_ACQUIRE, "agent");
      xb_add(&bar[XB_XGEN(b.x)], 1u);
      asm volatile("s_waitcnt vmcnt(0)" ::: "memory");
    } else {
      XB_SPIN(xb_ld(&bar[XB_XGEN(b.x)]) == gen, bar);
      __builtin_amdgcn_fence(__ATOMIC_ACQUIRE, "agent");
      asm volatile("s_waitcnt vmcnt(0)" ::: "memory");
    }
  }
  __syncthreads();
}

__global__ void __launch_bounds__(256, 2) mega_kernel(Params p, int ph_lo, int ph_hi) {
  __shared__ __attribute__((aligned(16))) char smem[65536 + 32];
  volatile LAS unsigned* st = (volatile LAS unsigned*)(&smem[65536 + 16]);
  if (threadIdx.x == 0) { st[0] = 0u; st[1] = 0u; }
  __syncthreads();
  const XcdBarrier xb = xcd_barrier_post(p.bar, st);
  for (int ph = ph_lo; ph < ph_hi; ++ph) {
    if (ph > ph_lo) xcd_barrier(xb);
    if (ph_hi < 0) cg::this_grid().sync();
    const int reps = (DUP_S >= 0 && ph == DUP_S) ? 2 : 1;
    for (int r = 0; r < reps; ++r) {
      if (r) xcd_barrier(xb);
#ifdef VAR_NOSTORE
      if (tidq() == 0) *(volatile int*)(smem + 65536 + 8) = r;
      __syncthreads();
#endif
      run_phase(p, ph, smem, r);
    }
  }
}

extern "C" void kernel_launch(void* const* d_in, const int* in_sizes, int n_in, void* d_out, int out_size,
                              void* d_ws, size_t ws_size, hipStream_t stream) {
  Params p{};
  for (int i = 0; i < 35; ++i) p.in[i] = (const float*)d_in[i];
  p.out = (float*)d_out;
  char* ws = (char*)d_ws;
  size_t off = 0;
  auto take = [&](size_t bytes) { char* r = ws + off; off += (bytes + 255) & ~(size_t)255; return r; };
  p.wt_in  = (u16*)take((size_t)2 * NIN * WLD1 * 2);
  p.wt_ff1 = (u16*)take((size_t)2 * DFF * WLD1 * 2);
  p.wt_ff2 = (u16*)take((size_t)2 * DM * WLD4 * 2);
  p.wt_br  = (u16*)take((size_t)2 * 4 * DM * WLD5 * 2);
  p.wt_out = (u16*)take((size_t)2 * DM * WLD1 * 2);
  p.wt_glu = (u16*)take((size_t)2 * 512 * WLD5 * 2);
  p.hb     = (u16*)take((size_t)MTOK * HLD * 2);
  p.pbuf   = (u16*)take((size_t)MTOK * NP * 2);
  p.obuf   = (u16*)take((size_t)MTOK * OLD * 2);
  p.zs5    = (u16*)take((size_t)MTOK * ZLD * 2);
  p.counters = (unsigned*)take(4096);
  p.bar = (unsigned*)take(16384);
  p.ssq = (float*)take((size_t)MTOK * 4 * 4);
  p.segdec = (float*)take((size_t)96 * 7 * 128 * 4);
  p.hlocal = (float*)take((size_t)8 * 32 * 7 * 128 * 4);
  p.nseg = 8;
  if (off + (size_t)96 * 7 * 32768 > ws_size) p.nseg = 4;
  p.cps = 128 / p.nseg;
  p.slocal = (u16*)take((size_t)96 * (p.nseg - 1) * 32768);
  p.tbuf = (float*)(p.pbuf + (size_t)MTOK * ULD);
  if (off > ws_size) { fprintf(stderr, "workspace too small: need %zu have %zu\n", off, ws_size); return; }
  size_t o = (size_t)MTOK * DM;
  p.o_ret_p = o;  o += (size_t)2 * 8 * 65536;
  p.o_ret_s = o;  o += (size_t)2 * 128 * 65536;
  p.o_ssd_p = o;  o += (size_t)2 * 8 * 65536;
  p.o_ssd_s = o;  o += (size_t)2 * 128 * 65536;
  p.o_conv_p = o; o += (size_t)2 * 8 * 3 * 1024;
  p.o_conv_s = o; o += (size_t)2 * 128 * 3 * 1024;
  p.o_hg_p = o;   o += (size_t)2 * 8 * 65536;
  p.o_hg_s = o;   o += (size_t)2 * 128 * 65536;
  p.o_s5r_p = o;  o += (size_t)2 * 8 * 2048;
  p.o_s5r_s = o;  o += (size_t)2 * 128 * 2048;
  p.o_s5i_p = o;  o += (size_t)2 * 8 * 2048;
  p.o_s5i_s = o;  o += (size_t)2 * 128 * 2048;

  static int grid_blocks = 0;
  if (!grid_blocks) {
    int dev = 0, cus = 0, per_cu = 0;
    hipGetDevice(&dev);
    hipDeviceGetAttribute(&cus, hipDeviceAttributeMultiprocessorCount, dev);
    hipOccupancyMaxActiveBlocksPerMultiprocessor(&per_cu, mega_kernel, 256, 0);
    if (per_cu > 2) per_cu = 2;
    if (per_cu < 1) per_cu = 1;
    grid_blocks = cus * per_cu;
  }
  hipMemsetAsync(p.counters, 0, 4096 + 16384, stream);
#if SINGLE_LAUNCH
  int lo = 0, hi = NPHASE;
  void* args[] = {&p, &lo, &hi};
  hipError_t e = hipLaunchCooperativeKernel((void*)mega_kernel, dim3(grid_blocks), dim3(256), args, 0, stream);
  if (e != hipSuccess) fprintf(stderr, "cooperative launch failed: %s (grid %d)\n", hipGetErrorString(e), grid_blocks);
#else
  for (int ph = 0; ph < NPHASE; ++ph)
    hipLaunchKernelGGL(mega_kernel, dim3(grid_blocks), dim3(256), 0, stream, p, ph, ph + 1);
#endif
}
```

```cpp
#include <hip/hip_runtime.h>
#include <hip/hip_cooperative_groups.h>
#include <cstdio>
#include <cstdint>
namespace cg = cooperative_groups;

#ifndef SINGLE_LAUNCH
#define SINGLE_LAUNCH 1
#endif
#ifndef ONLY
#define ONLY -1
#endif
#define EN(k) (ONLY < 0 || ONLY == (k))

typedef unsigned short u16;
using bf16x8 = __attribute__((ext_vector_type(8))) short;
using bf16x4 = __attribute__((ext_vector_type(4))) short;
using f32x4  = __attribute__((ext_vector_type(4))) float;
typedef unsigned u32x4 __attribute__((ext_vector_type(4)));
#define DI __device__ __forceinline__
#define MFMA16(a, b, c) __builtin_amdgcn_mfma_f32_16x16x32_bf16((a), (b), (c), 0, 0, 0)

constexpr int MTOK = 17408;
constexpr int MPR  = 16384;
constexpr int DM   = 1024;
constexpr int NP   = 6272;
constexpr int NIN  = 10368;
constexpr int DFF  = 4096;
constexpr int INC  = 10248;
constexpr int C_RQ = 0, C_RK = 512, C_RV = 1024, C_RG = 1536, C_SZ = 2048, C_SXBC = 2560;
constexpr int C_HQ = 3584, C_HF = 4096, C_HI = 4608, C_HG = 5120, C_SU = 5632, C_SDT = 6144;
constexpr float EPS = 1e-6f;
constexpr int HLD = 1024, WLD1 = 1024, ULD = 4096, WLD4 = 4096, OLD = 2048, ZLD = 512, WLD5 = 512;
constexpr int NITEMS = 160 + 128 * 20;
constexpr int NPHASE = 21;

struct Params {
  const float* in[35];
  float* out;
  u16 *wt_in, *wt_ff1, *wt_ff2, *wt_br, *wt_out, *wt_glu;
  u16 *hb, *pbuf, *obuf, *zs5;
  float* tbuf;
  unsigned* counters;
  unsigned* bar;
  float* ssq;
  u16* slocal;
  float* segdec;
  float* hlocal;
  int nseg, cps;
  size_t o_ret_p, o_ret_s, o_ssd_p, o_ssd_s, o_conv_p, o_conv_s, o_hg_p, o_hg_s, o_s5r_p, o_s5r_s, o_s5i_p, o_s5i_s;
};

DI int tidq() { int t = threadIdx.x; asm volatile("" : "+v"(t)); return t; }
typedef __bf16 bf16v2 __attribute__((ext_vector_type(2)));
typedef float f32v2 __attribute__((ext_vector_type(2)));
DI unsigned pack2(float a, float b) { f32v2 v = {a, b}; return __builtin_bit_cast(unsigned, __builtin_convertvector(v, bf16v2)); }
DI u16 f2bf(float f) { return (u16)(pack2(f, 0.f) & 0xffffu); }
DI float bf2f(u16 h) { return __uint_as_float(((unsigned)h) << 16); }
DI float sigmoidf_(float x) { return 1.f / (1.f + __expf(-x)); }
DI float siluf_(float x) { return x / (1.f + __expf(-x)); }
DI float softplusf_(float x) { return x > 20.f ? x : log1pf(__expf(x)); }
DI float gelu_tanh(float x) {
  float u = 0.7978845608028654f * (x + 0.044715f * x * x * x);
  float e = __expf(2.f * u);
  float th = 1.f - 2.f / (e + 1.f);
  return 0.5f * x * (1.f + th);
}
DI float wave_sum(float v) {
#pragma unroll
  for (int m = 32; m >= 1; m >>= 1) v += __shfl_xor(v, m);
  return v;
}
DI float sum16(float v) {
#pragma unroll
  for (int m = 8; m >= 1; m >>= 1) v += __shfl_xor(v, m);
  return v;
}
DI void sincos_red(float a, float& s, float& c) {
  float n = rintf(a * 0.15915494309189535f);
  float r = fmaf(-n, 6.28125f, a);
  r = fmaf(-n, 1.9353071795864769e-3f, r);
  s = __sinf(r); c = __cosf(r);
}

DI int map_win(int my) {
  if (my < 3584) return my;
  if (my < 6144) return my + 8;
  if (my < 6152) return my - 6144 + 3584;
  if (my < 6272) return -1;
  return my - 120;
}
DI void transpose_tile(const float* __restrict__ src, int src_ld, u16* __restrict__ dst, int dst_ld,
                       int k0, int n0, int mapmode, char* smem) {
  float* tile = (float*)smem;
  const int tid = tidq();
  {
    const int n = tid & 63;
    int sc = n0 + n;
    if (mapmode) sc = map_win(sc);
    const float* sp = src + (size_t)(k0 + (tid >> 6)) * src_ld + (sc >= 0 ? sc : 0);
    float v[32];
#pragma unroll
    for (int i = 0; i < 32; ++i) v[i] = sp[(size_t)(4 * i) * src_ld];
#pragma unroll
    for (int i = 0; i < 32; ++i) tile[n * 129 + (tid >> 6) + 4 * i] = (sc >= 0) ? v[i] : 0.f;
  }
  __syncthreads();
  {
    const int n = tid >> 2, kc = (tid & 3) * 32;
    unsigned pk[16];
#pragma unroll
    for (int x = 0; x < 16; ++x) pk[x] = pack2(tile[n * 129 + kc + 2 * x], tile[n * 129 + kc + 2 * x + 1]);
    uint4* d = (uint4*)(dst + (size_t)(n0 + n) * dst_ld + k0 + kc);
    d[0] = make_uint4(pk[0], pk[1], pk[2], pk[3]);
    d[1] = make_uint4(pk[4], pk[5], pk[6], pk[7]);
    d[2] = make_uint4(pk[8], pk[9], pk[10], pk[11]);
    d[3] = make_uint4(pk[12], pk[13], pk[14], pk[15]);
  }
  __syncthreads();
}

__device__ void phase_convert(const Params& p, char* smem) {
  constexpr int PER = 2736;
  for (int t = blockIdx.x; t < 2 * PER; t += gridDim.x) {
    int l = t / PER, r = t % PER;
    if (r < 1296) {
      int nt = r / 8, kt = r % 8;
      transpose_tile(p.in[12] + (size_t)l * DM * INC, INC, p.wt_in + (size_t)l * NIN * WLD1, WLD1, kt * 128, nt * 64, 1, smem);
    } else if (r < 1808) {
      r -= 1296; int nt = r / 8, kt = r % 8;
      transpose_tile(p.in[33] + (size_t)l * DM * DFF, DFF, p.wt_ff1 + (size_t)l * DFF * WLD1, WLD1, kt * 128, nt * 64, 0, smem);
    } else if (r < 2320) {
      r -= 1808; int nt = r / 32, kt = r % 32;
      transpose_tile(p.in[34] + (size_t)l * DFF * DM, DM, p.wt_ff2 + (size_t)l * DM * WLD4, WLD4, kt * 128, nt * 64, 0, smem);
    } else if (r < 2448) {
      r -= 2320; int nt = r / 8, kt = r % 8;
      transpose_tile(p.in[32] + (size_t)l * DM * DM, DM, p.wt_out + (size_t)l * DM * WLD1, WLD1, kt * 128, nt * 64, 0, smem);
    } else if (r < 2704) {
      r -= 2448; int b = r / 64; r %= 64; int nt = r / 4, kt = r % 4;
      transpose_tile(p.in[31] + (size_t)(l * 4 + b) * 512 * DM, DM, p.wt_br + (size_t)(l * 4 + b) * DM * WLD5, WLD5, kt * 128, nt * 64, 0, smem);
    } else {
      r -= 2704; int nt = r / 4, kt = r % 4;
      transpose_tile(p.in[30] + (size_t)l * 512 * 512, 512, p.wt_glu + (size_t)l * 512 * WLD5, WLD5, kt * 128, nt * 64, 0, smem);
    }
  }
}

__device__ void phase_rownorm(const Params& p, bool from_input, const float* __restrict__ t, const float* __restrict__ gpost,
                              const float* __restrict__ gpre, u16* __restrict__ hout) {
  const int lane = tidq() & 63, w = tidq() >> 6;
  float* xbuf = p.out;
  for (int row = blockIdx.x * 4 + w; row < MTOK; row += gridDim.x * 4) {
    const float* xin = from_input ? (row < MPR ? p.in[0] + (size_t)row * DM : p.in[1] + (size_t)(row - MPR) * DM)
                                  : xbuf + (size_t)row * DM;
    float4 x[4];
#pragma unroll
    for (int k = 0; k < 4; ++k) x[k] = *(const float4*)(xin + lane * 4 + 256 * k);
    if (t) {
      float4 tv[4];
      float ss = 0.f;
#pragma unroll
      for (int k = 0; k < 4; ++k) {
        if (gridDim.x == 512 && row >= MPR) {
          const float* pp = (const float*)p.obuf + (size_t)(row - MPR) * DM + lane * 4 + 256 * k;
          float4 a = *(const float4*)pp;
#pragma unroll
          for (int sl = 1; sl < 8; ++sl) {
            const float4 b = *(const float4*)(pp + (size_t)sl * 1024 * 1024);
            a.x += b.x; a.y += b.y; a.z += b.z; a.w += b.w;
          }
          tv[k] = a;
        } else {
          tv[k] = *(const float4*)(t + (size_t)row * DM + lane * 4 + 256 * k);
        }
        ss += tv[k].x * tv[k].x + tv[k].y * tv[k].y + tv[k].z * tv[k].z + tv[k].w * tv[k].w;
      }
      ss = wave_sum(ss);
      float r = rsqrtf(ss * (1.f / DM) + EPS);
#pragma unroll
      for (int k = 0; k < 4; ++k) {
        float4 g = *(const float4*)(gpost + lane * 4 + 256 * k);
        x[k].x += tv[k].x * r * g.x; x[k].y += tv[k].y * r * g.y; x[k].z += tv[k].z * r * g.z; x[k].w += tv[k].w * r * g.w;
      }
    }
#pragma unroll
    for (int k = 0; k < 4; ++k) *(float4*)(xbuf + (size_t)row * DM + lane * 4 + 256 * k) = x[k];
    if (hout) {
      float ss = 0.f;
#pragma unroll
      for (int k = 0; k < 4; ++k) ss += x[k].x * x[k].x + x[k].y * x[k].y + x[k].z * x[k].z + x[k].w * x[k].w;
      ss = wave_sum(ss);
      float r = rsqrtf(ss * (1.f / DM) + EPS);
#pragma unroll
      for (int k = 0; k < 4; ++k) {
        float4 g = *(const float4*)(gpre + lane * 4 + 256 * k);
        uint2 o;
        o.x = pack2(x[k].x * r * g.x, x[k].y * r * g.y);
        o.y = pack2(x[k].z * r * g.z, x[k].w * r * g.w);
        *(uint2*)(hout + (size_t)row * HLD + lane * 4 + 256 * k) = o;
      }
    }
  }
}

DI int swz(int r, int c) { return r * 128 + ((c ^ ((r >> 1) & 7)) << 4); }

#define GEMM_COMPUTE(AS_) do { const char* as_ = (AS_); const char* bs_ = as_ + 16384; \
  _Pragma("unroll") for (int s_ = 0; s_ < 2; ++s_) { \
    bf16x8 af_[4], bfr_[4]; \
    _Pragma("unroll") for (int i_ = 0; i_ < 4; ++i_) af_[i_] = *(const bf16x8*)(as_ + swz(wm * 64 + i_ * 16 + r16, s_ * 4 + quad)); \
    _Pragma("unroll") for (int j_ = 0; j_ < 4; ++j_) bfr_[j_] = *(const bf16x8*)(bs_ + swz(wn * 64 + j_ * 16 + r16, s_ * 4 + quad)); \
    _Pragma("unroll") for (int i_ = 0; i_ < 4; ++i_) \
      _Pragma("unroll") for (int j_ = 0; j_ < 4; ++j_) acc[i_][j_] = MFMA16(bfr_[j_], af_[i_], acc[i_][j_]); \
  } } while (0)

struct Stage { u32x4 a0, a1, a2, a3, b0, b1, b2, b3; };
DI void gload(Stage& s, const u16* ag, const u16* bg, int lda, int ldb, int kt) {
  s.a0 = *(const u32x4*)(ag + (size_t)0 * 32 * lda + kt * 64);
  s.a1 = *(const u32x4*)(ag + (size_t)1 * 32 * lda + kt * 64);
  s.a2 = *(const u32x4*)(ag + (size_t)2 * 32 * lda + kt * 64);
  s.a3 = *(const u32x4*)(ag + (size_t)3 * 32 * lda + kt * 64);
  s.b0 = *(const u32x4*)(bg + (size_t)0 * 32 * ldb + kt * 64);
  s.b1 = *(const u32x4*)(bg + (size_t)1 * 32 * ldb + kt * 64);
  s.b2 = *(const u32x4*)(bg + (size_t)2 * 32 * ldb + kt * 64);
  s.b3 = *(const u32x4*)(bg + (size_t)3 * 32 * ldb + kt * 64);
}
DI void lwrite(const Stage& s, char* d, int lr, int lc) {
  *(u32x4*)(d + swz(lr, lc)) = s.a0;
  *(u32x4*)(d + swz(lr + 32, lc)) = s.a1;
  *(u32x4*)(d + swz(lr + 64, lc)) = s.a2;
  *(u32x4*)(d + swz(lr + 96, lc)) = s.a3;
  *(u32x4*)(d + 16384 + swz(lr, lc)) = s.b0;
  *(u32x4*)(d + 16384 + swz(lr + 32, lc)) = s.b1;
  *(u32x4*)(d + 16384 + swz(lr + 64, lc)) = s.b2;
  *(u32x4*)(d + 16384 + swz(lr + 96, lc)) = s.b3;
}

template <bool DEEP>
DI void gemm_kloop(f32x4 (&acc)[4][4], const u16* __restrict__ A, int lda, const u16* __restrict__ Bt, int ldb,
                   int K, int m0, int n0, char* smem) {
  const int tid = tidq(), lane = tid & 63, w = tid >> 6, wm = w >> 1, wn = w & 1, r16 = lane & 15, quad = lane >> 4;
  const int lr = tid >> 3, lc = tid & 7;
  const u16* ag = A + (size_t)(m0 + lr) * lda + lc * 8;
  const u16* bg = Bt + (size_t)(n0 + lr) * ldb + lc * 8;
  const int nk = K >> 6;
  Stage s0;
  gload(s0, ag, bg, lda, ldb, 0);
  if (DEEP) {
    Stage s1;
    gload(s1, ag, bg, lda, ldb, 1);
    lwrite(s0, smem, lr, lc);
    __syncthreads();
    for (int kt = 0; kt < nk; kt += 2) {
      if (kt + 2 < nk) gload(s0, ag, bg, lda, ldb, kt + 2);
      GEMM_COMPUTE(smem);
      lwrite(s1, smem + 32768, lr, lc);
      __syncthreads();
      if (kt + 3 < nk) gload(s1, ag, bg, lda, ldb, kt + 3);
      GEMM_COMPUTE(smem + 32768);
      if (kt + 2 < nk) lwrite(s0, smem, lr, lc);
      __syncthreads();
    }
  } else {
    lwrite(s0, smem, lr, lc);
    __syncthreads();
    for (int kt = 0; kt < nk; ++kt) {
      const bool more = (kt + 1 < nk);
      if (more) gload(s0, ag, bg, lda, ldb, kt + 1);
      GEMM_COMPUTE(smem + (kt & 1) * 32768);
      if (more) lwrite(s0, smem + ((kt + 1) & 1) * 32768, lr, lc);
      __syncthreads();
    }
  }
}

DI void zero_acc(f32x4 (&acc)[4][4]) {
#pragma unroll
  for (int i = 0; i < 4; ++i)
#pragma unroll
    for (int j = 0; j < 4; ++j) acc[i][j] = f32x4{0.f, 0.f, 0.f, 0.f};
}

enum { EPI_BF16 = 0, EPI_SIG = 1, EPI_RELU2 = 2, EPI_F32 = 3, EPI_GLU = 4 };

template <int EPI>
DI void gemm_epilogue(f32x4 (&acc)[4][4], int m0, int n0, void* outp, int ldc, const u16* aux, int ldaux) {
  const int lane = tidq() & 63, w = tidq() >> 6, wm = w >> 1, wn = w & 1, r16 = lane & 15, quad = lane >> 4;
#pragma unroll
  for (int i = 0; i < 4; ++i) {
    const int m = m0 + wm * 64 + i * 16 + r16;
#pragma unroll
    for (int j = 0; j < 4; ++j) {
      const int n = n0 + wn * 64 + j * 16 + quad * 4;
      f32x4 v = acc[i][j];
      if (EPI == EPI_F32) {
        *(float4*)((float*)outp + (size_t)m * ldc + n) = make_float4(v[0], v[1], v[2], v[3]);
      } else {
        if (EPI == EPI_SIG) {
#pragma unroll
          for (int x = 0; x < 4; ++x) v[x] = sigmoidf_(v[x]);
        } else if (EPI == EPI_RELU2) {
#pragma unroll
          for (int x = 0; x < 4; ++x) { float r = fmaxf(v[x], 0.f); v[x] = r * r; }
        } else if (EPI == EPI_GLU) {
          uint2 zz = *(const uint2*)(aux + (size_t)m * ldaux + n);
          v[0] = bf2f((u16)(zz.x & 0xffff)) * sigmoidf_(v[0]);
          v[1] = bf2f((u16)(zz.x >> 16)) * sigmoidf_(v[1]);
          v[2] = bf2f((u16)(zz.y & 0xffff)) * sigmoidf_(v[2]);
          v[3] = bf2f((u16)(zz.y >> 16)) * sigmoidf_(v[3]);
        }
        uint2 o; o.x = pack2(v[0], v[1]); o.y = pack2(v[2], v[3]);
        *(uint2*)((u16*)outp + (size_t)m * ldc + n) = o;
      }
      acc[i][j] = f32x4{0.f, 0.f, 0.f, 0.f};
    }
  }
}

DI bool tile_at(int i, int T, int& t);
DI void tile_mn(int t, int nN, int& m0, int& n0);

template <int EPI>
DI void gemm_stream(const u16* __restrict__ A, int lda, const u16* __restrict__ Bt, int ldb, int K, int nN, int T,
                    void* outp, int ldc, const u16* aux, int ldaux, char* smem) {
  const int tid = tidq(), lane = tid & 63, w = tid >> 6, wm = w >> 1, wn = w & 1, r16 = lane & 15, quad = lane >> 4;
  const int lr = tid >> 3, lc = tid & 7;
  asm volatile("" : "+s"(lda), "+s"(ldb), "+s"(K));
  const int nk = K >> 6;
  int t, m0, n0, m1 = 0, n1 = 0;
  if (!tile_at(0, T, t)) return;
  tile_mn(t, nN, m0, n0);
  const size_t aoff = (size_t)lr * lda + lc * 8, boff = (size_t)lr * ldb + lc * 8;
  const u16* ag = A + (size_t)m0 * lda + aoff;
  const u16* bg = Bt + (size_t)n0 * ldb + boff;
  f32x4 acc[4][4];
  zero_acc(acc);
  Stage s0, s1;
  gload(s0, ag, bg, lda, ldb, 0);
  gload(s1, ag, bg, lda, ldb, 1);
  lwrite(s0, smem, lr, lc);
  __syncthreads();
  for (int i = 0;; ++i) {
    const bool has_next = tile_at(i + 1, T, t);
    if (has_next) tile_mn(t, nN, m1, n1);
    const u16* agn = A + (size_t)m1 * lda + aoff;
    const u16* bgn = Bt + (size_t)n1 * ldb + boff;
    for (int kt = 0; kt < nk; kt += 2) {
      if (kt + 2 < nk) gload(s0, ag, bg, lda, ldb, kt + 2);
      else if (has_next) gload(s0, agn, bgn, lda, ldb, 0);
      GEMM_COMPUTE(smem);
      lwrite(s1, smem + 32768, lr, lc);
      __syncthreads();
      if (kt + 2 < nk) gload(s1, ag, bg, lda, ldb, kt + 3);
      else if (has_next) gload(s1, agn, bgn, lda, ldb, 1);
      GEMM_COMPUTE(smem + 32768);
      if (kt + 2 < nk || has_next) lwrite(s0, smem, lr, lc);
      __syncthreads();
    }
    gemm_epilogue<EPI>(acc, m0, n0, outp, ldc, aux, ldaux);
    if (!has_next) break;
    m0 = m1; n0 = n1; ag = agn; bg = bgn;
  }
}

DI void gemm_stream_split(const u16* __restrict__ A, int lda, const u16* __restrict__ Bt, int ldb, int K,
                          float* outp, float* part, char* smem) {
  const int tid = tidq(), lane = tid & 63, w = tid >> 6, wm = w >> 1, wn = w & 1, r16 = lane & 15, quad = lane >> 4;
  const int lr = tid >> 3, lc = tid & 7;
  asm volatile("" : "+s"(lda), "+s"(ldb), "+s"(K));
  const int nk = K >> 6, nks = nk >> 3;
  const size_t aoff = (size_t)lr * lda + lc * 8, boff = (size_t)lr * ldb + lc * 8;
  const int slice = blockIdx.x & 7, tl = blockIdx.x >> 3;
  int t, m0, n0, m1 = 0, n1 = 0;
  tile_at(0, 1024, t);
  tile_mn(t, 8, m0, n0);
  const u16* ag = A + (size_t)m0 * lda + aoff;
  const u16* bg = Bt + (size_t)n0 * ldb + boff;
  int nku = nk;
  f32x4 acc[4][4];
  zero_acc(acc);
  Stage s0, s1;
  gload(s0, ag, bg, lda, ldb, 0);
  gload(s1, ag, bg, lda, ldb, 1);
  lwrite(s0, smem, lr, lc);
  __syncthreads();
  for (int u = 0; u < 3; ++u) {
    const bool has_next = (u < 2);
    int nkn = nk;
    const u16* agn = ag;
    const u16* bgn = bg;
    if (u == 0) {
      tile_at(1, 1024, t);
      tile_mn(t, 8, m1, n1);
      agn = A + (size_t)m1 * lda + aoff;
      bgn = Bt + (size_t)n1 * ldb + boff;
    } else if (u == 1) {
      m1 = MPR + (tl >> 3) * 128; n1 = (tl & 7) * 128;
      agn = A + (size_t)m1 * lda + aoff + (size_t)slice * nks * 64;
      bgn = Bt + (size_t)n1 * ldb + boff + (size_t)slice * nks * 64;
      nkn = nks;
    }
    for (int kt = 0; kt < nku; kt += 2) {
      if (kt + 2 < nku) gload(s0, ag, bg, lda, ldb, kt + 2);
      else if (has_next) gload(s0, agn, bgn, lda, ldb, 0);
      GEMM_COMPUTE(smem);
      lwrite(s1, smem + 32768, lr, lc);
      __syncthreads();
      if (kt + 2 < nku) gload(s1, ag, bg, lda, ldb, kt + 3);
      else if (has_next) gload(s1, agn, bgn, lda, ldb, 1);
      GEMM_COMPUTE(smem + 32768);
      if (kt + 2 < nku || has_next) lwrite(s0, smem, lr, lc);
      __syncthreads();
    }
    if (u < 2) gemm_epilogue<EPI_F32>(acc, m0, n0, outp, DM, nullptr, 0);
    else gemm_epilogue<EPI_F32>(acc, m0 - MPR, n0, part + (size_t)slice * 1024 * 1024, DM, nullptr, 0);
    m0 = m1; n0 = n1; ag = agn; bg = bgn; nku = nkn;
  }
}

DI void merge_tile(const Params& p, int l, int m0, int n0, char* smem) {
  f32x4 macc[4][4];
  zero_acc(macc);
  const int lane = tidq() & 63, w = tidq() >> 6, wm = w >> 1, wn = w & 1, r16 = lane & 15, quad = lane >> 4;
  const u16* gates = p.pbuf;
  for (int b = 0; b < 4; ++b) {
    f32x4 acc[4][4];
    zero_acc(acc);
    gemm_kloop<false>(acc, p.obuf + b * 512, OLD, p.wt_br + (size_t)(l * 4 + b) * DM * WLD5, WLD5, 512, m0, n0, smem);
#pragma unroll
    for (int i = 0; i < 4; ++i) {
      const int m = m0 + wm * 64 + i * 16 + r16;
#pragma unroll
      for (int j = 0; j < 4; ++j) {
        const int n = n0 + wn * 64 + j * 16 + quad * 4;
        uint2 gg = *(const uint2*)(gates + (size_t)m * 4096 + b * 1024 + n);
        macc[i][j][0] += bf2f((u16)(gg.x & 0xffff)) * acc[i][j][0];
        macc[i][j][1] += bf2f((u16)(gg.x >> 16)) * acc[i][j][1];
        macc[i][j][2] += bf2f((u16)(gg.y & 0xffff)) * acc[i][j][2];
        macc[i][j][3] += bf2f((u16)(gg.y >> 16)) * acc[i][j][3];
      }
    }
  }
#pragma unroll
  for (int i = 0; i < 4; ++i) {
    const int m = m0 + wm * 64 + i * 16 + r16;
#pragma unroll
    for (int j = 0; j < 4; ++j) {
      const int n = n0 + wn * 64 + j * 16 + quad * 4;
      uint2 o; o.x = pack2(macc[i][j][0], macc[i][j][1]); o.y = pack2(macc[i][j][2], macc[i][j][3]);
      *(uint2*)(p.hb + (size_t)m * HLD + n) = o;
    }
  }
}

constexpr int QS = 136;
constexpr int TS = 20;
constexpr int OFS = 260;

template <int MODE>
__device__ void run_chain(const Params& p, int l, int seq, int sub, int seg, int pass, char* smem) {
  constexpr int NE = 2;
  const int tid = tidq(), lane = tid & 63, w = tid >> 6, r16 = lane & 15, quad = lane >> 4;
  const bool prompt = seq < 8;
  const int bidx = prompt ? seq : seq - 8;
  const int NB = prompt ? 8 : 128;
  const int L = prompt ? 2048 : 8;
  const int row0 = prompt ? seq * 2048 : MPR + (seq - 8) * 8;
  const int pos0 = prompt ? 0 : 16384;
  const int cps = p.cps;
  const int ch_begin = prompt ? seg * cps : 0;
  const int ch_end = prompt ? ch_begin + cps : 1;
  const bool light = prompt && (pass == 1);
  const bool last_seg = !prompt || (seg == p.nseg - 1);
  const int cid = seq * 12 + MODE * 4 + sub;

  u16* Qa = (u16*)smem;
  u16* Ka = (u16*)(smem + 4352);
  u16* KuT = (u16*)(smem + 8704);
  u16* VaT = (u16*)(smem + 13824);
  u16* VuT = (MODE == 1) ? (u16*)(smem + 18944) : VaT;
  float* Of = (float*)(smem + 24064);
  u16* Raw = (u16*)(smem + 40704);
  u16* Xc = (u16*)(smem + 53248);
  float* tot = (float*)(smem + 57344);
  float* cdec = (float*)(smem + 58368);
  float* dtl = (float*)(smem + 58624);
  float* rsc = (float*)(smem + 58880);
  float* clast = (float*)(smem + 59392);
  float* segacc = (float*)(smem + 59408);

  const float* sin_ = nullptr;
  float* sout = nullptr;
  if (MODE == 0) {
    if (!prompt) sin_ = p.in[2] + (((size_t)l * 128 + bidx) * 4 + sub) * 16384;
    sout = p.out + (prompt ? p.o_ret_p : p.o_ret_s) + (((size_t)l * NB + bidx) * 4 + sub) * 16384;
  } else if (MODE == 2) {
    if (!prompt) sin_ = p.in[5] + (((size_t)l * 128 + bidx) * 4 + sub) * 16384;
    sout = p.out + (prompt ? p.o_hg_p : p.o_hg_s) + (((size_t)l * NB + bidx) * 4 + sub) * 16384;
  } else {
    if (!prompt) sin_ = p.in[3] + (((size_t)l * 128 + bidx) * 8 + sub * 2 + (w >> 1)) * 8192;
    sout = p.out + (prompt ? p.o_ssd_p : p.o_ssd_s) + (((size_t)l * NB + bidx) * 8 + sub * 2 + (w >> 1)) * 8192;
  }

  float lg = 0.f;
  if (MODE == 0) lg = log1pf(-exp2f(-5.f - (float)sub));

  int sbase = (MODE == 1) ? (((w & 1) * 32 + r16) * 128 + quad * 4) : (quad * 512 + w * 32 + r16);
  asm volatile("" : "+v"(sbase));
  f32x4 S[8][NE];
#pragma unroll
  for (int t = 0; t < 8; ++t)
#pragma unroll
    for (int u = 0; u < NE; ++u) {
      if (sin_) {
        if (MODE == 1) {
          S[t][u] = *(const f32x4*)(sin_ + sbase + u * 2048 + t * 16);
        } else {
#pragma unroll
          for (int jj = 0; jj < 4; ++jj) S[t][u][jj] = sin_[sbase + t * 2048 + jj * 128 + u * 16];
        }
      } else {
        S[t][u] = f32x4{0.f, 0.f, 0.f, 0.f};
      }
    }
  if (prompt && pass == 2) {
    for (int r = 0; r < seg; ++r) {
      const uint2* sl = (const uint2*)(p.slocal + (size_t)(cid * (p.nseg - 1) + r) * 16384) + tid;
      const float* sd = p.segdec + (size_t)(cid * 7 + r) * 128;
      float dsc = 1.f;
      if (MODE == 0) dsc = __expf(lg * (float)(16 * cps));
      if (MODE == 1) dsc = __expf(sd[w >> 1]);
#pragma unroll
      for (int t = 0; t < 8; ++t) {
        f32x4 dv = f32x4{dsc, dsc, dsc, dsc};
        if (MODE == 2) {
          f32x4 lv = *(const f32x4*)(sd + t * 16 + quad * 4);
          dv = f32x4{__expf(lv[0]), __expf(lv[1]), __expf(lv[2]), __expf(lv[3])};
        }
#pragma unroll
        for (int u = 0; u < NE; ++u) {
          uint2 pk = sl[(t * NE + u) * 256];
          S[t][u][0] = S[t][u][0] * dv[0] + bf2f((u16)(pk.x & 0xffff));
          S[t][u][1] = S[t][u][1] * dv[1] + bf2f((u16)(pk.x >> 16));
          S[t][u][2] = S[t][u][2] * dv[2] + bf2f((u16)(pk.y & 0xffff));
          S[t][u][3] = S[t][u][3] * dv[3] + bf2f((u16)(pk.y >> 16));
        }
      }
    }
  }

  float lbv = 0.f;
  float hg_tot = 0.f;
  float cprev[2][3];
  float cw[2][4], cb[2];
  int ccidx[2];
  float dt_bias = 0.f, dt_A = 0.f;
  float rinv = 0.f, rcD = 1.f, rsD = 0.f;
  const int gg = sub >> 1, pair = sub & 1;
  if (MODE == 0) {
    rinv = exp2f(-(float)(tid & 63) * (13.287712379549449f / 64.f));
    rsD = __sinf(rinv); rcD = __cosf(rinv);
  }
  if (MODE == 2) {
    if (l == 1) {
      float a0 = p.in[20][sub * 128 + (tid & 127)], a1 = p.in[20][512 + sub * 128 + (tid & 127)];
      float mx = fmaxf(a0, a1);
      float e0 = __expf(a0 - mx), e1 = __expf(a1 - mx);
      lbv = e1 / (e0 + e1);
    }
  }
  if (MODE == 1) {
    if (tid < 32) {
      const int hh = sub * 2 + (tid >> 4);
      dt_A = -__expf(p.in[16][l * 8 + hh]);
      dt_bias = p.in[17][l * 8 + hh];
    }
    if (tid < 2) segacc[tid] = 0.f;
#pragma unroll
    for (int k = 0; k < 2; ++k) {
      int ci = tid + 256 * k;
      int cc = 0;
      if (ci < 128) cc = gg * 256 + pair * 128 + ci;
      else if (ci < 256) cc = 512 + gg * 128 + (ci - 128);
      else cc = 768 + gg * 128 + (ci - 256);
      if (ci >= 384) cc = 0;
      ccidx[k] = cc;
#pragma unroll
      for (int j = 0; j < 4; ++j) cw[k][j] = p.in[14][((size_t)l * 4 + j) * 1024 + cc];
      cb[k] = p.in[15][l * 1024 + cc];
#pragma unroll
      for (int j = 0; j < 3; ++j) {
        float v = 0.f;
        if (!prompt) v = p.in[4][(((size_t)l * 128 + bidx) * 3 + j) * 1024 + cc];
        else if (ch_begin > 0) v = bf2f(p.pbuf[(size_t)(row0 + ch_begin * 16 - 3 + j) * NP + C_SXBC + cc]);
        cprev[k][j] = v;
      }
    }
  }

  float fgain[8];
  {
    const int eg_ = tid & 15;
#pragma unroll
    for (int x = 0; x < 8; ++x) {
      if (MODE == 0) fgain[x] = p.in[13][(l * 4 + sub) * 128 + eg_ * 8 + x];
      else if (MODE == 2) fgain[x] = p.in[21][l * 128 + eg_ * 8 + x];
      else fgain[x] = p.in[18][l * 8 + sub * 2 + ((eg_ * 8) >> 6)];
    }
  }
  const int lt = tid >> 4, lc = tid & 15;
  uint4 r0, r1, r2, g0;
  unsigned rdt = 0;
  const uint4 z4 = make_uint4(0, 0, 0, 0);
  r0 = r1 = r2 = g0 = z4;
  auto load_raw = [&](int ch) {
    const int t0 = ch * 16;
    const int nv = (L - t0 < 16) ? (L - t0) : 16;
    const u16* Pr = p.pbuf + (size_t)(row0 + t0 + lt) * NP;
    r0 = r1 = r2 = g0 = z4;
    rdt = 0;
    if (lt < nv) {
      if (MODE == 0) {
        r0 = *(const uint4*)(Pr + C_RQ + sub * 128 + lc * 8);
        r1 = *(const uint4*)(Pr + C_RK + sub * 128 + lc * 8);
        r2 = *(const uint4*)(Pr + C_RV + sub * 128 + lc * 8);
        g0 = *(const uint4*)(Pr + C_RG + sub * 128 + lc * 8);
      } else if (MODE == 2) {
        r0 = *(const uint4*)(Pr + C_HQ + sub * 128 + lc * 8);
        r1 = *(const uint4*)(Pr + C_HF + sub * 128 + lc * 8);
        r2 = *(const uint4*)(Pr + C_HI + sub * 128 + lc * 8);
        g0 = *(const uint4*)(Pr + C_HG + sub * 128 + lc * 8);
      } else {
        r0 = *(const uint4*)(Pr + C_SXBC + gg * 256 + pair * 128 + lc * 8);
        r1 = *(const uint4*)(Pr + C_SXBC + 512 + gg * 128 + lc * 8);
        r2 = *(const uint4*)(Pr + C_SXBC + 768 + gg * 128 + lc * 8);
        g0 = *(const uint4*)(Pr + C_SZ + gg * 256 + pair * 128 + lc * 8);
        if (lc < 2) rdt = Pr[C_SDT + sub * 2 + lc];
      }
    }
  };
  load_raw(ch_begin);

  for (int ch = ch_begin; ch < ch_end; ++ch) {
    const int t0 = ch * 16;
    const int nvalid = (L - t0 < 16) ? (L - t0) : 16;
    float sscale = 1.f;
    int tidv = threadIdx.x;
    asm volatile("" : "+v"(tidv));
    const int tid = tidv, lane = tid & 63, w = tid >> 6, r16 = lane & 15, quad = lane >> 4, lt = tid >> 4, lc = tid & 15;

    *(uint4*)(Raw + lt * 128 + lc * 8) = r0;
    *(uint4*)(Raw + 2048 + lt * 128 + lc * 8) = r1;
    *(uint4*)(Raw + 4096 + lt * 128 + lc * 8) = r2;
    if (MODE == 1) { if (lc < 2) Raw[6144 + lt * 2 + lc] = (u16)rdt; }
    const uint4 gc0 = g0;
    __syncthreads();
    if (ch + 1 < ch_end) load_raw(ch + 1);

    if (MODE == 0) {
      const int which = tid >> 7, pr = tid & 63, th = (tid >> 6) & 1;
      if (which == 1 || !light) {
        const u16* R = Raw + which * 2048;
        float sn, cs;
        sincos_red((float)(pos0 + t0 + th * 8) * rinv, sn, cs);
#pragma unroll
        for (int x = 0; x < 8; ++x) {
          const int t = th * 8 + x;
          float x1 = bf2f(R[t * 128 + pr]);
          float x2 = bf2f(R[t * 128 + pr + 64]);
          float y1 = x1 * cs - x2 * sn, y2 = x1 * sn + x2 * cs;
          if (which) {
            y1 *= 0.08838834764831845f; y2 *= 0.08838834764831845f;
            Ka[t * QS + pr] = f2bf(y1); Ka[t * QS + pr + 64] = f2bf(y2);
            float kd = __expf(lg * (float)(nvalid - 1 - t));
            KuT[pr * TS + t] = f2bf(y1 * kd);
            KuT[(pr + 64) * TS + t] = f2bf(y2 * kd);
          } else {
            Qa[t * QS + pr] = f2bf(y1); Qa[t * QS + pr + 64] = f2bf(y2);
          }
          float ncs = cs * rcD - sn * rsD;
          sn = sn * rcD + cs * rsD; cs = ncs;
        }
      }
      if (tid < 16) cdec[tid] = lg * (float)(tid + 1);
      sscale = __expf(lg * (float)nvalid);
    } else if (MODE == 2) {
      const int d = tid & 127, th = tid >> 7;
      float cl[8], kk[8], qv[8];
      float c = 0.f;
#pragma unroll
      for (int x = 0; x < 8; ++x) {
        const int t = th * 8 + x;
        kk[x] = 0.f; qv[x] = 0.f;
        if (t < nvalid) {
          float z = bf2f(Raw[2048 + t * 128 + d]);
          float sg = sigmoidf_(z);
          float f = lbv + (1.f - lbv) * sg;
          c += __logf(f);
          kk[x] = (1.f - lbv) * (1.f - sg);
          if (!light) qv[x] = siluf_(bf2f(Raw[t * 128 + d]));
        }
        cl[x] = c;
      }
      tot[th * 128 + d] = c;
      __syncthreads();
      const float c_lo = tot[d];
      const float c_all = c_lo + tot[128 + d];
      const float off = th ? c_lo : 0.f;
      const float e_all = __expf(c_all);
#pragma unroll
      for (int x = 0; x < 8; ++x) {
        const int t = th * 8 + x;
        const float ct = off + cl[x];
        const float ein = __expf(-ct);
        if (!light) {
          Qa[t * QS + d] = f2bf(qv[x] * __frcp_rn(ein));
          Ka[t * QS + d] = f2bf(kk[x] * ein);
        }
        KuT[d * TS + t] = f2bf(kk[x] * ein * e_all);
      }
      if (th == 0) { rsc[d] = e_all; hg_tot += c_all; }
    } else {
      if (tid < 32) {
        const int hl = tid >> 4, t = tid & 15;
        float dtv = 0.f, c = 0.f;
        if (t < nvalid) {
          dtv = softplusf_(bf2f(Raw[6144 + t * 2 + hl]) + dt_bias);
          c = dtv * dt_A;
        }
#pragma unroll
        for (int o = 1; o < 16; o <<= 1) {
          float v = __shfl_up(c, o, 16);
          if (t >= o) c += v;
        }
        cdec[hl * 16 + t] = c;
        dtl[hl * 16 + t] = dtv;
        if (t == 15) { clast[hl] = c; segacc[hl] += c; }
      }
      __syncthreads();
#pragma unroll
      for (int k = 0; k < 2; ++k) {
        const int ci = tid + 256 * k;
        if (ci < 256 || (ci < 384 && !light)) {
          const int hl = (ci < 128) ? (ci >> 6) : 0;
          const float cl = clast[hl];
          const u16* R = Raw + ((ci < 128) ? ci : ((ci < 256) ? (2048 + (ci - 128)) : (4096 + (ci - 256))));
#pragma unroll 4
          for (int t = 0; t < 16; ++t) {
            float v = 0.f;
            if (t < nvalid) {
              float raw = bf2f(R[t * 128]);
              float o = cb[k] + cprev[k][0] * cw[k][0] + cprev[k][1] * cw[k][1] + cprev[k][2] * cw[k][2] + raw * cw[k][3];
              cprev[k][0] = cprev[k][1]; cprev[k][1] = cprev[k][2]; cprev[k][2] = raw;
              v = siluf_(o);
            }
            if (ci < 128) {
              float dtv = dtl[hl * 16 + t];
              if (!light) { Xc[t * 128 + ci] = f2bf(v); VaT[ci * TS + t] = f2bf(v * dtv); }
              VuT[ci * TS + t] = f2bf(v * dtv * __expf(cl - cdec[hl * 16 + t]));
            } else if (ci < 256) {
              u16 a = f2bf(v);
              if (!light) Ka[t * QS + (ci - 128)] = a;
              KuT[(ci - 128) * TS + t] = a;
            } else {
              Qa[t * QS + (ci - 256)] = f2bf(v);
            }
          }
        }
      }
    }
    if (MODE != 1) {
      const int e = tid & 127, th = tid >> 7;
#pragma unroll
      for (int x = 0; x < 4; ++x) {
        const int t = th * 8 + 2 * x;
        unsigned lo = Raw[4096 + t * 128 + e], hi = Raw[4096 + (t + 1) * 128 + e];
        *(unsigned*)(VaT + e * TS + t) = lo | (hi << 16);
      }
    }
    __syncthreads();

    {
      const float* cd = cdec + ((MODE == 1) ? (w >> 1) * 16 : 0);
      bf16x8 attA;
      float rr[4];
      bf16x8 qf[4];
      if (!light) {
        f32x4 at = f32x4{0.f, 0.f, 0.f, 0.f};
#pragma unroll
        for (int s = 0; s < 4; ++s) {
          bf16x8 a = *(const bf16x8*)(Ka + r16 * QS + s * 32 + quad * 8);
          bf16x8 b = *(const bf16x8*)(Qa + r16 * QS + s * 32 + quad * 8);
          at = MFMA16(a, b, at);
        }
        float ci_ = (MODE != 2) ? cd[r16] : 0.f;
        float vv[4];
#pragma unroll
        for (int jj = 0; jj < 4; ++jj) {
          int j = quad * 4 + jj;
          float v = at[jj];
          if (MODE != 2) v *= __expf(fminf(ci_ - cd[j], 0.f));
          vv[jj] = (j <= r16) ? v : 0.f;
        }
        unsigned a01 = pack2(vv[0], vv[1]), a23 = pack2(vv[2], vv[3]);
        attA = __builtin_bit_cast(bf16x8, (u32x4){a01, a23, 0u, 0u});
#pragma unroll
        for (int jj = 0; jj < 4; ++jj) rr[jj] = (MODE != 2) ? __expf(cd[quad * 4 + jj]) : 1.f;
#pragma unroll
        for (int s = 0; s < 4; ++s) {
          bf16x4 lo = *(const bf16x4*)(Qa + r16 * QS + s * 32 + quad * 4);
          bf16x4 hi = *(const bf16x4*)(Qa + r16 * QS + s * 32 + 16 + quad * 4);
          qf[s] = bf16x8{lo[0], lo[1], lo[2], lo[3], hi[0], hi[1], hi[2], hi[3]};
        }
      }
      if (!light) {
#pragma unroll
        for (int u = 0; u < NE; ++u) {
          const int e0 = (w * NE + u) * 16;
          bf16x4 v4 = *(const bf16x4*)(VaT + (e0 + r16) * TS + quad * 4);
          bf16x8 vb = bf16x8{v4[0], v4[1], v4[2], v4[3], 0, 0, 0, 0};
          f32x4 o1 = MFMA16(attA, vb, (f32x4{0.f, 0.f, 0.f, 0.f}));
          f32x4 o2 = f32x4{0.f, 0.f, 0.f, 0.f};
#pragma unroll
          for (int s = 0; s < 4; ++s) {
            u32x4 sp = {pack2(S[2 * s][u][0], S[2 * s][u][1]), pack2(S[2 * s][u][2], S[2 * s][u][3]),
                        pack2(S[2 * s + 1][u][0], S[2 * s + 1][u][1]), pack2(S[2 * s + 1][u][2], S[2 * s + 1][u][3])};
            o2 = MFMA16(qf[s], __builtin_bit_cast(bf16x8, sp), o2);
          }
#pragma unroll
          for (int jj = 0; jj < 4; ++jj) Of[(quad * 4 + jj) * OFS + e0 + r16] = o1[jj] + rr[jj] * o2[jj];
        }
      }
      float hs = 1.f;
      if (MODE == 0) hs = sscale;
      if (MODE == 1) hs = __expf(clast[w >> 1]);
#pragma unroll
      for (int u = 0; u < NE; ++u) {
        const int e0 = (w * NE + u) * 16;
        bf16x4 v4 = *(const bf16x4*)(VuT + (e0 + r16) * TS + quad * 4);
        bf16x8 vb = bf16x8{v4[0], v4[1], v4[2], v4[3], 0, 0, 0, 0};
#pragma unroll
        for (int t = 0; t < 8; ++t) {
          bf16x4 k4 = *(const bf16x4*)(KuT + (t * 16 + r16) * TS + quad * 4);
          bf16x8 ka = bf16x8{k4[0], k4[1], k4[2], k4[3], 0, 0, 0, 0};
          f32x4 sv = S[t][u];
          if (MODE == 2) {
            f32x4 r4 = *(const f32x4*)(rsc + t * 16 + quad * 4);
            sv[0] *= r4[0]; sv[1] *= r4[1]; sv[2] *= r4[2]; sv[3] *= r4[3];
          } else {
            sv[0] *= hs; sv[1] *= hs; sv[2] *= hs; sv[3] *= hs;
          }
          S[t][u] = MFMA16(ka, vb, sv);
        }
      }
    }
    __syncthreads();

    if (!light) {
      const int i = tid >> 4, eg = tid & 15;
      const int grow = row0 + t0 + i;
      unsigned gw[4] = {gc0.x, gc0.y, gc0.z, gc0.w};
      if (MODE == 0 || MODE == 2) {
        float o[8];
#pragma unroll
        for (int x = 0; x < 8; ++x) o[x] = Of[i * OFS + eg * 8 + x];
        float s1 = 0.f;
        float mu = 0.f;
        if (MODE == 0) {
#pragma unroll
          for (int x = 0; x < 8; ++x) s1 += o[x];
          mu = sum16(s1) * (1.f / 128.f);
        }
        float s2 = 0.f;
#pragma unroll
        for (int x = 0; x < 8; ++x) { o[x] -= mu; s2 += o[x] * o[x]; }
        float r = rsqrtf(sum16(s2) * (1.f / 128.f) + EPS);
        if (i < nvalid) {
          float res[8];
#pragma unroll
          for (int x = 0; x < 8; ++x) {
            float g = bf2f((u16)((x & 1) ? (gw[x >> 1] >> 16) : (gw[x >> 1] & 0xffff)));
            float gate = (MODE == 0) ? siluf_(g) : sigmoidf_(g);
            res[x] = o[x] * r * fgain[x] * gate;
          }
          uint4 ov = make_uint4(pack2(res[0], res[1]), pack2(res[2], res[3]), pack2(res[4], res[5]), pack2(res[6], res[7]));
          const int ocol = ((MODE == 0) ? 0 : 1024) + sub * 128 + eg * 8;
          *(uint4*)(p.obuf + (size_t)grow * OLD + ocol) = ov;
        }
      } else {
        float y[8];
        const int chb = eg * 8;
        const float Dh = fgain[0];
        float s2 = 0.f;
#pragma unroll
        for (int x = 0; x < 8; ++x) {
          float g = bf2f((u16)((x & 1) ? (gw[x >> 1] >> 16) : (gw[x >> 1] & 0xffff)));
          float v = Of[i * OFS + chb + x] + bf2f(Xc[i * 128 + chb + x]) * Dh;
          v *= siluf_(g);
          y[x] = v; s2 += v * v;
        }
        s2 = sum16(s2);
        if (i < nvalid) {
          if (eg == 0) p.ssq[(size_t)grow * 4 + sub] = s2;
          uint4 ov = make_uint4(pack2(y[0], y[1]), pack2(y[2], y[3]), pack2(y[4], y[5]), pack2(y[6], y[7]));
          *(uint4*)(p.obuf + (size_t)grow * OLD + 512 + sub * 128 + chb) = ov;
        }
      }
    }
  }
  __syncthreads();

  if (light) {
    uint2* sl = (uint2*)(p.slocal + (size_t)(cid * (p.nseg - 1) + seg) * 16384) + tid;
#pragma unroll
    for (int t = 0; t < 8; ++t)
#pragma unroll
      for (int u = 0; u < NE; ++u)
        sl[(t * NE + u) * 256] = make_uint2(pack2(S[t][u][0], S[t][u][1]), pack2(S[t][u][2], S[t][u][3]));
    float* sd = p.segdec + (size_t)(cid * 7 + seg) * 128;
    if (MODE == 1) { if (tid < 2) sd[tid] = segacc[tid]; }
    if (MODE == 2) { if (tid < 128) sd[tid] = hg_tot; }
  } else if (last_seg) {
    asm volatile("" : "+v"(sbase));
#pragma unroll
    for (int t = 0; t < 8; ++t)
#pragma unroll
      for (int u = 0; u < NE; ++u) {
        if (MODE == 1) {
          *(f32x4*)(sout + sbase + u * 2048 + t * 16) = S[t][u];
        } else {
#pragma unroll
          for (int jj = 0; jj < 4; ++jj) sout[sbase + t * 2048 + jj * 128 + u * 16] = S[t][u][jj];
        }
      }
    if (MODE == 1) {
      float* co = p.out + (prompt ? p.o_conv_p : p.o_conv_s) + ((size_t)l * NB + bidx) * 3 * 1024;
#pragma unroll
      for (int k = 0; k < 2; ++k) {
        const int ci = tid + 256 * k;
        if (ci < 128 || (ci < 384 && pair == 0)) {
#pragma unroll
          for (int j = 0; j < 3; ++j) co[j * 1024 + ccidx[k]] = cprev[k][j];
        }
      }
    }
  }
}

__device__ void run_s5(const Params& p, int l, int seq, int gq, int seg, int pass, char* smem) {
  const int tid = tidq(), lane = tid & 63, w = tid >> 6, r16 = lane & 15, quad = lane >> 4;
  const int g = gq * 4 + w;
  const bool prompt = seq < 8;
  const int bidx = prompt ? seq : seq - 8;
  const int NB = prompt ? 8 : 128;
  const int row0 = prompt ? seq * 2048 : MPR + (seq - 8) * 8;
  const int nch = prompt ? p.cps : 1;
  const int ch_begin = prompt ? seg * nch : 0;
  const int ch_end = ch_begin + nch;
  const int nvalid = prompt ? 16 : 8;
  const bool light = prompt && (pass == 1);
  const bool last_seg = !prompt || (seg == p.nseg - 1);
  char* wb = smem + w * 5120;
  u16* Hs = (u16*)wb;
  u16* Us = (u16*)(wb + 4352);
  const int lg_ = l * 32 + g;

  const float dt = __expf(p.in[29][lg_]);
  float Ar[4][4], Ai[4][4];
  float fre[4], fim[4];
  float dtare[4], thv[4];
#pragma unroll
  for (int i = 0; i < 4; ++i) {
    const int pi = i * 16 + r16;
    const float are = p.in[22][lg_ * 64 + pi], aim = p.in[23][lg_ * 64 + pi];
    const float th = dt * aim;
    float sn, cs; sincos_red(th, sn, cs);
    float shalf, chalf; sincos_red(0.5f * th, shalf, chalf);
    const float em1 = expm1f(dt * are);
    const float mag = em1 + 1.f;
    const float abr = mag * cs, abi = mag * sn;
    const float nre = em1 * cs - 2.f * shalf * shalf, nim = abi;
    const float den = are * are + aim * aim;
    fre[i] = (nre * are + nim * aim) / den; fim[i] = (nim * are - nre * aim) / den;
    dtare[i] = dt * are; thv[i] = th;
    Ar[0][i] = abr; Ai[0][i] = abi;
    Ar[1][i] = abr * abr - abi * abi; Ai[1][i] = 2.f * abr * abi;
    Ar[2][i] = Ar[1][i] * abr - Ai[1][i] * abi; Ai[2][i] = Ar[1][i] * abi + Ai[1][i] * abr;
    Ar[3][i] = Ar[1][i] * Ar[1][i] - Ai[1][i] * Ai[1][i]; Ai[3][i] = 2.f * Ar[1][i] * Ai[1][i];
  }
  bf16x8 Bop[8];
#pragma unroll
  for (int nt = 0; nt < 8; ++nt) {
    const int i = nt & 3;
    u32x4 pk = {0u, 0u, 0u, 0u};
    if (quad < 2) {
      const size_t bo = ((size_t)lg_ * 64 + i * 16 + r16) * 16 + quad * 8;
      const float4 br0 = *(const float4*)(p.in[24] + bo), br1 = *(const float4*)(p.in[24] + bo + 4);
      const float4 bi0 = *(const float4*)(p.in[25] + bo), bi1 = *(const float4*)(p.in[25] + bo + 4);
      const float brv[8] = {br0.x, br0.y, br0.z, br0.w, br1.x, br1.y, br1.z, br1.w};
      const float biv[8] = {bi0.x, bi0.y, bi0.z, bi0.w, bi1.x, bi1.y, bi1.z, bi1.w};
      float v[8];
#pragma unroll
      for (int j = 0; j < 8; ++j)
        v[j] = (nt < 4) ? (fre[i] * brv[j] - fim[i] * biv[j]) : (fre[i] * biv[j] + fim[i] * brv[j]);
      pk = u32x4{pack2(v[0], v[1]), pack2(v[2], v[3]), pack2(v[4], v[5]), pack2(v[6], v[7])};
    }
    Bop[nt] = __builtin_bit_cast(bf16x8, pk);
  }
  bf16x8 Cop[4];
  float Dm[4] = {0.f, 0.f, 0.f, 0.f};
  if (!light) {
#pragma unroll
    for (int s = 0; s < 4; ++s) {
      const int n0 = 32 * s + quad * 8;
      const float* src = ((n0 >= 64) ? p.in[27] : p.in[26]) + ((size_t)lg_ * 16 + r16) * 64 + (n0 & 63);
      const float sg = (n0 >= 64) ? -1.f : 1.f;
      const float4 c0 = *(const float4*)src, c1 = *(const float4*)(src + 4);
      Cop[s] = __builtin_bit_cast(bf16x8, (u32x4{pack2(sg * c0.x, sg * c0.y), pack2(sg * c0.z, sg * c0.w),
                                                 pack2(sg * c1.x, sg * c1.y), pack2(sg * c1.z, sg * c1.w)}));
    }
#pragma unroll
    for (int jj = 0; jj < 4; ++jj) Dm[jj] = p.in[28][lg_ * 16 + quad * 4 + jj];
  }
  float hr[4], hi[4];
#pragma unroll
  for (int i = 0; i < 4; ++i) { hr[i] = 0.f; hi[i] = 0.f; }
  if (!prompt) {
#pragma unroll
    for (int i = 0; i < 4; ++i) {
      hr[i] = p.in[6][((size_t)(l * 128 + bidx) * 32 + g) * 64 + i * 16 + r16];
      hi[i] = p.in[7][((size_t)(l * 128 + bidx) * 32 + g) * 64 + i * 16 + r16];
    }
  } else if (pass == 2 && seg > 0) {
    const float len = (float)(nch * 16);
#pragma unroll
    for (int i = 0; i < 4; ++i) {
      const float pm = __expf(len * dtare[i]);
      float ps, pc; sincos_red(len * thv[i], ps, pc);
      const float pr_ = pm * pc, pi_ = pm * ps;
      for (int r = 0; r < seg; ++r) {
        const float* hl = p.hlocal + ((size_t)((seq * 32 + g) * 7 + r)) * 128;
        const float lr_ = hl[i * 16 + r16], li_ = hl[64 + i * 16 + r16];
        const float nr = pr_ * hr[i] - pi_ * hi[i] + lr_;
        const float ni = pr_ * hi[i] + pi_ * hr[i] + li_;
        hr[i] = nr; hi[i] = ni;
      }
    }
  }
  const int ut = lane >> 1, uh = lane & 1;
  const u16* ubase = p.pbuf + (size_t)(row0 + ut) * NP + C_SU + g * 16 + uh * 8;
  const uint4 z4 = make_uint4(0, 0, 0, 0);
  uint4 nxt = z4;
  if (lane < 32 && ut < nvalid) nxt = *(const uint4*)(ubase + (size_t)ch_begin * 16 * NP);
  for (int ch = ch_begin; ch < ch_end; ++ch) {
    const uint4 cur = nxt;
    nxt = z4;
    if (ch + 1 < ch_end && lane < 32) nxt = *(const uint4*)(ubase + (size_t)(ch + 1) * 16 * NP);
    if (lane < 32) *(uint4*)(Us + ut * 16 + uh * 8) = cur;
    __syncthreads();
    bf16x8 Uop = bf16x8{0, 0, 0, 0, 0, 0, 0, 0};
    if (quad < 2) Uop = *(const bf16x8*)(Us + r16 * 16 + quad * 8);
    f32x4 bu[8];
#pragma unroll
    for (int nt = 0; nt < 8; ++nt) bu[nt] = MFMA16(Uop, Bop[nt], (f32x4{0.f, 0.f, 0.f, 0.f}));
    float Er[4], Ei[4];
#pragma unroll
    for (int i = 0; i < 4; ++i) {
      float xr = 0.f, xi = 0.f;
#pragma unroll
      for (int jj = 0; jj < 4; ++jj) {
        const float nr = Ar[0][i] * xr - Ai[0][i] * xi + bu[i][jj];
        const float ni = Ar[0][i] * xi + Ai[0][i] * xr + bu[4 + i][jj];
        xr = nr; xi = ni;
        bu[i][jj] = xr; bu[4 + i][jj] = xi;
      }
      Er[i] = xr; Ei[i] = xi;
    }
    float cr[4], ci[4];
#pragma unroll
    for (int i = 0; i < 4; ++i) { cr[i] = hr[i]; ci[i] = hi[i]; }
#pragma unroll
    for (int k = 0; k < 4; ++k) {
#pragma unroll
      for (int i = 0; i < 4; ++i) {
        const float er = __shfl(Er[i], r16 + 16 * k), ei = __shfl(Ei[i], r16 + 16 * k);
        const float nr = Ar[3][i] * hr[i] - Ai[3][i] * hi[i] + er;
        const float ni = Ar[3][i] * hi[i] + Ai[3][i] * hr[i] + ei;
        if (k * 4 < nvalid) { hr[i] = nr; hi[i] = ni; }
        if (k < quad) { cr[i] = nr; ci[i] = ni; }
      }
    }
    if (!light) {
#pragma unroll
      for (int i = 0; i < 4; ++i)
#pragma unroll
        for (int jj = 0; jj < 4; ++jj) {
          const float vr = bu[i][jj] + Ar[jj][i] * cr[i] - Ai[jj][i] * ci[i];
          const float vi = bu[4 + i][jj] + Ar[jj][i] * ci[i] + Ai[jj][i] * cr[i];
          Hs[(quad * 4 + jj) * 136 + i * 16 + r16] = f2bf(vr);
          Hs[(quad * 4 + jj) * 136 + 64 + i * 16 + r16] = f2bf(vi);
        }
      __syncthreads();
      f32x4 ya = f32x4{0.f, 0.f, 0.f, 0.f};
#pragma unroll
      for (int s = 0; s < 4; ++s) {
        const bf16x8 bh = *(const bf16x8*)(Hs + r16 * 136 + s * 32 + quad * 8);
        ya = MFMA16(Cop[s], bh, ya);
      }
      const uint2 uu = *(const uint2*)(Us + r16 * 16 + quad * 4);
      const float u0 = bf2f((u16)(uu.x & 0xffff)), u1 = bf2f((u16)(uu.x >> 16));
      const float u2 = bf2f((u16)(uu.y & 0xffff)), u3 = bf2f((u16)(uu.y >> 16));
      const float z0 = gelu_tanh(ya[0] + Dm[0] * u0), z1 = gelu_tanh(ya[1] + Dm[1] * u1);
      const float z2 = gelu_tanh(ya[2] + Dm[2] * u2), z3 = gelu_tanh(ya[3] + Dm[3] * u3);
      if (r16 < nvalid)
        *(uint2*)(p.zs5 + (size_t)(row0 + ch * 16 + r16) * ZLD + g * 16 + quad * 4) = make_uint2(pack2(z0, z1), pack2(z2, z3));
    }
    __syncthreads();
  }
  if (light) {
    if (quad == 0) {
      float* hl = p.hlocal + ((size_t)((seq * 32 + g) * 7 + seg)) * 128;
#pragma unroll
      for (int i = 0; i < 4; ++i) { hl[i * 16 + r16] = hr[i]; hl[64 + i * 16 + r16] = hi[i]; }
    }
  } else if (last_seg) {
    if (quad == 0) {
      float* o_r = p.out + (prompt ? p.o_s5r_p : p.o_s5r_s) + ((size_t)(l * NB + bidx) * 32 + g) * 64;
      float* o_i = p.out + (prompt ? p.o_s5i_p : p.o_s5i_s) + ((size_t)(l * NB + bidx) * 32 + g) * 64;
#pragma unroll
      for (int i = 0; i < 4; ++i) { o_r[i * 16 + r16] = hr[i]; o_i[i * 16 + r16] = hi[i]; }
    }
  }
}

__device__ void phase_mixers(const Params& p, int l, int pass, char* smem, int visit) {
  int* s_item = (int*)(smem + 65536);
  unsigned* cnt = p.counters + l * 64 + (pass - 1) * 32 + visit * 16;
  const int nseg = p.nseg;
  const int ns1 = nseg - 1;
  const int n_chain = (pass == 1) ? 96 * ns1 : 96 * nseg;
  const int n_s5 = (pass == 1) ? 64 * ns1 : 64 * nseg;
  const int n_items = n_chain + n_s5 + ((pass == 1) ? 128 * 20 : 0);
  for (;;) {
    if (tidq() == 0) *s_item = (int)atomicAdd(cnt, 1u);
    __syncthreads();
    const int item = *s_item;
    __syncthreads();
    if (item >= n_items) break;
    int mode, seq, sub, seg = 0;
    const int per = (pass == 1) ? ns1 : nseg;
    if (item < n_chain) {
      const int c = item / per; seg = item % per;
      const int kind = c >> 5, r = c & 31;
      seq = r >> 2; sub = r & 3;
      mode = (kind == 0) ? 1 : ((kind == 1) ? 2 : 0);
    } else if (item < n_chain + n_s5) {
      const int k = item - n_chain;
      const int c = k / per; seg = k % per;
      mode = 3; seq = c >> 3; sub = c & 7;
    } else {
      int k = item - n_chain - n_s5; int b = k / 20; sub = k % 20; seq = 8 + b;
      if (sub < 4) mode = 1;
      else if (sub < 8) { mode = 0; sub -= 4; }
      else if (sub < 12) { mode = 2; sub -= 8; }
      else { mode = 3; sub -= 12; }
    }
    const int ps = (seq >= 8) ? 2 : pass;
    if (mode == 0) { if (EN(2) || ONLY == 20) run_chain<0>(p, l, seq, sub, seg, ps, smem); }
    else if (mode == 1) { if (EN(2) || ONLY == 21) run_chain<1>(p, l, seq, sub, seg, ps, smem); }
    else if (mode == 2) { if (EN(2) || ONLY == 22) run_chain<2>(p, l, seq, sub, seg, ps, smem); }
    else { if (EN(2) || ONLY == 23) run_s5(p, l, seq, sub, seg, ps, smem); }
    __syncthreads();
  }
}

DI bool tile_at(int i, int T, int& t) {
  const int bpx = gridDim.x >> 3;
  t = ((blockIdx.x & 7) + 8 * i) * bpx + (blockIdx.x >> 3);
  return t < T;
}
DI void tile_mn(int t, int nN, int& m0, int& n0) {
  const int per = 8 * nN;
  const int grp = t / per, r = t - grp * per;
  m0 = (grp * 8 + (r & 7)) * 128;
  n0 = (r >> 3) * 128;
}

__device__ void run_phase(const Params& p, int ph, char* smem, int visit) {
  constexpr int NMT = MTOK / 128;
  if (ph == 0) {
    if (EN(9)) phase_convert(p, smem);
    if (EN(0)) phase_rownorm(p, true, nullptr, nullptr, p.in[8], p.hb);
    return;
  }
  if (ph == NPHASE - 1) {
    if (EN(10)) phase_rownorm(p, false, p.tbuf, p.in[11] + 1 * DM, nullptr, nullptr);
    return;
  }
  const int l = (ph <= 9) ? 0 : 1, s0_ = (ph <= 9) ? ph : ph - 10;
  const int s = (s0_ <= 2) ? s0_ : s0_ - 1;
  switch (s) {
    case 0:
      if (!EN(0)) break;
      phase_rownorm(p, false, p.tbuf, p.in[11] + (l - 1) * DM, p.in[8] + l * DM, p.hb);
      break;
    case 1: if (EN(1)) {
      constexpr int NN = NP / 128;
      gemm_stream<EPI_BF16>(p.hb, HLD, p.wt_in + (size_t)l * NIN * WLD1, WLD1, DM, NN, NMT * NN, p.pbuf, NP, nullptr, 0, smem);
    } break;
    case 2: if (EN(2) || (ONLY >= 20 && ONLY <= 23)) phase_mixers(p, l, (s0_ == 2) ? 1 : 2, smem, visit); break;
    case 3: if (EN(3)) {
      constexpr int NG = 32, NGLU = 4;
      {
        const int lane = tidq() & 63, w = tidq() >> 6;
        for (int row = blockIdx.x * 4 + w; row < MTOK; row += gridDim.x * 4) {
          const float4 sq = *(const float4*)(p.ssq + (size_t)row * 4);
          const float ms = (lane < 32) ? (sq.x + sq.y) : (sq.z + sq.w);
          const float r = rsqrtf(ms * (1.f / 256.f) + EPS);
          u16* ptr = p.obuf + (size_t)row * OLD + 512 + lane * 8;
          uint4 v = *(const uint4*)ptr;
          const float* gn = p.in[19] + l * 512 + lane * 8;
          unsigned vw[4] = {v.x, v.y, v.z, v.w};
          unsigned ow[4];
#pragma unroll
          for (int x = 0; x < 4; ++x)
            ow[x] = pack2(bf2f((u16)(vw[x] & 0xffff)) * r * gn[2 * x], bf2f((u16)(vw[x] >> 16)) * r * gn[2 * x + 1]);
          *(uint4*)ptr = make_uint4(ow[0], ow[1], ow[2], ow[3]);
        }
      }
      gemm_stream<EPI_SIG>(p.hb, HLD, p.wt_in + ((size_t)l * NIN + NP) * WLD1, WLD1, DM, NG, NMT * NG, p.pbuf, 4096, nullptr, 0, smem);
      gemm_stream<EPI_GLU>(p.zs5, ZLD, p.wt_glu + (size_t)l * 512 * WLD5, WLD5, 512, NGLU, NMT * NGLU,
                           p.obuf + 1536, OLD, p.zs5, ZLD, smem);
    } break;
    case 4:
      if (EN(4)) {
        int t, m0, n0;
        for (int i = 0; tile_at(i, NMT * 8, t); ++i) { tile_mn(t, 8, m0, n0); merge_tile(p, l, m0, n0, smem); }
      }
      break;
    case 5:
      if (EN(5)) {
        if (gridDim.x == 512) gemm_stream_split(p.hb, HLD, p.wt_out + (size_t)l * DM * WLD1, WLD1, DM, p.tbuf, (float*)p.obuf, smem);
        else gemm_stream<EPI_F32>(p.hb, HLD, p.wt_out + (size_t)l * DM * WLD1, WLD1, DM, 8, NMT * 8, p.tbuf, DM, nullptr, 0, smem);
      }
      break;
    case 6:
      if (EN(6)) phase_rownorm(p, false, p.tbuf, p.in[9] + l * DM, p.in[10] + l * DM, p.hb);
      break;
    case 7:
      if (EN(7)) {
        gemm_stream<EPI_RELU2>(p.hb, HLD, p.wt_ff1 + (size_t)l * DFF * WLD1, WLD1, DM, 32, NMT * 32, p.pbuf, ULD, nullptr, 0, smem);
      }
      break;
    case 8:
      if (EN(8)) {
        if (gridDim.x == 512) gemm_stream_split(p.pbuf, ULD, p.wt_ff2 + (size_t)l * DM * WLD4, WLD4, DFF, p.tbuf, (float*)p.obuf, smem);
        else gemm_stream<EPI_F32>(p.pbuf, ULD, p.wt_ff2 + (size_t)l * DM * WLD4, WLD4, DFF, 8, NMT * 8, p.tbuf, DM, nullptr, 0, smem);
      }
      break;
  }
}

#ifndef DUP_S
#define DUP_S -1
#endif
#define XB_TMO      128
#define XB_XCNT(j)  (256  + 64 * (j))
#define XB_XSUB(j)  (1280 + 64 * (j))
#define XB_XGEN(j)  (2304 + 64 * (j))
#define XB_TOP      3328
#define XB_TOPGEN   3392
#define XCD_BAR_WORDS 3456
#define XB_SPIN_CAP (1u << 22)
#define LAS __attribute__((address_space(3)))
DI unsigned xb_ld(unsigned* p)              { return __hip_atomic_load(p, __ATOMIC_RELAXED, __HIP_MEMORY_SCOPE_AGENT); }
DI unsigned xb_add(unsigned* p, unsigned v) { return __hip_atomic_fetch_add(p, v, __ATOMIC_RELAXED, __HIP_MEMORY_SCOPE_AGENT); }
DI unsigned xb_xcc_id() { return (unsigned)__builtin_amdgcn_s_getreg((3 << 11) | 20) & 0xFu; }
#define XB_SPIN(cond, bar) do { unsigned _sp = 0; while (cond) { __builtin_amdgcn_s_sleep(1); \
    if ((++_sp & 255u) == 0u) { if (xb_ld(&(bar)[XB_TMO])) break; if (_sp > XB_SPIN_CAP) { atomicAdd(&(bar)[XB_TMO], 1u); break; } } } } while (0)
struct XcdBarrier { unsigned* bar; unsigned x; volatile LAS unsigned* st; };
DI XcdBarrier xcd_barrier_post(unsigned* bar, volatile LAS unsigned* st) {
  XcdBarrier b; b.bar = bar; b.x = xb_xcc_id(); b.st = st;
  if (threadIdx.x == 0) (void)xb_add(&bar[XB_XCNT(b.x)], 1u);
  return b;
}
DI void xcd_barrier_complete(unsigned* bar, unsigned x, unsigned& nloc, unsigned& nx) {
  const unsigned G = gridDim.x * gridDim.y * gridDim.z;
  unsigned sum, cnt, mine, sp = 0u;
  for (;;) {
    sum = 0u; cnt = 0u; mine = 0u;
#pragma unroll
    for (unsigned j = 0; j < 16; ++j) { const unsigned c = xb_ld(&bar[XB_XCNT(j)]); sum += c; cnt += (c > 0u) ? 1u : 0u; mine = (j == x) ? c : mine; }
    if (sum == G) break;
    __builtin_amdgcn_s_sleep(1);
    if ((++sp & 255u) == 0u) { if (xb_ld(&bar[XB_TMO])) break; if (sp > XB_SPIN_CAP) { atomicAdd(&bar[XB_TMO], 1u); break; } }
  }
  nloc = mine > 0u ? mine : 1u; nx = cnt > 0u ? cnt : 1u;
}
DI void xcd_barrier(const XcdBarrier& b) {
  asm volatile("s_waitcnt vmcnt(0)" ::: "memory");
  __syncthreads();
  if (threadIdx.x == 0) {
    unsigned* bar = b.bar;
    __builtin_amdgcn_s_waitcnt(0);
    unsigned nloc = b.st[0], nx = b.st[1];
    if (nloc == 0u) { xcd_barrier_complete(bar, b.x, nloc, nx); b.st[0] = nloc; b.st[1] = nx; }
    const unsigned old = xb_add(&bar[XB_XSUB(b.x)], 1u);
    const unsigned gen = old / nloc;
    if (old + 1u == (gen + 1u) * nloc) {
      __builtin_amdgcn_fence(__ATOMIC_RELEASE, "agent");
      asm volatile("s_waitcnt vmcnt(0)" ::: "memory");
      const unsigned og = xb_add(&bar[XB_TOP], 1u);
      const unsigned tg = og / nx;
      if (og + 1u == (tg + 1u) * nx) xb_add(&bar[XB_TOPGEN], 1u);
      else XB_SPIN(xb_ld(&bar[XB_TOPGEN]) == tg, bar);
      __builtin_amdgcn_fence(__ATOMIC_ACQUIRE, "agent");
      xb_add(&bar[XB_XGEN(b.x)], 1u);
      asm volatile("s_waitcnt vmcnt(0)" ::: "memory");
    } else {
      XB_SPIN(xb_ld(&bar[XB_XGEN(b.x)]) == gen, bar);
      __builtin_amdgcn_fence(__ATOMIC_ACQUIRE, "agent");
      asm volatile("s_waitcnt vmcnt(0)" ::: "memory");
    }
  }
  __syncthreads();
}

__global__ void __launch_bounds__(256, 2) mega_kernel(Params p, int ph_lo, int ph_hi) {
  __shared__ __attribute__((aligned(16))) char smem[65536 + 32];
  volatile LAS unsigned* st = (volatile LAS unsigned*)(&smem[65536 + 16]);
  if (threadIdx.x == 0) { st[0] = 0u; st[1] = 0u; }
  __syncthreads();
  const XcdBarrier xb = xcd_barrier_post(p.bar, st);
  for (int ph = ph_lo; ph < ph_hi; ++ph) {
    if (ph > ph_lo) xcd_barrier(xb);
    if (ph_hi < 0) cg::this_grid().sync();
    const int reps = (DUP_S >= 0 && ph == DUP_S) ? 2 : 1;
    for (int r = 0; r < reps; ++r) {
      if (r) xcd_barrier(xb);
#ifdef VAR_NOSTORE
      if (tidq() == 0) *(volatile int*)(smem + 65536 + 8) = r;
      __syncthreads();
#endif
      run_phase(p, ph, smem, r);
    }
  }
}

extern "C" void kernel_launch(void* const* d_in, const int* in_sizes, int n_in, void* d_out, int out_size,
                              void* d_ws, size_t ws_size, hipStream_t stream) {
  Params p{};
  for (int i = 0; i < 35; ++i) p.in[i] = (const float*)d_in[i];
  p.out = (float*)d_out;
  char* ws = (char*)d_ws;
  size_t off = 0;
  auto take = [&](size_t bytes) { char* r = ws + off; off += (bytes + 255) & ~(size_t)255; return r; };
  p.wt_in  = (u16*)take((size_t)2 * NIN * WLD1 * 2);
  p.wt_ff1 = (u16*)take((size_t)2 * DFF * WLD1 * 2);
  p.wt_ff2 = (u16*)take((size_t)2 * DM * WLD4 * 2);
  p.wt_br  = (u16*)take((size_t)2 * 4 * DM * WLD5 * 2);
  p.wt_out = (u16*)take((size_t)2 * DM * WLD1 * 2);
  p.wt_glu = (u16*)take((size_t)2 * 512 * WLD5 * 2);
  p.hb     = (u16*)take((size_t)MTOK * HLD * 2);
  p.pbuf   = (u16*)take((size_t)MTOK * NP * 2);
  p.obuf   = (u16*)take((size_t)MTOK * OLD * 2);
  p.zs5    = (u16*)take((size_t)MTOK * ZLD * 2);
  p.counters = (unsigned*)take(4096);
  p.bar = (unsigned*)take(16384);
  p.ssq = (float*)take((size_t)MTOK * 4 * 4);
  p.segdec = (float*)take((size_t)96 * 7 * 128 * 4);
  p.hlocal = (float*)take((size_t)8 * 32 * 7 * 128 * 4);
  p.nseg = 8;
  if (off + (size_t)96 * 7 * 32768 > ws_size) p.nseg = 4;
  p.cps = 128 / p.nseg;
  p.slocal = (u16*)take((size_t)96 * (p.nseg - 1) * 32768);
  p.tbuf = (float*)(p.pbuf + (size_t)MTOK * ULD);
  if (off > ws_size) { fprintf(stderr, "workspace too small: need %zu have %zu\n", off, ws_size); return; }
  size_t o = (size_t)MTOK * DM;
  p.o_ret_p = o;  o += (size_t)2 * 8 * 65536;
  p.o_ret_s = o;  o += (size_t)2 * 128 * 65536;
  p.o_ssd_p = o;  o += (size_t)2 * 8 * 65536;
  p.o_ssd_s = o;  o += (size_t)2 * 128 * 65536;
  p.o_conv_p = o; o += (size_t)2 * 8 * 3 * 1024;
  p.o_conv_s = o; o += (size_t)2 * 128 * 3 * 1024;
  p.o_hg_p = o;   o += (size_t)2 * 8 * 65536;
  p.o_hg_s = o;   o += (size_t)2 * 128 * 65536;
  p.o_s5r_p = o;  o += (size_t)2 * 8 * 2048;
  p.o_s5r_s = o;  o += (size_t)2 * 128 * 2048;
  p.o_s5i_p = o;  o += (size_t)2 * 8 * 2048;
  p.o_s5i_s = o;  o += (size_t)2 * 128 * 2048;

  static int grid_blocks = 0;
  if (!grid_blocks) {
    int dev = 0, cus = 0, per_cu = 0;
    hipGetDevice(&dev);
    hipDeviceGetAttribute(&cus, hipDeviceAttributeMultiprocessorCount, dev);
    hipOccupancyMaxActiveBlocksPerMultiprocessor(&per_cu, mega_kernel, 256, 0);
    if (per_cu > 2) per_cu = 2;
    if (per_cu < 1) per_cu = 1;
    grid_blocks = cus * per_cu;
  }
  hipMemsetAsync(p.counters, 0, 4096 + 16384, stream);
#if SINGLE_LAUNCH
  int lo = 0, hi = NPHASE;
  void* args[] = {&p, &lo, &hi};
  hipError_t e = hipLaunchCooperativeKernel((void*)mega_kernel, dim3(grid_blocks), dim3(256), args, 0, stream);
  if (e != hipSuccess) fprintf(stderr, "cooperative launch failed: %s (grid %d)\n", hipGetErrorString(e), grid_blocks);
#else
  for (int ph = 0; ph < NPHASE; ++ph)
    hipLaunchKernelGGL(mega_kernel, dim3(grid_blocks), dim3(256), 0, stream, p, ph, ph + 1);
#endif
}
```

```cpp
#include <hip/hip_runtime.h>
#include <hip/hip_cooperative_groups.h>
#include <cstdio>
#include <cstdint>
namespace cg = cooperative_groups;

#ifndef SINGLE_LAUNCH
#define SINGLE_LAUNCH 1
#endif
#ifndef ONLY
#define ONLY -1
#endif
#define EN(k) (ONLY < 0 || ONLY == (k))

typedef unsigned short u16;
using bf16x8 = __attribute__((ext_vector_type(8))) short;
using bf16x4 = __attribute__((ext_vector_type(4))) short;
using f32x4  = __attribute__((ext_vector_type(4))) float;
typedef unsigned u32x4 __attribute__((ext_vector_type(4)));
#define DI __device__ __forceinline__
#define MFMA16(a, b, c) __builtin_amdgcn_mfma_f32_16x16x32_bf16((a), (b), (c), 0, 0, 0)

constexpr int MTOK = 17408;
constexpr int MPR  = 16384;
constexpr int DM   = 1024;
constexpr int NP   = 6272;
constexpr int NIN  = 10368;
constexpr int DFF  = 4096;
constexpr int INC  = 10248;
constexpr int C_RQ = 0, C_RK = 512, C_RV = 1024, C_RG = 1536, C_SZ = 2048, C_SXBC = 2560;
constexpr int C_HQ = 3584, C_HF = 4096, C_HI = 4608, C_HG = 5120, C_SU = 5632, C_SDT = 6144;
constexpr float EPS = 1e-6f;
constexpr int HLD = 1024, WLD1 = 1024, ULD = 4096, WLD4 = 4096, OLD = 2048, ZLD = 512, WLD5 = 512;
constexpr int NITEMS = 160 + 128 * 20;
constexpr int NPHASE = 21;

struct Params {
  const float* in[35];
  float* out;
  u16 *wt_in, *wt_ff1, *wt_ff2, *wt_br, *wt_out, *wt_glu;
  u16 *hb, *pbuf, *obuf, *zs5;
  float* tbuf;
  unsigned* counters;
  unsigned* bar;
  float* ssq;
  u16* slocal;
  float* segdec;
  float* hlocal;
  int nseg, cps;
  size_t o_ret_p, o_ret_s, o_ssd_p, o_ssd_s, o_conv_p, o_conv_s, o_hg_p, o_hg_s, o_s5r_p, o_s5r_s, o_s5i_p, o_s5i_s;
};

DI int tidq() { int t = threadIdx.x; asm volatile("" : "+v"(t)); return t; }
typedef __bf16 bf16v2 __attribute__((ext_vector_type(2)));
typedef float f32v2 __attribute__((ext_vector_type(2)));
DI unsigned pack2(float a, float b) { f32v2 v = {a, b}; return __builtin_bit_cast(unsigned, __builtin_convertvector(v, bf16v2)); }
DI u16 f2bf(float f) { return (u16)(pack2(f, 0.f) & 0xffffu); }
DI float bf2f(u16 h) { return __uint_as_float(((unsigned)h) << 16); }
DI float sigmoidf_(float x) { return __builtin_amdgcn_rcpf(1.f + __expf(-x)); }
DI float siluf_(float x) { return x * __builtin_amdgcn_rcpf(1.f + __expf(-x)); }
DI float softplusf_(float x) { return x > 20.f ? x : log1pf(__expf(x)); }
DI float gelu_tanh(float x) {
  float u = 0.7978845608028654f * (x + 0.044715f * x * x * x);
  float e = __expf(2.f * u);
  float th = 1.f - 2.f * __builtin_amdgcn_rcpf(e + 1.f);
  return 0.5f * x * (1.f + th);
}
DI float wave_sum(float v) {
#pragma unroll
  for (int m = 32; m >= 1; m >>= 1) v += __shfl_xor(v, m);
  return v;
}
DI float sum16(float v) {
#pragma unroll
  for (int m = 8; m >= 1; m >>= 1) v += __shfl_xor(v, m);
  return v;
}
DI void sincos_red(float a, float& s, float& c) {
  float n = rintf(a * 0.15915494309189535f);
  float r = fmaf(-n, 6.28125f, a);
  r = fmaf(-n, 1.9353071795864769e-3f, r);
  s = __sinf(r); c = __cosf(r);
}

DI int map_win(int my) {
  if (my < 3584) return my;
  if (my < 6144) return my + 8;
  if (my < 6152) return my - 6144 + 3584;
  if (my < 6272) return -1;
  return my - 120;
}
DI void transpose_tile(const float* __restrict__ src, int src_ld, u16* __restrict__ dst, int dst_ld,
                       int k0, int n0, int mapmode, char* smem) {
  float* tile = (float*)smem;
  const int tid = tidq();
  {
    const int n = tid & 63;
    int sc = n0 + n;
    if (mapmode) sc = map_win(sc);
    const float* sp = src + (size_t)(k0 + (tid >> 6)) * src_ld + (sc >= 0 ? sc : 0);
    float v[32];
#pragma unroll
    for (int i = 0; i < 32; ++i) v[i] = sp[(size_t)(4 * i) * src_ld];
#pragma unroll
    for (int i = 0; i < 32; ++i) tile[n * 129 + (tid >> 6) + 4 * i] = (sc >= 0) ? v[i] : 0.f;
  }
  __syncthreads();
  {
    const int n = tid >> 2, kc = (tid & 3) * 32;
    unsigned pk[16];
#pragma unroll
    for (int x = 0; x < 16; ++x) pk[x] = pack2(tile[n * 129 + kc + 2 * x], tile[n * 129 + kc + 2 * x + 1]);
    uint4* d = (uint4*)(dst + (size_t)(n0 + n) * dst_ld + k0 + kc);
    d[0] = make_uint4(pk[0], pk[1], pk[2], pk[3]);
    d[1] = make_uint4(pk[4], pk[5], pk[6], pk[7]);
    d[2] = make_uint4(pk[8], pk[9], pk[10], pk[11]);
    d[3] = make_uint4(pk[12], pk[13], pk[14], pk[15]);
  }
  __syncthreads();
}

__device__ void phase_convert(const Params& p, char* smem) {
  constexpr int PER = 2736;
  for (int t = blockIdx.x; t < 2 * PER; t += gridDim.x) {
    int l = t / PER, r = t % PER;
    if (r < 1296) {
      int nt = r / 8, kt = r % 8;
      transpose_tile(p.in[12] + (size_t)l * DM * INC, INC, p.wt_in + (size_t)l * NIN * WLD1, WLD1, kt * 128, nt * 64, 1, smem);
    } else if (r < 1808) {
      r -= 1296; int nt = r / 8, kt = r % 8;
      transpose_tile(p.in[33] + (size_t)l * DM * DFF, DFF, p.wt_ff1 + (size_t)l * DFF * WLD1, WLD1, kt * 128, nt * 64, 0, smem);
    } else if (r < 2320) {
      r -= 1808; int nt = r / 32, kt = r % 32;
      transpose_tile(p.in[34] + (size_t)l * DFF * DM, DM, p.wt_ff2 + (size_t)l * DM * WLD4, WLD4, kt * 128, nt * 64, 0, smem);
    } else if (r < 2448) {
      r -= 2320; int nt = r / 8, kt = r % 8;
      transpose_tile(p.in[32] + (size_t)l * DM * DM, DM, p.wt_out + (size_t)l * DM * WLD1, WLD1, kt * 128, nt * 64, 0, smem);
    } else if (r < 2704) {
      r -= 2448; int b = r / 64; r %= 64; int nt = r / 4, kt = r % 4;
      transpose_tile(p.in[31] + (size_t)(l * 4 + b) * 512 * DM, DM, p.wt_br + (size_t)(l * 4 + b) * DM * WLD5, WLD5, kt * 128, nt * 64, 0, smem);
    } else {
      r -= 2704; int nt = r / 4, kt = r % 4;
      transpose_tile(p.in[30] + (size_t)l * 512 * 512, 512, p.wt_glu + (size_t)l * 512 * WLD5, WLD5, kt * 128, nt * 64, 0, smem);
    }
  }
}

__device__ void phase_rownorm(const Params& p, bool from_input, const float* __restrict__ t, const float* __restrict__ gpost,
                              const float* __restrict__ gpre, u16* __restrict__ hout) {
  const int lane = tidq() & 63, w = tidq() >> 6;
  float* xbuf = p.out;
  for (int row = blockIdx.x * 4 + w; row < MTOK; row += gridDim.x * 4) {
    const float* xin = from_input ? (row < MPR ? p.in[0] + (size_t)row * DM : p.in[1] + (size_t)(row - MPR) * DM)
                                  : xbuf + (size_t)row * DM;
    float4 x[4];
#pragma unroll
    for (int k = 0; k < 4; ++k) x[k] = *(const float4*)(xin + lane * 4 + 256 * k);
    if (t) {
      float4 tv[4];
      float ss = 0.f;
#pragma unroll
      for (int k = 0; k < 4; ++k) {
        if (gridDim.x == 512 && row >= MPR) {
          const float* pp = (const float*)p.obuf + (size_t)(row - MPR) * DM + lane * 4 + 256 * k;
          float4 a = *(const float4*)pp;
#pragma unroll
          for (int sl = 1; sl < 8; ++sl) {
            const float4 b = *(const float4*)(pp + (size_t)sl * 1024 * 1024);
            a.x += b.x; a.y += b.y; a.z += b.z; a.w += b.w;
          }
          tv[k] = a;
        } else {
          tv[k] = *(const float4*)(t + (size_t)row * DM + lane * 4 + 256 * k);
        }
        ss += tv[k].x * tv[k].x + tv[k].y * tv[k].y + tv[k].z * tv[k].z + tv[k].w * tv[k].w;
      }
      ss = wave_sum(ss);
      float r = rsqrtf(ss * (1.f / DM) + EPS);
#pragma unroll
      for (int k = 0; k < 4; ++k) {
        float4 g = *(const float4*)(gpost + lane * 4 + 256 * k);
        x[k].x += tv[k].x * r * g.x; x[k].y += tv[k].y * r * g.y; x[k].z += tv[k].z * r * g.z; x[k].w += tv[k].w * r * g.w;
      }
    }
#pragma unroll
    for (int k = 0; k < 4; ++k) *(float4*)(xbuf + (size_t)row * DM + lane * 4 + 256 * k) = x[k];
    if (hout) {
      float ss = 0.f;
#pragma unroll
      for (int k = 0; k < 4; ++k) ss += x[k].x * x[k].x + x[k].y * x[k].y + x[k].z * x[k].z + x[k].w * x[k].w;
      ss = wave_sum(ss);
      float r = rsqrtf(ss * (1.f / DM) + EPS);
#pragma unroll
      for (int k = 0; k < 4; ++k) {
        float4 g = *(const float4*)(gpre + lane * 4 + 256 * k);
        uint2 o;
        o.x = pack2(x[k].x * r * g.x, x[k].y * r * g.y);
        o.y = pack2(x[k].z * r * g.z, x[k].w * r * g.w);
        *(uint2*)(hout + (size_t)row * HLD + lane * 4 + 256 * k) = o;
      }
    }
  }
}

DI int swz(int r, int c) { return r * 128 + ((c ^ ((r >> 1) & 7)) << 4); }

#define GEMM_COMPUTE(AS_) do { const char* as_ = (AS_); const char* bs_ = as_ + 16384; \
  _Pragma("unroll") for (int s_ = 0; s_ < 2; ++s_) { \
    bf16x8 af_[4], bfr_[4]; \
    _Pragma("unroll") for (int i_ = 0; i_ < 4; ++i_) af_[i_] = *(const bf16x8*)(as_ + swz(wm * 64 + i_ * 16 + r16, s_ * 4 + quad)); \
    _Pragma("unroll") for (int j_ = 0; j_ < 4; ++j_) bfr_[j_] = *(const bf16x8*)(bs_ + swz(wn * 64 + j_ * 16 + r16, s_ * 4 + quad)); \
    _Pragma("unroll") for (int i_ = 0; i_ < 4; ++i_) \
      _Pragma("unroll") for (int j_ = 0; j_ < 4; ++j_) acc[i_][j_] = MFMA16(bfr_[j_], af_[i_], acc[i_][j_]); \
  } } while (0)

struct Stage { u32x4 a0, a1, a2, a3, b0, b1, b2, b3; };
DI void gload(Stage& s, const u16* ag, const u16* bg, int lda, int ldb, int kt) {
  s.a0 = *(const u32x4*)(ag + (size_t)0 * 32 * lda + kt * 64);
  s.a1 = *(const u32x4*)(ag + (size_t)1 * 32 * lda + kt * 64);
  s.a2 = *(const u32x4*)(ag + (size_t)2 * 32 * lda + kt * 64);
  s.a3 = *(const u32x4*)(ag + (size_t)3 * 32 * lda + kt * 64);
  s.b0 = *(const u32x4*)(bg + (size_t)0 * 32 * ldb + kt * 64);
  s.b1 = *(const u32x4*)(bg + (size_t)1 * 32 * ldb + kt * 64);
  s.b2 = *(const u32x4*)(bg + (size_t)2 * 32 * ldb + kt * 64);
  s.b3 = *(const u32x4*)(bg + (size_t)3 * 32 * ldb + kt * 64);
}
DI void lwrite(const Stage& s, char* d, int lr, int lc) {
  *(u32x4*)(d + swz(lr, lc)) = s.a0;
  *(u32x4*)(d + swz(lr + 32, lc)) = s.a1;
  *(u32x4*)(d + swz(lr + 64, lc)) = s.a2;
  *(u32x4*)(d + swz(lr + 96, lc)) = s.a3;
  *(u32x4*)(d + 16384 + swz(lr, lc)) = s.b0;
  *(u32x4*)(d + 16384 + swz(lr + 32, lc)) = s.b1;
  *(u32x4*)(d + 16384 + swz(lr + 64, lc)) = s.b2;
  *(u32x4*)(d + 16384 + swz(lr + 96, lc)) = s.b3;
}

template <bool DEEP>
DI void gemm_kloop(f32x4 (&acc)[4][4], const u16* __restrict__ A, int lda, const u16* __restrict__ Bt, int ldb,
                   int K, int m0, int n0, char* smem) {
  const int tid = tidq(), lane = tid & 63, w = tid >> 6, wm = w >> 1, wn = w & 1, r16 = lane & 15, quad = lane >> 4;
  const int lr = tid >> 3, lc = tid & 7;
  const u16* ag = A + (size_t)(m0 + lr) * lda + lc * 8;
  const u16* bg = Bt + (size_t)(n0 + lr) * ldb + lc * 8;
  const int nk = K >> 6;
  Stage s0;
  gload(s0, ag, bg, lda, ldb, 0);
  if (DEEP) {
    Stage s1;
    gload(s1, ag, bg, lda, ldb, 1);
    lwrite(s0, smem, lr, lc);
    __syncthreads();
    for (int kt = 0; kt < nk; kt += 2) {
      if (kt + 2 < nk) gload(s0, ag, bg, lda, ldb, kt + 2);
      GEMM_COMPUTE(smem);
      lwrite(s1, smem + 32768, lr, lc);
      __syncthreads();
      if (kt + 3 < nk) gload(s1, ag, bg, lda, ldb, kt + 3);
      GEMM_COMPUTE(smem + 32768);
      if (kt + 2 < nk) lwrite(s0, smem, lr, lc);
      __syncthreads();
    }
  } else {
    lwrite(s0, smem, lr, lc);
    __syncthreads();
    for (int kt = 0; kt < nk; ++kt) {
      const bool more = (kt + 1 < nk);
      if (more) gload(s0, ag, bg, lda, ldb, kt + 1);
      GEMM_COMPUTE(smem + (kt & 1) * 32768);
      if (more) lwrite(s0, smem + ((kt + 1) & 1) * 32768, lr, lc);
      __syncthreads();
    }
  }
}

DI void zero_acc(f32x4 (&acc)[4][4]) {
#pragma unroll
  for (int i = 0; i < 4; ++i)
#pragma unroll
    for (int j = 0; j < 4; ++j) acc[i][j] = f32x4{0.f, 0.f, 0.f, 0.f};
}

enum { EPI_BF16 = 0, EPI_SIG = 1, EPI_RELU2 = 2, EPI_F32 = 3, EPI_GLU = 4 };

template <int EPI>
DI void gemm_epilogue(f32x4 (&acc)[4][4], int m0, int n0, void* outp, int ldc, const u16* aux, int ldaux) {
  const int lane = tidq() & 63, w = tidq() >> 6, wm = w >> 1, wn = w & 1, r16 = lane & 15, quad = lane >> 4;
#pragma unroll
  for (int i = 0; i < 4; ++i) {
    const int m = m0 + wm * 64 + i * 16 + r16;
#pragma unroll
    for (int j = 0; j < 4; ++j) {
      const int n = n0 + wn * 64 + j * 16 + quad * 4;
      f32x4 v = acc[i][j];
      if (EPI == EPI_F32) {
        *(float4*)((float*)outp + (size_t)m * ldc + n) = make_float4(v[0], v[1], v[2], v[3]);
      } else {
        if (EPI == EPI_SIG) {
#pragma unroll
          for (int x = 0; x < 4; ++x) v[x] = sigmoidf_(v[x]);
        } else if (EPI == EPI_RELU2) {
#pragma unroll
          for (int x = 0; x < 4; ++x) { float r = fmaxf(v[x], 0.f); v[x] = r * r; }
        } else if (EPI == EPI_GLU) {
          uint2 zz = *(const uint2*)(aux + (size_t)m * ldaux + n);
          v[0] = bf2f((u16)(zz.x & 0xffff)) * sigmoidf_(v[0]);
          v[1] = bf2f((u16)(zz.x >> 16)) * sigmoidf_(v[1]);
          v[2] = bf2f((u16)(zz.y & 0xffff)) * sigmoidf_(v[2]);
          v[3] = bf2f((u16)(zz.y >> 16)) * sigmoidf_(v[3]);
        }
        uint2 o; o.x = pack2(v[0], v[1]); o.y = pack2(v[2], v[3]);
        *(uint2*)((u16*)outp + (size_t)m * ldc + n) = o;
      }
      acc[i][j] = f32x4{0.f, 0.f, 0.f, 0.f};
    }
  }
}

DI bool tile_at(int i, int T, int& t);
DI void tile_mn(int t, int nN, int& m0, int& n0);

template <int EPI>
DI void gemm_stream(const u16* __restrict__ A, int lda, const u16* __restrict__ Bt, int ldb, int K, int nN, int T,
                    void* outp, int ldc, const u16* aux, int ldaux, char* smem) {
  const int tid = tidq(), lane = tid & 63, w = tid >> 6, wm = w >> 1, wn = w & 1, r16 = lane & 15, quad = lane >> 4;
  const int lr = tid >> 3, lc = tid & 7;
  asm volatile("" : "+s"(lda), "+s"(ldb), "+s"(K));
  const int nk = K >> 6;
  int t, m0, n0, m1 = 0, n1 = 0;
  if (!tile_at(0, T, t)) return;
  tile_mn(t, nN, m0, n0);
  const size_t aoff = (size_t)lr * lda + lc * 8, boff = (size_t)lr * ldb + lc * 8;
  const u16* ag = A + (size_t)m0 * lda + aoff;
  const u16* bg = Bt + (size_t)n0 * ldb + boff;
  f32x4 acc[4][4];
  zero_acc(acc);
  Stage s0, s1;
  gload(s0, ag, bg, lda, ldb, 0);
  gload(s1, ag, bg, lda, ldb, 1);
  lwrite(s0, smem, lr, lc);
  __syncthreads();
  for (int i = 0;; ++i) {
    const bool has_next = tile_at(i + 1, T, t);
    if (has_next) tile_mn(t, nN, m1, n1);
    const u16* agn = A + (size_t)m1 * lda + aoff;
    const u16* bgn = Bt + (size_t)n1 * ldb + boff;
    for (int kt = 0; kt < nk; kt += 2) {
      if (kt + 2 < nk) gload(s0, ag, bg, lda, ldb, kt + 2);
      else if (has_next) gload(s0, agn, bgn, lda, ldb, 0);
      GEMM_COMPUTE(smem);
      lwrite(s1, smem + 32768, lr, lc);
      __syncthreads();
      if (kt + 2 < nk) gload(s1, ag, bg, lda, ldb, kt + 3);
      else if (has_next) gload(s1, agn, bgn, lda, ldb, 1);
      GEMM_COMPUTE(smem + 32768);
      if (kt + 2 < nk || has_next) lwrite(s0, smem, lr, lc);
      __syncthreads();
    }
    gemm_epilogue<EPI>(acc, m0, n0, outp, ldc, aux, ldaux);
    if (!has_next) break;
    m0 = m1; n0 = n1; ag = agn; bg = bgn;
  }
}

DI void gemm_stream_split(const u16* __restrict__ A, int lda, const u16* __restrict__ Bt, int ldb, int K,
                          float* outp, float* part, char* smem) {
  const int tid = tidq(), lane = tid & 63, w = tid >> 6, wm = w >> 1, wn = w & 1, r16 = lane & 15, quad = lane >> 4;
  const int lr = tid >> 3, lc = tid & 7;
  asm volatile("" : "+s"(lda), "+s"(ldb), "+s"(K));
  const int nk = K >> 6, nks = nk >> 3;
  const size_t aoff = (size_t)lr * lda + lc * 8, boff = (size_t)lr * ldb + lc * 8;
  const int slice = blockIdx.x & 7, tl = blockIdx.x >> 3;
  int t, m0, n0, m1 = 0, n1 = 0;
  tile_at(0, 1024, t);
  tile_mn(t, 8, m0, n0);
  const u16* ag = A + (size_t)m0 * lda + aoff;
  const u16* bg = Bt + (size_t)n0 * ldb + boff;
  int nku = nk;
  f32x4 acc[4][4];
  zero_acc(acc);
  Stage s0, s1;
  gload(s0, ag, bg, lda, ldb, 0);
  gload(s1, ag, bg, lda, ldb, 1);
  lwrite(s0, smem, lr, lc);
  __syncthreads();
  for (int u = 0; u < 3; ++u) {
    const bool has_next = (u < 2);
    int nkn = nk;
    const u16* agn = ag;
    const u16* bgn = bg;
    if (u == 0) {
      tile_at(1, 1024, t);
      tile_mn(t, 8, m1, n1);
      agn = A + (size_t)m1 * lda + aoff;
      bgn = Bt + (size_t)n1 * ldb + boff;
    } else if (u == 1) {
      m1 = MPR + (tl >> 3) * 128; n1 = (tl & 7) * 128;
      agn = A + (size_t)m1 * lda + aoff + (size_t)slice * nks * 64;
      bgn = Bt + (size_t)n1 * ldb + boff + (size_t)slice * nks * 64;
      nkn = nks;
    }
    for (int kt = 0; kt < nku; kt += 2) {
      if (kt + 2 < nku) gload(s0, ag, bg, lda, ldb, kt + 2);
      else if (has_next) gload(s0, agn, bgn, lda, ldb, 0);
      GEMM_COMPUTE(smem);
      lwrite(s1, smem + 32768, lr, lc);
      __syncthreads();
      if (kt + 2 < nku) gload(s1, ag, bg, lda, ldb, kt + 3);
      else if (has_next) gload(s1, agn, bgn, lda, ldb, 1);
      GEMM_COMPUTE(smem + 32768);
      if (kt + 2 < nku || has_next) lwrite(s0, smem, lr, lc);
      __syncthreads();
    }
    if (u < 2) gemm_epilogue<EPI_F32>(acc, m0, n0, outp, DM, nullptr, 0);
    else gemm_epilogue<EPI_F32>(acc, m0 - MPR, n0, part + (size_t)slice * 1024 * 1024, DM, nullptr, 0);
    m0 = m1; n0 = n1; ag = agn; bg = bgn; nku = nkn;
  }
}

DI void merge_tile(const Params& p, int l, int m0, int n0, char* smem) {
  f32x4 macc[4][4];
  zero_acc(macc);
  const int lane = tidq() & 63, w = tidq() >> 6, wm = w >> 1, wn = w & 1, r16 = lane & 15, quad = lane >> 4;
  const u16* gates = p.pbuf;
  for (int b = 0; b < 4; ++b) {
    f32x4 acc[4][4];
    zero_acc(acc);
    gemm_kloop<false>(acc, p.obuf + b * 512, OLD, p.wt_br + (size_t)(l * 4 + b) * DM * WLD5, WLD5, 512, m0, n0, smem);
#pragma unroll
    for (int i = 0; i < 4; ++i) {
      const int m = m0 + wm * 64 + i * 16 + r16;
#pragma unroll
      for (int j = 0; j < 4; ++j) {
        const int n = n0 + wn * 64 + j * 16 + quad * 4;
        uint2 gg = *(const uint2*)(gates + (size_t)m * 4096 + b * 1024 + n);
        macc[i][j][0] += bf2f((u16)(gg.x & 0xffff)) * acc[i][j][0];
        macc[i][j][1] += bf2f((u16)(gg.x >> 16)) * acc[i][j][1];
        macc[i][j][2] += bf2f((u16)(gg.y & 0xffff)) * acc[i][j][2];
        macc[i][j][3] += bf2f((u16)(gg.y >> 16)) * acc[i][j][3];
      }
    }
  }
#pragma unroll
  for (int i = 0; i < 4; ++i) {
    const int m = m0 + wm * 64 + i * 16 + r16;
#pragma unroll
    for (int j = 0; j < 4; ++j) {
      const int n = n0 + wn * 64 + j * 16 + quad * 4;
      uint2 o; o.x = pack2(macc[i][j][0], macc[i][j][1]); o.y = pack2(macc[i][j][2], macc[i][j][3]);
      *(uint2*)(p.hb + (size_t)m * HLD + n) = o;
    }
  }
}

constexpr int QS = 136;
constexpr int TS = 20;
constexpr int OFS = 260;

template <int MODE>
__device__ void run_chain(const Params& p, int l, int seq, int sub, int seg, int pass, char* smem) {
  constexpr int NE = 2;
  const int tid = tidq(), lane = tid & 63, w = tid >> 6, r16 = lane & 15, quad = lane >> 4;
  const bool prompt = seq < 8;
  const int bidx = prompt ? seq : seq - 8;
  const int NB = prompt ? 8 : 128;
  const int L = prompt ? 2048 : 8;
  const int row0 = prompt ? seq * 2048 : MPR + (seq - 8) * 8;
  const int pos0 = prompt ? 0 : 16384;
  const int cps = p.cps;
  const int ch_begin = prompt ? seg * cps : 0;
  const int ch_end = prompt ? ch_begin + cps : 1;
  const bool light = prompt && (pass == 1);
  const bool last_seg = !prompt || (seg == p.nseg - 1);
  const int cid = seq * 12 + MODE * 4 + sub;

  u16* Qa = (u16*)smem;
  u16* Ka = (u16*)(smem + 4352);
  u16* KuT = (u16*)(smem + 8704);
  u16* VaT = (u16*)(smem + 13824);
  u16* VuT = (MODE == 1) ? (u16*)(smem + 18944) : VaT;
  float* Of = (float*)(smem + 24064);
  u16* Raw = (u16*)(smem + 40704);
  u16* Xc = (u16*)(smem + 53248);
  float* tot = (float*)(smem + 57344);
  float* cdec = (float*)(smem + 58368);
  float* dtl = (float*)(smem + 58624);
  float* rsc = (float*)(smem + 58880);
  float* clast = (float*)(smem + 59392);
  float* segacc = (float*)(smem + 59408);

  const float* sin_ = nullptr;
  float* sout = nullptr;
  if (MODE == 0) {
    if (!prompt) sin_ = p.in[2] + (((size_t)l * 128 + bidx) * 4 + sub) * 16384;
    sout = p.out + (prompt ? p.o_ret_p : p.o_ret_s) + (((size_t)l * NB + bidx) * 4 + sub) * 16384;
  } else if (MODE == 2) {
    if (!prompt) sin_ = p.in[5] + (((size_t)l * 128 + bidx) * 4 + sub) * 16384;
    sout = p.out + (prompt ? p.o_hg_p : p.o_hg_s) + (((size_t)l * NB + bidx) * 4 + sub) * 16384;
  } else {
    if (!prompt) sin_ = p.in[3] + (((size_t)l * 128 + bidx) * 8 + sub * 2 + (w >> 1)) * 8192;
    sout = p.out + (prompt ? p.o_ssd_p : p.o_ssd_s) + (((size_t)l * NB + bidx) * 8 + sub * 2 + (w >> 1)) * 8192;
  }

  float lg = 0.f;
  if (MODE == 0) lg = log1pf(-exp2f(-5.f - (float)sub));

  int sbase = (MODE == 1) ? (((w & 1) * 32 + r16) * 128 + quad * 4) : (quad * 512 + w * 32 + r16);
  asm volatile("" : "+v"(sbase));
  f32x4 S[8][NE];
#pragma unroll
  for (int t = 0; t < 8; ++t)
#pragma unroll
    for (int u = 0; u < NE; ++u) {
      if (sin_) {
        if (MODE == 1) {
          S[t][u] = *(const f32x4*)(sin_ + sbase + u * 2048 + t * 16);
        } else {
#pragma unroll
          for (int jj = 0; jj < 4; ++jj) S[t][u][jj] = sin_[sbase + t * 2048 + jj * 128 + u * 16];
        }
      } else {
        S[t][u] = f32x4{0.f, 0.f, 0.f, 0.f};
      }
    }
  if (prompt && pass == 2) {
    for (int r = 0; r < seg; ++r) {
      const uint2* sl = (const uint2*)(p.slocal + (size_t)(cid * (p.nseg - 1) + r) * 16384) + tid;
      const float* sd = p.segdec + (size_t)(cid * 7 + r) * 128;
      float dsc = 1.f;
      if (MODE == 0) dsc = __expf(lg * (float)(16 * cps));
      if (MODE == 1) dsc = __expf(sd[w >> 1]);
#pragma unroll
      for (int t = 0; t < 8; ++t) {
        f32x4 dv = f32x4{dsc, dsc, dsc, dsc};
        if (MODE == 2) {
          f32x4 lv = *(const f32x4*)(sd + t * 16 + quad * 4);
          dv = f32x4{__expf(lv[0]), __expf(lv[1]), __expf(lv[2]), __expf(lv[3])};
        }
#pragma unroll
        for (int u = 0; u < NE; ++u) {
          uint2 pk = sl[(t * NE + u) * 256];
          S[t][u][0] = S[t][u][0] * dv[0] + bf2f((u16)(pk.x & 0xffff));
          S[t][u][1] = S[t][u][1] * dv[1] + bf2f((u16)(pk.x >> 16));
          S[t][u][2] = S[t][u][2] * dv[2] + bf2f((u16)(pk.y & 0xffff));
          S[t][u][3] = S[t][u][3] * dv[3] + bf2f((u16)(pk.y >> 16));
        }
      }
    }
  }

  float lbv = 0.f;
  float hg_tot = 0.f;
  float cprev[2][3];
  float cw[2][4], cb[2];
  int ccidx[2];
  float dt_bias = 0.f, dt_A = 0.f;
  float rinv = 0.f, rcD = 1.f, rsD = 0.f;
  const int gg = sub >> 1, pair = sub & 1;
  if (MODE == 0) {
    rinv = exp2f(-(float)(tid & 63) * (13.287712379549449f / 64.f));
    rsD = __sinf(rinv); rcD = __cosf(rinv);
  }
  if (MODE == 2) {
    if (l == 1) {
      float a0 = p.in[20][sub * 128 + (tid & 127)], a1 = p.in[20][512 + sub * 128 + (tid & 127)];
      float mx = fmaxf(a0, a1);
      float e0 = __expf(a0 - mx), e1 = __expf(a1 - mx);
      lbv = e1 / (e0 + e1);
    }
  }
  if (MODE == 1) {
    if (tid < 32) {
      const int hh = sub * 2 + (tid >> 4);
      dt_A = -__expf(p.in[16][l * 8 + hh]);
      dt_bias = p.in[17][l * 8 + hh];
    }
    if (tid < 2) segacc[tid] = 0.f;
#pragma unroll
    for (int k = 0; k < 2; ++k) {
      int ci = tid + 256 * k;
      int cc = 0;
      if (ci < 128) cc = gg * 256 + pair * 128 + ci;
      else if (ci < 256) cc = 512 + gg * 128 + (ci - 128);
      else cc = 768 + gg * 128 + (ci - 256);
      if (ci >= 384) cc = 0;
      ccidx[k] = cc;
#pragma unroll
      for (int j = 0; j < 4; ++j) cw[k][j] = p.in[14][((size_t)l * 4 + j) * 1024 + cc];
      cb[k] = p.in[15][l * 1024 + cc];
#pragma unroll
      for (int j = 0; j < 3; ++j) {
        float v = 0.f;
        if (!prompt) v = p.in[4][(((size_t)l * 128 + bidx) * 3 + j) * 1024 + cc];
        else if (ch_begin > 0) v = bf2f(p.pbuf[(size_t)(row0 + ch_begin * 16 - 3 + j) * NP + C_SXBC + cc]);
        cprev[k][j] = v;
      }
    }
  }

  float fgain[8];
  {
    const int eg_ = tid & 15;
#pragma unroll
    for (int x = 0; x < 8; ++x) {
      if (MODE == 0) fgain[x] = p.in[13][(l * 4 + sub) * 128 + eg_ * 8 + x];
      else if (MODE == 2) fgain[x] = p.in[21][l * 128 + eg_ * 8 + x];
      else fgain[x] = p.in[18][l * 8 + sub * 2 + ((eg_ * 8) >> 6)];
    }
  }
  const int lt = tid >> 4, lc = tid & 15;
  uint4 r0, r1, r2, g0;
  unsigned rdt = 0;
  const uint4 z4 = make_uint4(0, 0, 0, 0);
  r0 = r1 = r2 = g0 = z4;
  auto load_raw = [&](int ch) {
    const int t0 = ch * 16;
    const int nv = (L - t0 < 16) ? (L - t0) : 16;
    const u16* Pr = p.pbuf + (size_t)(row0 + t0 + lt) * NP;
    r0 = r1 = r2 = g0 = z4;
    rdt = 0;
    if (lt < nv) {
      if (MODE == 0) {
        r0 = *(const uint4*)(Pr + C_RQ + sub * 128 + lc * 8);
        r1 = *(const uint4*)(Pr + C_RK + sub * 128 + lc * 8);
        r2 = *(const uint4*)(Pr + C_RV + sub * 128 + lc * 8);
        g0 = *(const uint4*)(Pr + C_RG + sub * 128 + lc * 8);
      } else if (MODE == 2) {
        r0 = *(const uint4*)(Pr + C_HQ + sub * 128 + lc * 8);
        r1 = *(const uint4*)(Pr + C_HF + sub * 128 + lc * 8);
        r2 = *(const uint4*)(Pr + C_HI + sub * 128 + lc * 8);
        g0 = *(const uint4*)(Pr + C_HG + sub * 128 + lc * 8);
      } else {
        r0 = *(const uint4*)(Pr + C_SXBC + gg * 256 + pair * 128 + lc * 8);
        r1 = *(const uint4*)(Pr + C_SXBC + 512 + gg * 128 + lc * 8);
        r2 = *(const uint4*)(Pr + C_SXBC + 768 + gg * 128 + lc * 8);
        g0 = *(const uint4*)(Pr + C_SZ + gg * 256 + pair * 128 + lc * 8);
        if (lc < 2) rdt = Pr[C_SDT + sub * 2 + lc];
      }
    }
  };
  load_raw(ch_begin);

  for (int ch = ch_begin; ch < ch_end; ++ch) {
    const int t0 = ch * 16;
    const int nvalid = (L - t0 < 16) ? (L - t0) : 16;
    float sscale = 1.f;
    int tidv = threadIdx.x;
    asm volatile("" : "+v"(tidv));
    const int tid = tidv, lane = tid & 63, w = tid >> 6, r16 = lane & 15, quad = lane >> 4, lt = tid >> 4, lc = tid & 15;

    *(uint4*)(Raw + lt * 128 + lc * 8) = r0;
    *(uint4*)(Raw + 2048 + lt * 128 + lc * 8) = r1;
    *(uint4*)(Raw + 4096 + lt * 128 + lc * 8) = r2;
    if (MODE == 1) { if (lc < 2) Raw[6144 + lt * 2 + lc] = (u16)rdt; }
    const uint4 gc0 = g0;
    __syncthreads();
    if (ch + 1 < ch_end) load_raw(ch + 1);

    if (MODE == 0) {
      const int which = tid >> 7, pr = tid & 63, th = (tid >> 6) & 1;
      if (which == 1 || !light) {
        const u16* R = Raw + which * 2048;
        float sn, cs;
        sincos_red((float)(pos0 + t0 + th * 8) * rinv, sn, cs);
#pragma unroll
        for (int x = 0; x < 8; ++x) {
          const int t = th * 8 + x;
          float x1 = bf2f(R[t * 128 + pr]);
          float x2 = bf2f(R[t * 128 + pr + 64]);
          float y1 = x1 * cs - x2 * sn, y2 = x1 * sn + x2 * cs;
          if (which) {
            y1 *= 0.08838834764831845f; y2 *= 0.08838834764831845f;
            Ka[t * QS + pr] = f2bf(y1); Ka[t * QS + pr + 64] = f2bf(y2);
            float kd = __expf(lg * (float)(nvalid - 1 - t));
            KuT[pr * TS + t] = f2bf(y1 * kd);
            KuT[(pr + 64) * TS + t] = f2bf(y2 * kd);
          } else {
            Qa[t * QS + pr] = f2bf(y1); Qa[t * QS + pr + 64] = f2bf(y2);
          }
          float ncs = cs * rcD - sn * rsD;
          sn = sn * rcD + cs * rsD; cs = ncs;
        }
      }
      if (tid < 16) cdec[tid] = lg * (float)(tid + 1);
      sscale = __expf(lg * (float)nvalid);
    } else if (MODE == 2) {
      const int d = tid & 127, th = tid >> 7;
      float cl[8], kk[8], qv[8];
      float c = 0.f;
#pragma unroll
      for (int x = 0; x < 8; ++x) {
        const int t = th * 8 + x;
        kk[x] = 0.f; qv[x] = 0.f;
        if (t < nvalid) {
          float z = bf2f(Raw[2048 + t * 128 + d]);
          float sg = sigmoidf_(z);
          float f = lbv + (1.f - lbv) * sg;
          c += __logf(f);
          kk[x] = (1.f - lbv) * (1.f - sg);
          if (!light) qv[x] = siluf_(bf2f(Raw[t * 128 + d]));
        }
        cl[x] = c;
      }
      tot[th * 128 + d] = c;
      __syncthreads();
      const float c_lo = tot[d];
      const float c_all = c_lo + tot[128 + d];
      const float off = th ? c_lo : 0.f;
      const float e_all = __expf(c_all);
#pragma unroll
      for (int x = 0; x < 8; ++x) {
        const int t = th * 8 + x;
        const float ct = off + cl[x];
        const float ein = __expf(-ct);
        if (!light) {
          Qa[t * QS + d] = f2bf(qv[x] * __frcp_rn(ein));
          Ka[t * QS + d] = f2bf(kk[x] * ein);
        }
        KuT[d * TS + t] = f2bf(kk[x] * ein * e_all);
      }
      if (th == 0) { rsc[d] = e_all; hg_tot += c_all; }
    } else {
      if (tid < 32) {
        const int hl = tid >> 4, t = tid & 15;
        float dtv = 0.f, c = 0.f;
        if (t < nvalid) {
          dtv = softplusf_(bf2f(Raw[6144 + t * 2 + hl]) + dt_bias);
          c = dtv * dt_A;
        }
#pragma unroll
        for (int o = 1; o < 16; o <<= 1) {
          float v = __shfl_up(c, o, 16);
          if (t >= o) c += v;
        }
        cdec[hl * 16 + t] = c;
        dtl[hl * 16 + t] = dtv;
        if (t == 15) { clast[hl] = c; segacc[hl] += c; }
      }
      __syncthreads();
#pragma unroll
      for (int k = 0; k < 2; ++k) {
        const int ci = tid + 256 * k;
        if (ci < 256 || (ci < 384 && !light)) {
          const int hl = (ci < 128) ? (ci >> 6) : 0;
          const float cl = clast[hl];
          const u16* R = Raw + ((ci < 128) ? ci : ((ci < 256) ? (2048 + (ci - 128)) : (4096 + (ci - 256))));
#pragma unroll 4
          for (int t = 0; t < 16; ++t) {
            float v = 0.f;
            if (t < nvalid) {
              float raw = bf2f(R[t * 128]);
              float o = cb[k] + cprev[k][0] * cw[k][0] + cprev[k][1] * cw[k][1] + cprev[k][2] * cw[k][2] + raw * cw[k][3];
              cprev[k][0] = cprev[k][1]; cprev[k][1] = cprev[k][2]; cprev[k][2] = raw;
              v = siluf_(o);
            }
            if (ci < 128) {
              float dtv = dtl[hl * 16 + t];
              if (!light) { Xc[t * 128 + ci] = f2bf(v); VaT[ci * TS + t] = f2bf(v * dtv); }
              VuT[ci * TS + t] = f2bf(v * dtv * __expf(cl - cdec[hl * 16 + t]));
            } else if (ci < 256) {
              u16 a = f2bf(v);
              if (!light) Ka[t * QS + (ci - 128)] = a;
              KuT[(ci - 128) * TS + t] = a;
            } else {
              Qa[t * QS + (ci - 256)] = f2bf(v);
            }
          }
        }
      }
    }
    if (MODE != 1) {
      const int e = tid & 127, th = tid >> 7;
#pragma unroll
      for (int x = 0; x < 4; ++x) {
        const int t = th * 8 + 2 * x;
        unsigned lo = Raw[4096 + t * 128 + e], hi = Raw[4096 + (t + 1) * 128 + e];
        *(unsigned*)(VaT + e * TS + t) = lo | (hi << 16);
      }
    }
    __syncthreads();

    {
      const float* cd = cdec + ((MODE == 1) ? (w >> 1) * 16 : 0);
      bf16x8 attA;
      float rr[4];
      bf16x8 qf[4];
      if (!light) {
        f32x4 at = f32x4{0.f, 0.f, 0.f, 0.f};
#pragma unroll
        for (int s = 0; s < 4; ++s) {
          bf16x8 a = *(const bf16x8*)(Ka + r16 * QS + s * 32 + quad * 8);
          bf16x8 b = *(const bf16x8*)(Qa + r16 * QS + s * 32 + quad * 8);
          at = MFMA16(a, b, at);
        }
        float ci_ = (MODE != 2) ? cd[r16] : 0.f;
        float vv[4];
#pragma unroll
        for (int jj = 0; jj < 4; ++jj) {
          int j = quad * 4 + jj;
          float v = at[jj];
          if (MODE != 2) v *= __expf(fminf(ci_ - cd[j], 0.f));
          vv[jj] = (j <= r16) ? v : 0.f;
        }
        unsigned a01 = pack2(vv[0], vv[1]), a23 = pack2(vv[2], vv[3]);
        attA = __builtin_bit_cast(bf16x8, (u32x4){a01, a23, 0u, 0u});
#pragma unroll
        for (int jj = 0; jj < 4; ++jj) rr[jj] = (MODE != 2) ? __expf(cd[quad * 4 + jj]) : 1.f;
#pragma unroll
        for (int s = 0; s < 4; ++s) {
          bf16x4 lo = *(const bf16x4*)(Qa + r16 * QS + s * 32 + quad * 4);
          bf16x4 hi = *(const bf16x4*)(Qa + r16 * QS + s * 32 + 16 + quad * 4);
          qf[s] = bf16x8{lo[0], lo[1], lo[2], lo[3], hi[0], hi[1], hi[2], hi[3]};
        }
      }
      if (!light) {
#pragma unroll
        for (int u = 0; u < NE; ++u) {
          const int e0 = (w * NE + u) * 16;
          bf16x4 v4 = *(const bf16x4*)(VaT + (e0 + r16) * TS + quad * 4);
          bf16x8 vb = bf16x8{v4[0], v4[1], v4[2], v4[3], 0, 0, 0, 0};
          f32x4 o1 = MFMA16(attA, vb, (f32x4{0.f, 0.f, 0.f, 0.f}));
          f32x4 o2 = f32x4{0.f, 0.f, 0.f, 0.f};
#pragma unroll
          for (int s = 0; s < 4; ++s) {
            u32x4 sp = {pack2(S[2 * s][u][0], S[2 * s][u][1]), pack2(S[2 * s][u][2], S[2 * s][u][3]),
                        pack2(S[2 * s + 1][u][0], S[2 * s + 1][u][1]), pack2(S[2 * s + 1][u][2], S[2 * s + 1][u][3])};
            o2 = MFMA16(qf[s], __builtin_bit_cast(bf16x8, sp), o2);
          }
#pragma unroll
          for (int jj = 0; jj < 4; ++jj) Of[(quad * 4 + jj) * OFS + e0 + r16] = o1[jj] + rr[jj] * o2[jj];
        }
      }
      float hs = 1.f;
      if (MODE == 0) hs = sscale;
      if (MODE == 1) hs = __expf(clast[w >> 1]);
#pragma unroll
      for (int u = 0; u < NE; ++u) {
        const int e0 = (w * NE + u) * 16;
        bf16x4 v4 = *(const bf16x4*)(VuT + (e0 + r16) * TS + quad * 4);
        bf16x8 vb = bf16x8{v4[0], v4[1], v4[2], v4[3], 0, 0, 0, 0};
#pragma unroll
        for (int t = 0; t < 8; ++t) {
          bf16x4 k4 = *(const bf16x4*)(KuT + (t * 16 + r16) * TS + quad * 4);
          bf16x8 ka = bf16x8{k4[0], k4[1], k4[2], k4[3], 0, 0, 0, 0};
          f32x4 sv = S[t][u];
          if (MODE == 2) {
            f32x4 r4 = *(const f32x4*)(rsc + t * 16 + quad * 4);
            sv[0] *= r4[0]; sv[1] *= r4[1]; sv[2] *= r4[2]; sv[3] *= r4[3];
          } else {
            sv[0] *= hs; sv[1] *= hs; sv[2] *= hs; sv[3] *= hs;
          }
          S[t][u] = MFMA16(ka, vb, sv);
        }
      }
    }
    __syncthreads();

    if (!light) {
      const int i = tid >> 4, eg = tid & 15;
      const int grow = row0 + t0 + i;
      unsigned gw[4] = {gc0.x, gc0.y, gc0.z, gc0.w};
      if (MODE == 0 || MODE == 2) {
        float o[8];
#pragma unroll
        for (int x = 0; x < 8; ++x) o[x] = Of[i * OFS + eg * 8 + x];
        float s1 = 0.f;
        float mu = 0.f;
        if (MODE == 0) {
#pragma unroll
          for (int x = 0; x < 8; ++x) s1 += o[x];
          mu = sum16(s1) * (1.f / 128.f);
        }
        float s2 = 0.f;
#pragma unroll
        for (int x = 0; x < 8; ++x) { o[x] -= mu; s2 += o[x] * o[x]; }
        float r = rsqrtf(sum16(s2) * (1.f / 128.f) + EPS);
        if (i < nvalid) {
          float res[8];
#pragma unroll
          for (int x = 0; x < 8; ++x) {
            float g = bf2f((u16)((x & 1) ? (gw[x >> 1] >> 16) : (gw[x >> 1] & 0xffff)));
            float gate = (MODE == 0) ? siluf_(g) : sigmoidf_(g);
            res[x] = o[x] * r * fgain[x] * gate;
          }
          uint4 ov = make_uint4(pack2(res[0], res[1]), pack2(res[2], res[3]), pack2(res[4], res[5]), pack2(res[6], res[7]));
          const int ocol = ((MODE == 0) ? 0 : 1024) + sub * 128 + eg * 8;
          *(uint4*)(p.obuf + (size_t)grow * OLD + ocol) = ov;
        }
      } else {
        float y[8];
        const int chb = eg * 8;
        const float Dh = fgain[0];
        float s2 = 0.f;
#pragma unroll
        for (int x = 0; x < 8; ++x) {
          float g = bf2f((u16)((x & 1) ? (gw[x >> 1] >> 16) : (gw[x >> 1] & 0xffff)));
          float v = Of[i * OFS + chb + x] + bf2f(Xc[i * 128 + chb + x]) * Dh;
          v *= siluf_(g);
          y[x] = v; s2 += v * v;
        }
        s2 = sum16(s2);
        if (i < nvalid) {
          if (eg == 0) p.ssq[(size_t)grow * 4 + sub] = s2;
          uint4 ov = make_uint4(pack2(y[0], y[1]), pack2(y[2], y[3]), pack2(y[4], y[5]), pack2(y[6], y[7]));
          *(uint4*)(p.obuf + (size_t)grow * OLD + 512 + sub * 128 + chb) = ov;
        }
      }
    }
  }
  __syncthreads();

  if (light) {
    uint2* sl = (uint2*)(p.slocal + (size_t)(cid * (p.nseg - 1) + seg) * 16384) + tid;
#pragma unroll
    for (int t = 0; t < 8; ++t)
#pragma unroll
      for (int u = 0; u < NE; ++u)
        sl[(t * NE + u) * 256] = make_uint2(pack2(S[t][u][0], S[t][u][1]), pack2(S[t][u][2], S[t][u][3]));
    float* sd = p.segdec + (size_t)(cid * 7 + seg) * 128;
    if (MODE == 1) { if (tid < 2) sd[tid] = segacc[tid]; }
    if (MODE == 2) { if (tid < 128) sd[tid] = hg_tot; }
  } else if (last_seg) {
    asm volatile("" : "+v"(sbase));
#pragma unroll
    for (int t = 0; t < 8; ++t)
#pragma unroll
      for (int u = 0; u < NE; ++u) {
        if (MODE == 1) {
          *(f32x4*)(sout + sbase + u * 2048 + t * 16) = S[t][u];
        } else {
#pragma unroll
          for (int jj = 0; jj < 4; ++jj) sout[sbase + t * 2048 + jj * 128 + u * 16] = S[t][u][jj];
        }
      }
    if (MODE == 1) {
      float* co = p.out + (prompt ? p.o_conv_p : p.o_conv_s) + ((size_t)l * NB + bidx) * 3 * 1024;
#pragma unroll
      for (int k = 0; k < 2; ++k) {
        const int ci = tid + 256 * k;
        if (ci < 128 || (ci < 384 && pair == 0)) {
#pragma unroll
          for (int j = 0; j < 3; ++j) co[j * 1024 + ccidx[k]] = cprev[k][j];
        }
      }
    }
  }
}

__device__ void run_s5(const Params& p, int l, int seq, int gq, int seg, int pass, char* smem) {
  const int tid = tidq(), lane = tid & 63, w = tid >> 6, r16 = lane & 15, quad = lane >> 4;
  const int g = gq * 4 + w;
  const bool prompt = seq < 8;
  const int bidx = prompt ? seq : seq - 8;
  const int NB = prompt ? 8 : 128;
  const int row0 = prompt ? seq * 2048 : MPR + (seq - 8) * 8;
  const int nch = prompt ? p.cps : 1;
  const int ch_begin = prompt ? seg * nch : 0;
  const int ch_end = ch_begin + nch;
  const int nvalid = prompt ? 16 : 8;
  const bool light = prompt && (pass == 1);
  const bool last_seg = !prompt || (seg == p.nseg - 1);
  char* wb = smem + w * 5120;
  u16* Hs = (u16*)wb;
  u16* Us = (u16*)(wb + 4352);
  const int lg_ = l * 32 + g;

  const float dt = __expf(p.in[29][lg_]);
  float Ar[4][4], Ai[4][4];
  float fre[4], fim[4];
  float dtare[4], thv[4];
#pragma unroll
  for (int i = 0; i < 4; ++i) {
    const int pi = i * 16 + r16;
    const float are = p.in[22][lg_ * 64 + pi], aim = p.in[23][lg_ * 64 + pi];
    const float th = dt * aim;
    float sn, cs; sincos_red(th, sn, cs);
    float shalf, chalf; sincos_red(0.5f * th, shalf, chalf);
    const float em1 = expm1f(dt * are);
    const float mag = em1 + 1.f;
    const float abr = mag * cs, abi = mag * sn;
    const float nre = em1 * cs - 2.f * shalf * shalf, nim = abi;
    const float den = are * are + aim * aim;
    fre[i] = (nre * are + nim * aim) / den; fim[i] = (nim * are - nre * aim) / den;
    dtare[i] = dt * are; thv[i] = th;
    Ar[0][i] = abr; Ai[0][i] = abi;
    Ar[1][i] = abr * abr - abi * abi; Ai[1][i] = 2.f * abr * abi;
    Ar[2][i] = Ar[1][i] * abr - Ai[1][i] * abi; Ai[2][i] = Ar[1][i] * abi + Ai[1][i] * abr;
    Ar[3][i] = Ar[1][i] * Ar[1][i] - Ai[1][i] * Ai[1][i]; Ai[3][i] = 2.f * Ar[1][i] * Ai[1][i];
  }
  bf16x8 Bop[8];
#pragma unroll
  for (int nt = 0; nt < 8; ++nt) {
    const int i = nt & 3;
    u32x4 pk = {0u, 0u, 0u, 0u};
    if (quad < 2) {
      const size_t bo = ((size_t)lg_ * 64 + i * 16 + r16) * 16 + quad * 8;
      const float4 br0 = *(const float4*)(p.in[24] + bo), br1 = *(const float4*)(p.in[24] + bo + 4);
      const float4 bi0 = *(const float4*)(p.in[25] + bo), bi1 = *(const float4*)(p.in[25] + bo + 4);
      const float brv[8] = {br0.x, br0.y, br0.z, br0.w, br1.x, br1.y, br1.z, br1.w};
      const float biv[8] = {bi0.x, bi0.y, bi0.z, bi0.w, bi1.x, bi1.y, bi1.z, bi1.w};
      float v[8];
#pragma unroll
      for (int j = 0; j < 8; ++j)
        v[j] = (nt < 4) ? (fre[i] * brv[j] - fim[i] * biv[j]) : (fre[i] * biv[j] + fim[i] * brv[j]);
      pk = u32x4{pack2(v[0], v[1]), pack2(v[2], v[3]), pack2(v[4], v[5]), pack2(v[6], v[7])};
    }
    Bop[nt] = __builtin_bit_cast(bf16x8, pk);
  }
  bf16x8 Cop[4];
  float Dm[4] = {0.f, 0.f, 0.f, 0.f};
  if (!light) {
#pragma unroll
    for (int s = 0; s < 4; ++s) {
      const int n0 = 32 * s + quad * 8;
      const float* src = ((n0 >= 64) ? p.in[27] : p.in[26]) + ((size_t)lg_ * 16 + r16) * 64 + (n0 & 63);
      const float sg = (n0 >= 64) ? -1.f : 1.f;
      const float4 c0 = *(const float4*)src, c1 = *(const float4*)(src + 4);
      Cop[s] = __builtin_bit_cast(bf16x8, (u32x4{pack2(sg * c0.x, sg * c0.y), pack2(sg * c0.z, sg * c0.w),
                                                 pack2(sg * c1.x, sg * c1.y), pack2(sg * c1.z, sg * c1.w)}));
    }
#pragma unroll
    for (int jj = 0; jj < 4; ++jj) Dm[jj] = p.in[28][lg_ * 16 + quad * 4 + jj];
  }
  float hr[4], hi[4];
#pragma unroll
  for (int i = 0; i < 4; ++i) { hr[i] = 0.f; hi[i] = 0.f; }
  if (!prompt) {
#pragma unroll
    for (int i = 0; i < 4; ++i) {
      hr[i] = p.in[6][((size_t)(l * 128 + bidx) * 32 + g) * 64 + i * 16 + r16];
      hi[i] = p.in[7][((size_t)(l * 128 + bidx) * 32 + g) * 64 + i * 16 + r16];
    }
  } else if (pass == 2 && seg > 0) {
    const float len = (float)(nch * 16);
#pragma unroll
    for (int i = 0; i < 4; ++i) {
      const float pm = __expf(len * dtare[i]);
      float ps, pc; sincos_red(len * thv[i], ps, pc);
      const float pr_ = pm * pc, pi_ = pm * ps;
      for (int r = 0; r < seg; ++r) {
        const float* hl = p.hlocal + ((size_t)((seq * 32 + g) * 7 + r)) * 128;
        const float lr_ = hl[i * 16 + r16], li_ = hl[64 + i * 16 + r16];
        const float nr = pr_ * hr[i] - pi_ * hi[i] + lr_;
        const float ni = pr_ * hi[i] + pi_ * hr[i] + li_;
        hr[i] = nr; hi[i] = ni;
      }
    }
  }
  const int ut = lane >> 1, uh = lane & 1;
  const u16* ubase = p.pbuf + (size_t)(row0 + ut) * NP + C_SU + g * 16 + uh * 8;
  const uint4 z4 = make_uint4(0, 0, 0, 0);
  uint4 nxt = z4;
  if (lane < 32 && ut < nvalid) nxt = *(const uint4*)(ubase + (size_t)ch_begin * 16 * NP);
  for (int ch = ch_begin; ch < ch_end; ++ch) {
    const uint4 cur = nxt;
    nxt = z4;
    if (ch + 1 < ch_end && lane < 32) nxt = *(const uint4*)(ubase + (size_t)(ch + 1) * 16 * NP);
    if (lane < 32) *(uint4*)(Us + ut * 16 + uh * 8) = cur;
    __syncthreads();
    bf16x8 Uop = bf16x8{0, 0, 0, 0, 0, 0, 0, 0};
    if (quad < 2) Uop = *(const bf16x8*)(Us + r16 * 16 + quad * 8);
    f32x4 bu[8];
#pragma unroll
    for (int nt = 0; nt < 8; ++nt) bu[nt] = MFMA16(Uop, Bop[nt], (f32x4{0.f, 0.f, 0.f, 0.f}));
    float Er[4], Ei[4];
#pragma unroll
    for (int i = 0; i < 4; ++i) {
      float xr = 0.f, xi = 0.f;
#pragma unroll
      for (int jj = 0; jj < 4; ++jj) {
        const float nr = Ar[0][i] * xr - Ai[0][i] * xi + bu[i][jj];
        const float ni = Ar[0][i] * xi + Ai[0][i] * xr + bu[4 + i][jj];
        xr = nr; xi = ni;
        bu[i][jj] = xr; bu[4 + i][jj] = xi;
      }
      Er[i] = xr; Ei[i] = xi;
    }
    float cr[4], ci[4];
#pragma unroll
    for (int i = 0; i < 4; ++i) { cr[i] = hr[i]; ci[i] = hi[i]; }
#pragma unroll
    for (int k = 0; k < 4; ++k) {
#pragma unroll
      for (int i = 0; i < 4; ++i) {
        const float er = __shfl(Er[i], r16 + 16 * k), ei = __shfl(Ei[i], r16 + 16 * k);
        const float nr = Ar[3][i] * hr[i] - Ai[3][i] * hi[i] + er;
        const float ni = Ar[3][i] * hi[i] + Ai[3][i] * hr[i] + ei;
        if (k * 4 < nvalid) { hr[i] = nr; hi[i] = ni; }
        if (k < quad) { cr[i] = nr; ci[i] = ni; }
      }
    }
    if (!light) {
#pragma unroll
      for (int i = 0; i < 4; ++i)
#pragma unroll
        for (int jj = 0; jj < 4; ++jj) {
          const float vr = bu[i][jj] + Ar[jj][i] * cr[i] - Ai[jj][i] * ci[i];
          const float vi = bu[4 + i][jj] + Ar[jj][i] * ci[i] + Ai[jj][i] * cr[i];
          Hs[(quad * 4 + jj) * 136 + i * 16 + r16] = f2bf(vr);
          Hs[(quad * 4 + jj) * 136 + 64 + i * 16 + r16] = f2bf(vi);
        }
      __syncthreads();
      f32x4 ya = f32x4{0.f, 0.f, 0.f, 0.f};
#pragma unroll
      for (int s = 0; s < 4; ++s) {
        const bf16x8 bh = *(const bf16x8*)(Hs + r16 * 136 + s * 32 + quad * 8);
        ya = MFMA16(Cop[s], bh, ya);
      }
      const uint2 uu = *(const uint2*)(Us + r16 * 16 + quad * 4);
      const float u0 = bf2f((u16)(uu.x & 0xffff)), u1 = bf2f((u16)(uu.x >> 16));
      const float u2 = bf2f((u16)(uu.y & 0xffff)), u3 = bf2f((u16)(uu.y >> 16));
      const float z0 = gelu_tanh(ya[0] + Dm[0] * u0), z1 = gelu_tanh(ya[1] + Dm[1] * u1);
      const float z2 = gelu_tanh(ya[2] + Dm[2] * u2), z3 = gelu_tanh(ya[3] + Dm[3] * u3);
      if (r16 < nvalid)
        *(uint2*)(p.zs5 + (size_t)(row0 + ch * 16 + r16) * ZLD + g * 16 + quad * 4) = make_uint2(pack2(z0, z1), pack2(z2, z3));
    }
    __syncthreads();
  }
  if (light) {
    if (quad == 0) {
      float* hl = p.hlocal + ((size_t)((seq * 32 + g) * 7 + seg)) * 128;
#pragma unroll
      for (int i = 0; i < 4; ++i) { hl[i * 16 + r16] = hr[i]; hl[64 + i * 16 + r16] = hi[i]; }
    }
  } else if (last_seg) {
    if (quad == 0) {
      float* o_r = p.out + (prompt ? p.o_s5r_p : p.o_s5r_s) + ((size_t)(l * NB + bidx) * 32 + g) * 64;
      float* o_i = p.out + (prompt ? p.o_s5i_p : p.o_s5i_s) + ((size_t)(l * NB + bidx) * 32 + g) * 64;
#pragma unroll
      for (int i = 0; i < 4; ++i) { o_r[i * 16 + r16] = hr[i]; o_i[i * 16 + r16] = hi[i]; }
    }
  }
}

__device__ void phase_mixers(const Params& p, int l, int pass, char* smem, int visit) {
  int* s_item = (int*)(smem + 65536);
  unsigned* cnt = p.counters + l * 64 + (pass - 1) * 32 + visit * 16;
  const int nseg = p.nseg;
  const int ns1 = nseg - 1;
  const int n_chain = (pass == 1) ? 96 * ns1 : 96 * nseg;
  const int n_s5 = (pass == 1) ? 64 * ns1 : 64 * nseg;
  const int n_items = n_chain + n_s5 + ((pass == 1) ? 128 * 20 : 0);
  for (;;) {
    if (tidq() == 0) *s_item = (int)atomicAdd(cnt, 1u);
    __syncthreads();
    const int item = *s_item;
    __syncthreads();
    if (item >= n_items) break;
    int mode, seq, sub, seg = 0;
    const int per = (pass == 1) ? ns1 : nseg;
    if (item < n_chain) {
      const int c = item / per; seg = item % per;
      const int kind = c >> 5, r = c & 31;
      seq = r >> 2; sub = r & 3;
      mode = (kind == 0) ? 1 : ((kind == 1) ? 2 : 0);
    } else if (item < n_chain + n_s5) {
      const int k = item - n_chain;
      const int c = k / per; seg = k % per;
      mode = 3; seq = c >> 3; sub = c & 7;
    } else {
      int k = item - n_chain - n_s5; int b = k / 20; sub = k % 20; seq = 8 + b;
      if (sub < 4) mode = 1;
      else if (sub < 8) { mode = 0; sub -= 4; }
      else if (sub < 12) { mode = 2; sub -= 8; }
      else { mode = 3; sub -= 12; }
    }
    const int ps = (seq >= 8) ? 2 : pass;
    if (mode == 0) { if (EN(2) || ONLY == 20) run_chain<0>(p, l, seq, sub, seg, ps, smem); }
    else if (mode == 1) { if (EN(2) || ONLY == 21) run_chain<1>(p, l, seq, sub, seg, ps, smem); }
    else if (mode == 2) { if (EN(2) || ONLY == 22) run_chain<2>(p, l, seq, sub, seg, ps, smem); }
    else { if (EN(2) || ONLY == 23) run_s5(p, l, seq, sub, seg, ps, smem); }
    __syncthreads();
  }
}

DI bool tile_at(int i, int T, int& t) {
  const int bpx = gridDim.x >> 3;
  t = ((blockIdx.x & 7) + 8 * i) * bpx + (blockIdx.x >> 3);
  return t < T;
}
DI void tile_mn(int t, int nN, int& m0, int& n0) {
  const int per = 8 * nN;
  const int grp = t / per, r = t - grp * per;
  m0 = (grp * 8 + (r & 7)) * 128;
  n0 = (r >> 3) * 128;
}

__device__ void run_phase(const Params& p, int ph, char* smem, int visit) {
  constexpr int NMT = MTOK / 128;
  if (ph == 0) {
    if (EN(9)) phase_convert(p, smem);
    if (EN(0)) phase_rownorm(p, true, nullptr, nullptr, p.in[8], p.hb);
    return;
  }
  if (ph == NPHASE - 1) {
    if (EN(10)) phase_rownorm(p, false, p.tbuf, p.in[11] + 1 * DM, nullptr, nullptr);
    return;
  }
  const int l = (ph <= 9) ? 0 : 1, s0_ = (ph <= 9) ? ph : ph - 10;
  const int s = (s0_ <= 2) ? s0_ : s0_ - 1;
  switch (s) {
    case 0:
      if (!EN(0)) break;
      phase_rownorm(p, false, p.tbuf, p.in[11] + (l - 1) * DM, p.in[8] + l * DM, p.hb);
      break;
    case 1: if (EN(1)) {
      constexpr int NN = NP / 128;
      gemm_stream<EPI_BF16>(p.hb, HLD, p.wt_in + (size_t)l * NIN * WLD1, WLD1, DM, NN, NMT * NN, p.pbuf, NP, nullptr, 0, smem);
    } break;
    case 2: if (EN(2) || (ONLY >= 20 && ONLY <= 23)) phase_mixers(p, l, (s0_ == 2) ? 1 : 2, smem, visit); break;
    case 3: if (EN(3)) {
      constexpr int NG = 32, NGLU = 4;
      {
        const int lane = tidq() & 63, w = tidq() >> 6;
        for (int row = blockIdx.x * 4 + w; row < MTOK; row += gridDim.x * 4) {
          const float4 sq = *(const float4*)(p.ssq + (size_t)row * 4);
          const float ms = (lane < 32) ? (sq.x + sq.y) : (sq.z + sq.w);
          const float r = rsqrtf(ms * (1.f / 256.f) + EPS);
          u16* ptr = p.obuf + (size_t)row * OLD + 512 + lane * 8;
          uint4 v = *(const uint4*)ptr;
          const float* gn = p.in[19] + l * 512 + lane * 8;
          unsigned vw[4] = {v.x, v.y, v.z, v.w};
          unsigned ow[4];
#pragma unroll
          for (int x = 0; x < 4; ++x)
            ow[x] = pack2(bf2f((u16)(vw[x] & 0xffff)) * r * gn[2 * x], bf2f((u16)(vw[x] >> 16)) * r * gn[2 * x + 1]);
          *(uint4*)ptr = make_uint4(ow[0], ow[1], ow[2], ow[3]);
        }
      }
      gemm_stream<EPI_SIG>(p.hb, HLD, p.wt_in + ((size_t)l * NIN + NP) * WLD1, WLD1, DM, NG, NMT * NG, p.pbuf, 4096, nullptr, 0, smem);
      gemm_stream<EPI_GLU>(p.zs5, ZLD, p.wt_glu + (size_t)l * 512 * WLD5, WLD5, 512, NGLU, NMT * NGLU,
                           p.obuf + 1536, OLD, p.zs5, ZLD, smem);
    } break;
    case 4:
      if (EN(4)) {
        int t, m0, n0;
        for (int i = 0; tile_at(i, NMT * 8, t); ++i) { tile_mn(t, 8, m0, n0); merge_tile(p, l, m0, n0, smem); }
      }
      break;
    case 5:
      if (EN(5)) {
        if (gridDim.x == 512) gemm_stream_split(p.hb, HLD, p.wt_out + (size_t)l * DM * WLD1, WLD1, DM, p.tbuf, (float*)p.obuf, smem);
        else gemm_stream<EPI_F32>(p.hb, HLD, p.wt_out + (size_t)l * DM * WLD1, WLD1, DM, 8, NMT * 8, p.tbuf, DM, nullptr, 0, smem);
      }
      break;
    case 6:
      if (EN(6)) phase_rownorm(p, false, p.tbuf, p.in[9] + l * DM, p.in[10] + l * DM, p.hb);
      break;
    case 7:
      if (EN(7)) {
        gemm_stream<EPI_RELU2>(p.hb, HLD, p.wt_ff1 + (size_t)l * DFF * WLD1, WLD1, DM, 32, NMT * 32, p.pbuf, ULD, nullptr, 0, smem);
      }
      break;
    case 8:
      if (EN(8)) {
        if (gridDim.x == 512) gemm_stream_split(p.pbuf, ULD, p.wt_ff2 + (size_t)l * DM * WLD4, WLD4, DFF, p.tbuf, (float*)p.obuf, smem);
        else gemm_stream<EPI_F32>(p.pbuf, ULD, p.wt_ff2 + (size_t)l * DM * WLD4, WLD4, DFF, 8, NMT * 8, p.tbuf, DM, nullptr, 0, smem);
      }
      break;
  }
}

#ifndef DUP_S
#define DUP_S -1
#endif
#define XB_TMO      128
#define XB_XCNT(j)  (256  + 64 * (j))
#define XB_XSUB(j)  (1280 + 64 * (j))
#define XB_XGEN(j)  (2304 + 64 * (j))
#define XB_TOP      3328
#define XB_TOPGEN   3392
#define XCD_BAR_WORDS 3456
#define XB_SPIN_CAP (1u << 22)
#define LAS __attribute__((address_space(3)))
DI unsigned xb_ld(unsigned* p)              { return __hip_atomic_load(p, __ATOMIC_RELAXED, __HIP_MEMORY_SCOPE_AGENT); }
DI unsigned xb_add(unsigned* p, unsigned v) { return __hip_atomic_fetch_add(p, v, __ATOMIC_RELAXED, __HIP_MEMORY_SCOPE_AGENT); }
DI unsigned xb_xcc_id() { return (unsigned)__builtin_amdgcn_s_getreg((3 << 11) | 20) & 0xFu; }
#define XB_SPIN(cond, bar) do { unsigned _sp = 0; while (cond) { __builtin_amdgcn_s_sleep(1); \
    if ((++_sp & 255u) == 0u) { if (xb_ld(&(bar)[XB_TMO])) break; if (_sp > XB_SPIN_CAP) { atomicAdd(&(bar)[XB_TMO], 1u); break; } } } } while (0)
struct XcdBarrier { unsigned* bar; unsigned x; volatile LAS unsigned* st; };
DI XcdBarrier xcd_barrier_post(unsigned* bar, volatile LAS unsigned* st) {
  XcdBarrier b; b.bar = bar; b.x = xb_xcc_id(); b.st = st;
  if (threadIdx.x == 0) (void)xb_add(&bar[XB_XCNT(b.x)], 1u);
  return b;
}
DI void xcd_barrier_complete(unsigned* bar, unsigned x, unsigned& nloc, unsigned& nx) {
  const unsigned G = gridDim.x * gridDim.y * gridDim.z;
  unsigned sum, cnt, mine, sp = 0u;
  for (;;) {
    sum = 0u; cnt = 0u; mine = 0u;
#pragma unroll
    for (unsigned j = 0; j < 16; ++j) { const unsigned c = xb_ld(&bar[XB_XCNT(j)]); sum += c; cnt += (c > 0u) ? 1u : 0u; mine = (j == x) ? c : mine; }
    if (sum == G) break;
    __builtin_amdgcn_s_sleep(1);
    if ((++sp & 255u) == 0u) { if (xb_ld(&bar[XB_TMO])) break; if (sp > XB_SPIN_CAP) { atomicAdd(&bar[XB_TMO], 1u); break; } }
  }
  nloc = mine > 0u ? mine : 1u; nx = cnt > 0u ? cnt : 1u;
}
DI void xcd_barrier(const XcdBarrier& b) {
  asm volatile("s_waitcnt vmcnt(0)" ::: "memory");
  __syncthreads();
  if (threadIdx.x == 0) {
    unsigned* bar = b.bar;
    __builtin_amdgcn_s_waitcnt(0);
    unsigned nloc = b.st[0], nx = b.st[1];
    if (nloc == 0u) { xcd_barrier_complete(bar, b.x, nloc, nx); b.st[0] = nloc; b.st[1] = nx; }
    const unsigned old = xb_add(&bar[XB_XSUB(b.x)], 1u);
    const unsigned gen = old / nloc;
    if (old + 1u == (gen + 1u) * nloc) {
      __builtin_amdgcn_fence(__ATOMIC_RELEASE, "agent");
      asm volatile("s_waitcnt vmcnt(0)" ::: "memory");
      const unsigned og = xb_add(&bar[XB_TOP], 1u);
      const unsigned tg = og / nx;
      if (og + 1u == (tg + 1u) * nx) xb_add(&bar[XB_TOPGEN], 1u);
      else XB_SPIN(xb_ld(&bar[XB_TOPGEN]) == tg, bar);
      __builtin_amdgcn_fence(__ATOMIC_ACQUIRE, "agent");
      xb_add(&bar[XB_XGEN(b.x)], 1u);
      asm volatile("s_waitcnt vmcnt(0)" ::: "memory");
    } else {
      XB_SPIN(xb_ld(&bar[XB_XGEN(b.x)]) == gen, bar);
      __builtin_amdgcn_fence(__ATOMIC_ACQUIRE, "agent");
      asm volatile("s_waitcnt vmcnt(0)" ::: "memory");
    }
  }
  __syncthreads();
}

__global__ void __launch_bounds__(256, 2) mega_kernel(Params p, int ph_lo, int ph_hi) {
  __shared__ __attribute__((aligned(16))) char smem[65536 + 32];
  volatile LAS unsigned* st = (volatile LAS unsigned*)(&smem[65536 + 16]);
  if (threadIdx.x == 0) { st[0] = 0u; st[1] = 0u; }
  __syncthreads();
  const XcdBarrier xb = xcd_barrier_post(p.bar, st);
  for (int ph = ph_lo; ph < ph_hi; ++ph) {
    if (ph > ph_lo) xcd_barrier(xb);
    if (ph_hi < 0) cg::this_grid().sync();
    const int reps = (DUP_S >= 0 && ph == DUP_S) ? 2 : 1;
    for (int r = 0; r < reps; ++r) {
      if (r) xcd_barrier(xb);
#ifdef VAR_NOSTORE
      if (tidq() == 0) *(volatile int*)(smem + 65536 + 8) = r;
      __syncthreads();
#endif
      run_phase(p, ph, smem, r);
    }
  }
}

extern "C" void kernel_launch(void* const* d_in, const int* in_sizes, int n_in, void* d_out, int out_size,
                              void* d_ws, size_t ws_size, hipStream_t stream) {
  Params p{};
  for (int i = 0; i < 35; ++i) p.in[i] = (const float*)d_in[i];
  p.out = (float*)d_out;
  char* ws = (char*)d_ws;
  size_t off = 0;
  auto take = [&](size_t bytes) { char* r = ws + off; off += (bytes + 255) & ~(size_t)255; return r; };
  p.wt_in  = (u16*)take((size_t)2 * NIN * WLD1 * 2);
  p.wt_ff1 = (u16*)take((size_t)2 * DFF * WLD1 * 2);
  p.wt_ff2 = (u16*)take((size_t)2 * DM * WLD4 * 2);
  p.wt_br  = (u16*)take((size_t)2 * 4 * DM * WLD5 * 2);
  p.wt_out = (u16*)take((size_t)2 * DM * WLD1 * 2);
  p.wt_glu = (u16*)take((size_t)2 * 512 * WLD5 * 2);
  p.hb     = (u16*)take((size_t)MTOK * HLD * 2);
  p.pbuf   = (u16*)take((size_t)MTOK * NP * 2);
  p.obuf   = (u16*)take((size_t)MTOK * OLD * 2);
  p.zs5    = (u16*)take((size_t)MTOK * ZLD * 2);
  p.counters = (unsigned*)take(4096);
  p.bar = (unsigned*)take(16384);
  p.ssq = (float*)take((size_t)MTOK * 4 * 4);
  p.segdec = (float*)take((size_t)96 * 7 * 128 * 4);
  p.hlocal = (float*)take((size_t)8 * 32 * 7 * 128 * 4);
  p.nseg = 8;
  if (off + (size_t)96 * 7 * 32768 > ws_size) p.nseg = 4;
  p.cps = 128 / p.nseg;
  p.slocal = (u16*)take((size_t)96 * (p.nseg - 1) * 32768);
  p.tbuf = (float*)(p.pbuf + (size_t)MTOK * ULD);
  if (off > ws_size) { fprintf(stderr, "workspace too small: need %zu have %zu\n", off, ws_size); return; }
  size_t o = (size_t)MTOK * DM;
  p.o_ret_p = o;  o += (size_t)2 * 8 * 65536;
  p.o_ret_s = o;  o += (size_t)2 * 128 * 65536;
  p.o_ssd_p = o;  o += (size_t)2 * 8 * 65536;
  p.o_ssd_s = o;  o += (size_t)2 * 128 * 65536;
  p.o_conv_p = o; o += (size_t)2 * 8 * 3 * 1024;
  p.o_conv_s = o; o += (size_t)2 * 128 * 3 * 1024;
  p.o_hg_p = o;   o += (size_t)2 * 8 * 65536;
  p.o_hg_s = o;   o += (size_t)2 * 128 * 65536;
  p.o_s5r_p = o;  o += (size_t)2 * 8 * 2048;
  p.o_s5r_s = o;  o += (size_t)2 * 128 * 2048;
  p.o_s5i_p = o;  o += (size_t)2 * 8 * 2048;
  p.o_s5i_s = o;  o += (size_t)2 * 128 * 2048;

  static int grid_blocks = 0;
  if (!grid_blocks) {
    int dev = 0, cus = 0, per_cu = 0;
    hipGetDevice(&dev);
    hipDeviceGetAttribute(&cus, hipDeviceAttributeMultiprocessorCount, dev);
    hipOccupancyMaxActiveBlocksPerMultiprocessor(&per_cu, mega_kernel, 256, 0);
    if (per_cu > 2) per_cu = 2;
    if (per_cu < 1) per_cu = 1;
    grid_blocks = cus * per_cu;
  }
  hipMemsetAsync(p.counters, 0, 4096 + 16384, stream);
#if SINGLE_LAUNCH
  int lo = 0, hi = NPHASE;
  void* args[] = {&p, &lo, &hi};
  hipError_t e = hipLaunchCooperativeKernel((void*)mega_kernel, dim3(grid_blocks), dim3(256), args, 0, stream);
  if (e != hipSuccess) fprintf(stderr, "cooperative launch failed: %s (grid %d)\n", hipGetErrorString(e), grid_blocks);
#else
  for (int ph = 0; ph < NPHASE; ++ph)
    hipLaunchKernelGGL(mega_kernel, dim3(grid_blocks), dim3(256), 0, stream, p, ph, ph + 1);
#endif
}
```

```cpp
#include <hip/hip_runtime.h>
#include <hip/hip_cooperative_groups.h>
#include <cstdio>
#include <cstdint>
namespace cg = cooperative_groups;

#ifndef SINGLE_LAUNCH
#define SINGLE_LAUNCH 1
#endif
#ifndef ONLY
#define ONLY -1
#endif
#define EN(k) (ONLY < 0 || ONLY == (k))

typedef unsigned short u16;
using bf16x8 = __attribute__((ext_vector_type(8))) short;
using bf16x4 = __attribute__((ext_vector_type(4))) short;
using f32x4  = __attribute__((ext_vector_type(4))) float;
typedef unsigned u32x4 __attribute__((ext_vector_type(4)));
#define DI __device__ __forceinline__
#define MFMA16(a, b, c) __builtin_amdgcn_mfma_f32_16x16x32_bf16((a), (b), (c), 0, 0, 0)

constexpr int MTOK = 17408;
constexpr int MPR  = 16384;
constexpr int DM   = 1024;
constexpr int NP   = 6272;
constexpr int NIN  = 10368;
constexpr int DFF  = 4096;
constexpr int INC  = 10248;
constexpr int C_RQ = 0, C_RK = 512, C_RV = 1024, C_RG = 1536, C_SZ = 2048, C_SXBC = 2560;
constexpr int C_HQ = 3584, C_HF = 4096, C_HI = 4608, C_HG = 5120, C_SU = 5632, C_SDT = 6144;
constexpr float EPS = 1e-6f;
constexpr int HLD = 1024, WLD1 = 1024, ULD = 4096, WLD4 = 4096, OLD = 2048, ZLD = 512, WLD5 = 512;
constexpr int NITEMS = 160 + 128 * 20;
constexpr int NPHASE = 21;

struct Params {
  const float* in[35];
  float* out;
  u16 *wt_in, *wt_ff1, *wt_ff2, *wt_br, *wt_out, *wt_glu;
  u16 *hb, *pbuf, *obuf, *zs5;
  float* tbuf;
  unsigned* counters;
  unsigned* bar;
  float* ssq;
  u16* slocal;
  float* segdec;
  float* hlocal;
  int nseg, cps;
  size_t o_ret_p, o_ret_s, o_ssd_p, o_ssd_s, o_conv_p, o_conv_s, o_hg_p, o_hg_s, o_s5r_p, o_s5r_s, o_s5i_p, o_s5i_s;
};

DI int tidq() { int t = threadIdx.x; asm volatile("" : "+v"(t)); return t; }
typedef __bf16 bf16v2 __attribute__((ext_vector_type(2)));
typedef float f32v2 __attribute__((ext_vector_type(2)));
DI unsigned pack2(float a, float b) { f32v2 v = {a, b}; return __builtin_bit_cast(unsigned, __builtin_convertvector(v, bf16v2)); }
DI u16 f2bf(float f) { return (u16)(pack2(f, 0.f) & 0xffffu); }
DI float bf2f(u16 h) { return __uint_as_float(((unsigned)h) << 16); }
DI float sigmoidf_(float x) { return __builtin_amdgcn_rcpf(1.f + __expf(-x)); }
DI float siluf_(float x) { return x * __builtin_amdgcn_rcpf(1.f + __expf(-x)); }
DI float softplusf_(float x) { return x > 20.f ? x : log1pf(__expf(x)); }
DI float gelu_tanh(float x) {
  float u = 0.7978845608028654f * (x + 0.044715f * x * x * x);
  float e = __expf(2.f * u);
  float th = 1.f - 2.f * __builtin_amdgcn_rcpf(e + 1.f);
  return 0.5f * x * (1.f + th);
}
DI float wave_sum(float v) {
#pragma unroll
  for (int m = 32; m >= 1; m >>= 1) v += __shfl_xor(v, m);
  return v;
}
DI float sum16(float v) {
#pragma unroll
  for (int m = 8; m >= 1; m >>= 1) v += __shfl_xor(v, m);
  return v;
}
DI void sincos_red(float a, float& s, float& c) {
  float n = rintf(a * 0.15915494309189535f);
  float r = fmaf(-n, 6.28125f, a);
  r = fmaf(-n, 1.9353071795864769e-3f, r);
  s = __sinf(r); c = __cosf(r);
}

DI int map_win(int my) {
  if (my < 3584) return my;
  if (my < 6144) return my + 8;
  if (my < 6152) return my - 6144 + 3584;
  if (my < 6272) return -1;
  return my - 120;
}
DI void transpose_tile(const float* __restrict__ src, int src_ld, u16* __restrict__ dst, int dst_ld,
                       int k0, int n0, int mapmode, char* smem) {
  float* tile = (float*)smem;
  const int tid = tidq();
  {
    const int n = tid & 63;
    int sc = n0 + n;
    if (mapmode) sc = map_win(sc);
    const float* sp = src + (size_t)(k0 + (tid >> 6)) * src_ld + (sc >= 0 ? sc : 0);
    float v[32];
#pragma unroll
    for (int i = 0; i < 32; ++i) v[i] = sp[(size_t)(4 * i) * src_ld];
#pragma unroll
    for (int i = 0; i < 32; ++i) tile[n * 129 + (tid >> 6) + 4 * i] = (sc >= 0) ? v[i] : 0.f;
  }
  __syncthreads();
  {
    const int n = tid >> 2, kc = (tid & 3) * 32;
    unsigned pk[16];
#pragma unroll
    for (int x = 0; x < 16; ++x) pk[x] = pack2(tile[n * 129 + kc + 2 * x], tile[n * 129 + kc + 2 * x + 1]);
    uint4* d = (uint4*)(dst + (size_t)(n0 + n) * dst_ld + k0 + kc);
    d[0] = make_uint4(pk[0], pk[1], pk[2], pk[3]);
    d[1] = make_uint4(pk[4], pk[5], pk[6], pk[7]);
    d[2] = make_uint4(pk[8], pk[9], pk[10], pk[11]);
    d[3] = make_uint4(pk[12], pk[13], pk[14], pk[15]);
  }
  __syncthreads();
}

__device__ void phase_convert(const Params& p, char* smem) {
  constexpr int PER = 2736;
  for (int t = blockIdx.x; t < 2 * PER; t += gridDim.x) {
    int l = t / PER, r = t % PER;
    if (r < 1296) {
      int nt = r / 8, kt = r % 8;
      transpose_tile(p.in[12] + (size_t)l * DM * INC, INC, p.wt_in + (size_t)l * NIN * WLD1, WLD1, kt * 128, nt * 64, 1, smem);
    } else if (r < 1808) {
      r -= 1296; int nt = r / 8, kt = r % 8;
      transpose_tile(p.in[33] + (size_t)l * DM * DFF, DFF, p.wt_ff1 + (size_t)l * DFF * WLD1, WLD1, kt * 128, nt * 64, 0, smem);
    } else if (r < 2320) {
      r -= 1808; int nt = r / 32, kt = r % 32;
      transpose_tile(p.in[34] + (size_t)l * DFF * DM, DM, p.wt_ff2 + (size_t)l * DM * WLD4, WLD4, kt * 128, nt * 64, 0, smem);
    } else if (r < 2448) {
      r -= 2320; int nt = r / 8, kt = r % 8;
      transpose_tile(p.in[32] + (size_t)l * DM * DM, DM, p.wt_out + (size_t)l * DM * WLD1, WLD1, kt * 128, nt * 64, 0, smem);
    } else if (r < 2704) {
      r -= 2448; int b = r / 64; r %= 64; int nt = r / 4, kt = r % 4;
      transpose_tile(p.in[31] + (size_t)(l * 4 + b) * 512 * DM, DM, p.wt_br + (size_t)(l * 4 + b) * DM * WLD5, WLD5, kt * 128, nt * 64, 0, smem);
    } else {
      r -= 2704; int nt = r / 4, kt = r % 4;
      transpose_tile(p.in[30] + (size_t)l * 512 * 512, 512, p.wt_glu + (size_t)l * 512 * WLD5, WLD5, kt * 128, nt * 64, 0, smem);
    }
  }
}

__device__ void phase_rownorm(const Params& p, bool from_input, const float* __restrict__ t, const float* __restrict__ gpost,
                              const float* __restrict__ gpre, u16* __restrict__ hout) {
  const int lane = tidq() & 63, w = tidq() >> 6;
  float* xbuf = p.out;
  for (int row = blockIdx.x * 4 + w; row < MTOK; row += gridDim.x * 4) {
    const float* xin = from_input ? (row < MPR ? p.in[0] + (size_t)row * DM : p.in[1] + (size_t)(row - MPR) * DM)
                                  : xbuf + (size_t)row * DM;
    float4 x[4];
#pragma unroll
    for (int k = 0; k < 4; ++k) x[k] = *(const float4*)(xin + lane * 4 + 256 * k);
    if (t) {
      float4 tv[4];
      float ss = 0.f;
#pragma unroll
      for (int k = 0; k < 4; ++k) {
        if (gridDim.x == 512 && row >= MPR) {
          const float* pp = (const float*)p.obuf + (size_t)(row - MPR) * DM + lane * 4 + 256 * k;
          float4 a = *(const float4*)pp;
#pragma unroll
          for (int sl = 1; sl < 8; ++sl) {
            const float4 b = *(const float4*)(pp + (size_t)sl * 1024 * 1024);
            a.x += b.x; a.y += b.y; a.z += b.z; a.w += b.w;
          }
          tv[k] = a;
        } else {
          tv[k] = *(const float4*)(t + (size_t)row * DM + lane * 4 + 256 * k);
        }
        ss += tv[k].x * tv[k].x + tv[k].y * tv[k].y + tv[k].z * tv[k].z + tv[k].w * tv[k].w;
      }
      ss = wave_sum(ss);
      float r = rsqrtf(ss * (1.f / DM) + EPS);
#pragma unroll
      for (int k = 0; k < 4; ++k) {
        float4 g = *(const float4*)(gpost + lane * 4 + 256 * k);
        x[k].x += tv[k].x * r * g.x; x[k].y += tv[k].y * r * g.y; x[k].z += tv[k].z * r * g.z; x[k].w += tv[k].w * r * g.w;
      }
    }
#pragma unroll
    for (int k = 0; k < 4; ++k) *(float4*)(xbuf + (size_t)row * DM + lane * 4 + 256 * k) = x[k];
    if (hout) {
      float ss = 0.f;
#pragma unroll
      for (int k = 0; k < 4; ++k) ss += x[k].x * x[k].x + x[k].y * x[k].y + x[k].z * x[k].z + x[k].w * x[k].w;
      ss = wave_sum(ss);
      float r = rsqrtf(ss * (1.f / DM) + EPS);
#pragma unroll
      for (int k = 0; k < 4; ++k) {
        float4 g = *(const float4*)(gpre + lane * 4 + 256 * k);
        uint2 o;
        o.x = pack2(x[k].x * r * g.x, x[k].y * r * g.y);
        o.y = pack2(x[k].z * r * g.z, x[k].w * r * g.w);
        *(uint2*)(hout + (size_t)row * HLD + lane * 4 + 256 * k) = o;
      }
    }
  }
}

DI int swz(int r, int c) { return r * 128 + ((c ^ ((r >> 1) & 7)) << 4); }

#define GEMM_COMPUTE(AS_) do { const char* as_ = (AS_); const char* bs_ = as_ + 16384; \
  _Pragma("unroll") for (int s_ = 0; s_ < 2; ++s_) { \
    bf16x8 af_[4], bfr_[4]; \
    _Pragma("unroll") for (int i_ = 0; i_ < 4; ++i_) af_[i_] = *(const bf16x8*)(as_ + swz(wm * 64 + i_ * 16 + r16, s_ * 4 + quad)); \
    _Pragma("unroll") for (int j_ = 0; j_ < 4; ++j_) bfr_[j_] = *(const bf16x8*)(bs_ + swz(wn * 64 + j_ * 16 + r16, s_ * 4 + quad)); \
    _Pragma("unroll") for (int i_ = 0; i_ < 4; ++i_) \
      _Pragma("unroll") for (int j_ = 0; j_ < 4; ++j_) acc[i_][j_] = MFMA16(bfr_[j_], af_[i_], acc[i_][j_]); \
  } } while (0)

struct Stage { u32x4 a0, a1, a2, a3, b0, b1, b2, b3; };
DI void gload(Stage& s, const u16* ag, const u16* bg, int lda, int ldb, int kt) {
  s.a0 = *(const u32x4*)(ag + (size_t)0 * 32 * lda + kt * 64);
  s.a1 = *(const u32x4*)(ag + (size_t)1 * 32 * lda + kt * 64);
  s.a2 = *(const u32x4*)(ag + (size_t)2 * 32 * lda + kt * 64);
  s.a3 = *(const u32x4*)(ag + (size_t)3 * 32 * lda + kt * 64);
  s.b0 = *(const u32x4*)(bg + (size_t)0 * 32 * ldb + kt * 64);
  s.b1 = *(const u32x4*)(bg + (size_t)1 * 32 * ldb + kt * 64);
  s.b2 = *(const u32x4*)(bg + (size_t)2 * 32 * ldb + kt * 64);
  s.b3 = *(const u32x4*)(bg + (size_t)3 * 32 * ldb + kt * 64);
}
DI void lwrite(const Stage& s, char* d, int lr, int lc) {
  *(u32x4*)(d + swz(lr, lc)) = s.a0;
  *(u32x4*)(d + swz(lr + 32, lc)) = s.a1;
  *(u32x4*)(d + swz(lr + 64, lc)) = s.a2;
  *(u32x4*)(d + swz(lr + 96, lc)) = s.a3;
  *(u32x4*)(d + 16384 + swz(lr, lc)) = s.b0;
  *(u32x4*)(d + 16384 + swz(lr + 32, lc)) = s.b1;
  *(u32x4*)(d + 16384 + swz(lr + 64, lc)) = s.b2;
  *(u32x4*)(d + 16384 + swz(lr + 96, lc)) = s.b3;
}

template <bool DEEP>
DI void gemm_kloop(f32x4 (&acc)[4][4], const u16* __restrict__ A, int lda, const u16* __restrict__ Bt, int ldb,
                   int K, int m0, int n0, char* smem) {
  const int tid = tidq(), lane = tid & 63, w = tid >> 6, wm = w >> 1, wn = w & 1, r16 = lane & 15, quad = lane >> 4;
  const int lr = tid >> 3, lc = tid & 7;
  const u16* ag = A + (size_t)(m0 + lr) * lda + lc * 8;
  const u16* bg = Bt + (size_t)(n0 + lr) * ldb + lc * 8;
  const int nk = K >> 6;
  Stage s0;
  gload(s0, ag, bg, lda, ldb, 0);
  if (DEEP) {
    Stage s1;
    gload(s1, ag, bg, lda, ldb, 1);
    lwrite(s0, smem, lr, lc);
    __syncthreads();
    for (int kt = 0; kt < nk; kt += 2) {
      if (kt + 2 < nk) gload(s0, ag, bg, lda, ldb, kt + 2);
      GEMM_COMPUTE(smem);
      lwrite(s1, smem + 32768, lr, lc);
      __syncthreads();
      if (kt + 3 < nk) gload(s1, ag, bg, lda, ldb, kt + 3);
      GEMM_COMPUTE(smem + 32768);
      if (kt + 2 < nk) lwrite(s0, smem, lr, lc);
      __syncthreads();
    }
  } else {
    lwrite(s0, smem, lr, lc);
    __syncthreads();
    for (int kt = 0; kt < nk; ++kt) {
      const bool more = (kt + 1 < nk);
      if (more) gload(s0, ag, bg, lda, ldb, kt + 1);
      GEMM_COMPUTE(smem + (kt & 1) * 32768);
      if (more) lwrite(s0, smem + ((kt + 1) & 1) * 32768, lr, lc);
      __syncthreads();
    }
  }
}

DI void zero_acc(f32x4 (&acc)[4][4]) {
#pragma unroll
  for (int i = 0; i < 4; ++i)
#pragma unroll
    for (int j = 0; j < 4; ++j) acc[i][j] = f32x4{0.f, 0.f, 0.f, 0.f};
}

enum { EPI_BF16 = 0, EPI_SIG = 1, EPI_RELU2 = 2, EPI_F32 = 3, EPI_GLU = 4 };

template <int EPI>
DI void gemm_epilogue(f32x4 (&acc)[4][4], int m0, int n0, void* outp, int ldc, const u16* aux, int ldaux) {
  const int lane = tidq() & 63, w = tidq() >> 6, wm = w >> 1, wn = w & 1, r16 = lane & 15, quad = lane >> 4;
#pragma unroll
  for (int i = 0; i < 4; ++i) {
    const int m = m0 + wm * 64 + i * 16 + r16;
    if (EPI == EPI_F32) {
#pragma unroll
      for (int j = 0; j < 4; ++j) {
        const int n = n0 + wn * 64 + j * 16 + quad * 4;
        const f32x4 v = acc[i][j];
        *(float4*)((float*)outp + (size_t)m * ldc + n) = make_float4(v[0], v[1], v[2], v[3]);
        acc[i][j] = f32x4{0.f, 0.f, 0.f, 0.f};
      }
    } else {
      uint2 o[4];
#pragma unroll
      for (int j = 0; j < 4; ++j) {
        const int n = n0 + wn * 64 + j * 16 + quad * 4;
        f32x4 v = acc[i][j];
        if (EPI == EPI_SIG) {
#pragma unroll
          for (int x = 0; x < 4; ++x) v[x] = sigmoidf_(v[x]);
        } else if (EPI == EPI_RELU2) {
#pragma unroll
          for (int x = 0; x < 4; ++x) { float r = fmaxf(v[x], 0.f); v[x] = r * r; }
        } else if (EPI == EPI_GLU) {
          uint2 zz = *(const uint2*)(aux + (size_t)m * ldaux + n);
          v[0] = bf2f((u16)(zz.x & 0xffff)) * sigmoidf_(v[0]);
          v[1] = bf2f((u16)(zz.x >> 16)) * sigmoidf_(v[1]);
          v[2] = bf2f((u16)(zz.y & 0xffff)) * sigmoidf_(v[2]);
          v[3] = bf2f((u16)(zz.y >> 16)) * sigmoidf_(v[3]);
        }
        o[j].x = pack2(v[0], v[1]); o[j].y = pack2(v[2], v[3]);
        acc[i][j] = f32x4{0.f, 0.f, 0.f, 0.f};
      }
#pragma unroll
      for (int jp = 0; jp < 2; ++jp) {
        const bool odd = quad & 1;
        const uint2 mine = odd ? o[2 * jp + 1] : o[2 * jp];
        const uint2 send = odd ? o[2 * jp] : o[2 * jp + 1];
        uint2 recv;
        recv.x = __shfl_xor(send.x, 16); recv.y = __shfl_xor(send.y, 16);
        const int n = n0 + wn * 64 + (2 * jp + (odd ? 1 : 0)) * 16 + (quad & 2) * 4;
        const uint4 st = odd ? make_uint4(recv.x, recv.y, mine.x, mine.y) : make_uint4(mine.x, mine.y, recv.x, recv.y);
        *(uint4*)((u16*)outp + (size_t)m * ldc + n) = st;
      }
    }
  }
}

DI bool tile_at(int i, int T, int& t);
DI void tile_mn(int t, int nN, int& m0, int& n0);

template <int EPI>
DI void gemm_stream(const u16* __restrict__ A, int lda, const u16* __restrict__ Bt, int ldb, int K, int nN, int T,
                    void* outp, int ldc, const u16* aux, int ldaux, char* smem) {
  const int tid = tidq(), lane = tid & 63, w = tid >> 6, wm = w >> 1, wn = w & 1, r16 = lane & 15, quad = lane >> 4;
  const int lr = tid >> 3, lc = tid & 7;
  asm volatile("" : "+s"(lda), "+s"(ldb), "+s"(K));
  const int nk = K >> 6;
  int t, m0, n0, m1 = 0, n1 = 0;
  if (!tile_at(0, T, t)) return;
  tile_mn(t, nN, m0, n0);
  const size_t aoff = (size_t)lr * lda + lc * 8, boff = (size_t)lr * ldb + lc * 8;
  const u16* ag = A + (size_t)m0 * lda + aoff;
  const u16* bg = Bt + (size_t)n0 * ldb + boff;
  f32x4 acc[4][4];
  zero_acc(acc);
  Stage s0, s1;
  gload(s0, ag, bg, lda, ldb, 0);
  gload(s1, ag, bg, lda, ldb, 1);
  lwrite(s0, smem, lr, lc);
  __syncthreads();
  for (int i = 0;; ++i) {
    const bool has_next = tile_at(i + 1, T, t);
    if (has_next) tile_mn(t, nN, m1, n1);
    const u16* agn = A + (size_t)m1 * lda + aoff;
    const u16* bgn = Bt + (size_t)n1 * ldb + boff;
    for (int kt = 0; kt < nk; kt += 2) {
      if (kt + 2 < nk) gload(s0, ag, bg, lda, ldb, kt + 2);
      else if (has_next) gload(s0, agn, bgn, lda, ldb, 0);
      GEMM_COMPUTE(smem);
      lwrite(s1, smem + 32768, lr, lc);
      __syncthreads();
      if (kt + 2 < nk) gload(s1, ag, bg, lda, ldb, kt + 3);
      else if (has_next) gload(s1, agn, bgn, lda, ldb, 1);
      GEMM_COMPUTE(smem + 32768);
      if (kt + 2 < nk || has_next) lwrite(s0, smem, lr, lc);
      __syncthreads();
    }
    gemm_epilogue<EPI>(acc, m0, n0, outp, ldc, aux, ldaux);
    if (!has_next) break;
    m0 = m1; n0 = n1; ag = agn; bg = bgn;
  }
}

DI void gemm_stream_split(const u16* __restrict__ A, int lda, const u16* __restrict__ Bt, int ldb, int K,
                          float* outp, float* part, char* smem) {
  const int tid = tidq(), lane = tid & 63, w = tid >> 6, wm = w >> 1, wn = w & 1, r16 = lane & 15, quad = lane >> 4;
  const int lr = tid >> 3, lc = tid & 7;
  asm volatile("" : "+s"(lda), "+s"(ldb), "+s"(K));
  const int nk = K >> 6, nks = nk >> 3;
  const size_t aoff = (size_t)lr * lda + lc * 8, boff = (size_t)lr * ldb + lc * 8;
  const int slice = blockIdx.x & 7, tl = blockIdx.x >> 3;
  int t, m0, n0, m1 = 0, n1 = 0;
  tile_at(0, 1024, t);
  tile_mn(t, 8, m0, n0);
  const u16* ag = A + (size_t)m0 * lda + aoff;
  const u16* bg = Bt + (size_t)n0 * ldb + boff;
  int nku = nk;
  f32x4 acc[4][4];
  zero_acc(acc);
  Stage s0, s1;
  gload(s0, ag, bg, lda, ldb, 0);
  gload(s1, ag, bg, lda, ldb, 1);
  lwrite(s0, smem, lr, lc);
  __syncthreads();
  for (int u = 0; u < 3; ++u) {
    const bool has_next = (u < 2);
    int nkn = nk;
    const u16* agn = ag;
    const u16* bgn = bg;
    if (u == 0) {
      tile_at(1, 1024, t);
      tile_mn(t, 8, m1, n1);
      agn = A + (size_t)m1 * lda + aoff;
      bgn = Bt + (size_t)n1 * ldb + boff;
    } else if (u == 1) {
      m1 = MPR + (tl >> 3) * 128; n1 = (tl & 7) * 128;
      agn = A + (size_t)m1 * lda + aoff + (size_t)slice * nks * 64;
      bgn = Bt + (size_t)n1 * ldb + boff + (size_t)slice * nks * 64;
      nkn = nks;
    }
    for (int kt = 0; kt < nku; kt += 2) {
      if (kt + 2 < nku) gload(s0, ag, bg, lda, ldb, kt + 2);
      else if (has_next) gload(s0, agn, bgn, lda, ldb, 0);
      GEMM_COMPUTE(smem);
      lwrite(s1, smem + 32768, lr, lc);
      __syncthreads();
      if (kt + 2 < nku) gload(s1, ag, bg, lda, ldb, kt + 3);
      else if (has_next) gload(s1, agn, bgn, lda, ldb, 1);
      GEMM_COMPUTE(smem + 32768);
      if (kt + 2 < nku || has_next) lwrite(s0, smem, lr, lc);
      __syncthreads();
    }
    if (u < 2) gemm_epilogue<EPI_F32>(acc, m0, n0, outp, DM, nullptr, 0);
    else gemm_epilogue<EPI_F32>(acc, m0 - MPR, n0, part + (size_t)slice * 1024 * 1024, DM, nullptr, 0);
    m0 = m1; n0 = n1; ag = agn; bg = bgn; nku = nkn;
  }
}

DI void merge_tile(const Params& p, int l, int m0, int n0, char* smem) {
  f32x4 macc[4][4];
  zero_acc(macc);
  const int lane = tidq() & 63, w = tidq() >> 6, wm = w >> 1, wn = w & 1, r16 = lane & 15, quad = lane >> 4;
  const u16* gates = p.pbuf;
  for (int b = 0; b < 4; ++b) {
    f32x4 acc[4][4];
    zero_acc(acc);
    gemm_kloop<false>(acc, p.obuf + b * 512, OLD, p.wt_br + (size_t)(l * 4 + b) * DM * WLD5, WLD5, 512, m0, n0, smem);
#pragma unroll
    for (int i = 0; i < 4; ++i) {
      const int m = m0 + wm * 64 + i * 16 + r16;
#pragma unroll
      for (int j = 0; j < 4; ++j) {
        const int n = n0 + wn * 64 + j * 16 + quad * 4;
        uint2 gg = *(const uint2*)(gates + (size_t)m * 4096 + b * 1024 + n);
        macc[i][j][0] += bf2f((u16)(gg.x & 0xffff)) * acc[i][j][0];
        macc[i][j][1] += bf2f((u16)(gg.x >> 16)) * acc[i][j][1];
        macc[i][j][2] += bf2f((u16)(gg.y & 0xffff)) * acc[i][j][2];
        macc[i][j][3] += bf2f((u16)(gg.y >> 16)) * acc[i][j][3];
      }
    }
  }
#pragma unroll
  for (int i = 0; i < 4; ++i) {
    const int m = m0 + wm * 64 + i * 16 + r16;
#pragma unroll
    for (int j = 0; j < 4; ++j) {
      const int n = n0 + wn * 64 + j * 16 + quad * 4;
      uint2 o; o.x = pack2(macc[i][j][0], macc[i][j][1]); o.y = pack2(macc[i][j][2], macc[i][j][3]);
      *(uint2*)(p.hb + (size_t)m * HLD + n) = o;
    }
  }
}

constexpr int QS = 136;
constexpr int TS = 20;
constexpr int OFS = 260;

template <int MODE>
__device__ void run_chain(const Params& p, int l, int seq, int sub, int seg, int pass, char* smem) {
  constexpr int NE = 2;
  const int tid = tidq(), lane = tid & 63, w = tid >> 6, r16 = lane & 15, quad = lane >> 4;
  const bool prompt = seq < 8;
  const int bidx = prompt ? seq : seq - 8;
  const int NB = prompt ? 8 : 128;
  const int L = prompt ? 2048 : 8;
  const int row0 = prompt ? seq * 2048 : MPR + (seq - 8) * 8;
  const int pos0 = prompt ? 0 : 16384;
  int cps = p.cps;
  asm volatile("" : "+s"(cps));
  const int ch_begin = prompt ? seg * cps : 0;
  const int ch_end = prompt ? ch_begin + cps : 1;
  const bool light = prompt && (pass == 1);
  const bool last_seg = !prompt || (seg == p.nseg - 1);
  const int cid = seq * 12 + MODE * 4 + sub;

  u16* Qa = (u16*)smem;
  u16* Ka = (u16*)(smem + 4352);
  u16* KuT = (u16*)(smem + 8704);
  u16* VaT = (u16*)(smem + 13824);
  u16* VuT = (MODE == 1) ? (u16*)(smem + 18944) : VaT;
  float* Of = (float*)(smem + 24064);
  u16* Raw = (u16*)(smem + 40704);
  u16* Xc = (u16*)(smem + 53248);
  float* tot = (float*)(smem + 57344);
  float* cdec = (float*)(smem + 58368);
  float* dtl = (float*)(smem + 58624);
  float* rsc = (float*)(smem + 58880);
  float* clast = (float*)(smem + 59392);
  float* segacc = (float*)(smem + 59408);

  const float* sin_ = nullptr;
  float* sout = nullptr;
  if (MODE == 0) {
    if (!prompt) sin_ = p.in[2] + (((size_t)l * 128 + bidx) * 4 + sub) * 16384;
    sout = p.out + (prompt ? p.o_ret_p : p.o_ret_s) + (((size_t)l * NB + bidx) * 4 + sub) * 16384;
  } else if (MODE == 2) {
    if (!prompt) sin_ = p.in[5] + (((size_t)l * 128 + bidx) * 4 + sub) * 16384;
    sout = p.out + (prompt ? p.o_hg_p : p.o_hg_s) + (((size_t)l * NB + bidx) * 4 + sub) * 16384;
  } else {
    if (!prompt) sin_ = p.in[3] + (((size_t)l * 128 + bidx) * 8 + sub * 2 + (w >> 1)) * 8192;
    sout = p.out + (prompt ? p.o_ssd_p : p.o_ssd_s) + (((size_t)l * NB + bidx) * 8 + sub * 2 + (w >> 1)) * 8192;
  }

  float lg = 0.f;
  if (MODE == 0) lg = log1pf(-exp2f(-5.f - (float)sub));

  int sbase = (MODE == 1) ? (((w & 1) * 32 + r16) * 128 + quad * 4) : (quad * 512 + w * 32 + r16);
  asm volatile("" : "+v"(sbase));
  f32x4 S[8][NE];
#pragma unroll
  for (int t = 0; t < 8; ++t)
#pragma unroll
    for (int u = 0; u < NE; ++u) {
      if (sin_) {
        if (MODE == 1) {
          S[t][u] = *(const f32x4*)(sin_ + sbase + u * 2048 + t * 16);
        } else {
#pragma unroll
          for (int jj = 0; jj < 4; ++jj) S[t][u][jj] = sin_[sbase + t * 2048 + jj * 128 + u * 16];
        }
      } else {
        S[t][u] = f32x4{0.f, 0.f, 0.f, 0.f};
      }
    }
  if (prompt && pass == 2) {
    for (int r = 0; r < seg; ++r) {
      const uint2* sl = (const uint2*)(p.slocal + (size_t)(cid * (p.nseg - 1) + r) * 16384) + tid;
      const float* sd = p.segdec + (size_t)(cid * 7 + r) * 128;
      float dsc = 1.f;
      if (MODE == 0) dsc = __expf(lg * (float)(16 * cps));
      if (MODE == 1) dsc = __expf(sd[w >> 1]);
#pragma unroll
      for (int t = 0; t < 8; ++t) {
        f32x4 dv = f32x4{dsc, dsc, dsc, dsc};
        if (MODE == 2) {
          f32x4 lv = *(const f32x4*)(sd + t * 16 + quad * 4);
          dv = f32x4{__expf(lv[0]), __expf(lv[1]), __expf(lv[2]), __expf(lv[3])};
        }
#pragma unroll
        for (int u = 0; u < NE; ++u) {
          uint2 pk = sl[(t * NE + u) * 256];
          S[t][u][0] = S[t][u][0] * dv[0] + bf2f((u16)(pk.x & 0xffff));
          S[t][u][1] = S[t][u][1] * dv[1] + bf2f((u16)(pk.x >> 16));
          S[t][u][2] = S[t][u][2] * dv[2] + bf2f((u16)(pk.y & 0xffff));
          S[t][u][3] = S[t][u][3] * dv[3] + bf2f((u16)(pk.y >> 16));
        }
      }
    }
  }

  float lbv = 0.f;
  float hg_tot = 0.f;
  float cprev[2][3];
  float cw[2][4], cb[2];
  int ccidx[2];
  float dt_bias = 0.f, dt_A = 0.f;
  float rinv = 0.f, rcD = 1.f, rsD = 0.f;
  const int gg = sub >> 1, pair = sub & 1;
  if (MODE == 0) {
    rinv = exp2f(-(float)(tid & 63) * (13.287712379549449f / 64.f));
    rsD = __sinf(rinv); rcD = __cosf(rinv);
  }
  if (MODE == 2) {
    if (l == 1) {
      float a0 = p.in[20][sub * 128 + (tid & 127)], a1 = p.in[20][512 + sub * 128 + (tid & 127)];
      float mx = fmaxf(a0, a1);
      float e0 = __expf(a0 - mx), e1 = __expf(a1 - mx);
      lbv = e1 / (e0 + e1);
    }
  }
  if (MODE == 1) {
    if (tid < 32) {
      const int hh = sub * 2 + (tid >> 4);
      dt_A = -__expf(p.in[16][l * 8 + hh]);
      dt_bias = p.in[17][l * 8 + hh];
    }
    if (tid < 2) segacc[tid] = 0.f;
#pragma unroll
    for (int k = 0; k < 2; ++k) {
      int ci = tid + 256 * k;
      int cc = 0;
      if (ci < 128) cc = gg * 256 + pair * 128 + ci;
      else if (ci < 256) cc = 512 + gg * 128 + (ci - 128);
      else cc = 768 + gg * 128 + (ci - 256);
      if (ci >= 384) cc = 0;
      ccidx[k] = cc;
#pragma unroll
      for (int j = 0; j < 4; ++j) cw[k][j] = p.in[14][((size_t)l * 4 + j) * 1024 + cc];
      cb[k] = p.in[15][l * 1024 + cc];
#pragma unroll
      for (int j = 0; j < 3; ++j) {
        float v = 0.f;
        if (!prompt) v = p.in[4][(((size_t)l * 128 + bidx) * 3 + j) * 1024 + cc];
        else if (ch_begin > 0) v = bf2f(p.pbuf[(size_t)(row0 + ch_begin * 16 - 3 + j) * NP + C_SXBC + cc]);
        cprev[k][j] = v;
      }
    }
  }

  float fgain[8];
  {
    const int eg_ = tid & 15;
#pragma unroll
    for (int x = 0; x < 8; ++x) {
      if (MODE == 0) fgain[x] = p.in[13][(l * 4 + sub) * 128 + eg_ * 8 + x];
      else if (MODE == 2) fgain[x] = p.in[21][l * 128 + eg_ * 8 + x];
      else fgain[x] = p.in[18][l * 8 + sub * 2 + ((eg_ * 8) >> 6)];
    }
  }
  const int lt = tid >> 4, lc = tid & 15;
  uint4 r0, r1, r2, g0;
  unsigned rdt = 0;
  const uint4 z4 = make_uint4(0, 0, 0, 0);
  r0 = r1 = r2 = g0 = z4;
  auto load_raw = [&](int ch) {
    const int t0 = ch * 16;
    const int nv = (L - t0 < 16) ? (L - t0) : 16;
    const u16* Pr = p.pbuf + (size_t)(row0 + t0 + lt) * NP;
    r0 = r1 = r2 = g0 = z4;
    rdt = 0;
    if (lt < nv) {
      if (MODE == 0) {
        r0 = *(const uint4*)(Pr + C_RQ + sub * 128 + lc * 8);
        r1 = *(const uint4*)(Pr + C_RK + sub * 128 + lc * 8);
        r2 = *(const uint4*)(Pr + C_RV + sub * 128 + lc * 8);
        g0 = *(const uint4*)(Pr + C_RG + sub * 128 + lc * 8);
      } else if (MODE == 2) {
        r0 = *(const uint4*)(Pr + C_HQ + sub * 128 + lc * 8);
        r1 = *(const uint4*)(Pr + C_HF + sub * 128 + lc * 8);
        r2 = *(const uint4*)(Pr + C_HI + sub * 128 + lc * 8);
        g0 = *(const uint4*)(Pr + C_HG + sub * 128 + lc * 8);
      } else {
        r0 = *(const uint4*)(Pr + C_SXBC + gg * 256 + pair * 128 + lc * 8);
        r1 = *(const uint4*)(Pr + C_SXBC + 512 + gg * 128 + lc * 8);
        r2 = *(const uint4*)(Pr + C_SXBC + 768 + gg * 128 + lc * 8);
        g0 = *(const uint4*)(Pr + C_SZ + gg * 256 + pair * 128 + lc * 8);
        if (lc < 2) rdt = Pr[C_SDT + sub * 2 + lc];
      }
    }
  };
  load_raw(ch_begin);

  for (int ch = ch_begin; ch < ch_end; ++ch) {
    const int t0 = ch * 16;
    const int nvalid = (L - t0 < 16) ? (L - t0) : 16;
    float sscale = 1.f;
    int tidv = threadIdx.x;
    asm volatile("" : "+v"(tidv));
    const int tid = tidv, lane = tid & 63, w = tid >> 6, r16 = lane & 15, quad = lane >> 4, lt = tid >> 4, lc = tid & 15;

    *(uint4*)(Raw + lt * 128 + lc * 8) = r0;
    *(uint4*)(Raw + 2048 + lt * 128 + lc * 8) = r1;
    *(uint4*)(Raw + 4096 + lt * 128 + lc * 8) = r2;
    if (MODE == 1) { if (lc < 2) Raw[6144 + lt * 2 + lc] = (u16)rdt; }
    const uint4 gc0 = g0;
    __syncthreads();
    if (ch + 1 < ch_end) load_raw(ch + 1);

    if (MODE == 0) {
      const int which = tid >> 7, pr = tid & 63, th = (tid >> 6) & 1;
      if (which == 1 || !light) {
        const u16* R = Raw + which * 2048;
        float sn, cs;
        sincos_red((float)(pos0 + t0 + th * 8) * rinv, sn, cs);
#pragma unroll
        for (int x = 0; x < 8; ++x) {
          const int t = th * 8 + x;
          float x1 = bf2f(R[t * 128 + pr]);
          float x2 = bf2f(R[t * 128 + pr + 64]);
          float y1 = x1 * cs - x2 * sn, y2 = x1 * sn + x2 * cs;
          if (which) {
            y1 *= 0.08838834764831845f; y2 *= 0.08838834764831845f;
            Ka[t * QS + pr] = f2bf(y1); Ka[t * QS + pr + 64] = f2bf(y2);
            float kd = __expf(lg * (float)(nvalid - 1 - t));
            KuT[pr * TS + t] = f2bf(y1 * kd);
            KuT[(pr + 64) * TS + t] = f2bf(y2 * kd);
          } else {
            Qa[t * QS + pr] = f2bf(y1); Qa[t * QS + pr + 64] = f2bf(y2);
          }
          float ncs = cs * rcD - sn * rsD;
          sn = sn * rcD + cs * rsD; cs = ncs;
        }
      }
      if (tid < 16) cdec[tid] = lg * (float)(tid + 1);
      sscale = __expf(lg * (float)nvalid);
    } else if (MODE == 2) {
      const int d = tid & 127, th = tid >> 7;
      float cl[8], kk[8], qv[8];
      float c = 0.f;
#pragma unroll
      for (int x = 0; x < 8; ++x) {
        const int t = th * 8 + x;
        kk[x] = 0.f; qv[x] = 0.f;
        if (t < nvalid) {
          float z = bf2f(Raw[2048 + t * 128 + d]);
          float sg = sigmoidf_(z);
          float f = lbv + (1.f - lbv) * sg;
          c += __logf(f);
          kk[x] = (1.f - lbv) * (1.f - sg);
          if (!light) qv[x] = siluf_(bf2f(Raw[t * 128 + d]));
        }
        cl[x] = c;
      }
      tot[th * 128 + d] = c;
      __syncthreads();
      const float c_lo = tot[d];
      const float c_all = c_lo + tot[128 + d];
      const float off = th ? c_lo : 0.f;
      const float e_all = __expf(c_all);
#pragma unroll
      for (int x = 0; x < 8; ++x) {
        const int t = th * 8 + x;
        const float ct = off + cl[x];
        const float ein = __expf(-ct);
        if (!light) {
          Qa[t * QS + d] = f2bf(qv[x] * __frcp_rn(ein));
          Ka[t * QS + d] = f2bf(kk[x] * ein);
        }
        KuT[d * TS + t] = f2bf(kk[x] * ein * e_all);
      }
      if (th == 0) { rsc[d] = e_all; hg_tot += c_all; }
    } else {
      if (tid < 32) {
        const int hl = tid >> 4, t = tid & 15;
        float dtv = 0.f, c = 0.f;
        if (t < nvalid) {
          dtv = softplusf_(bf2f(Raw[6144 + t * 2 + hl]) + dt_bias);
          c = dtv * dt_A;
        }
#pragma unroll
        for (int o = 1; o < 16; o <<= 1) {
          float v = __shfl_up(c, o, 16);
          if (t >= o) c += v;
        }
        cdec[hl * 16 + t] = c;
        dtl[hl * 16 + t] = dtv;
        if (t == 15) { clast[hl] = c; segacc[hl] += c; }
      }
      __syncthreads();
#pragma unroll
      for (int k = 0; k < 2; ++k) {
        const int ci = tid + 256 * k;
        if (ci < 256 || (ci < 384 && !light)) {
          const int hl = (ci < 128) ? (ci >> 6) : 0;
          const float cl = clast[hl];
          const u16* R = Raw + ((ci < 128) ? ci : ((ci < 256) ? (2048 + (ci - 128)) : (4096 + (ci - 256))));
#pragma unroll 4
          for (int t = 0; t < 16; ++t) {
            float v = 0.f;
            if (t < nvalid) {
              float raw = bf2f(R[t * 128]);
              float o = cb[k] + cprev[k][0] * cw[k][0] + cprev[k][1] * cw[k][1] + cprev[k][2] * cw[k][2] + raw * cw[k][3];
              cprev[k][0] = cprev[k][1]; cprev[k][1] = cprev[k][2]; cprev[k][2] = raw;
              v = siluf_(o);
            }
            if (ci < 128) {
              float dtv = dtl[hl * 16 + t];
              if (!light) { Xc[t * 128 + ci] = f2bf(v); VaT[ci * TS + t] = f2bf(v * dtv); }
              VuT[ci * TS + t] = f2bf(v * dtv * __expf(cl - cdec[hl * 16 + t]));
            } else if (ci < 256) {
              u16 a = f2bf(v);
              if (!light) Ka[t * QS + (ci - 128)] = a;
              KuT[(ci - 128) * TS + t] = a;
            } else {
              Qa[t * QS + (ci - 256)] = f2bf(v);
            }
          }
        }
      }
    }
    if (MODE != 1) {
      const int e = tid & 127, th = tid >> 7;
#pragma unroll
      for (int x = 0; x < 4; ++x) {
        const int t = th * 8 + 2 * x;
        unsigned lo = Raw[4096 + t * 128 + e], hi = Raw[4096 + (t + 1) * 128 + e];
        *(unsigned*)(VaT + e * TS + t) = lo | (hi << 16);
      }
    }
    __syncthreads();

    {
      const float* cd = cdec + ((MODE == 1) ? (w >> 1) * 16 : 0);
      bf16x8 attA;
      float rr[4];
      bf16x8 qf[4];
      if (!light) {
        f32x4 at = f32x4{0.f, 0.f, 0.f, 0.f};
#pragma unroll
        for (int s = 0; s < 4; ++s) {
          bf16x8 a = *(const bf16x8*)(Ka + r16 * QS + s * 32 + quad * 8);
          bf16x8 b = *(const bf16x8*)(Qa + r16 * QS + s * 32 + quad * 8);
          at = MFMA16(a, b, at);
        }
        float ci_ = (MODE != 2) ? cd[r16] : 0.f;
        float vv[4];
#pragma unroll
        for (int jj = 0; jj < 4; ++jj) {
          int j = quad * 4 + jj;
          float v = at[jj];
          if (MODE != 2) v *= __expf(fminf(ci_ - cd[j], 0.f));
          vv[jj] = (j <= r16) ? v : 0.f;
        }
        unsigned a01 = pack2(vv[0], vv[1]), a23 = pack2(vv[2], vv[3]);
        attA = __builtin_bit_cast(bf16x8, (u32x4){a01, a23, 0u, 0u});
#pragma unroll
        for (int jj = 0; jj < 4; ++jj) rr[jj] = (MODE != 2) ? __expf(cd[quad * 4 + jj]) : 1.f;
#pragma unroll
        for (int s = 0; s < 4; ++s) {
          bf16x4 lo = *(const bf16x4*)(Qa + r16 * QS + s * 32 + quad * 4);
          bf16x4 hi = *(const bf16x4*)(Qa + r16 * QS + s * 32 + 16 + quad * 4);
          qf[s] = bf16x8{lo[0], lo[1], lo[2], lo[3], hi[0], hi[1], hi[2], hi[3]};
        }
      }
      if (!light) {
#pragma unroll
        for (int u = 0; u < NE; ++u) {
          const int e0 = (w * NE + u) * 16;
          bf16x4 v4 = *(const bf16x4*)(VaT + (e0 + r16) * TS + quad * 4);
          bf16x8 vb = bf16x8{v4[0], v4[1], v4[2], v4[3], 0, 0, 0, 0};
          f32x4 o1 = MFMA16(attA, vb, (f32x4{0.f, 0.f, 0.f, 0.f}));
          f32x4 o2 = f32x4{0.f, 0.f, 0.f, 0.f};
#pragma unroll
          for (int s = 0; s < 4; ++s) {
            u32x4 sp = {pack2(S[2 * s][u][0], S[2 * s][u][1]), pack2(S[2 * s][u][2], S[2 * s][u][3]),
                        pack2(S[2 * s + 1][u][0], S[2 * s + 1][u][1]), pack2(S[2 * s + 1][u][2], S[2 * s + 1][u][3])};
            o2 = MFMA16(qf[s], __builtin_bit_cast(bf16x8, sp), o2);
          }
#pragma unroll
          for (int jj = 0; jj < 4; ++jj) Of[(quad * 4 + jj) * OFS + e0 + r16] = o1[jj] + rr[jj] * o2[jj];
        }
      }
      float hs = 1.f;
      if (MODE == 0) hs = sscale;
      if (MODE == 1) hs = __expf(clast[w >> 1]);
#pragma unroll
      for (int u = 0; u < NE; ++u) {
        const int e0 = (w * NE + u) * 16;
        bf16x4 v4 = *(const bf16x4*)(VuT + (e0 + r16) * TS + quad * 4);
        bf16x8 vb = bf16x8{v4[0], v4[1], v4[2], v4[3], 0, 0, 0, 0};
#pragma unroll
        for (int t = 0; t < 8; ++t) {
          bf16x4 k4 = *(const bf16x4*)(KuT + (t * 16 + r16) * TS + quad * 4);
          bf16x8 ka = bf16x8{k4[0], k4[1], k4[2], k4[3], 0, 0, 0, 0};
          f32x4 sv = S[t][u];
          if (MODE == 2) {
            f32x4 r4 = *(const f32x4*)(rsc + t * 16 + quad * 4);
            sv[0] *= r4[0]; sv[1] *= r4[1]; sv[2] *= r4[2]; sv[3] *= r4[3];
          } else {
            sv[0] *= hs; sv[1] *= hs; sv[2] *= hs; sv[3] *= hs;
          }
          S[t][u] = MFMA16(ka, vb, sv);
        }
      }
    }
    __syncthreads();

    if (!light) {
      const int i = tid >> 4, eg = tid & 15;
      const int grow = row0 + t0 + i;
      unsigned gw[4] = {gc0.x, gc0.y, gc0.z, gc0.w};
      if (MODE == 0 || MODE == 2) {
        float o[8];
#pragma unroll
        for (int x = 0; x < 8; ++x) o[x] = Of[i * OFS + eg * 8 + x];
        float s1 = 0.f;
        float mu = 0.f;
        if (MODE == 0) {
#pragma unroll
          for (int x = 0; x < 8; ++x) s1 += o[x];
          mu = sum16(s1) * (1.f / 128.f);
        }
        float s2 = 0.f;
#pragma unroll
        for (int x = 0; x < 8; ++x) { o[x] -= mu; s2 += o[x] * o[x]; }
        float r = rsqrtf(sum16(s2) * (1.f / 128.f) + EPS);
        if (i < nvalid) {
          float res[8];
#pragma unroll
          for (int x = 0; x < 8; ++x) {
            float g = bf2f((u16)((x & 1) ? (gw[x >> 1] >> 16) : (gw[x >> 1] & 0xffff)));
            float gate = (MODE == 0) ? siluf_(g) : sigmoidf_(g);
            res[x] = o[x] * r * fgain[x] * gate;
          }
          uint4 ov = make_uint4(pack2(res[0], res[1]), pack2(res[2], res[3]), pack2(res[4], res[5]), pack2(res[6], res[7]));
          const int ocol = ((MODE == 0) ? 0 : 1024) + sub * 128 + eg * 8;
          *(uint4*)(p.obuf + (size_t)grow * OLD + ocol) = ov;
        }
      } else {
        float y[8];
        const int chb = eg * 8;
        const float Dh = fgain[0];
        float s2 = 0.f;
#pragma unroll
        for (int x = 0; x < 8; ++x) {
          float g = bf2f((u16)((x & 1) ? (gw[x >> 1] >> 16) : (gw[x >> 1] & 0xffff)));
          float v = Of[i * OFS + chb + x] + bf2f(Xc[i * 128 + chb + x]) * Dh;
          v *= siluf_(g);
          y[x] = v; s2 += v * v;
        }
        s2 = sum16(s2);
        if (i < nvalid) {
          if (eg == 0) p.ssq[(size_t)grow * 4 + sub] = s2;
          uint4 ov = make_uint4(pack2(y[0], y[1]), pack2(y[2], y[3]), pack2(y[4], y[5]), pack2(y[6], y[7]));
          *(uint4*)(p.obuf + (size_t)grow * OLD + 512 + sub * 128 + chb) = ov;
        }
      }
    }
  }
  __syncthreads();

  if (light) {
    uint2* sl = (uint2*)(p.slocal + (size_t)(cid * (p.nseg - 1) + seg) * 16384) + tid;
#pragma unroll
    for (int t = 0; t < 8; ++t)
#pragma unroll
      for (int u = 0; u < NE; ++u)
        sl[(t * NE + u) * 256] = make_uint2(pack2(S[t][u][0], S[t][u][1]), pack2(S[t][u][2], S[t][u][3]));
    float* sd = p.segdec + (size_t)(cid * 7 + seg) * 128;
    if (MODE == 1) { if (tid < 2) sd[tid] = segacc[tid]; }
    if (MODE == 2) { if (tid < 128) sd[tid] = hg_tot; }
  } else if (last_seg) {
    asm volatile("" : "+v"(sbase));
#pragma unroll
    for (int t = 0; t < 8; ++t)
#pragma unroll
      for (int u = 0; u < NE; ++u) {
        if (MODE == 1) {
          *(f32x4*)(sout + sbase + u * 2048 + t * 16) = S[t][u];
        } else {
#pragma unroll
          for (int jj = 0; jj < 4; ++jj) sout[sbase + t * 2048 + jj * 128 + u * 16] = S[t][u][jj];
        }
      }
    if (MODE == 1) {
      float* co = p.out + (prompt ? p.o_conv_p : p.o_conv_s) + ((size_t)l * NB + bidx) * 3 * 1024;
#pragma unroll
      for (int k = 0; k < 2; ++k) {
        const int ci = tid + 256 * k;
        if (ci < 128 || (ci < 384 && pair == 0)) {
#pragma unroll
          for (int j = 0; j < 3; ++j) co[j * 1024 + ccidx[k]] = cprev[k][j];
        }
      }
    }
  }
}

__device__ void run_s5(const Params& p, int l, int seq, int gq, int seg, int pass, char* smem) {
  const int tid = tidq(), lane = tid & 63, w = tid >> 6, r16 = lane & 15, quad = lane >> 4;
  const int g = gq * 4 + w;
  const bool prompt = seq < 8;
  const int bidx = prompt ? seq : seq - 8;
  const int NB = prompt ? 8 : 128;
  const int row0 = prompt ? seq * 2048 : MPR + (seq - 8) * 8;
  int cps_ = p.cps;
  asm volatile("" : "+s"(cps_));
  const int nch = prompt ? cps_ : 1;
  const int ch_begin = prompt ? seg * nch : 0;
  const int ch_end = ch_begin + nch;
  const int nvalid = prompt ? 16 : 8;
  const bool light = prompt && (pass == 1);
  const bool last_seg = !prompt || (seg == p.nseg - 1);
  char* wb = smem + w * 5120;
  u16* Hs = (u16*)wb;
  u16* Us = (u16*)(wb + 4352);
  const int lg_ = l * 32 + g;

  const float dt = __expf(p.in[29][lg_]);
  float Ar[4][4], Ai[4][4];
  float fre[4], fim[4];
  float dtare[4], thv[4];
#pragma unroll
  for (int i = 0; i < 4; ++i) {
    const int pi = i * 16 + r16;
    const float are = p.in[22][lg_ * 64 + pi], aim = p.in[23][lg_ * 64 + pi];
    const float th = dt * aim;
    float sn, cs; sincos_red(th, sn, cs);
    float shalf, chalf; sincos_red(0.5f * th, shalf, chalf);
    const float em1 = expm1f(dt * are);
    const float mag = em1 + 1.f;
    const float abr = mag * cs, abi = mag * sn;
    const float nre = em1 * cs - 2.f * shalf * shalf, nim = abi;
    const float den = are * are + aim * aim;
    fre[i] = (nre * are + nim * aim) / den; fim[i] = (nim * are - nre * aim) / den;
    dtare[i] = dt * are; thv[i] = th;
    Ar[0][i] = abr; Ai[0][i] = abi;
    Ar[1][i] = abr * abr - abi * abi; Ai[1][i] = 2.f * abr * abi;
    Ar[2][i] = Ar[1][i] * abr - Ai[1][i] * abi; Ai[2][i] = Ar[1][i] * abi + Ai[1][i] * abr;
    Ar[3][i] = Ar[1][i] * Ar[1][i] - Ai[1][i] * Ai[1][i]; Ai[3][i] = 2.f * Ar[1][i] * Ai[1][i];
  }
  bf16x8 Bop[8];
#pragma unroll
  for (int nt = 0; nt < 8; ++nt) {
    const int i = nt & 3;
    u32x4 pk = {0u, 0u, 0u, 0u};
    if (quad < 2) {
      const size_t bo = ((size_t)lg_ * 64 + i * 16 + r16) * 16 + quad * 8;
      const float4 br0 = *(const float4*)(p.in[24] + bo), br1 = *(const float4*)(p.in[24] + bo + 4);
      const float4 bi0 = *(const float4*)(p.in[25] + bo), bi1 = *(const float4*)(p.in[25] + bo + 4);
      const float brv[8] = {br0.x, br0.y, br0.z, br0.w, br1.x, br1.y, br1.z, br1.w};
      const float biv[8] = {bi0.x, bi0.y, bi0.z, bi0.w, bi1.x, bi1.y, bi1.z, bi1.w};
      float v[8];
#pragma unroll
      for (int j = 0; j < 8; ++j)
        v[j] = (nt < 4) ? (fre[i] * brv[j] - fim[i] * biv[j]) : (fre[i] * biv[j] + fim[i] * brv[j]);
      pk = u32x4{pack2(v[0], v[1]), pack2(v[2], v[3]), pack2(v[4], v[5]), pack2(v[6], v[7])};
    }
    Bop[nt] = __builtin_bit_cast(bf16x8, pk);
  }
  bf16x8 Cop[4];
  float Dm[4] = {0.f, 0.f, 0.f, 0.f};
  if (!light) {
#pragma unroll
    for (int s = 0; s < 4; ++s) {
      const int n0 = 32 * s + quad * 8;
      const float* src = ((n0 >= 64) ? p.in[27] : p.in[26]) + ((size_t)lg_ * 16 + r16) * 64 + (n0 & 63);
      const float sg = (n0 >= 64) ? -1.f : 1.f;
      const float4 c0 = *(const float4*)src, c1 = *(const float4*)(src + 4);
      Cop[s] = __builtin_bit_cast(bf16x8, (u32x4{pack2(sg * c0.x, sg * c0.y), pack2(sg * c0.z, sg * c0.w),
                                                 pack2(sg * c1.x, sg * c1.y), pack2(sg * c1.z, sg * c1.w)}));
    }
#pragma unroll
    for (int jj = 0; jj < 4; ++jj) Dm[jj] = p.in[28][lg_ * 16 + quad * 4 + jj];
  }
  float hr[4], hi[4];
#pragma unroll
  for (int i = 0; i < 4; ++i) { hr[i] = 0.f; hi[i] = 0.f; }
  if (!prompt) {
#pragma unroll
    for (int i = 0; i < 4; ++i) {
      hr[i] = p.in[6][((size_t)(l * 128 + bidx) * 32 + g) * 64 + i * 16 + r16];
      hi[i] = p.in[7][((size_t)(l * 128 + bidx) * 32 + g) * 64 + i * 16 + r16];
    }
  } else if (pass == 2 && seg > 0) {
    const float len = (float)(nch * 16);
#pragma unroll
    for (int i = 0; i < 4; ++i) {
      const float pm = __expf(len * dtare[i]);
      float ps, pc; sincos_red(len * thv[i], ps, pc);
      const float pr_ = pm * pc, pi_ = pm * ps;
      for (int r = 0; r < seg; ++r) {
        const float* hl = p.hlocal + ((size_t)((seq * 32 + g) * 7 + r)) * 128;
        const float lr_ = hl[i * 16 + r16], li_ = hl[64 + i * 16 + r16];
        const float nr = pr_ * hr[i] - pi_ * hi[i] + lr_;
        const float ni = pr_ * hi[i] + pi_ * hr[i] + li_;
        hr[i] = nr; hi[i] = ni;
      }
    }
  }
  const int ut = lane >> 1, uh = lane & 1;
  const u16* ubase = p.pbuf + (size_t)(row0 + ut) * NP + C_SU + g * 16 + uh * 8;
  const uint4 z4 = make_uint4(0, 0, 0, 0);
  uint4 nxt = z4;
  if (lane < 32 && ut < nvalid) nxt = *(const uint4*)(ubase + (size_t)ch_begin * 16 * NP);
  for (int ch = ch_begin; ch < ch_end; ++ch) {
    const uint4 cur = nxt;
    nxt = z4;
    if (ch + 1 < ch_end && lane < 32) nxt = *(const uint4*)(ubase + (size_t)(ch + 1) * 16 * NP);
    if (lane < 32) *(uint4*)(Us + ut * 16 + uh * 8) = cur;
    __syncthreads();
    bf16x8 Uop = bf16x8{0, 0, 0, 0, 0, 0, 0, 0};
    if (quad < 2) Uop = *(const bf16x8*)(Us + r16 * 16 + quad * 8);
    f32x4 bu[8];
#pragma unroll
    for (int nt = 0; nt < 8; ++nt) bu[nt] = MFMA16(Uop, Bop[nt], (f32x4{0.f, 0.f, 0.f, 0.f}));
    float Er[4], Ei[4];
#pragma unroll
    for (int i = 0; i < 4; ++i) {
      float xr = 0.f, xi = 0.f;
#pragma unroll
      for (int jj = 0; jj < 4; ++jj) {
        const float nr = Ar[0][i] * xr - Ai[0][i] * xi + bu[i][jj];
        const float ni = Ar[0][i] * xi + Ai[0][i] * xr + bu[4 + i][jj];
        xr = nr; xi = ni;
        bu[i][jj] = xr; bu[4 + i][jj] = xi;
      }
      Er[i] = xr; Ei[i] = xi;
    }
    float cr[4], ci[4];
#pragma unroll
    for (int i = 0; i < 4; ++i) { cr[i] = hr[i]; ci[i] = hi[i]; }
#pragma unroll
    for (int k = 0; k < 4; ++k) {
#pragma unroll
      for (int i = 0; i < 4; ++i) {
        const float er = __shfl(Er[i], r16 + 16 * k), ei = __shfl(Ei[i], r16 + 16 * k);
        const float nr = Ar[3][i] * hr[i] - Ai[3][i] * hi[i] + er;
        const float ni = Ar[3][i] * hi[i] + Ai[3][i] * hr[i] + ei;
        if (k * 4 < nvalid) { hr[i] = nr; hi[i] = ni; }
        if (k < quad) { cr[i] = nr; ci[i] = ni; }
      }
    }
    if (!light) {
#pragma unroll
      for (int i = 0; i < 4; ++i)
#pragma unroll
        for (int jj = 0; jj < 4; ++jj) {
          const float vr = bu[i][jj] + Ar[jj][i] * cr[i] - Ai[jj][i] * ci[i];
          const float vi = bu[4 + i][jj] + Ar[jj][i] * ci[i] + Ai[jj][i] * cr[i];
          Hs[(quad * 4 + jj) * 136 + i * 16 + r16] = f2bf(vr);
          Hs[(quad * 4 + jj) * 136 + 64 + i * 16 + r16] = f2bf(vi);
        }
      __syncthreads();
      f32x4 ya = f32x4{0.f, 0.f, 0.f, 0.f};
#pragma unroll
      for (int s = 0; s < 4; ++s) {
        const bf16x8 bh = *(const bf16x8*)(Hs + r16 * 136 + s * 32 + quad * 8);
        ya = MFMA16(Cop[s], bh, ya);
      }
      const uint2 uu = *(const uint2*)(Us + r16 * 16 + quad * 4);
      const float u0 = bf2f((u16)(uu.x & 0xffff)), u1 = bf2f((u16)(uu.x >> 16));
      const float u2 = bf2f((u16)(uu.y & 0xffff)), u3 = bf2f((u16)(uu.y >> 16));
      const float z0 = gelu_tanh(ya[0] + Dm[0] * u0), z1 = gelu_tanh(ya[1] + Dm[1] * u1);
      const float z2 = gelu_tanh(ya[2] + Dm[2] * u2), z3 = gelu_tanh(ya[3] + Dm[3] * u3);
      if (r16 < nvalid)
        *(uint2*)(p.zs5 + (size_t)(row0 + ch * 16 + r16) * ZLD + g * 16 + quad * 4) = make_uint2(pack2(z0, z1), pack2(z2, z3));
    }
    __syncthreads();
  }
  if (light) {
    if (quad == 0) {
      float* hl = p.hlocal + ((size_t)((seq * 32 + g) * 7 + seg)) * 128;
#pragma unroll
      for (int i = 0; i < 4; ++i) { hl[i * 16 + r16] = hr[i]; hl[64 + i * 16 + r16] = hi[i]; }
    }
  } else if (last_seg) {
    if (quad == 0) {
      float* o_r = p.out + (prompt ? p.o_s5r_p : p.o_s5r_s) + ((size_t)(l * NB + bidx) * 32 + g) * 64;
      float* o_i = p.out + (prompt ? p.o_s5i_p : p.o_s5i_s) + ((size_t)(l * NB + bidx) * 32 + g) * 64;
#pragma unroll
      for (int i = 0; i < 4; ++i) { o_r[i * 16 + r16] = hr[i]; o_i[i * 16 + r16] = hi[i]; }
    }
  }
}

__device__ void phase_mixers(const Params& p, int l, int pass, char* smem, int visit) {
  int* s_item = (int*)(smem + 65536);
  unsigned* cnt = p.counters + l * 64 + (pass - 1) * 32 + visit * 16;
  const int nseg = p.nseg;
  const int ns1 = nseg - 1;
  const int n_chain = (pass == 1) ? 96 * ns1 : 96 * nseg;
  const int n_s5 = (pass == 1) ? 64 * ns1 : 64 * nseg;
  const int n_items = n_chain + n_s5 + ((pass == 1) ? 128 * 20 : 0);
  for (;;) {
    if (tidq() == 0) *s_item = (int)atomicAdd(cnt, 1u);
    __syncthreads();
    const int item = *s_item;
    __syncthreads();
    if (item >= n_items) break;
    int mode, seq, sub, seg = 0;
    const int per = (pass == 1) ? ns1 : nseg;
    if (item < n_chain) {
      const int c = item / per; seg = item % per;
      const int kind = c >> 5, r = c & 31;
      seq = r >> 2; sub = r & 3;
      mode = (kind == 0) ? 1 : ((kind == 1) ? 2 : 0);
    } else if (item < n_chain + n_s5) {
      const int k = item - n_chain;
      const int c = k / per; seg = k % per;
      mode = 3; seq = c >> 3; sub = c & 7;
    } else {
      int k = item - n_chain - n_s5; int b = k / 20; sub = k % 20; seq = 8 + b;
      if (sub < 4) mode = 1;
      else if (sub < 8) { mode = 0; sub -= 4; }
      else if (sub < 12) { mode = 2; sub -= 8; }
      else { mode = 3; sub -= 12; }
    }
    const int ps = (seq >= 8) ? 2 : pass;
    if (mode == 0) { if (EN(2) || ONLY == 20) run_chain<0>(p, l, seq, sub, seg, ps, smem); }
    else if (mode == 1) { if (EN(2) || ONLY == 21) run_chain<1>(p, l, seq, sub, seg, ps, smem); }
    else if (mode == 2) { if (EN(2) || ONLY == 22) run_chain<2>(p, l, seq, sub, seg, ps, smem); }
    else { if (EN(2) || ONLY == 23) run_s5(p, l, seq, sub, seg, ps, smem); }
    __syncthreads();
  }
}

DI bool tile_at(int i, int T, int& t) {
  const int bpx = gridDim.x >> 3;
  t = ((blockIdx.x & 7) + 8 * i) * bpx + (blockIdx.x >> 3);
  return t < T;
}
DI void tile_mn(int t, int nN, int& m0, int& n0) {
  const int per = 8 * nN;
  const int grp = t / per, r = t - grp * per;
  m0 = (grp * 8 + (r & 7)) * 128;
  n0 = (r >> 3) * 128;
}

__device__ void run_phase(const Params& p, int ph, char* smem, int visit) {
  constexpr int NMT = MTOK / 128;
  if (ph == 0) {
    if (EN(9)) phase_convert(p, smem);
    if (EN(0)) phase_rownorm(p, true, nullptr, nullptr, p.in[8], p.hb);
    return;
  }
  if (ph == NPHASE - 1) {
    if (EN(10)) phase_rownorm(p, false, p.tbuf, p.in[11] + 1 * DM, nullptr, nullptr);
    return;
  }
  const int l = (ph <= 9) ? 0 : 1, s0_ = (ph <= 9) ? ph : ph - 10;
  const int s = (s0_ <= 2) ? s0_ : s0_ - 1;
  switch (s) {
    case 0:
      if (!EN(0)) break;
      phase_rownorm(p, false, p.tbuf, p.in[11] + (l - 1) * DM, p.in[8] + l * DM, p.hb);
      break;
    case 1: if (EN(1)) {
      constexpr int NN = NP / 128;
      gemm_stream<EPI_BF16>(p.hb, HLD, p.wt_in + (size_t)l * NIN * WLD1, WLD1, DM, NN, NMT * NN, p.pbuf, NP, nullptr, 0, smem);
    } break;
    case 2: if (EN(2) || (ONLY >= 20 && ONLY <= 23)) phase_mixers(p, l, (s0_ == 2) ? 1 : 2, smem, visit); break;
    case 3: if (EN(3)) {
      constexpr int NG = 32, NGLU = 4;
      {
        const int lane = tidq() & 63, w = tidq() >> 6;
        for (int row = blockIdx.x * 4 + w; row < MTOK; row += gridDim.x * 4) {
          const float4 sq = *(const float4*)(p.ssq + (size_t)row * 4);
          const float ms = (lane < 32) ? (sq.x + sq.y) : (sq.z + sq.w);
          const float r = rsqrtf(ms * (1.f / 256.f) + EPS);
          u16* ptr = p.obuf + (size_t)row * OLD + 512 + lane * 8;
          uint4 v = *(const uint4*)ptr;
          const float* gn = p.in[19] + l * 512 + lane * 8;
          unsigned vw[4] = {v.x, v.y, v.z, v.w};
          unsigned ow[4];
#pragma unroll
          for (int x = 0; x < 4; ++x)
            ow[x] = pack2(bf2f((u16)(vw[x] & 0xffff)) * r * gn[2 * x], bf2f((u16)(vw[x] >> 16)) * r * gn[2 * x + 1]);
          *(uint4*)ptr = make_uint4(ow[0], ow[1], ow[2], ow[3]);
        }
      }
      gemm_stream<EPI_SIG>(p.hb, HLD, p.wt_in + ((size_t)l * NIN + NP) * WLD1, WLD1, DM, NG, NMT * NG, p.pbuf, 4096, nullptr, 0, smem);
      gemm_stream<EPI_GLU>(p.zs5, ZLD, p.wt_glu + (size_t)l * 512 * WLD5, WLD5, 512, NGLU, NMT * NGLU,
                           p.obuf + 1536, OLD, p.zs5, ZLD, smem);
    } break;
    case 4:
      if (EN(4)) {
        int t, m0, n0;
        for (int i = 0; tile_at(i, NMT * 8, t); ++i) { tile_mn(t, 8, m0, n0); merge_tile(p, l, m0, n0, smem); }
      }
      break;
    case 5:
      if (EN(5)) {
        if (gridDim.x == 512) gemm_stream_split(p.hb, HLD, p.wt_out + (size_t)l * DM * WLD1, WLD1, DM, p.tbuf, (float*)p.obuf, smem);
        else gemm_stream<EPI_F32>(p.hb, HLD, p.wt_out + (size_t)l * DM * WLD1, WLD1, DM, 8, NMT * 8, p.tbuf, DM, nullptr, 0, smem);
      }
      break;
    case 6:
      if (EN(6)) phase_rownorm(p, false, p.tbuf, p.in[9] + l * DM, p.in[10] + l * DM, p.hb);
      break;
    case 7:
      if (EN(7)) {
        gemm_stream<EPI_RELU2>(p.hb, HLD, p.wt_ff1 + (size_t)l * DFF * WLD1, WLD1, DM, 32, NMT * 32, p.pbuf, ULD, nullptr, 0, smem);
      }
      break;
    case 8:
      if (EN(8)) {
        if (gridDim.x == 512) gemm_stream_split(p.pbuf, ULD, p.wt_ff2 + (size_t)l * DM * WLD4, WLD4, DFF, p.tbuf, (float*)p.obuf, smem);
        else gemm_stream<EPI_F32>(p.pbuf, ULD, p.wt_ff2 + (size_t)l * DM * WLD4, WLD4, DFF, 8, NMT * 8, p.tbuf, DM, nullptr, 0, smem);
      }
      break;
  }
}

#ifndef DUP_S
#define DUP_S -1
#endif
#define XB_TMO      128
#define XB_XCNT(j)  (256  + 64 * (j))
#define XB_XSUB(j)  (1280 + 64 * (j))
#define XB_XGEN(j)  (2304 + 64 * (j))
#define XB_TOP      3328
#define XB_TOPGEN   3392
#define XCD_BAR_WORDS 3456
#define XB_SPIN_CAP (1u << 22)
#define LAS __attribute__((address_space(3)))
DI unsigned xb_ld(unsigned* p)              { return __hip_atomic_load(p, __ATOMIC_RELAXED, __HIP_MEMORY_SCOPE_AGENT); }
DI unsigned xb_add(unsigned* p, unsigned v) { return __hip_atomic_fetch_add(p, v, __ATOMIC_RELAXED, __HIP_MEMORY_SCOPE_AGENT); }
DI unsigned xb_xcc_id() { return (unsigned)__builtin_amdgcn_s_getreg((3 << 11) | 20) & 0xFu; }
#define XB_SPIN(cond, bar) do { unsigned _sp = 0; while (cond) { __builtin_amdgcn_s_sleep(1); \
    if ((++_sp & 255u) == 0u) { if (xb_ld(&(bar)[XB_TMO])) break; if (_sp > XB_SPIN_CAP) { atomicAdd(&(bar)[XB_TMO], 1u); break; } } } } while (0)
struct XcdBarrier { unsigned* bar; unsigned x; volatile LAS unsigned* st; };
DI XcdBarrier xcd_barrier_post(unsigned* bar, volatile LAS unsigned* st) {
  XcdBarrier b; b.bar = bar; b.x = xb_xcc_id(); b.st = st;
  if (threadIdx.x == 0) (void)xb_add(&bar[XB_XCNT(b.x)], 1u);
  return b;
}
DI void xcd_barrier_complete(unsigned* bar, unsigned x, unsigned& nloc, unsigned& nx) {
  const unsigned G = gridDim.x * gridDim.y * gridDim.z;
  unsigned sum, cnt, mine, sp = 0u;
  for (;;) {
    sum = 0u; cnt = 0u; mine = 0u;
#pragma unroll
    for (unsigned j = 0; j < 16; ++j) { const unsigned c = xb_ld(&bar[XB_XCNT(j)]); sum += c; cnt += (c > 0u) ? 1u : 0u; mine = (j == x) ? c : mine; }
    if (sum == G) break;
    __builtin_amdgcn_s_sleep(1);
    if ((++sp & 255u) == 0u) { if (xb_ld(&bar[XB_TMO])) break; if (sp > XB_SPIN_CAP) { atomicAdd(&bar[XB_TMO], 1u); break; } }
  }
  nloc = mine > 0u ? mine : 1u; nx = cnt > 0u ? cnt : 1u;
}
DI void xcd_barrier(const XcdBarrier& b) {
  asm volatile("s_waitcnt vmcnt(0)" ::: "memory");
  __syncthreads();
  if (threadIdx.x == 0) {
    unsigned* bar = b.bar;
    __builtin_amdgcn_s_waitcnt(0);
    unsigned nloc = b.st[0], nx = b.st[1];
    if (nloc == 0u) { xcd_barrier_complete(bar, b.x, nloc, nx); b.st[0] = nloc; b.st[1] = nx; }
    const unsigned old = xb_add(&bar[XB_XSUB(b.x)], 1u);
    const unsigned gen = old / nloc;
    if (old + 1u == (gen + 1u) * nloc) {
      __builtin_amdgcn_fence(__ATOMIC_RELEASE, "agent");
      asm volatile("s_waitcnt vmcnt(0)" ::: "memory");
      const unsigned og = xb_add(&bar[XB_TOP], 1u);
      const unsigned tg = og / nx;
      if (og + 1u == (tg + 1u) * nx) xb_add(&bar[XB_TOPGEN], 1u);
      else XB_SPIN(xb_ld(&bar[XB_TOPGEN]) == tg, bar);
      __builtin_amdgcn_fence(__ATOMIC_ACQUIRE, "agent");
      xb_add(&bar[XB_XGEN(b.x)], 1u);
      asm volatile("s_waitcnt vmcnt(0)" ::: "memory");
    } else {
      XB_SPIN(xb_ld(&bar[XB_XGEN(b.x)]) == gen, bar);
      __builtin_amdgcn_fence(__ATOMIC_ACQUIRE, "agent");
      asm volatile("s_waitcnt vmcnt(0)" ::: "memory");
    }
  }
  __syncthreads();
}

__global__ void __launch_bounds__(256, 2) mega_kernel(Params p, int ph_lo, int ph_hi) {
  __shared__ __attribute__((aligned(16))) char smem[65536 + 32];
  volatile LAS unsigned* st = (volatile LAS unsigned*)(&smem[65536 + 16]);
  if (threadIdx.x == 0) { st[0] = 0u; st[1] = 0u; }
  __syncthreads();
  const XcdBarrier xb = xcd_barrier_post(p.bar, st);
  for (int ph = ph_lo; ph < ph_hi; ++ph) {
    if (ph > ph_lo) xcd_barrier(xb);
    if (ph_hi < 0) cg::this_grid().sync();
    const int reps = (DUP_S >= 0 && ph == DUP_S) ? 2 : 1;
    for (int r = 0; r < reps; ++r) {
      if (r) xcd_barrier(xb);
#ifdef VAR_NOSTORE
      if (tidq() == 0) *(volatile int*)(smem + 65536 + 8) = r;
      __syncthreads();
#endif
      run_phase(p, ph, smem, r);
    }
  }
}

extern "C" void kernel_launch(void* const* d_in, const int* in_sizes, int n_in, void* d_out, int out_size,
                              void* d_ws, size_t ws_size, hipStream_t stream) {
  Params p{};
  for (int i = 0; i < 35; ++i) p.in[i] = (const float*)d_in[i];
  p.out = (float*)d_out;
  char* ws = (char*)d_ws;
  size_t off = 0;
  auto take = [&](size_t bytes) { char* r = ws + off; off += (bytes + 255) & ~(size_t)255; return r; };
  p.wt_in  = (u16*)take((size_t)2 * NIN * WLD1 * 2);
  p.wt_ff1 = (u16*)take((size_t)2 * DFF * WLD1 * 2);
  p.wt_ff2 = (u16*)take((size_t)2 * DM * WLD4 * 2);
  p.wt_br  = (u16*)take((size_t)2 * 4 * DM * WLD5 * 2);
  p.wt_out = (u16*)take((size_t)2 * DM * WLD1 * 2);
  p.wt_glu = (u16*)take((size_t)2 * 512 * WLD5 * 2);
  p.hb     = (u16*)take((size_t)MTOK * HLD * 2);
  p.pbuf   = (u16*)take((size_t)MTOK * NP * 2);
  p.obuf   = (u16*)take((size_t)MTOK * OLD * 2);
  p.zs5    = (u16*)take((size_t)MTOK * ZLD * 2);
  p.counters = (unsigned*)take(4096);
  p.bar = (unsigned*)take(16384);
  p.ssq = (float*)take((size_t)MTOK * 4 * 4);
  p.segdec = (float*)take((size_t)96 * 7 * 128 * 4);
  p.hlocal = (float*)take((size_t)8 * 32 * 7 * 128 * 4);
  p.nseg = 8;
  if (off + (size_t)96 * 7 * 32768 > ws_size) p.nseg = 4;
  p.cps = 128 / p.nseg;
  p.slocal = (u16*)take((size_t)96 * (p.nseg - 1) * 32768);
  p.tbuf = (float*)(p.pbuf + (size_t)MTOK * ULD);
  if (off > ws_size) { fprintf(stderr, "workspace too small: need %zu have %zu\n", off, ws_size); return; }
  size_t o = (size_t)MTOK * DM;
  p.o_ret_p = o;  o += (size_t)2 * 8 * 65536;
  p.o_ret_s = o;  o += (size_t)2 * 128 * 65536;
  p.o_ssd_p = o;  o += (size_t)2 * 8 * 65536;
  p.o_ssd_s = o;  o += (size_t)2 * 128 * 65536;
  p.o_conv_p = o; o += (size_t)2 * 8 * 3 * 1024;
  p.o_conv_s = o; o += (size_t)2 * 128 * 3 * 1024;
  p.o_hg_p = o;   o += (size_t)2 * 8 * 65536;
  p.o_hg_s = o;   o += (size_t)2 * 128 * 65536;
  p.o_s5r_p = o;  o += (size_t)2 * 8 * 2048;
  p.o_s5r_s = o;  o += (size_t)2 * 128 * 2048;
  p.o_s5i_p = o;  o += (size_t)2 * 8 * 2048;
  p.o_s5i_s = o;  o += (size_t)2 * 128 * 2048;

  static int grid_blocks = 0;
  if (!grid_blocks) {
    int dev = 0, cus = 0, per_cu = 0;
    hipGetDevice(&dev);
    hipDeviceGetAttribute(&cus, hipDeviceAttributeMultiprocessorCount, dev);
    hipOccupancyMaxActiveBlocksPerMultiprocessor(&per_cu, mega_kernel, 256, 0);
    if (per_cu > 2) per_cu = 2;
    if (per_cu < 1) per_cu = 1;
    grid_blocks = cus * per_cu;
  }
  hipMemsetAsync(p.counters, 0, 4096 + 16384, stream);
#if SINGLE_LAUNCH
  int lo = 0, hi = NPHASE;
  void* args[] = {&p, &lo, &hi};
  hipError_t e = hipLaunchCooperativeKernel((void*)mega_kernel, dim3(grid_blocks), dim3(256), args, 0, stream);
  if (e != hipSuccess) fprintf(stderr, "cooperative launch failed: %s (grid %d)\n", hipGetErrorString(e), grid_blocks);
#else
  for (int ph = 0; ph < NPHASE; ++ph)
    hipLaunchKernelGGL(mega_kernel, dim3(grid_blocks), dim3(256), 0, stream, p, ph, ph + 1);
#endif
}
```

```cpp
#include <hip/hip_runtime.h>
#include <hip/hip_cooperative_groups.h>
#include <cstdio>
#include <cstdint>
namespace cg = cooperative_groups;

#ifndef SINGLE_LAUNCH
#define SINGLE_LAUNCH 1
#endif
#ifndef ONLY
#define ONLY -1
#endif
#define EN(k) (ONLY < 0 || ONLY == (k))

typedef unsigned short u16;
using bf16x8 = __attribute__((ext_vector_type(8))) short;
using bf16x4 = __attribute__((ext_vector_type(4))) short;
using f32x4  = __attribute__((ext_vector_type(4))) float;
typedef unsigned u32x4 __attribute__((ext_vector_type(4)));
#define DI __device__ __forceinline__
#define MFMA16(a, b, c) __builtin_amdgcn_mfma_f32_16x16x32_bf16((a), (b), (c), 0, 0, 0)

constexpr int MTOK = 17408;
constexpr int MPR  = 16384;
constexpr int DM   = 1024;
constexpr int NP   = 6272;
constexpr int NIN  = 10368;
constexpr int DFF  = 4096;
constexpr int INC  = 10248;
constexpr int C_RQ = 0, C_RK = 512, C_RV = 1024, C_RG = 1536, C_SZ = 2048, C_SXBC = 2560;
constexpr int C_HQ = 3584, C_HF = 4096, C_HI = 4608, C_HG = 5120, C_SU = 5632, C_SDT = 6144;
constexpr float EPS = 1e-6f;
constexpr int HLD = 1024, WLD1 = 1024, ULD = 4096, WLD4 = 4096, OLD = 2048, ZLD = 512, WLD5 = 512;
constexpr int NITEMS = 160 + 128 * 20;
constexpr int NPHASE = 21;

struct Params {
  const float* in[35];
  float* out;
  u16 *wt_in, *wt_ff1, *wt_ff2, *wt_br, *wt_out, *wt_glu;
  u16 *hb, *pbuf, *obuf, *zs5;
  float* tbuf;
  unsigned* counters;
  unsigned* bar;
  float* ssq;
  u16* slocal;
  float* segdec;
  float* hlocal;
  int nseg, cps;
  size_t o_ret_p, o_ret_s, o_ssd_p, o_ssd_s, o_conv_p, o_conv_s, o_hg_p, o_hg_s, o_s5r_p, o_s5r_s, o_s5i_p, o_s5i_s;
};

DI int tidq() { int t = threadIdx.x; asm volatile("" : "+v"(t)); return t; }
typedef __bf16 bf16v2 __attribute__((ext_vector_type(2)));
typedef float f32v2 __attribute__((ext_vector_type(2)));
DI unsigned pack2(float a, float b) { f32v2 v = {a, b}; return __builtin_bit_cast(unsigned, __builtin_convertvector(v, bf16v2)); }
DI u16 f2bf(float f) { return (u16)(pack2(f, 0.f) & 0xffffu); }
DI float bf2f(u16 h) { return __uint_as_float(((unsigned)h) << 16); }
DI float sigmoidf_(float x) { return __builtin_amdgcn_rcpf(1.f + __expf(-x)); }
DI float siluf_(float x) { return x * __builtin_amdgcn_rcpf(1.f + __expf(-x)); }
DI float softplusf_(float x) { return x > 20.f ? x : log1pf(__expf(x)); }
DI float gelu_tanh(float x) {
  float u = 0.7978845608028654f * (x + 0.044715f * x * x * x);
  float e = __expf(2.f * u);
  float th = 1.f - 2.f * __builtin_amdgcn_rcpf(e + 1.f);
  return 0.5f * x * (1.f + th);
}
DI float wave_sum(float v) {
#pragma unroll
  for (int m = 32; m >= 1; m >>= 1) v += __shfl_xor(v, m);
  return v;
}
DI float sum16(float v) {
#pragma unroll
  for (int m = 8; m >= 1; m >>= 1) v += __shfl_xor(v, m);
  return v;
}
DI void sincos_red(float a, float& s, float& c) {
  float n = rintf(a * 0.15915494309189535f);
  float r = fmaf(-n, 6.28125f, a);
  r = fmaf(-n, 1.9353071795864769e-3f, r);
  s = __sinf(r); c = __cosf(r);
}

DI int map_win(int my) {
  if (my < 3584) return my;
  if (my < 6144) return my + 8;
  if (my < 6152) return my - 6144 + 3584;
  if (my < 6272) return -1;
  return my - 120;
}
DI void transpose_tile(const float* __restrict__ src, int src_ld, u16* __restrict__ dst, int dst_ld,
                       int k0, int n0, int mapmode, char* smem) {
  float* tile = (float*)smem;
  const int tid = tidq();
  {
    const int n = tid & 63;
    int sc = n0 + n;
    if (mapmode) sc = map_win(sc);
    const float* sp = src + (size_t)(k0 + (tid >> 6)) * src_ld + (sc >= 0 ? sc : 0);
    float v[32];
#pragma unroll
    for (int i = 0; i < 32; ++i) v[i] = sp[(size_t)(4 * i) * src_ld];
#pragma unroll
    for (int i = 0; i < 32; ++i) tile[n * 129 + (tid >> 6) + 4 * i] = (sc >= 0) ? v[i] : 0.f;
  }
  __syncthreads();
  {
    const int n = tid >> 2, kc = (tid & 3) * 32;
    unsigned pk[16];
#pragma unroll
    for (int x = 0; x < 16; ++x) pk[x] = pack2(tile[n * 129 + kc + 2 * x], tile[n * 129 + kc + 2 * x + 1]);
    uint4* d = (uint4*)(dst + (size_t)(n0 + n) * dst_ld + k0 + kc);
    d[0] = make_uint4(pk[0], pk[1], pk[2], pk[3]);
    d[1] = make_uint4(pk[4], pk[5], pk[6], pk[7]);
    d[2] = make_uint4(pk[8], pk[9], pk[10], pk[11]);
    d[3] = make_uint4(pk[12], pk[13], pk[14], pk[15]);
  }
  __syncthreads();
}

__device__ void phase_convert(const Params& p, char* smem) {
  constexpr int PER = 2736;
  for (int t = blockIdx.x; t < 2 * PER; t += gridDim.x) {
    int l = t / PER, r = t % PER;
    if (r < 1296) {
      int nt = r / 8, kt = r % 8;
      transpose_tile(p.in[12] + (size_t)l * DM * INC, INC, p.wt_in + (size_t)l * NIN * WLD1, WLD1, kt * 128, nt * 64, 1, smem);
    } else if (r < 1808) {
      r -= 1296; int nt = r / 8, kt = r % 8;
      transpose_tile(p.in[33] + (size_t)l * DM * DFF, DFF, p.wt_ff1 + (size_t)l * DFF * WLD1, WLD1, kt * 128, nt * 64, 0, smem);
    } else if (r < 2320) {
      r -= 1808; int nt = r / 32, kt = r % 32;
      transpose_tile(p.in[34] + (size_t)l * DFF * DM, DM, p.wt_ff2 + (size_t)l * DM * WLD4, WLD4, kt * 128, nt * 64, 0, smem);
    } else if (r < 2448) {
      r -= 2320; int nt = r / 8, kt = r % 8;
      transpose_tile(p.in[32] + (size_t)l * DM * DM, DM, p.wt_out + (size_t)l * DM * WLD1, WLD1, kt * 128, nt * 64, 0, smem);
    } else if (r < 2704) {
      r -= 2448; int b = r / 64; r %= 64; int nt = r / 4, kt = r % 4;
      transpose_tile(p.in[31] + (size_t)(l * 4 + b) * 512 * DM, DM, p.wt_br + (size_t)(l * 4 + b) * DM * WLD5, WLD5, kt * 128, nt * 64, 0, smem);
    } else {
      r -= 2704; int nt = r / 4, kt = r % 4;
      transpose_tile(p.in[30] + (size_t)l * 512 * 512, 512, p.wt_glu + (size_t)l * 512 * WLD5, WLD5, kt * 128, nt * 64, 0, smem);
    }
  }
}

__device__ void phase_rownorm(const Params& p, bool from_input, const float* __restrict__ t, const float* __restrict__ gpost,
                              const float* __restrict__ gpre, u16* __restrict__ hout) {
  const int lane = tidq() & 63, w = tidq() >> 6;
  float* xbuf = p.out;
  for (int row = blockIdx.x * 4 + w; row < MTOK; row += gridDim.x * 4) {
    const float* xin = from_input ? (row < MPR ? p.in[0] + (size_t)row * DM : p.in[1] + (size_t)(row - MPR) * DM)
                                  : xbuf + (size_t)row * DM;
    float4 x[4];
#pragma unroll
    for (int k = 0; k < 4; ++k) x[k] = *(const float4*)(xin + lane * 4 + 256 * k);
    if (t) {
      float4 tv[4];
      float ss = 0.f;
#pragma unroll
      for (int k = 0; k < 4; ++k) {
        if (gridDim.x == 512 && row >= MPR) {
          const float* pp = (const float*)p.obuf + (size_t)(row - MPR) * DM + lane * 4 + 256 * k;
          float4 a = *(const float4*)pp;
#pragma unroll
          for (int sl = 1; sl < 8; ++sl) {
            const float4 b = *(const float4*)(pp + (size_t)sl * 1024 * 1024);
            a.x += b.x; a.y += b.y; a.z += b.z; a.w += b.w;
          }
          tv[k] = a;
        } else {
          tv[k] = *(const float4*)(t + (size_t)row * DM + lane * 4 + 256 * k);
        }
        ss += tv[k].x * tv[k].x + tv[k].y * tv[k].y + tv[k].z * tv[k].z + tv[k].w * tv[k].w;
      }
      ss = wave_sum(ss);
      float r = rsqrtf(ss * (1.f / DM) + EPS);
#pragma unroll
      for (int k = 0; k < 4; ++k) {
        float4 g = *(const float4*)(gpost + lane * 4 + 256 * k);
        x[k].x += tv[k].x * r * g.x; x[k].y += tv[k].y * r * g.y; x[k].z += tv[k].z * r * g.z; x[k].w += tv[k].w * r * g.w;
      }
    }
#pragma unroll
    for (int k = 0; k < 4; ++k) *(float4*)(xbuf + (size_t)row * DM + lane * 4 + 256 * k) = x[k];
    if (hout) {
      float ss = 0.f;
#pragma unroll
      for (int k = 0; k < 4; ++k) ss += x[k].x * x[k].x + x[k].y * x[k].y + x[k].z * x[k].z + x[k].w * x[k].w;
      ss = wave_sum(ss);
      float r = rsqrtf(ss * (1.f / DM) + EPS);
#pragma unroll
      for (int k = 0; k < 4; ++k) {
        float4 g = *(const float4*)(gpre + lane * 4 + 256 * k);
        uint2 o;
        o.x = pack2(x[k].x * r * g.x, x[k].y * r * g.y);
        o.y = pack2(x[k].z * r * g.z, x[k].w * r * g.w);
        *(uint2*)(hout + (size_t)row * HLD + lane * 4 + 256 * k) = o;
      }
    }
  }
}

DI int swz(int r, int c) { return r * 128 + ((c ^ ((r >> 1) & 7)) << 4); }

#define GEMM_COMPUTE(AS_) do { const char* as_ = (AS_); const char* bs_ = as_ + 16384; \
  _Pragma("unroll") for (int s_ = 0; s_ < 2; ++s_) { \
    bf16x8 af_[4], bfr_[4]; \
    _Pragma("unroll") for (int i_ = 0; i_ < 4; ++i_) af_[i_] = *(const bf16x8*)(as_ + swz(wm * 64 + i_ * 16 + r16, s_ * 4 + quad)); \
    _Pragma("unroll") for (int j_ = 0; j_ < 4; ++j_) bfr_[j_] = *(const bf16x8*)(bs_ + swz(wn * 64 + j_ * 16 + r16, s_ * 4 + quad)); \
    _Pragma("unroll") for (int i_ = 0; i_ < 4; ++i_) \
      _Pragma("unroll") for (int j_ = 0; j_ < 4; ++j_) acc[i_][j_] = MFMA16(bfr_[j_], af_[i_], acc[i_][j_]); \
  } } while (0)

struct Stage { u32x4 a0, a1, a2, a3, b0, b1, b2, b3; };
DI void gload(Stage& s, const u16* ag, const u16* bg, int lda, int ldb, int kt) {
  s.a0 = *(const u32x4*)(ag + (size_t)0 * 32 * lda + kt * 64);
  s.a1 = *(const u32x4*)(ag + (size_t)1 * 32 * lda + kt * 64);
  s.a2 = *(const u32x4*)(ag + (size_t)2 * 32 * lda + kt * 64);
  s.a3 = *(const u32x4*)(ag + (size_t)3 * 32 * lda + kt * 64);
  s.b0 = *(const u32x4*)(bg + (size_t)0 * 32 * ldb + kt * 64);
  s.b1 = *(const u32x4*)(bg + (size_t)1 * 32 * ldb + kt * 64);
  s.b2 = *(const u32x4*)(bg + (size_t)2 * 32 * ldb + kt * 64);
  s.b3 = *(const u32x4*)(bg + (size_t)3 * 32 * ldb + kt * 64);
}
DI void lwrite(const Stage& s, char* d, int lr, int lc) {
  *(u32x4*)(d + swz(lr, lc)) = s.a0;
  *(u32x4*)(d + swz(lr + 32, lc)) = s.a1;
  *(u32x4*)(d + swz(lr + 64, lc)) = s.a2;
  *(u32x4*)(d + swz(lr + 96, lc)) = s.a3;
  *(u32x4*)(d + 16384 + swz(lr, lc)) = s.b0;
  *(u32x4*)(d + 16384 + swz(lr + 32, lc)) = s.b1;
  *(u32x4*)(d + 16384 + swz(lr + 64, lc)) = s.b2;
  *(u32x4*)(d + 16384 + swz(lr + 96, lc)) = s.b3;
}

template <bool DEEP>
DI void gemm_kloop(f32x4 (&acc)[4][4], const u16* __restrict__ A, int lda, const u16* __restrict__ Bt, int ldb,
                   int K, int m0, int n0, char* smem) {
  const int tid = tidq(), lane = tid & 63, w = tid >> 6, wm = w >> 1, wn = w & 1, r16 = lane & 15, quad = lane >> 4;
  const int lr = tid >> 3, lc = tid & 7;
  const u16* ag = A + (size_t)(m0 + lr) * lda + lc * 8;
  const u16* bg = Bt + (size_t)(n0 + lr) * ldb + lc * 8;
  const int nk = K >> 6;
  Stage s0;
  gload(s0, ag, bg, lda, ldb, 0);
  if (DEEP) {
    Stage s1;
    gload(s1, ag, bg, lda, ldb, 1);
    lwrite(s0, smem, lr, lc);
    __syncthreads();
    for (int kt = 0; kt < nk; kt += 2) {
      if (kt + 2 < nk) gload(s0, ag, bg, lda, ldb, kt + 2);
      GEMM_COMPUTE(smem);
      lwrite(s1, smem + 32768, lr, lc);
      __syncthreads();
      if (kt + 3 < nk) gload(s1, ag, bg, lda, ldb, kt + 3);
      GEMM_COMPUTE(smem + 32768);
      if (kt + 2 < nk) lwrite(s0, smem, lr, lc);
      __syncthreads();
    }
  } else {
    lwrite(s0, smem, lr, lc);
    __syncthreads();
    for (int kt = 0; kt < nk; ++kt) {
      const bool more = (kt + 1 < nk);
      if (more) gload(s0, ag, bg, lda, ldb, kt + 1);
      GEMM_COMPUTE(smem + (kt & 1) * 32768);
      if (more) lwrite(s0, smem + ((kt + 1) & 1) * 32768, lr, lc);
      __syncthreads();
    }
  }
}

DI void zero_acc(f32x4 (&acc)[4][4]) {
#pragma unroll
  for (int i = 0; i < 4; ++i)
#pragma unroll
    for (int j = 0; j < 4; ++j) acc[i][j] = f32x4{0.f, 0.f, 0.f, 0.f};
}

enum { EPI_BF16 = 0, EPI_SIG = 1, EPI_RELU2 = 2, EPI_F32 = 3, EPI_GLU = 4 };

template <int EPI>
DI void gemm_epilogue(f32x4 (&acc)[4][4], int m0, int n0, void* outp, int ldc, const u16* aux, int ldaux) {
  const int lane = tidq() & 63, w = tidq() >> 6, wm = w >> 1, wn = w & 1, r16 = lane & 15, quad = lane >> 4;
#pragma unroll
  for (int i = 0; i < 4; ++i) {
    const int m = m0 + wm * 64 + i * 16 + r16;
    if (EPI == EPI_F32) {
#pragma unroll
      for (int j = 0; j < 4; ++j) {
        const int n = n0 + wn * 64 + j * 16 + quad * 4;
        const f32x4 v = acc[i][j];
        *(float4*)((float*)outp + (size_t)m * ldc + n) = make_float4(v[0], v[1], v[2], v[3]);
        acc[i][j] = f32x4{0.f, 0.f, 0.f, 0.f};
      }
    } else {
      uint2 o[4];
#pragma unroll
      for (int j = 0; j < 4; ++j) {
        const int n = n0 + wn * 64 + j * 16 + quad * 4;
        f32x4 v = acc[i][j];
        if (EPI == EPI_SIG) {
#pragma unroll
          for (int x = 0; x < 4; ++x) v[x] = sigmoidf_(v[x]);
        } else if (EPI == EPI_RELU2) {
#pragma unroll
          for (int x = 0; x < 4; ++x) { float r = fmaxf(v[x], 0.f); v[x] = r * r; }
        } else if (EPI == EPI_GLU) {
          uint2 zz = *(const uint2*)(aux + (size_t)m * ldaux + n);
          v[0] = bf2f((u16)(zz.x & 0xffff)) * sigmoidf_(v[0]);
          v[1] = bf2f((u16)(zz.x >> 16)) * sigmoidf_(v[1]);
          v[2] = bf2f((u16)(zz.y & 0xffff)) * sigmoidf_(v[2]);
          v[3] = bf2f((u16)(zz.y >> 16)) * sigmoidf_(v[3]);
        }
        o[j].x = pack2(v[0], v[1]); o[j].y = pack2(v[2], v[3]);
        acc[i][j] = f32x4{0.f, 0.f, 0.f, 0.f};
      }
#pragma unroll
      for (int jp = 0; jp < 2; ++jp) {
        const bool odd = quad & 1;
        const uint2 mine = odd ? o[2 * jp + 1] : o[2 * jp];
        const uint2 send = odd ? o[2 * jp] : o[2 * jp + 1];
        uint2 recv;
        recv.x = __shfl_xor(send.x, 16); recv.y = __shfl_xor(send.y, 16);
        const int n = n0 + wn * 64 + (2 * jp + (odd ? 1 : 0)) * 16 + (quad & 2) * 4;
        const uint4 st = odd ? make_uint4(recv.x, recv.y, mine.x, mine.y) : make_uint4(mine.x, mine.y, recv.x, recv.y);
        *(uint4*)((u16*)outp + (size_t)m * ldc + n) = st;
      }
    }
  }
}

DI bool tile_at(int i, int T, int& t);
DI void tile_mn(int t, int nN, int& m0, int& n0);

template <int EPI>
DI void gemm_stream(const u16* __restrict__ A, int lda, const u16* __restrict__ Bt, int ldb, int K, int nN, int T,
                    void* outp, int ldc, const u16* aux, int ldaux, char* smem) {
  const int tid = tidq(), lane = tid & 63, w = tid >> 6, wm = w >> 1, wn = w & 1, r16 = lane & 15, quad = lane >> 4;
  const int lr = tid >> 3, lc = tid & 7;
  asm volatile("" : "+s"(lda), "+s"(ldb), "+s"(K));
  const int nk = K >> 6;
  int t, m0, n0, m1 = 0, n1 = 0;
  if (!tile_at(0, T, t)) return;
  tile_mn(t, nN, m0, n0);
  const size_t aoff = (size_t)lr * lda + lc * 8, boff = (size_t)lr * ldb + lc * 8;
  const u16* ag = A + (size_t)m0 * lda + aoff;
  const u16* bg = Bt + (size_t)n0 * ldb + boff;
  f32x4 acc[4][4];
  zero_acc(acc);
  Stage s0, s1;
  gload(s0, ag, bg, lda, ldb, 0);
  gload(s1, ag, bg, lda, ldb, 1);
  lwrite(s0, smem, lr, lc);
  __syncthreads();
  for (int i = 0;; ++i) {
    const bool has_next = tile_at(i + 1, T, t);
    if (has_next) tile_mn(t, nN, m1, n1);
    const u16* agn = A + (size_t)m1 * lda + aoff;
    const u16* bgn = Bt + (size_t)n1 * ldb + boff;
    for (int kt = 0; kt < nk; kt += 2) {
      if (kt + 2 < nk) gload(s0, ag, bg, lda, ldb, kt + 2);
      else if (has_next) gload(s0, agn, bgn, lda, ldb, 0);
      GEMM_COMPUTE(smem);
      lwrite(s1, smem + 32768, lr, lc);
      __syncthreads();
      if (kt + 2 < nk) gload(s1, ag, bg, lda, ldb, kt + 3);
      else if (has_next) gload(s1, agn, bgn, lda, ldb, 1);
      GEMM_COMPUTE(smem + 32768);
      if (kt + 2 < nk || has_next) lwrite(s0, smem, lr, lc);
      __syncthreads();
    }
    gemm_epilogue<EPI>(acc, m0, n0, outp, ldc, aux, ldaux);
    if (!has_next) break;
    m0 = m1; n0 = n1; ag = agn; bg = bgn;
  }
}

DI void gemm_stream_split(const u16* __restrict__ A, int lda, const u16* __restrict__ Bt, int ldb, int K,
                          float* outp, float* part, char* smem) {
  const int tid = tidq(), lane = tid & 63, w = tid >> 6, wm = w >> 1, wn = w & 1, r16 = lane & 15, quad = lane >> 4;
  const int lr = tid >> 3, lc = tid & 7;
  asm volatile("" : "+s"(lda), "+s"(ldb), "+s"(K));
  const int nk = K >> 6, nks = nk >> 3;
  const size_t aoff = (size_t)lr * lda + lc * 8, boff = (size_t)lr * ldb + lc * 8;
  const int slice = blockIdx.x & 7, tl = blockIdx.x >> 3;
  int t, m0, n0, m1 = 0, n1 = 0;
  tile_at(0, 1024, t);
  tile_mn(t, 8, m0, n0);
  const u16* ag = A + (size_t)m0 * lda + aoff;
  const u16* bg = Bt + (size_t)n0 * ldb + boff;
  int nku = nk;
  f32x4 acc[4][4];
  zero_acc(acc);
  Stage s0, s1;
  gload(s0, ag, bg, lda, ldb, 0);
  gload(s1, ag, bg, lda, ldb, 1);
  lwrite(s0, smem, lr, lc);
  __syncthreads();
  for (int u = 0; u < 3; ++u) {
    const bool has_next = (u < 2);
    int nkn = nk;
    const u16* agn = ag;
    const u16* bgn = bg;
    if (u == 0) {
      tile_at(1, 1024, t);
      tile_mn(t, 8, m1, n1);
      agn = A + (size_t)m1 * lda + aoff;
      bgn = Bt + (size_t)n1 * ldb + boff;
    } else if (u == 1) {
      m1 = MPR + (tl >> 3) * 128; n1 = (tl & 7) * 128;
      agn = A + (size_t)m1 * lda + aoff + (size_t)slice * nks * 64;
      bgn = Bt + (size_t)n1 * ldb + boff + (size_t)slice * nks * 64;
      nkn = nks;
    }
    for (int kt = 0; kt < nku; kt += 2) {
      if (kt + 2 < nku) gload(s0, ag, bg, lda, ldb, kt + 2);
      else if (has_next) gload(s0, agn, bgn, lda, ldb, 0);
      GEMM_COMPUTE(smem);
      lwrite(s1, smem + 32768, lr, lc);
      __syncthreads();
      if (kt + 2 < nku) gload(s1, ag, bg, lda, ldb, kt + 3);
      else if (has_next) gload(s1, agn, bgn, lda, ldb, 1);
      GEMM_COMPUTE(smem + 32768);
      if (kt + 2 < nku || has_next) lwrite(s0, smem, lr, lc);
      __syncthreads();
    }
    if (u < 2) gemm_epilogue<EPI_F32>(acc, m0, n0, outp, DM, nullptr, 0);
    else gemm_epilogue<EPI_F32>(acc, m0 - MPR, n0, part + (size_t)slice * 1024 * 1024, DM, nullptr, 0);
    m0 = m1; n0 = n1; ag = agn; bg = bgn; nku = nkn;
  }
}

DI void merge_tile(const Params& p, int l, int m0, int n0, char* smem) {
  f32x4 macc[4][4];
  zero_acc(macc);
  const int lane = tidq() & 63, w = tidq() >> 6, wm = w >> 1, wn = w & 1, r16 = lane & 15, quad = lane >> 4;
  const bool odd = quad & 1;
  const u16* gates = p.pbuf;
  for (int b = 0; b < 4; ++b) {
    f32x4 acc[4][4];
    zero_acc(acc);
    gemm_kloop<false>(acc, p.obuf + b * 512, OLD, p.wt_br + (size_t)(l * 4 + b) * DM * WLD5, WLD5, 512, m0, n0, smem);
#pragma unroll
    for (int i = 0; i < 4; ++i) {
      const int m = m0 + wm * 64 + i * 16 + r16;
#pragma unroll
      for (int jp = 0; jp < 2; ++jp) {
        const int n = n0 + wn * 64 + (2 * jp + (odd ? 1 : 0)) * 16 + (quad & 2) * 4;
        const uint4 g16 = *(const uint4*)(gates + (size_t)m * 4096 + b * 1024 + n);
        const uint2 lo = make_uint2(g16.x, g16.y), hi = make_uint2(g16.z, g16.w);
        const uint2 send = odd ? lo : hi;
        uint2 recv;
        recv.x = __shfl_xor(send.x, 16); recv.y = __shfl_xor(send.y, 16);
        const uint2 g0 = odd ? recv : lo;
        const uint2 g1 = odd ? hi : recv;
        macc[i][2 * jp][0] += bf2f((u16)(g0.x & 0xffff)) * acc[i][2 * jp][0];
        macc[i][2 * jp][1] += bf2f((u16)(g0.x >> 16)) * acc[i][2 * jp][1];
        macc[i][2 * jp][2] += bf2f((u16)(g0.y & 0xffff)) * acc[i][2 * jp][2];
        macc[i][2 * jp][3] += bf2f((u16)(g0.y >> 16)) * acc[i][2 * jp][3];
        macc[i][2 * jp + 1][0] += bf2f((u16)(g1.x & 0xffff)) * acc[i][2 * jp + 1][0];
        macc[i][2 * jp + 1][1] += bf2f((u16)(g1.x >> 16)) * acc[i][2 * jp + 1][1];
        macc[i][2 * jp + 1][2] += bf2f((u16)(g1.y & 0xffff)) * acc[i][2 * jp + 1][2];
        macc[i][2 * jp + 1][3] += bf2f((u16)(g1.y >> 16)) * acc[i][2 * jp + 1][3];
      }
    }
  }
#pragma unroll
  for (int i = 0; i < 4; ++i) {
    const int m = m0 + wm * 64 + i * 16 + r16;
    uint2 o[4];
#pragma unroll
    for (int j = 0; j < 4; ++j) { o[j].x = pack2(macc[i][j][0], macc[i][j][1]); o[j].y = pack2(macc[i][j][2], macc[i][j][3]); }
#pragma unroll
    for (int jp = 0; jp < 2; ++jp) {
      const uint2 mine = odd ? o[2 * jp + 1] : o[2 * jp];
      const uint2 send = odd ? o[2 * jp] : o[2 * jp + 1];
      uint2 recv;
      recv.x = __shfl_xor(send.x, 16); recv.y = __shfl_xor(send.y, 16);
      const int n = n0 + wn * 64 + (2 * jp + (odd ? 1 : 0)) * 16 + (quad & 2) * 4;
      const uint4 st = odd ? make_uint4(recv.x, recv.y, mine.x, mine.y) : make_uint4(mine.x, mine.y, recv.x, recv.y);
      *(uint4*)(p.hb + (size_t)m * HLD + n) = st;
    }
  }
}

constexpr int QS = 136;
constexpr int TS = 20;
constexpr int OFS = 260;

template <int MODE>
__device__ void run_chain(const Params& p, int l, int seq, int sub, int seg, int pass, char* smem) {
  constexpr int NE = 2;
  const int tid = tidq(), lane = tid & 63, w = tid >> 6, r16 = lane & 15, quad = lane >> 4;
  const bool prompt = seq < 8;
  const int bidx = prompt ? seq : seq - 8;
  const int NB = prompt ? 8 : 128;
  const int L = prompt ? 2048 : 8;
  const int row0 = prompt ? seq * 2048 : MPR + (seq - 8) * 8;
  const int pos0 = prompt ? 0 : 16384;
  int cps = p.cps;
  asm volatile("" : "+s"(cps));
  const int ch_begin = prompt ? seg * cps : 0;
  const int ch_end = prompt ? ch_begin + cps : 1;
  const bool light = prompt && (pass == 1);
  const bool last_seg = !prompt || (seg == p.nseg - 1);
  const int cid = seq * 12 + MODE * 4 + sub;

  u16* Qa = (u16*)smem;
  u16* Ka = (u16*)(smem + 4352);
  u16* KuT = (u16*)(smem + 8704);
  u16* VaT = (u16*)(smem + 13824);
  u16* VuT = (MODE == 1) ? (u16*)(smem + 18944) : VaT;
  float* Of = (float*)(smem + 24064);
  u16* Raw = (u16*)(smem + 40704);
  u16* Xc = (u16*)(smem + 53248);
  float* tot = (float*)(smem + 57344);
  float* cdec = (float*)(smem + 58368);
  float* dtl = (float*)(smem + 58624);
  float* rsc = (float*)(smem + 58880);
  float* clast = (float*)(smem + 59392);
  float* segacc = (float*)(smem + 59408);

  const float* sin_ = nullptr;
  float* sout = nullptr;
  if (MODE == 0) {
    if (!prompt) sin_ = p.in[2] + (((size_t)l * 128 + bidx) * 4 + sub) * 16384;
    sout = p.out + (prompt ? p.o_ret_p : p.o_ret_s) + (((size_t)l * NB + bidx) * 4 + sub) * 16384;
  } else if (MODE == 2) {
    if (!prompt) sin_ = p.in[5] + (((size_t)l * 128 + bidx) * 4 + sub) * 16384;
    sout = p.out + (prompt ? p.o_hg_p : p.o_hg_s) + (((size_t)l * NB + bidx) * 4 + sub) * 16384;
  } else {
    if (!prompt) sin_ = p.in[3] + (((size_t)l * 128 + bidx) * 8 + sub * 2 + (w >> 1)) * 8192;
    sout = p.out + (prompt ? p.o_ssd_p : p.o_ssd_s) + (((size_t)l * NB + bidx) * 8 + sub * 2 + (w >> 1)) * 8192;
  }

  float lg = 0.f;
  if (MODE == 0) lg = log1pf(-exp2f(-5.f - (float)sub));

  int sbase = (MODE == 1) ? (((w & 1) * 32 + r16) * 128 + quad * 4) : (quad * 512 + w * 32 + r16);
  asm volatile("" : "+v"(sbase));
  f32x4 S[8][NE];
#pragma unroll
  for (int t = 0; t < 8; ++t)
#pragma unroll
    for (int u = 0; u < NE; ++u) {
      if (sin_) {
        if (MODE == 1) {
          S[t][u] = *(const f32x4*)(sin_ + sbase + u * 2048 + t * 16);
        } else {
#pragma unroll
          for (int jj = 0; jj < 4; ++jj) S[t][u][jj] = sin_[sbase + t * 2048 + jj * 128 + u * 16];
        }
      } else {
        S[t][u] = f32x4{0.f, 0.f, 0.f, 0.f};
      }
    }
  if (prompt && pass == 2) {
    for (int r = 0; r < seg; ++r) {
      const uint2* sl = (const uint2*)(p.slocal + (size_t)(cid * (p.nseg - 1) + r) * 16384) + tid;
      const float* sd = p.segdec + (size_t)(cid * 7 + r) * 128;
      float dsc = 1.f;
      if (MODE == 0) dsc = __expf(lg * (float)(16 * cps));
      if (MODE == 1) dsc = __expf(sd[w >> 1]);
#pragma unroll
      for (int t = 0; t < 8; ++t) {
        f32x4 dv = f32x4{dsc, dsc, dsc, dsc};
        if (MODE == 2) {
          f32x4 lv = *(const f32x4*)(sd + t * 16 + quad * 4);
          dv = f32x4{__expf(lv[0]), __expf(lv[1]), __expf(lv[2]), __expf(lv[3])};
        }
#pragma unroll
        for (int u = 0; u < NE; ++u) {
          uint2 pk = sl[(t * NE + u) * 256];
          S[t][u][0] = S[t][u][0] * dv[0] + bf2f((u16)(pk.x & 0xffff));
          S[t][u][1] = S[t][u][1] * dv[1] + bf2f((u16)(pk.x >> 16));
          S[t][u][2] = S[t][u][2] * dv[2] + bf2f((u16)(pk.y & 0xffff));
          S[t][u][3] = S[t][u][3] * dv[3] + bf2f((u16)(pk.y >> 16));
        }
      }
    }
  }

  float lbv = 0.f;
  float hg_tot = 0.f;
  float cprev[2][3];
  float cw[2][4], cb[2];
  int ccidx[2];
  float dt_bias = 0.f, dt_A = 0.f;
  float rinv = 0.f, rcD = 1.f, rsD = 0.f;
  const int gg = sub >> 1, pair = sub & 1;
  if (MODE == 0) {
    rinv = exp2f(-(float)(tid & 63) * (13.287712379549449f / 64.f));
    rsD = __sinf(rinv); rcD = __cosf(rinv);
  }
  if (MODE == 2) {
    if (l == 1) {
      float a0 = p.in[20][sub * 128 + (tid & 127)], a1 = p.in[20][512 + sub * 128 + (tid & 127)];
      float mx = fmaxf(a0, a1);
      float e0 = __expf(a0 - mx), e1 = __expf(a1 - mx);
      lbv = e1 / (e0 + e1);
    }
  }
  if (MODE == 1) {
    if (tid < 32) {
      const int hh = sub * 2 + (tid >> 4);
      dt_A = -__expf(p.in[16][l * 8 + hh]);
      dt_bias = p.in[17][l * 8 + hh];
    }
    if (tid < 2) segacc[tid] = 0.f;
#pragma unroll
    for (int k = 0; k < 2; ++k) {
      int ci = tid + 256 * k;
      int cc = 0;
      if (ci < 128) cc = gg * 256 + pair * 128 + ci;
      else if (ci < 256) cc = 512 + gg * 128 + (ci - 128);
      else cc = 768 + gg * 128 + (ci - 256);
      if (ci >= 384) cc = 0;
      ccidx[k] = cc;
#pragma unroll
      for (int j = 0; j < 4; ++j) cw[k][j] = p.in[14][((size_t)l * 4 + j) * 1024 + cc];
      cb[k] = p.in[15][l * 1024 + cc];
#pragma unroll
      for (int j = 0; j < 3; ++j) {
        float v = 0.f;
        if (!prompt) v = p.in[4][(((size_t)l * 128 + bidx) * 3 + j) * 1024 + cc];
        else if (ch_begin > 0) v = bf2f(p.pbuf[(size_t)(row0 + ch_begin * 16 - 3 + j) * NP + C_SXBC + cc]);
        cprev[k][j] = v;
      }
    }
  }

  float fgain[8];
  {
    const int eg_ = tid & 15;
#pragma unroll
    for (int x = 0; x < 8; ++x) {
      if (MODE == 0) fgain[x] = p.in[13][(l * 4 + sub) * 128 + eg_ * 8 + x];
      else if (MODE == 2) fgain[x] = p.in[21][l * 128 + eg_ * 8 + x];
      else fgain[x] = p.in[18][l * 8 + sub * 2 + ((eg_ * 8) >> 6)];
    }
  }
  const int lt = tid >> 4, lc = tid & 15;
  uint4 r0, r1, r2, g0;
  unsigned rdt = 0;
  const uint4 z4 = make_uint4(0, 0, 0, 0);
  r0 = r1 = r2 = g0 = z4;
  auto load_raw = [&](int ch) {
    const int t0 = ch * 16;
    const int nv = (L - t0 < 16) ? (L - t0) : 16;
    const u16* Pr = p.pbuf + (size_t)(row0 + t0 + lt) * NP;
    r0 = r1 = r2 = g0 = z4;
    rdt = 0;
    if (lt < nv) {
      if (MODE == 0) {
        r0 = *(const uint4*)(Pr + C_RQ + sub * 128 + lc * 8);
        r1 = *(const uint4*)(Pr + C_RK + sub * 128 + lc * 8);
        r2 = *(const uint4*)(Pr + C_RV + sub * 128 + lc * 8);
        g0 = *(const uint4*)(Pr + C_RG + sub * 128 + lc * 8);
      } else if (MODE == 2) {
        r0 = *(const uint4*)(Pr + C_HQ + sub * 128 + lc * 8);
        r1 = *(const uint4*)(Pr + C_HF + sub * 128 + lc * 8);
        r2 = *(const uint4*)(Pr + C_HI + sub * 128 + lc * 8);
        g0 = *(const uint4*)(Pr + C_HG + sub * 128 + lc * 8);
      } else {
        r0 = *(const uint4*)(Pr + C_SXBC + gg * 256 + pair * 128 + lc * 8);
        r1 = *(const uint4*)(Pr + C_SXBC + 512 + gg * 128 + lc * 8);
        r2 = *(const uint4*)(Pr + C_SXBC + 768 + gg * 128 + lc * 8);
        g0 = *(const uint4*)(Pr + C_SZ + gg * 256 + pair * 128 + lc * 8);
        if (lc < 2) rdt = Pr[C_SDT + sub * 2 + lc];
      }
    }
  };
  load_raw(ch_begin);

  for (int ch = ch_begin; ch < ch_end; ++ch) {
    const int t0 = ch * 16;
    const int nvalid = (L - t0 < 16) ? (L - t0) : 16;
    float sscale = 1.f;
    int tidv = threadIdx.x;
    asm volatile("" : "+v"(tidv));
    const int tid = tidv, lane = tid & 63, w = tid >> 6, r16 = lane & 15, quad = lane >> 4, lt = tid >> 4, lc = tid & 15;

    *(uint4*)(Raw + lt * 128 + lc * 8) = r0;
    *(uint4*)(Raw + 2048 + lt * 128 + lc * 8) = r1;
    *(uint4*)(Raw + 4096 + lt * 128 + lc * 8) = r2;
    if (MODE == 1) { if (lc < 2) Raw[6144 + lt * 2 + lc] = (u16)rdt; }
    const uint4 gc0 = g0;
    __syncthreads();
    if (ch + 1 < ch_end) load_raw(ch + 1);

    if (MODE == 0) {
      const int which = tid >> 7, pr = tid & 63, th = (tid >> 6) & 1;
      if (which == 1 || !light) {
        const u16* R = Raw + which * 2048;
        float sn, cs;
        sincos_red((float)(pos0 + t0 + th * 8) * rinv, sn, cs);
#pragma unroll
        for (int x = 0; x < 8; ++x) {
          const int t = th * 8 + x;
          float x1 = bf2f(R[t * 128 + pr]);
          float x2 = bf2f(R[t * 128 + pr + 64]);
          float y1 = x1 * cs - x2 * sn, y2 = x1 * sn + x2 * cs;
          if (which) {
            y1 *= 0.08838834764831845f; y2 *= 0.08838834764831845f;
            Ka[t * QS + pr] = f2bf(y1); Ka[t * QS + pr + 64] = f2bf(y2);
            float kd = __expf(lg * (float)(nvalid - 1 - t));
            KuT[pr * TS + t] = f2bf(y1 * kd);
            KuT[(pr + 64) * TS + t] = f2bf(y2 * kd);
          } else {
            Qa[t * QS + pr] = f2bf(y1); Qa[t * QS + pr + 64] = f2bf(y2);
          }
          float ncs = cs * rcD - sn * rsD;
          sn = sn * rcD + cs * rsD; cs = ncs;
        }
      }
      if (tid < 16) cdec[tid] = lg * (float)(tid + 1);
      sscale = __expf(lg * (float)nvalid);
    } else if (MODE == 2) {
      const int d = tid & 127, th = tid >> 7;
      float cl[8], kk[8], qv[8];
      float c = 0.f;
#pragma unroll
      for (int x = 0; x < 8; ++x) {
        const int t = th * 8 + x;
        kk[x] = 0.f; qv[x] = 0.f;
        if (t < nvalid) {
          float z = bf2f(Raw[2048 + t * 128 + d]);
          float sg = sigmoidf_(z);
          float f = lbv + (1.f - lbv) * sg;
          c += __logf(f);
          kk[x] = (1.f - lbv) * (1.f - sg);
          if (!light) qv[x] = siluf_(bf2f(Raw[t * 128 + d]));
        }
        cl[x] = c;
      }
      tot[th * 128 + d] = c;
      __syncthreads();
      const float c_lo = tot[d];
      const float c_all = c_lo + tot[128 + d];
      const float off = th ? c_lo : 0.f;
      const float e_all = __expf(c_all);
#pragma unroll
      for (int x = 0; x < 8; ++x) {
        const int t = th * 8 + x;
        const float ct = off + cl[x];
        const float ein = __expf(-ct);
        if (!light) {
          Qa[t * QS + d] = f2bf(qv[x] * __frcp_rn(ein));
          Ka[t * QS + d] = f2bf(kk[x] * ein);
        }
        KuT[d * TS + t] = f2bf(kk[x] * ein * e_all);
      }
      if (th == 0) { rsc[d] = e_all; hg_tot += c_all; }
    } else {
      if (tid < 32) {
        const int hl = tid >> 4, t = tid & 15;
        float dtv = 0.f, c = 0.f;
        if (t < nvalid) {
          dtv = softplusf_(bf2f(Raw[6144 + t * 2 + hl]) + dt_bias);
          c = dtv * dt_A;
        }
#pragma unroll
        for (int o = 1; o < 16; o <<= 1) {
          float v = __shfl_up(c, o, 16);
          if (t >= o) c += v;
        }
        cdec[hl * 16 + t] = c;
        dtl[hl * 16 + t] = dtv;
        if (t == 15) { clast[hl] = c; segacc[hl] += c; }
      }
      __syncthreads();
#pragma unroll
      for (int k = 0; k < 2; ++k) {
        const int ci = tid + 256 * k;
        if (ci < 256 || (ci < 384 && !light)) {
          const int hl = (ci < 128) ? (ci >> 6) : 0;
          const float cl = clast[hl];
          const u16* R = Raw + ((ci < 128) ? ci : ((ci < 256) ? (2048 + (ci - 128)) : (4096 + (ci - 256))));
#pragma unroll 4
          for (int t = 0; t < 16; ++t) {
            float v = 0.f;
            if (t < nvalid) {
              float raw = bf2f(R[t * 128]);
              float o = cb[k] + cprev[k][0] * cw[k][0] + cprev[k][1] * cw[k][1] + cprev[k][2] * cw[k][2] + raw * cw[k][3];
              cprev[k][0] = cprev[k][1]; cprev[k][1] = cprev[k][2]; cprev[k][2] = raw;
              v = siluf_(o);
            }
            if (ci < 128) {
              float dtv = dtl[hl * 16 + t];
              if (!light) { Xc[t * 128 + ci] = f2bf(v); VaT[ci * TS + t] = f2bf(v * dtv); }
              VuT[ci * TS + t] = f2bf(v * dtv * __expf(cl - cdec[hl * 16 + t]));
            } else if (ci < 256) {
              u16 a = f2bf(v);
              if (!light) Ka[t * QS + (ci - 128)] = a;
              KuT[(ci - 128) * TS + t] = a;
            } else {
              Qa[t * QS + (ci - 256)] = f2bf(v);
            }
          }
        }
      }
    }
    if (MODE != 1) {
      const int e = tid & 127, th = tid >> 7;
#pragma unroll
      for (int x = 0; x < 4; ++x) {
        const int t = th * 8 + 2 * x;
        unsigned lo = Raw[4096 + t * 128 + e], hi = Raw[4096 + (t + 1) * 128 + e];
        *(unsigned*)(VaT + e * TS + t) = lo | (hi << 16);
      }
    }
    __syncthreads();

    {
      const float* cd = cdec + ((MODE == 1) ? (w >> 1) * 16 : 0);
      bf16x8 attA;
      float rr[4];
      bf16x8 qf[4];
      if (!light) {
        f32x4 at = f32x4{0.f, 0.f, 0.f, 0.f};
#pragma unroll
        for (int s = 0; s < 4; ++s) {
          bf16x8 a = *(const bf16x8*)(Ka + r16 * QS + s * 32 + quad * 8);
          bf16x8 b = *(const bf16x8*)(Qa + r16 * QS + s * 32 + quad * 8);
          at = MFMA16(a, b, at);
        }
        float ci_ = (MODE != 2) ? cd[r16] : 0.f;
        float vv[4];
#pragma unroll
        for (int jj = 0; jj < 4; ++jj) {
          int j = quad * 4 + jj;
          float v = at[jj];
          if (MODE != 2) v *= __expf(fminf(ci_ - cd[j], 0.f));
          vv[jj] = (j <= r16) ? v : 0.f;
        }
        unsigned a01 = pack2(vv[0], vv[1]), a23 = pack2(vv[2], vv[3]);
        attA = __builtin_bit_cast(bf16x8, (u32x4){a01, a23, 0u, 0u});
#pragma unroll
        for (int jj = 0; jj < 4; ++jj) rr[jj] = (MODE != 2) ? __expf(cd[quad * 4 + jj]) : 1.f;
#pragma unroll
        for (int s = 0; s < 4; ++s) {
          bf16x4 lo = *(const bf16x4*)(Qa + r16 * QS + s * 32 + quad * 4);
          bf16x4 hi = *(const bf16x4*)(Qa + r16 * QS + s * 32 + 16 + quad * 4);
          qf[s] = bf16x8{lo[0], lo[1], lo[2], lo[3], hi[0], hi[1], hi[2], hi[3]};
        }
      }
      if (!light) {
#pragma unroll
        for (int u = 0; u < NE; ++u) {
          const int e0 = (w * NE + u) * 16;
          bf16x4 v4 = *(const bf16x4*)(VaT + (e0 + r16) * TS + quad * 4);
          bf16x8 vb = bf16x8{v4[0], v4[1], v4[2], v4[3], 0, 0, 0, 0};
          f32x4 o1 = MFMA16(attA, vb, (f32x4{0.f, 0.f, 0.f, 0.f}));
          f32x4 o2 = f32x4{0.f, 0.f, 0.f, 0.f};
#pragma unroll
          for (int s = 0; s < 4; ++s) {
            u32x4 sp = {pack2(S[2 * s][u][0], S[2 * s][u][1]), pack2(S[2 * s][u][2], S[2 * s][u][3]),
                        pack2(S[2 * s + 1][u][0], S[2 * s + 1][u][1]), pack2(S[2 * s + 1][u][2], S[2 * s + 1][u][3])};
            o2 = MFMA16(qf[s], __builtin_bit_cast(bf16x8, sp), o2);
          }
#pragma unroll
          for (int jj = 0; jj < 4; ++jj) Of[(quad * 4 + jj) * OFS + e0 + r16] = o1[jj] + rr[jj] * o2[jj];
        }
      }
      float hs = 1.f;
      if (MODE == 0) hs = sscale;
      if (MODE == 1) hs = __expf(clast[w >> 1]);
#pragma unroll
      for (int u = 0; u < NE; ++u) {
        const int e0 = (w * NE + u) * 16;
        bf16x4 v4 = *(const bf16x4*)(VuT + (e0 + r16) * TS + quad * 4);
        bf16x8 vb = bf16x8{v4[0], v4[1], v4[2], v4[3], 0, 0, 0, 0};
#pragma unroll
        for (int t = 0; t < 8; ++t) {
          bf16x4 k4 = *(const bf16x4*)(KuT + (t * 16 + r16) * TS + quad * 4);
          bf16x8 ka = bf16x8{k4[0], k4[1], k4[2], k4[3], 0, 0, 0, 0};
          f32x4 sv = S[t][u];
          if (MODE == 2) {
            f32x4 r4 = *(const f32x4*)(rsc + t * 16 + quad * 4);
            sv[0] *= r4[0]; sv[1] *= r4[1]; sv[2] *= r4[2]; sv[3] *= r4[3];
          } else {
            sv[0] *= hs; sv[1] *= hs; sv[2] *= hs; sv[3] *= hs;
          }
          S[t][u] = MFMA16(ka, vb, sv);
        }
      }
    }
    __syncthreads();

    if (!light) {
      const int i = tid >> 4, eg = tid & 15;
      const int grow = row0 + t0 + i;
      unsigned gw[4] = {gc0.x, gc0.y, gc0.z, gc0.w};
      if (MODE == 0 || MODE == 2) {
        float o[8];
#pragma unroll
        for (int x = 0; x < 8; ++x) o[x] = Of[i * OFS + eg * 8 + x];
        float s1 = 0.f;
        float mu = 0.f;
        if (MODE == 0) {
#pragma unroll
          for (int x = 0; x < 8; ++x) s1 += o[x];
          mu = sum16(s1) * (1.f / 128.f);
        }
        float s2 = 0.f;
#pragma unroll
        for (int x = 0; x < 8; ++x) { o[x] -= mu; s2 += o[x] * o[x]; }
        float r = rsqrtf(sum16(s2) * (1.f / 128.f) + EPS);
        if (i < nvalid) {
          float res[8];
#pragma unroll
          for (int x = 0; x < 8; ++x) {
            float g = bf2f((u16)((x & 1) ? (gw[x >> 1] >> 16) : (gw[x >> 1] & 0xffff)));
            float gate = (MODE == 0) ? siluf_(g) : sigmoidf_(g);
            res[x] = o[x] * r * fgain[x] * gate;
          }
          uint4 ov = make_uint4(pack2(res[0], res[1]), pack2(res[2], res[3]), pack2(res[4], res[5]), pack2(res[6], res[7]));
          const int ocol = ((MODE == 0) ? 0 : 1024) + sub * 128 + eg * 8;
          *(uint4*)(p.obuf + (size_t)grow * OLD + ocol) = ov;
        }
      } else {
        float y[8];
        const int chb = eg * 8;
        const float Dh = fgain[0];
        float s2 = 0.f;
#pragma unroll
        for (int x = 0; x < 8; ++x) {
          float g = bf2f((u16)((x & 1) ? (gw[x >> 1] >> 16) : (gw[x >> 1] & 0xffff)));
          float v = Of[i * OFS + chb + x] + bf2f(Xc[i * 128 + chb + x]) * Dh;
          v *= siluf_(g);
          y[x] = v; s2 += v * v;
        }
        s2 = sum16(s2);
        if (i < nvalid) {
          if (eg == 0) p.ssq[(size_t)grow * 4 + sub] = s2;
          uint4 ov = make_uint4(pack2(y[0], y[1]), pack2(y[2], y[3]), pack2(y[4], y[5]), pack2(y[6], y[7]));
          *(uint4*)(p.obuf + (size_t)grow * OLD + 512 + sub * 128 + chb) = ov;
        }
      }
    }
  }
  __syncthreads();

  if (light) {
    uint2* sl = (uint2*)(p.slocal + (size_t)(cid * (p.nseg - 1) + seg) * 16384) + tid;
#pragma unroll
    for (int t = 0; t < 8; ++t)
#pragma unroll
      for (int u = 0; u < NE; ++u)
        sl[(t * NE + u) * 256] = make_uint2(pack2(S[t][u][0], S[t][u][1]), pack2(S[t][u][2], S[t][u][3]));
    float* sd = p.segdec + (size_t)(cid * 7 + seg) * 128;
    if (MODE == 1) { if (tid < 2) sd[tid] = segacc[tid]; }
    if (MODE == 2) { if (tid < 128) sd[tid] = hg_tot; }
  } else if (last_seg) {
    asm volatile("" : "+v"(sbase));
#pragma unroll
    for (int t = 0; t < 8; ++t)
#pragma unroll
      for (int u = 0; u < NE; ++u) {
        if (MODE == 1) {
          *(f32x4*)(sout + sbase + u * 2048 + t * 16) = S[t][u];
        } else {
#pragma unroll
          for (int jj = 0; jj < 4; ++jj) sout[sbase + t * 2048 + jj * 128 + u * 16] = S[t][u][jj];
        }
      }
    if (MODE == 1) {
      float* co = p.out + (prompt ? p.o_conv_p : p.o_conv_s) + ((size_t)l * NB + bidx) * 3 * 1024;
#pragma unroll
      for (int k = 0; k < 2; ++k) {
        const int ci = tid + 256 * k;
        if (ci < 128 || (ci < 384 && pair == 0)) {
#pragma unroll
          for (int j = 0; j < 3; ++j) co[j * 1024 + ccidx[k]] = cprev[k][j];
        }
      }
    }
  }
}

__device__ void run_s5(const Params& p, int l, int seq, int gq, int seg, int pass, char* smem) {
  const int tid = tidq(), lane = tid & 63, w = tid >> 6, r16 = lane & 15, quad = lane >> 4;
  const int g = gq * 4 + w;
  const bool prompt = seq < 8;
  const int bidx = prompt ? seq : seq - 8;
  const int NB = prompt ? 8 : 128;
  const int row0 = prompt ? seq * 2048 : MPR + (seq - 8) * 8;
  int cps_ = p.cps;
  asm volatile("" : "+s"(cps_));
  const int nch = prompt ? cps_ : 1;
  const int ch_begin = prompt ? seg * nch : 0;
  const int ch_end = ch_begin + nch;
  const int nvalid = prompt ? 16 : 8;
  const bool light = prompt && (pass == 1);
  const bool last_seg = !prompt || (seg == p.nseg - 1);
  char* wb = smem + w * 5120;
  u16* Hs = (u16*)wb;
  u16* Us = (u16*)(wb + 4352);
  const int lg_ = l * 32 + g;

  const float dt = __expf(p.in[29][lg_]);
  float Ar[4][4], Ai[4][4];
  float fre[4], fim[4];
  float dtare[4], thv[4];
#pragma unroll
  for (int i = 0; i < 4; ++i) {
    const int pi = i * 16 + r16;
    const float are = p.in[22][lg_ * 64 + pi], aim = p.in[23][lg_ * 64 + pi];
    const float th = dt * aim;
    float sn, cs; sincos_red(th, sn, cs);
    float shalf, chalf; sincos_red(0.5f * th, shalf, chalf);
    const float em1 = expm1f(dt * are);
    const float mag = em1 + 1.f;
    const float abr = mag * cs, abi = mag * sn;
    const float nre = em1 * cs - 2.f * shalf * shalf, nim = abi;
    const float den = are * are + aim * aim;
    fre[i] = (nre * are + nim * aim) / den; fim[i] = (nim * are - nre * aim) / den;
    dtare[i] = dt * are; thv[i] = th;
    Ar[0][i] = abr; Ai[0][i] = abi;
    Ar[1][i] = abr * abr - abi * abi; Ai[1][i] = 2.f * abr * abi;
    Ar[2][i] = Ar[1][i] * abr - Ai[1][i] * abi; Ai[2][i] = Ar[1][i] * abi + Ai[1][i] * abr;
    Ar[3][i] = Ar[1][i] * Ar[1][i] - Ai[1][i] * Ai[1][i]; Ai[3][i] = 2.f * Ar[1][i] * Ai[1][i];
  }
  bf16x8 Bop[8];
#pragma unroll
  for (int nt = 0; nt < 8; ++nt) {
    const int i = nt & 3;
    u32x4 pk = {0u, 0u, 0u, 0u};
    if (quad < 2) {
      const size_t bo = ((size_t)lg_ * 64 + i * 16 + r16) * 16 + quad * 8;
      const float4 br0 = *(const float4*)(p.in[24] + bo), br1 = *(const float4*)(p.in[24] + bo + 4);
      const float4 bi0 = *(const float4*)(p.in[25] + bo), bi1 = *(const float4*)(p.in[25] + bo + 4);
      const float brv[8] = {br0.x, br0.y, br0.z, br0.w, br1.x, br1.y, br1.z, br1.w};
      const float biv[8] = {bi0.x, bi0.y, bi0.z, bi0.w, bi1.x, bi1.y, bi1.z, bi1.w};
      float v[8];
#pragma unroll
      for (int j = 0; j < 8; ++j)
        v[j] = (nt < 4) ? (fre[i] * brv[j] - fim[i] * biv[j]) : (fre[i] * biv[j] + fim[i] * brv[j]);
      pk = u32x4{pack2(v[0], v[1]), pack2(v[2], v[3]), pack2(v[4], v[5]), pack2(v[6], v[7])};
    }
    Bop[nt] = __builtin_bit_cast(bf16x8, pk);
  }
  bf16x8 Cop[4];
  float Dm[4] = {0.f, 0.f, 0.f, 0.f};
  if (!light) {
#pragma unroll
    for (int s = 0; s < 4; ++s) {
      const int n0 = 32 * s + quad * 8;
      const float* src = ((n0 >= 64) ? p.in[27] : p.in[26]) + ((size_t)lg_ * 16 + r16) * 64 + (n0 & 63);
      const float sg = (n0 >= 64) ? -1.f : 1.f;
      const float4 c0 = *(const float4*)src, c1 = *(const float4*)(src + 4);
      Cop[s] = __builtin_bit_cast(bf16x8, (u32x4{pack2(sg * c0.x, sg * c0.y), pack2(sg * c0.z, sg * c0.w),
                                                 pack2(sg * c1.x, sg * c1.y), pack2(sg * c1.z, sg * c1.w)}));
    }
#pragma unroll
    for (int jj = 0; jj < 4; ++jj) Dm[jj] = p.in[28][lg_ * 16 + quad * 4 + jj];
  }
  float hr[4], hi[4];
#pragma unroll
  for (int i = 0; i < 4; ++i) { hr[i] = 0.f; hi[i] = 0.f; }
  if (!prompt) {
#pragma unroll
    for (int i = 0; i < 4; ++i) {
      hr[i] = p.in[6][((size_t)(l * 128 + bidx) * 32 + g) * 64 + i * 16 + r16];
      hi[i] = p.in[7][((size_t)(l * 128 + bidx) * 32 + g) * 64 + i * 16 + r16];
    }
  } else if (pass == 2 && seg > 0) {
    const float len = (float)(nch * 16);
#pragma unroll
    for (int i = 0; i < 4; ++i) {
      const float pm = __expf(len * dtare[i]);
      float ps, pc; sincos_red(len * thv[i], ps, pc);
      const float pr_ = pm * pc, pi_ = pm * ps;
      for (int r = 0; r < seg; ++r) {
        const float* hl = p.hlocal + ((size_t)((seq * 32 + g) * 7 + r)) * 128;
        const float lr_ = hl[i * 16 + r16], li_ = hl[64 + i * 16 + r16];
        const float nr = pr_ * hr[i] - pi_ * hi[i] + lr_;
        const float ni = pr_ * hi[i] + pi_ * hr[i] + li_;
        hr[i] = nr; hi[i] = ni;
      }
    }
  }
  const int ut = lane >> 1, uh = lane & 1;
  const u16* ubase = p.pbuf + (size_t)(row0 + ut) * NP + C_SU + g * 16 + uh * 8;
  const uint4 z4 = make_uint4(0, 0, 0, 0);
  uint4 nxt = z4;
  if (lane < 32 && ut < nvalid) nxt = *(const uint4*)(ubase + (size_t)ch_begin * 16 * NP);
  for (int ch = ch_begin; ch < ch_end; ++ch) {
    const uint4 cur = nxt;
    nxt = z4;
    if (ch + 1 < ch_end && lane < 32) nxt = *(const uint4*)(ubase + (size_t)(ch + 1) * 16 * NP);
    if (lane < 32) *(uint4*)(Us + ut * 16 + uh * 8) = cur;
    __syncthreads();
    bf16x8 Uop = bf16x8{0, 0, 0, 0, 0, 0, 0, 0};
    if (quad < 2) Uop = *(const bf16x8*)(Us + r16 * 16 + quad * 8);
    f32x4 bu[8];
#pragma unroll
    for (int nt = 0; nt < 8; ++nt) bu[nt] = MFMA16(Uop, Bop[nt], (f32x4{0.f, 0.f, 0.f, 0.f}));
    float Er[4], Ei[4];
#pragma unroll
    for (int i = 0; i < 4; ++i) {
      float xr = 0.f, xi = 0.f;
#pragma unroll
      for (int jj = 0; jj < 4; ++jj) {
        const float nr = Ar[0][i] * xr - Ai[0][i] * xi + bu[i][jj];
        const float ni = Ar[0][i] * xi + Ai[0][i] * xr + bu[4 + i][jj];
        xr = nr; xi = ni;
        bu[i][jj] = xr; bu[4 + i][jj] = xi;
      }
      Er[i] = xr; Ei[i] = xi;
    }
    float cr[4], ci[4];
#pragma unroll
    for (int i = 0; i < 4; ++i) { cr[i] = hr[i]; ci[i] = hi[i]; }
#pragma unroll
    for (int k = 0; k < 4; ++k) {
#pragma unroll
      for (int i = 0; i < 4; ++i) {
        const float er = __shfl(Er[i], r16 + 16 * k), ei = __shfl(Ei[i], r16 + 16 * k);
        const float nr = Ar[3][i] * hr[i] - Ai[3][i] * hi[i] + er;
        const float ni = Ar[3][i] * hi[i] + Ai[3][i] * hr[i] + ei;
        if (k * 4 < nvalid) { hr[i] = nr; hi[i] = ni; }
        if (k < quad) { cr[i] = nr; ci[i] = ni; }
      }
    }
    if (!light) {
#pragma unroll
      for (int i = 0; i < 4; ++i)
#pragma unroll
        for (int jj = 0; jj < 4; ++jj) {
          const float vr = bu[i][jj] + Ar[jj][i] * cr[i] - Ai[jj][i] * ci[i];
          const float vi = bu[4 + i][jj] + Ar[jj][i] * ci[i] + Ai[jj][i] * cr[i];
          Hs[(quad * 4 + jj) * 136 + i * 16 + r16] = f2bf(vr);
          Hs[(quad * 4 + jj) * 136 + 64 + i * 16 + r16] = f2bf(vi);
        }
      __syncthreads();
      f32x4 ya = f32x4{0.f, 0.f, 0.f, 0.f};
#pragma unroll
      for (int s = 0; s < 4; ++s) {
        const bf16x8 bh = *(const bf16x8*)(Hs + r16 * 136 + s * 32 + quad * 8);
        ya = MFMA16(Cop[s], bh, ya);
      }
      const uint2 uu = *(const uint2*)(Us + r16 * 16 + quad * 4);
      const float u0 = bf2f((u16)(uu.x & 0xffff)), u1 = bf2f((u16)(uu.x >> 16));
      const float u2 = bf2f((u16)(uu.y & 0xffff)), u3 = bf2f((u16)(uu.y >> 16));
      const float z0 = gelu_tanh(ya[0] + Dm[0] * u0), z1 = gelu_tanh(ya[1] + Dm[1] * u1);
      const float z2 = gelu_tanh(ya[2] + Dm[2] * u2), z3 = gelu_tanh(ya[3] + Dm[3] * u3);
      if (r16 < nvalid)
        *(uint2*)(p.zs5 + (size_t)(row0 + ch * 16 + r16) * ZLD + g * 16 + quad * 4) = make_uint2(pack2(z0, z1), pack2(z2, z3));
    }
    __syncthreads();
  }
  if (light) {
    if (quad == 0) {
      float* hl = p.hlocal + ((size_t)((seq * 32 + g) * 7 + seg)) * 128;
#pragma unroll
      for (int i = 0; i < 4; ++i) { hl[i * 16 + r16] = hr[i]; hl[64 + i * 16 + r16] = hi[i]; }
    }
  } else if (last_seg) {
    if (quad == 0) {
      float* o_r = p.out + (prompt ? p.o_s5r_p : p.o_s5r_s) + ((size_t)(l * NB + bidx) * 32 + g) * 64;
      float* o_i = p.out + (prompt ? p.o_s5i_p : p.o_s5i_s) + ((size_t)(l * NB + bidx) * 32 + g) * 64;
#pragma unroll
      for (int i = 0; i < 4; ++i) { o_r[i * 16 + r16] = hr[i]; o_i[i * 16 + r16] = hi[i]; }
    }
  }
}

__device__ void phase_mixers(const Params& p, int l, int pass, char* smem, int visit) {
  int* s_item = (int*)(smem + 65536);
  unsigned* cnt = p.counters + l * 64 + (pass - 1) * 32 + visit * 16;
  const int nseg = p.nseg;
  const int ns1 = nseg - 1;
  const int n_chain = (pass == 1) ? 96 * ns1 : 96 * nseg;
  const int n_s5 = (pass == 1) ? 64 * ns1 : 64 * nseg;
  const int n_items = n_chain + n_s5 + ((pass == 1) ? 128 * 20 : 0);
  for (;;) {
    if (tidq() == 0) *s_item = (int)atomicAdd(cnt, 1u);
    __syncthreads();
    const int item = *s_item;
    __syncthreads();
    if (item >= n_items) break;
    int mode, seq, sub, seg = 0;
    const int per = (pass == 1) ? ns1 : nseg;
    if (item < n_chain) {
      const int c = item / per; seg = item % per;
      const int kind = c >> 5, r = c & 31;
      seq = r >> 2; sub = r & 3;
      mode = (kind == 0) ? 1 : ((kind == 1) ? 2 : 0);
    } else if (item < n_chain + n_s5) {
      const int k = item - n_chain;
      const int c = k / per; seg = k % per;
      mode = 3; seq = c >> 3; sub = c & 7;
    } else {
      int k = item - n_chain - n_s5; int b = k / 20; sub = k % 20; seq = 8 + b;
      if (sub < 4) mode = 1;
      else if (sub < 8) { mode = 0; sub -= 4; }
      else if (sub < 12) { mode = 2; sub -= 8; }
      else { mode = 3; sub -= 12; }
    }
    const int ps = (seq >= 8) ? 2 : pass;
    if (mode == 0) { if (EN(2) || ONLY == 20) run_chain<0>(p, l, seq, sub, seg, ps, smem); }
    else if (mode == 1) { if (EN(2) || ONLY == 21) run_chain<1>(p, l, seq, sub, seg, ps, smem); }
    else if (mode == 2) { if (EN(2) || ONLY == 22) run_chain<2>(p, l, seq, sub, seg, ps, smem); }
    else { if (EN(2) || ONLY == 23) run_s5(p, l, seq, sub, seg, ps, smem); }
    __syncthreads();
  }
}

DI bool tile_at(int i, int T, int& t) {
  const int bpx = gridDim.x >> 3;
  t = ((blockIdx.x & 7) + 8 * i) * bpx + (blockIdx.x >> 3);
  return t < T;
}
DI void tile_mn(int t, int nN, int& m0, int& n0) {
  const int per = 8 * nN;
  const int grp = t / per, r = t - grp * per;
  m0 = (grp * 8 + (r & 7)) * 128;
  n0 = (r >> 3) * 128;
}

__device__ void run_phase(const Params& p, int ph, char* smem, int visit) {
  constexpr int NMT = MTOK / 128;
  if (ph == 0) {
    if (EN(9)) phase_convert(p, smem);
    if (EN(0)) phase_rownorm(p, true, nullptr, nullptr, p.in[8], p.hb);
    return;
  }
  if (ph == NPHASE - 1) {
    if (EN(10)) phase_rownorm(p, false, p.tbuf, p.in[11] + 1 * DM, nullptr, nullptr);
    return;
  }
  const int l = (ph <= 9) ? 0 : 1, s0_ = (ph <= 9) ? ph : ph - 10;
  const int s = (s0_ <= 2) ? s0_ : s0_ - 1;
  switch (s) {
    case 0:
      if (!EN(0)) break;
      phase_rownorm(p, false, p.tbuf, p.in[11] + (l - 1) * DM, p.in[8] + l * DM, p.hb);
      break;
    case 1: if (EN(1)) {
      constexpr int NN = NP / 128;
      gemm_stream<EPI_BF16>(p.hb, HLD, p.wt_in + (size_t)l * NIN * WLD1, WLD1, DM, NN, NMT * NN, p.pbuf, NP, nullptr, 0, smem);
    } break;
    case 2: if (EN(2) || (ONLY >= 20 && ONLY <= 23)) phase_mixers(p, l, (s0_ == 2) ? 1 : 2, smem, visit); break;
    case 3: if (EN(3)) {
      constexpr int NG = 32, NGLU = 4;
      {
        const int lane = tidq() & 63, w = tidq() >> 6;
        for (int row = blockIdx.x * 4 + w; row < MTOK; row += gridDim.x * 4) {
          const float4 sq = *(const float4*)(p.ssq + (size_t)row * 4);
          const float ms = (lane < 32) ? (sq.x + sq.y) : (sq.z + sq.w);
          const float r = rsqrtf(ms * (1.f / 256.f) + EPS);
          u16* ptr = p.obuf + (size_t)row * OLD + 512 + lane * 8;
          uint4 v = *(const uint4*)ptr;
          const float* gn = p.in[19] + l * 512 + lane * 8;
          unsigned vw[4] = {v.x, v.y, v.z, v.w};
          unsigned ow[4];
#pragma unroll
          for (int x = 0; x < 4; ++x)
            ow[x] = pack2(bf2f((u16)(vw[x] & 0xffff)) * r * gn[2 * x], bf2f((u16)(vw[x] >> 16)) * r * gn[2 * x + 1]);
          *(uint4*)ptr = make_uint4(ow[0], ow[1], ow[2], ow[3]);
        }
      }
      gemm_stream<EPI_SIG>(p.hb, HLD, p.wt_in + ((size_t)l * NIN + NP) * WLD1, WLD1, DM, NG, NMT * NG, p.pbuf, 4096, nullptr, 0, smem);
      gemm_stream<EPI_GLU>(p.zs5, ZLD, p.wt_glu + (size_t)l * 512 * WLD5, WLD5, 512, NGLU, NMT * NGLU,
                           p.obuf + 1536, OLD, p.zs5, ZLD, smem);
    } break;
    case 4:
      if (EN(4)) {
        int t, m0, n0;
        for (int i = 0; tile_at(i, NMT * 8, t); ++i) { tile_mn(t, 8, m0, n0); merge_tile(p, l, m0, n0, smem); }
      }
      break;
    case 5:
      if (EN(5)) {
        if (gridDim.x == 512) gemm_stream_split(p.hb, HLD, p.wt_out + (size_t)l * DM * WLD1, WLD1, DM, p.tbuf, (float*)p.obuf, smem);
        else gemm_stream<EPI_F32>(p.hb, HLD, p.wt_out + (size_t)l * DM * WLD1, WLD1, DM, 8, NMT * 8, p.tbuf, DM, nullptr, 0, smem);
      }
      break;
    case 6:
      if (EN(6)) phase_rownorm(p, false, p.tbuf, p.in[9] + l * DM, p.in[10] + l * DM, p.hb);
      break;
    case 7:
      if (EN(7)) {
        gemm_stream<EPI_RELU2>(p.hb, HLD, p.wt_ff1 + (size_t)l * DFF * WLD1, WLD1, DM, 32, NMT * 32, p.pbuf, ULD, nullptr, 0, smem);
      }
      break;
    case 8:
      if (EN(8)) {
        if (gridDim.x == 512) gemm_stream_split(p.pbuf, ULD, p.wt_ff2 + (size_t)l * DM * WLD4, WLD4, DFF, p.tbuf, (float*)p.obuf, smem);
        else gemm_stream<EPI_F32>(p.pbuf, ULD, p.wt_ff2 + (size_t)l * DM * WLD4, WLD4, DFF, 8, NMT * 8, p.tbuf, DM, nullptr, 0, smem);
      }
      break;
  }
}

#ifndef DUP_S
#define DUP_S -1
#endif
#define XB_TMO      128
#define XB_XCNT(j)  (256  + 64 * (j))
#define XB_XSUB(j)  (1280 + 64 * (j))
#define XB_XGEN(j)  (2304 + 64 * (j))
#define XB_TOP      3328
#define XB_TOPGEN   3392
#define XCD_BAR_WORDS 3456
#define XB_SPIN_CAP (1u << 22)
#define LAS __attribute__((address_space(3)))
DI unsigned xb_ld(unsigned* p)              { return __hip_atomic_load(p, __ATOMIC_RELAXED, __HIP_MEMORY_SCOPE_AGENT); }
DI unsigned xb_add(unsigned* p, unsigned v) { return __hip_atomic_fetch_add(p, v, __ATOMIC_RELAXED, __HIP_MEMORY_SCOPE_AGENT); }
DI unsigned xb_xcc_id() { return (unsigned)__builtin_amdgcn_s_getreg((3 << 11) | 20) & 0xFu; }
#define XB_SPIN(cond, bar) do { unsigned _sp = 0; while (cond) { __builtin_amdgcn_s_sleep(1); \
    if ((++_sp & 255u) == 0u) { if (xb_ld(&(bar)[XB_TMO])) break; if (_sp > XB_SPIN_CAP) { atomicAdd(&(bar)[XB_TMO], 1u); break; } } } } while (0)
struct XcdBarrier { unsigned* bar; unsigned x; volatile LAS unsigned* st; };
DI XcdBarrier xcd_barrier_post(unsigned* bar, volatile LAS unsigned* st) {
  XcdBarrier b; b.bar = bar; b.x = xb_xcc_id(); b.st = st;
  if (threadIdx.x == 0) (void)xb_add(&bar[XB_XCNT(b.x)], 1u);
  return b;
}
DI void xcd_barrier_complete(unsigned* bar, unsigned x, unsigned& nloc, unsigned& nx) {
  const unsigned G = gridDim.x * gridDim.y * gridDim.z;
  unsigned sum, cnt, mine, sp = 0u;
  for (;;) {
    sum = 0u; cnt = 0u; mine = 0u;
#pragma unroll
    for (unsigned j = 0; j < 16; ++j) { const unsigned c = xb_ld(&bar[XB_XCNT(j)]); sum += c; cnt += (c > 0u) ? 1u : 0u; mine = (j == x) ? c : mine; }
    if (sum == G) break;
    __builtin_amdgcn_s_sleep(1);
    if ((++sp & 255u) == 0u) { if (xb_ld(&bar[XB_TMO])) break; if (sp > XB_SPIN_CAP) { atomicAdd(&bar[XB_TMO], 1u); break; } }
  }
  nloc = mine > 0u ? mine : 1u; nx = cnt > 0u ? cnt : 1u;
}
DI void xcd_barrier(const XcdBarrier& b) {
  asm volatile("s_waitcnt vmcnt(0)" ::: "memory");
  __syncthreads();
  if (threadIdx.x == 0) {
    unsigned* bar = b.bar;
    __builtin_amdgcn_s_waitcnt(0);
    unsigned nloc = b.st[0], nx = b.st[1];
    if (nloc == 0u) { xcd_barrier_complete(bar, b.x, nloc, nx); b.st[0] = nloc; b.st[1] = nx; }
    const unsigned old = xb_add(&bar[XB_XSUB(b.x)], 1u);
    const unsigned gen = old / nloc;
    if (old + 1u == (gen + 1u) * nloc) {
      __builtin_amdgcn_fence(__ATOMIC_RELEASE, "agent");
      asm volatile("s_waitcnt vmcnt(0)" ::: "memory");
      const unsigned og = xb_add(&bar[XB_TOP], 1u);
      const unsigned tg = og / nx;
      if (og + 1u == (tg + 1u) * nx) xb_add(&bar[XB_TOPGEN], 1u);
      else XB_SPIN(xb_ld(&bar[XB_TOPGEN]) == tg, bar);
      __builtin_amdgcn_fence(__ATOMIC_ACQUIRE, "agent");
      xb_add(&bar[XB_XGEN(b.x)], 1u);
      asm volatile("s_waitcnt vmcnt(0)" ::: "memory");
    } else {
      XB_SPIN(xb_ld(&bar[XB_XGEN(b.x)]) == gen, bar);
      __builtin_amdgcn_fence(__ATOMIC_ACQUIRE, "agent");
      asm volatile("s_waitcnt vmcnt(0)" ::: "memory");
    }
  }
  __syncthreads();
}

__global__ void __launch_bounds__(256, 2) mega_kernel(Params p, int ph_lo, int ph_hi) {
  __shared__ __attribute__((aligned(16))) char smem[65536 + 32];
  volatile LAS unsigned* st = (volatile LAS unsigned*)(&smem[65536 + 16]);
  if (threadIdx.x == 0) { st[0] = 0u; st[1] = 0u; }
  __syncthreads();
  const XcdBarrier xb = xcd_barrier_post(p.bar, st);
  for (int ph = ph_lo; ph < ph_hi; ++ph) {
    if (ph > ph_lo) xcd_barrier(xb);
    if (ph_hi < 0) cg::this_grid().sync();
    const int reps = (DUP_S >= 0 && ph == DUP_S) ? 2 : 1;
    for (int r = 0; r < reps; ++r) {
      if (r) xcd_barrier(xb);
#ifdef VAR_NOSTORE
      if (tidq() == 0) *(volatile int*)(smem + 65536 + 8) = r;
      __syncthreads();
#endif
      run_phase(p, ph, smem, r);
    }
  }
}

extern "C" void kernel_launch(void* const* d_in, const int* in_sizes, int n_in, void* d_out, int out_size,
                              void* d_ws, size_t ws_size, hipStream_t stream) {
  Params p{};
  for (int i = 0; i < 35; ++i) p.in[i] = (const float*)d_in[i];
  p.out = (float*)d_out;
  char* ws = (char*)d_ws;
  size_t off = 0;
  auto take = [&](size_t bytes) { char* r = ws + off; off += (bytes + 255) & ~(size_t)255; return r; };
  p.wt_in  = (u16*)take((size_t)2 * NIN * WLD1 * 2);
  p.wt_ff1 = (u16*)take((size_t)2 * DFF * WLD1 * 2);
  p.wt_ff2 = (u16*)take((size_t)2 * DM * WLD4 * 2);
  p.wt_br  = (u16*)take((size_t)2 * 4 * DM * WLD5 * 2);
  p.wt_out = (u16*)take((size_t)2 * DM * WLD1 * 2);
  p.wt_glu = (u16*)take((size_t)2 * 512 * WLD5 * 2);
  p.hb     = (u16*)take((size_t)MTOK * HLD * 2);
  p.pbuf   = (u16*)take((size_t)MTOK * NP * 2);
  p.obuf   = (u16*)take((size_t)MTOK * OLD * 2);
  p.zs5    = (u16*)take((size_t)MTOK * ZLD * 2);
  p.counters = (unsigned*)take(4096);
  p.bar = (unsigned*)take(16384);
  p.ssq = (float*)take((size_t)MTOK * 4 * 4);
  p.segdec = (float*)take((size_t)96 * 7 * 128 * 4);
  p.hlocal = (float*)take((size_t)8 * 32 * 7 * 128 * 4);
  p.nseg = 8;
  if (off + (size_t)96 * 7 * 32768 > ws_size) p.nseg = 4;
  p.cps = 128 / p.nseg;
  p.slocal = (u16*)take((size_t)96 * (p.nseg - 1) * 32768);
  p.tbuf = (float*)(p.pbuf + (size_t)MTOK * ULD);
  if (off > ws_size) { fprintf(stderr, "workspace too small: need %zu have %zu\n", off, ws_size); return; }
  size_t o = (size_t)MTOK * DM;
  p.o_ret_p = o;  o += (size_t)2 * 8 * 65536;
  p.o_ret_s = o;  o += (size_t)2 * 128 * 65536;
  p.o_ssd_p = o;  o += (size_t)2 * 8 * 65536;
  p.o_ssd_s = o;  o += (size_t)2 * 128 * 65536;
  p.o_conv_p = o; o += (size_t)2 * 8 * 3 * 1024;
  p.o_conv_s = o; o += (size_t)2 * 128 * 3 * 1024;
  p.o_hg_p = o;   o += (size_t)2 * 8 * 65536;
  p.o_hg_s = o;   o += (size_t)2 * 128 * 65536;
  p.o_s5r_p = o;  o += (size_t)2 * 8 * 2048;
  p.o_s5r_s = o;  o += (size_t)2 * 128 * 2048;
  p.o_s5i_p = o;  o += (size_t)2 * 8 * 2048;
  p.o_s5i_s = o;  o += (size_t)2 * 128 * 2048;

  static int grid_blocks = 0;
  if (!grid_blocks) {
    int dev = 0, cus = 0, per_cu = 0;
    hipGetDevice(&dev);
    hipDeviceGetAttribute(&cus, hipDeviceAttributeMultiprocessorCount, dev);
    hipOccupancyMaxActiveBlocksPerMultiprocessor(&per_cu, mega_kernel, 256, 0);
    if (per_cu > 2) per_cu = 2;
    if (per_cu < 1) per_cu = 1;
    grid_blocks = cus * per_cu;
  }
  hipMemsetAsync(p.counters, 0, 4096 + 16384, stream);
#if SINGLE_LAUNCH
  int lo = 0, hi = NPHASE;
  void* args[] = {&p, &lo, &hi};
  hipError_t e = hipLaunchCooperativeKernel((void*)mega_kernel, dim3(grid_blocks), dim3(256), args, 0, stream);
  if (e != hipSuccess) fprintf(stderr, "cooperative launch failed: %s (grid %d)\n", hipGetErrorString(e), grid_blocks);
#else
  for (int ph = 0; ph < NPHASE; ++ph)
    hipLaunchKernelGGL(mega_kernel, dim3(grid_blocks), dim3(256), 0, stream, p, ph, ph + 1);
#endif
}
```

```cpp
#include <hip/hip_runtime.h>
#include <hip/hip_cooperative_groups.h>
#include <cstdio>
#include <cstdint>
namespace cg = cooperative_groups;

#ifndef SINGLE_LAUNCH
#define SINGLE_LAUNCH 1
#endif
#ifndef ONLY
#define ONLY -1
#endif
#define EN(k) (ONLY < 0 || ONLY == (k))

typedef unsigned short u16;
using bf16x8 = __attribute__((ext_vector_type(8))) short;
using bf16x4 = __attribute__((ext_vector_type(4))) short;
using f32x4  = __attribute__((ext_vector_type(4))) float;
typedef unsigned u32x4 __attribute__((ext_vector_type(4)));
#define DI __device__ __forceinline__
#define MFMA16(a, b, c) __builtin_amdgcn_mfma_f32_16x16x32_bf16((a), (b), (c), 0, 0, 0)

constexpr int MTOK = 17408;
constexpr int MPR  = 16384;
constexpr int DM   = 1024;
constexpr int NP   = 6272;
constexpr int NIN  = 10368;
constexpr int DFF  = 4096;
constexpr int INC  = 10248;
constexpr int C_RQ = 0, C_RK = 512, C_RV = 1024, C_RG = 1536, C_SZ = 2048, C_SXBC = 2560;
constexpr int C_HQ = 3584, C_HF = 4096, C_HI = 4608, C_HG = 5120, C_SU = 5632, C_SDT = 6144;
constexpr float EPS = 1e-6f;
constexpr int HLD = 1024, WLD1 = 1024, ULD = 4096, WLD4 = 4096, OLD = 2048, ZLD = 512, WLD5 = 512;
constexpr int NITEMS = 160 + 128 * 20;
constexpr int NPHASE = 21;

struct Params {
  const float* in[35];
  float* out;
  u16 *wt_in, *wt_ff1, *wt_ff2, *wt_br, *wt_out, *wt_glu;
  u16 *hb, *pbuf, *obuf, *zs5;
  float* tbuf;
  unsigned* counters;
  unsigned* bar;
  float* ssq;
  u16* slocal;
  float* segdec;
  float* hlocal;
  int nseg, cps;
  size_t o_ret_p, o_ret_s, o_ssd_p, o_ssd_s, o_conv_p, o_conv_s, o_hg_p, o_hg_s, o_s5r_p, o_s5r_s, o_s5i_p, o_s5i_s;
};

DI int tidq() { int t = threadIdx.x; asm volatile("" : "+v"(t)); return t; }
typedef __bf16 bf16v2 __attribute__((ext_vector_type(2)));
typedef float f32v2 __attribute__((ext_vector_type(2)));
DI unsigned pack2(float a, float b) { f32v2 v = {a, b}; return __builtin_bit_cast(unsigned, __builtin_convertvector(v, bf16v2)); }
DI u16 f2bf(float f) { return (u16)(pack2(f, 0.f) & 0xffffu); }
DI float bf2f(u16 h) { return __uint_as_float(((unsigned)h) << 16); }
DI float sigmoidf_(float x) { return __builtin_amdgcn_rcpf(1.f + __expf(-x)); }
DI float siluf_(float x) { return x * __builtin_amdgcn_rcpf(1.f + __expf(-x)); }
DI float softplusf_(float x) { return x > 20.f ? x : log1pf(__expf(x)); }
DI float gelu_tanh(float x) {
  float u = 0.7978845608028654f * (x + 0.044715f * x * x * x);
  float e = __expf(2.f * u);
  float th = 1.f - 2.f * __builtin_amdgcn_rcpf(e + 1.f);
  return 0.5f * x * (1.f + th);
}
DI float wave_sum(float v) {
#pragma unroll
  for (int m = 32; m >= 1; m >>= 1) v += __shfl_xor(v, m);
  return v;
}
DI float sum16(float v) {
#pragma unroll
  for (int m = 8; m >= 1; m >>= 1) v += __shfl_xor(v, m);
  return v;
}
DI void sincos_red(float a, float& s, float& c) {
  float n = rintf(a * 0.15915494309189535f);
  float r = fmaf(-n, 6.28125f, a);
  r = fmaf(-n, 1.9353071795864769e-3f, r);
  s = __sinf(r); c = __cosf(r);
}

DI int map_win(int my) {
  if (my < 3584) return my;
  if (my < 6144) return my + 8;
  if (my < 6152) return my - 6144 + 3584;
  if (my < 6272) return -1;
  return my - 120;
}
DI void transpose_tile(const float* __restrict__ src, int src_ld, u16* __restrict__ dst, int dst_ld,
                       int k0, int n0, int mapmode, char* smem) {
  float* tile = (float*)smem;
  const int tid = tidq();
  {
    const int n = tid & 63;
    int sc = n0 + n;
    if (mapmode) sc = map_win(sc);
    const float* sp = src + (size_t)(k0 + (tid >> 6)) * src_ld + (sc >= 0 ? sc : 0);
    float v[32];
#pragma unroll
    for (int i = 0; i < 32; ++i) v[i] = sp[(size_t)(4 * i) * src_ld];
#pragma unroll
    for (int i = 0; i < 32; ++i) tile[n * 129 + (tid >> 6) + 4 * i] = (sc >= 0) ? v[i] : 0.f;
  }
  __syncthreads();
  {
    const int n = tid >> 2, kc = (tid & 3) * 32;
    unsigned pk[16];
#pragma unroll
    for (int x = 0; x < 16; ++x) pk[x] = pack2(tile[n * 129 + kc + 2 * x], tile[n * 129 + kc + 2 * x + 1]);
    uint4* d = (uint4*)(dst + (size_t)(n0 + n) * dst_ld + k0 + kc);
    d[0] = make_uint4(pk[0], pk[1], pk[2], pk[3]);
    d[1] = make_uint4(pk[4], pk[5], pk[6], pk[7]);
    d[2] = make_uint4(pk[8], pk[9], pk[10], pk[11]);
    d[3] = make_uint4(pk[12], pk[13], pk[14], pk[15]);
  }
  __syncthreads();
}

__device__ void phase_convert(const Params& p, char* smem) {
  constexpr int PER = 2736;
  for (int t = blockIdx.x; t < 2 * PER; t += gridDim.x) {
    int l = t / PER, r = t % PER;
    if (r < 1296) {
      int nt = r / 8, kt = r % 8;
      transpose_tile(p.in[12] + (size_t)l * DM * INC, INC, p.wt_in + (size_t)l * NIN * WLD1, WLD1, kt * 128, nt * 64, 1, smem);
    } else if (r < 1808) {
      r -= 1296; int nt = r / 8, kt = r % 8;
      transpose_tile(p.in[33] + (size_t)l * DM * DFF, DFF, p.wt_ff1 + (size_t)l * DFF * WLD1, WLD1, kt * 128, nt * 64, 0, smem);
    } else if (r < 2320) {
      r -= 1808; int nt = r / 32, kt = r % 32;
      transpose_tile(p.in[34] + (size_t)l * DFF * DM, DM, p.wt_ff2 + (size_t)l * DM * WLD4, WLD4, kt * 128, nt * 64, 0, smem);
    } else if (r < 2448) {
      r -= 2320; int nt = r / 8, kt = r % 8;
      transpose_tile(p.in[32] + (size_t)l * DM * DM, DM, p.wt_out + (size_t)l * DM * WLD1, WLD1, kt * 128, nt * 64, 0, smem);
    } else if (r < 2704) {
      r -= 2448; int b = r / 64; r %= 64; int nt = r / 4, kt = r % 4;
      transpose_tile(p.in[31] + (size_t)(l * 4 + b) * 512 * DM, DM, p.wt_br + (size_t)(l * 4 + b) * DM * WLD5, WLD5, kt * 128, nt * 64, 0, smem);
    } else {
      r -= 2704; int nt = r / 4, kt = r % 4;
      transpose_tile(p.in[30] + (size_t)l * 512 * 512, 512, p.wt_glu + (size_t)l * 512 * WLD5, WLD5, kt * 128, nt * 64, 0, smem);
    }
  }
}

__device__ void phase_rownorm(const Params& p, bool from_input, const float* __restrict__ t, const float* __restrict__ gpost,
                              const float* __restrict__ gpre, u16* __restrict__ hout) {
  const int lane = tidq() & 63, w = tidq() >> 6;
  float* xbuf = p.out;
  for (int row = blockIdx.x * 4 + w; row < MTOK; row += gridDim.x * 4) {
    const float* xin = from_input ? (row < MPR ? p.in[0] + (size_t)row * DM : p.in[1] + (size_t)(row - MPR) * DM)
                                  : xbuf + (size_t)row * DM;
    float4 x[4];
#pragma unroll
    for (int k = 0; k < 4; ++k) x[k] = *(const float4*)(xin + lane * 4 + 256 * k);
    if (t) {
      float4 tv[4];
      float ss = 0.f;
#pragma unroll
      for (int k = 0; k < 4; ++k) {
        if (gridDim.x == 512 && row >= MPR) {
          const float* pp = (const float*)p.obuf + (size_t)(row - MPR) * DM + lane * 4 + 256 * k;
          float4 a = *(const float4*)pp;
#pragma unroll
          for (int sl = 1; sl < 8; ++sl) {
            const float4 b = *(const float4*)(pp + (size_t)sl * 1024 * 1024);
            a.x += b.x; a.y += b.y; a.z += b.z; a.w += b.w;
          }
          tv[k] = a;
        } else {
          tv[k] = *(const float4*)(t + (size_t)row * DM + lane * 4 + 256 * k);
        }
        ss += tv[k].x * tv[k].x + tv[k].y * tv[k].y + tv[k].z * tv[k].z + tv[k].w * tv[k].w;
      }
      ss = wave_sum(ss);
      float r = rsqrtf(ss * (1.f / DM) + EPS);
#pragma unroll
      for (int k = 0; k < 4; ++k) {
        float4 g = *(const float4*)(gpost + lane * 4 + 256 * k);
        x[k].x += tv[k].x * r * g.x; x[k].y += tv[k].y * r * g.y; x[k].z += tv[k].z * r * g.z; x[k].w += tv[k].w * r * g.w;
      }
    }
#pragma unroll
    for (int k = 0; k < 4; ++k) *(float4*)(xbuf + (size_t)row * DM + lane * 4 + 256 * k) = x[k];
    if (hout) {
      float ss = 0.f;
#pragma unroll
      for (int k = 0; k < 4; ++k) ss += x[k].x * x[k].x + x[k].y * x[k].y + x[k].z * x[k].z + x[k].w * x[k].w;
      ss = wave_sum(ss);
      float r = rsqrtf(ss * (1.f / DM) + EPS);
#pragma unroll
      for (int k = 0; k < 4; ++k) {
        float4 g = *(const float4*)(gpre + lane * 4 + 256 * k);
        uint2 o;
        o.x = pack2(x[k].x * r * g.x, x[k].y * r * g.y);
        o.y = pack2(x[k].z * r * g.z, x[k].w * r * g.w);
        *(uint2*)(hout + (size_t)row * HLD + lane * 4 + 256 * k) = o;
      }
    }
  }
}

DI int swz(int r, int c) { return r * 128 + ((c ^ ((r >> 1) & 7)) << 4); }

#define GEMM_COMPUTE(AS_) do { const char* as_ = (AS_); const char* bs_ = as_ + 16384; \
  _Pragma("unroll") for (int s_ = 0; s_ < 2; ++s_) { \
    bf16x8 af_[4], bfr_[4]; \
    _Pragma("unroll") for (int i_ = 0; i_ < 4; ++i_) af_[i_] = *(const bf16x8*)(as_ + swz(wm * 64 + i_ * 16 + r16, s_ * 4 + quad)); \
    _Pragma("unroll") for (int j_ = 0; j_ < 4; ++j_) bfr_[j_] = *(const bf16x8*)(bs_ + swz(wn * 64 + j_ * 16 + r16, s_ * 4 + quad)); \
    _Pragma("unroll") for (int i_ = 0; i_ < 4; ++i_) \
      _Pragma("unroll") for (int j_ = 0; j_ < 4; ++j_) acc[i_][j_] = MFMA16(bfr_[j_], af_[i_], acc[i_][j_]); \
  } } while (0)

struct Stage { u32x4 a0, a1, a2, a3, b0, b1, b2, b3; };
DI void gload(Stage& s, const u16* ag, const u16* bg, int lda, int ldb, int kt) {
  s.a0 = *(const u32x4*)(ag + (size_t)0 * 32 * lda + kt * 64);
  s.a1 = *(const u32x4*)(ag + (size_t)1 * 32 * lda + kt * 64);
  s.a2 = *(const u32x4*)(ag + (size_t)2 * 32 * lda + kt * 64);
  s.a3 = *(const u32x4*)(ag + (size_t)3 * 32 * lda + kt * 64);
  s.b0 = *(const u32x4*)(bg + (size_t)0 * 32 * ldb + kt * 64);
  s.b1 = *(const u32x4*)(bg + (size_t)1 * 32 * ldb + kt * 64);
  s.b2 = *(const u32x4*)(bg + (size_t)2 * 32 * ldb + kt * 64);
  s.b3 = *(const u32x4*)(bg + (size_t)3 * 32 * ldb + kt * 64);
}
DI void lwrite(const Stage& s, char* d, int lr, int lc) {
  *(u32x4*)(d + swz(lr, lc)) = s.a0;
  *(u32x4*)(d + swz(lr + 32, lc)) = s.a1;
  *(u32x4*)(d + swz(lr + 64, lc)) = s.a2;
  *(u32x4*)(d + swz(lr + 96, lc)) = s.a3;
  *(u32x4*)(d + 16384 + swz(lr, lc)) = s.b0;
  *(u32x4*)(d + 16384 + swz(lr + 32, lc)) = s.b1;
  *(u32x4*)(d + 16384 + swz(lr + 64, lc)) = s.b2;
  *(u32x4*)(d + 16384 + swz(lr + 96, lc)) = s.b3;
}

template <bool DEEP>
DI void gemm_kloop(f32x4 (&acc)[4][4], const u16* __restrict__ A, int lda, const u16* __restrict__ Bt, int ldb,
                   int K, int m0, int n0, char* smem) {
  const int tid = tidq(), lane = tid & 63, w = tid >> 6, wm = w >> 1, wn = w & 1, r16 = lane & 15, quad = lane >> 4;
  const int lr = tid >> 3, lc = tid & 7;
  const u16* ag = A + (size_t)(m0 + lr) * lda + lc * 8;
  const u16* bg = Bt + (size_t)(n0 + lr) * ldb + lc * 8;
  const int nk = K >> 6;
  Stage s0;
  gload(s0, ag, bg, lda, ldb, 0);
  if (DEEP) {
    Stage s1;
    gload(s1, ag, bg, lda, ldb, 1);
    lwrite(s0, smem, lr, lc);
    __syncthreads();
    for (int kt = 0; kt < nk; kt += 2) {
      if (kt + 2 < nk) gload(s0, ag, bg, lda, ldb, kt + 2);
      GEMM_COMPUTE(smem);
      lwrite(s1, smem + 32768, lr, lc);
      __syncthreads();
      if (kt + 3 < nk) gload(s1, ag, bg, lda, ldb, kt + 3);
      GEMM_COMPUTE(smem + 32768);
      if (kt + 2 < nk) lwrite(s0, smem, lr, lc);
      __syncthreads();
    }
  } else {
    lwrite(s0, smem, lr, lc);
    __syncthreads();
    for (int kt = 0; kt < nk; ++kt) {
      const bool more = (kt + 1 < nk);
      if (more) gload(s0, ag, bg, lda, ldb, kt + 1);
      GEMM_COMPUTE(smem + (kt & 1) * 32768);
      if (more) lwrite(s0, smem + ((kt + 1) & 1) * 32768, lr, lc);
      __syncthreads();
    }
  }
}

DI void zero_acc(f32x4 (&acc)[4][4]) {
#pragma unroll
  for (int i = 0; i < 4; ++i)
#pragma unroll
    for (int j = 0; j < 4; ++j) acc[i][j] = f32x4{0.f, 0.f, 0.f, 0.f};
}

enum { EPI_BF16 = 0, EPI_SIG = 1, EPI_RELU2 = 2, EPI_F32 = 3, EPI_GLU = 4 };

template <int EPI>
DI void gemm_epilogue(f32x4 (&acc)[4][4], int m0, int n0, void* outp, int ldc, const u16* aux, int ldaux) {
  const int lane = tidq() & 63, w = tidq() >> 6, wm = w >> 1, wn = w & 1, r16 = lane & 15, quad = lane >> 4;
#pragma unroll
  for (int i = 0; i < 4; ++i) {
    const int m = m0 + wm * 64 + i * 16 + r16;
    if (EPI == EPI_F32) {
#pragma unroll
      for (int j = 0; j < 4; ++j) {
        const int n = n0 + wn * 64 + j * 16 + quad * 4;
        const f32x4 v = acc[i][j];
        *(float4*)((float*)outp + (size_t)m * ldc + n) = make_float4(v[0], v[1], v[2], v[3]);
        acc[i][j] = f32x4{0.f, 0.f, 0.f, 0.f};
      }
    } else {
      uint2 o[4];
#pragma unroll
      for (int j = 0; j < 4; ++j) {
        const int n = n0 + wn * 64 + j * 16 + quad * 4;
        f32x4 v = acc[i][j];
        if (EPI == EPI_SIG) {
#pragma unroll
          for (int x = 0; x < 4; ++x) v[x] = sigmoidf_(v[x]);
        } else if (EPI == EPI_RELU2) {
#pragma unroll
          for (int x = 0; x < 4; ++x) { float r = fmaxf(v[x], 0.f); v[x] = r * r; }
        } else if (EPI == EPI_GLU) {
          uint2 zz = *(const uint2*)(aux + (size_t)m * ldaux + n);
          v[0] = bf2f((u16)(zz.x & 0xffff)) * sigmoidf_(v[0]);
          v[1] = bf2f((u16)(zz.x >> 16)) * sigmoidf_(v[1]);
          v[2] = bf2f((u16)(zz.y & 0xffff)) * sigmoidf_(v[2]);
          v[3] = bf2f((u16)(zz.y >> 16)) * sigmoidf_(v[3]);
        }
        o[j].x = pack2(v[0], v[1]); o[j].y = pack2(v[2], v[3]);
        acc[i][j] = f32x4{0.f, 0.f, 0.f, 0.f};
      }
#pragma unroll
      for (int jp = 0; jp < 2; ++jp) {
        const bool odd = quad & 1;
        const uint2 mine = odd ? o[2 * jp + 1] : o[2 * jp];
        const uint2 send = odd ? o[2 * jp] : o[2 * jp + 1];
        uint2 recv;
        recv.x = __shfl_xor(send.x, 16); recv.y = __shfl_xor(send.y, 16);
        const int n = n0 + wn * 64 + (2 * jp + (odd ? 1 : 0)) * 16 + (quad & 2) * 4;
        const uint4 st = odd ? make_uint4(recv.x, recv.y, mine.x, mine.y) : make_uint4(mine.x, mine.y, recv.x, recv.y);
        *(uint4*)((u16*)outp + (size_t)m * ldc + n) = st;
      }
    }
  }
}

DI bool tile_at(int i, int T, int& t);
DI void tile_mn(int t, int nN, int& m0, int& n0);

template <int EPI>
DI void gemm_stream(const u16* __restrict__ A, int lda, const u16* __restrict__ Bt, int ldb, int K, int nN, int T,
                    void* outp, int ldc, const u16* aux, int ldaux, char* smem) {
  const int tid = tidq(), lane = tid & 63, w = tid >> 6, wm = w >> 1, wn = w & 1, r16 = lane & 15, quad = lane >> 4;
  const int lr = tid >> 3, lc = tid & 7;
  asm volatile("" : "+s"(lda), "+s"(ldb), "+s"(K));
  const int nk = K >> 6;
  int t, m0, n0, m1 = 0, n1 = 0;
  if (!tile_at(0, T, t)) return;
  tile_mn(t, nN, m0, n0);
  const size_t aoff = (size_t)lr * lda + lc * 8, boff = (size_t)lr * ldb + lc * 8;
  const u16* ag = A + (size_t)m0 * lda + aoff;
  const u16* bg = Bt + (size_t)n0 * ldb + boff;
  f32x4 acc[4][4];
  zero_acc(acc);
  Stage s0, s1;
  gload(s0, ag, bg, lda, ldb, 0);
  gload(s1, ag, bg, lda, ldb, 1);
  lwrite(s0, smem, lr, lc);
  __syncthreads();
  for (int i = 0;; ++i) {
    const bool has_next = tile_at(i + 1, T, t);
    if (has_next) tile_mn(t, nN, m1, n1);
    const u16* agn = A + (size_t)m1 * lda + aoff;
    const u16* bgn = Bt + (size_t)n1 * ldb + boff;
    for (int kt = 0; kt < nk; kt += 2) {
      if (kt + 2 < nk) gload(s0, ag, bg, lda, ldb, kt + 2);
      else if (has_next) gload(s0, agn, bgn, lda, ldb, 0);
      GEMM_COMPUTE(smem);
      lwrite(s1, smem + 32768, lr, lc);
      __syncthreads();
      if (kt + 2 < nk) gload(s1, ag, bg, lda, ldb, kt + 3);
      else if (has_next) gload(s1, agn, bgn, lda, ldb, 1);
      GEMM_COMPUTE(smem + 32768);
      if (kt + 2 < nk || has_next) lwrite(s0, smem, lr, lc);
      __syncthreads();
    }
    gemm_epilogue<EPI>(acc, m0, n0, outp, ldc, aux, ldaux);
    if (!has_next) break;
    m0 = m1; n0 = n1; ag = agn; bg = bgn;
  }
}

DI void gemm_stream_split(const u16* __restrict__ A, int lda, const u16* __restrict__ Bt, int ldb, int K,
                          float* outp, float* part, char* smem) {
  const int tid = tidq(), lane = tid & 63, w = tid >> 6, wm = w >> 1, wn = w & 1, r16 = lane & 15, quad = lane >> 4;
  const int lr = tid >> 3, lc = tid & 7;
  asm volatile("" : "+s"(lda), "+s"(ldb), "+s"(K));
  const int nk = K >> 6, nks = nk >> 3;
  const size_t aoff = (size_t)lr * lda + lc * 8, boff = (size_t)lr * ldb + lc * 8;
  const int slice = blockIdx.x & 7, tl = blockIdx.x >> 3;
  int t, m0, n0, m1 = 0, n1 = 0;
  tile_at(0, 1024, t);
  tile_mn(t, 8, m0, n0);
  const u16* ag = A + (size_t)m0 * lda + aoff;
  const u16* bg = Bt + (size_t)n0 * ldb + boff;
  int nku = nk;
  f32x4 acc[4][4];
  zero_acc(acc);
  Stage s0, s1;
  gload(s0, ag, bg, lda, ldb, 0);
  gload(s1, ag, bg, lda, ldb, 1);
  lwrite(s0, smem, lr, lc);
  __syncthreads();
  for (int u = 0; u < 3; ++u) {
    const bool has_next = (u < 2);
    int nkn = nk;
    const u16* agn = ag;
    const u16* bgn = bg;
    if (u == 0) {
      tile_at(1, 1024, t);
      tile_mn(t, 8, m1, n1);
      agn = A + (size_t)m1 * lda + aoff;
      bgn = Bt + (size_t)n1 * ldb + boff;
    } else if (u == 1) {
      m1 = MPR + (tl >> 3) * 128; n1 = (tl & 7) * 128;
      agn = A + (size_t)m1 * lda + aoff + (size_t)slice * nks * 64;
      bgn = Bt + (size_t)n1 * ldb + boff + (size_t)slice * nks * 64;
      nkn = nks;
    }
    for (int kt = 0; kt < nku; kt += 2) {
      if (kt + 2 < nku) gload(s0, ag, bg, lda, ldb, kt + 2);
      else if (has_next) gload(s0, agn, bgn, lda, ldb, 0);
      GEMM_COMPUTE(smem);
      lwrite(s1, smem + 32768, lr, lc);
      __syncthreads();
      if (kt + 2 < nku) gload(s1, ag, bg, lda, ldb, kt + 3);
      else if (has_next) gload(s1, agn, bgn, lda, ldb, 1);
      GEMM_COMPUTE(smem + 32768);
      if (kt + 2 < nku || has_next) lwrite(s0, smem, lr, lc);
      __syncthreads();
    }
    if (u < 2) gemm_epilogue<EPI_F32>(acc, m0, n0, outp, DM, nullptr, 0);
    else gemm_epilogue<EPI_F32>(acc, m0 - MPR, n0, part + (size_t)slice * 1024 * 1024, DM, nullptr, 0);
    m0 = m1; n0 = n1; ag = agn; bg = bgn; nku = nkn;
  }
}

DI void merge_tile(const Params& p, int l, int m0, int n0, char* smem) {
  f32x4 macc[4][4];
  zero_acc(macc);
  const int lane = tidq() & 63, w = tidq() >> 6, wm = w >> 1, wn = w & 1, r16 = lane & 15, quad = lane >> 4;
  const bool odd = quad & 1;
  const u16* gates = p.pbuf;
  for (int b = 0; b < 4; ++b) {
    f32x4 acc[4][4];
    zero_acc(acc);
    gemm_kloop<false>(acc, p.obuf + b * 512, OLD, p.wt_br + (size_t)(l * 4 + b) * DM * WLD5, WLD5, 512, m0, n0, smem);
#pragma unroll
    for (int i = 0; i < 4; ++i) {
      const int m = m0 + wm * 64 + i * 16 + r16;
#pragma unroll
      for (int jp = 0; jp < 2; ++jp) {
        const int n = n0 + wn * 64 + (2 * jp + (odd ? 1 : 0)) * 16 + (quad & 2) * 4;
        const uint4 g16 = *(const uint4*)(gates + (size_t)m * 4096 + b * 1024 + n);
        const uint2 lo = make_uint2(g16.x, g16.y), hi = make_uint2(g16.z, g16.w);
        const uint2 send = odd ? lo : hi;
        uint2 recv;
        recv.x = __shfl_xor(send.x, 16); recv.y = __shfl_xor(send.y, 16);
        const uint2 g0 = odd ? recv : lo;
        const uint2 g1 = odd ? hi : recv;
        macc[i][2 * jp][0] += bf2f((u16)(g0.x & 0xffff)) * acc[i][2 * jp][0];
        macc[i][2 * jp][1] += bf2f((u16)(g0.x >> 16)) * acc[i][2 * jp][1];
        macc[i][2 * jp][2] += bf2f((u16)(g0.y & 0xffff)) * acc[i][2 * jp][2];
        macc[i][2 * jp][3] += bf2f((u16)(g0.y >> 16)) * acc[i][2 * jp][3];
        macc[i][2 * jp + 1][0] += bf2f((u16)(g1.x & 0xffff)) * acc[i][2 * jp + 1][0];
        macc[i][2 * jp + 1][1] += bf2f((u16)(g1.x >> 16)) * acc[i][2 * jp + 1][1];
        macc[i][2 * jp + 1][2] += bf2f((u16)(g1.y & 0xffff)) * acc[i][2 * jp + 1][2];
        macc[i][2 * jp + 1][3] += bf2f((u16)(g1.y >> 16)) * acc[i][2 * jp + 1][3];
      }
    }
  }
#pragma unroll
  for (int i = 0; i < 4; ++i) {
    const int m = m0 + wm * 64 + i * 16 + r16;
    uint2 o[4];
#pragma unroll
    for (int j = 0; j < 4; ++j) { o[j].x = pack2(macc[i][j][0], macc[i][j][1]); o[j].y = pack2(macc[i][j][2], macc[i][j][3]); }
#pragma unroll
    for (int jp = 0; jp < 2; ++jp) {
      const uint2 mine = odd ? o[2 * jp + 1] : o[2 * jp];
      const uint2 send = odd ? o[2 * jp] : o[2 * jp + 1];
      uint2 recv;
      recv.x = __shfl_xor(send.x, 16); recv.y = __shfl_xor(send.y, 16);
      const int n = n0 + wn * 64 + (2 * jp + (odd ? 1 : 0)) * 16 + (quad & 2) * 4;
      const uint4 st = odd ? make_uint4(recv.x, recv.y, mine.x, mine.y) : make_uint4(mine.x, mine.y, recv.x, recv.y);
      *(uint4*)(p.hb + (size_t)m * HLD + n) = st;
    }
  }
}

constexpr int QS = 136;
constexpr int TS = 20;
constexpr int OFS = 260;

template <int MODE>
__device__ void run_chain(const Params& p, int l, int seq, int sub, int seg, int pass, char* smem) {
  constexpr int NE = 2;
  const int tid = tidq(), lane = tid & 63, w = tid >> 6, r16 = lane & 15, quad = lane >> 4;
  const bool prompt = seq < 8;
  const int bidx = prompt ? seq : seq - 8;
  const int NB = prompt ? 8 : 128;
  const int L = prompt ? 2048 : 8;
  const int row0 = prompt ? seq * 2048 : MPR + (seq - 8) * 8;
  const int pos0 = prompt ? 0 : 16384;
  int cps = p.cps;
  asm volatile("" : "+s"(cps));
  const int ch_begin = prompt ? seg * cps : 0;
  const int ch_end = prompt ? ch_begin + cps : 1;
  const bool light = prompt && (pass == 1) && (seg > 0);
  const bool store_local = prompt && (pass == 1);
  const bool last_seg = !prompt || (seg == p.nseg - 1);
  const int cid = seq * 12 + MODE * 4 + sub;

  u16* Qa = (u16*)smem;
  u16* Ka = (u16*)(smem + 4352);
  u16* KuT = (u16*)(smem + 8704);
  u16* VaT = (u16*)(smem + 13824);
  u16* VuT = (MODE == 1) ? (u16*)(smem + 18944) : VaT;
  float* Of = (float*)(smem + 24064);
  u16* Raw = (u16*)(smem + 40704);
  u16* Xc = (u16*)(smem + 53248);
  float* tot = (float*)(smem + 57344);
  float* cdec = (float*)(smem + 58368);
  float* dtl = (float*)(smem + 58624);
  float* rsc = (float*)(smem + 58880);
  float* clast = (float*)(smem + 59392);
  float* segacc = (float*)(smem + 59408);

  const float* sin_ = nullptr;
  float* sout = nullptr;
  if (MODE == 0) {
    if (!prompt) sin_ = p.in[2] + (((size_t)l * 128 + bidx) * 4 + sub) * 16384;
    sout = p.out + (prompt ? p.o_ret_p : p.o_ret_s) + (((size_t)l * NB + bidx) * 4 + sub) * 16384;
  } else if (MODE == 2) {
    if (!prompt) sin_ = p.in[5] + (((size_t)l * 128 + bidx) * 4 + sub) * 16384;
    sout = p.out + (prompt ? p.o_hg_p : p.o_hg_s) + (((size_t)l * NB + bidx) * 4 + sub) * 16384;
  } else {
    if (!prompt) sin_ = p.in[3] + (((size_t)l * 128 + bidx) * 8 + sub * 2 + (w >> 1)) * 8192;
    sout = p.out + (prompt ? p.o_ssd_p : p.o_ssd_s) + (((size_t)l * NB + bidx) * 8 + sub * 2 + (w >> 1)) * 8192;
  }

  float lg = 0.f;
  if (MODE == 0) lg = log1pf(-exp2f(-5.f - (float)sub));

  int sbase = (MODE == 1) ? (((w & 1) * 32 + r16) * 128 + quad * 4) : (quad * 512 + w * 32 + r16);
  asm volatile("" : "+v"(sbase));
  f32x4 S[8][NE];
#pragma unroll
  for (int t = 0; t < 8; ++t)
#pragma unroll
    for (int u = 0; u < NE; ++u) {
      if (sin_) {
        if (MODE == 1) {
          S[t][u] = *(const f32x4*)(sin_ + sbase + u * 2048 + t * 16);
        } else {
#pragma unroll
          for (int jj = 0; jj < 4; ++jj) S[t][u][jj] = sin_[sbase + t * 2048 + jj * 128 + u * 16];
        }
      } else {
        S[t][u] = f32x4{0.f, 0.f, 0.f, 0.f};
      }
    }
  if (prompt && pass == 2) {
    for (int r = 0; r < seg; ++r) {
      const uint2* sl = (const uint2*)(p.slocal + (size_t)(cid * (p.nseg - 1) + r) * 16384) + tid;
      const float* sd = p.segdec + (size_t)(cid * 7 + r) * 128;
      float dsc = 1.f;
      if (MODE == 0) dsc = __expf(lg * (float)(16 * cps));
      if (MODE == 1) dsc = __expf(sd[w >> 1]);
#pragma unroll
      for (int t = 0; t < 8; ++t) {
        f32x4 dv = f32x4{dsc, dsc, dsc, dsc};
        if (MODE == 2) {
          f32x4 lv = *(const f32x4*)(sd + t * 16 + quad * 4);
          dv = f32x4{__expf(lv[0]), __expf(lv[1]), __expf(lv[2]), __expf(lv[3])};
        }
#pragma unroll
        for (int u = 0; u < NE; ++u) {
          uint2 pk = sl[(t * NE + u) * 256];
          S[t][u][0] = S[t][u][0] * dv[0] + bf2f((u16)(pk.x & 0xffff));
          S[t][u][1] = S[t][u][1] * dv[1] + bf2f((u16)(pk.x >> 16));
          S[t][u][2] = S[t][u][2] * dv[2] + bf2f((u16)(pk.y & 0xffff));
          S[t][u][3] = S[t][u][3] * dv[3] + bf2f((u16)(pk.y >> 16));
        }
      }
    }
  }

  float lbv = 0.f;
  float hg_tot = 0.f;
  float cprev[2][3];
  float cw[2][4], cb[2];
  int ccidx[2];
  float dt_bias = 0.f, dt_A = 0.f;
  float rinv = 0.f, rcD = 1.f, rsD = 0.f;
  const int gg = sub >> 1, pair = sub & 1;
  if (MODE == 0) {
    rinv = exp2f(-(float)(tid & 63) * (13.287712379549449f / 64.f));
    rsD = __sinf(rinv); rcD = __cosf(rinv);
  }
  if (MODE == 2) {
    if (l == 1) {
      float a0 = p.in[20][sub * 128 + (tid & 127)], a1 = p.in[20][512 + sub * 128 + (tid & 127)];
      float mx = fmaxf(a0, a1);
      float e0 = __expf(a0 - mx), e1 = __expf(a1 - mx);
      lbv = e1 / (e0 + e1);
    }
  }
  if (MODE == 1) {
    if (tid < 32) {
      const int hh = sub * 2 + (tid >> 4);
      dt_A = -__expf(p.in[16][l * 8 + hh]);
      dt_bias = p.in[17][l * 8 + hh];
    }
    if (tid < 2) segacc[tid] = 0.f;
#pragma unroll
    for (int k = 0; k < 2; ++k) {
      int ci = tid + 256 * k;
      int cc = 0;
      if (ci < 128) cc = gg * 256 + pair * 128 + ci;
      else if (ci < 256) cc = 512 + gg * 128 + (ci - 128);
      else cc = 768 + gg * 128 + (ci - 256);
      if (ci >= 384) cc = 0;
      ccidx[k] = cc;
#pragma unroll
      for (int j = 0; j < 4; ++j) cw[k][j] = p.in[14][((size_t)l * 4 + j) * 1024 + cc];
      cb[k] = p.in[15][l * 1024 + cc];
#pragma unroll
      for (int j = 0; j < 3; ++j) {
        float v = 0.f;
        if (!prompt) v = p.in[4][(((size_t)l * 128 + bidx) * 3 + j) * 1024 + cc];
        else if (ch_begin > 0) v = bf2f(p.pbuf[(size_t)(row0 + ch_begin * 16 - 3 + j) * NP + C_SXBC + cc]);
        cprev[k][j] = v;
      }
    }
  }

  float fgain[8];
  {
    const int eg_ = tid & 15;
#pragma unroll
    for (int x = 0; x < 8; ++x) {
      if (MODE == 0) fgain[x] = p.in[13][(l * 4 + sub) * 128 + eg_ * 8 + x];
      else if (MODE == 2) fgain[x] = p.in[21][l * 128 + eg_ * 8 + x];
      else fgain[x] = p.in[18][l * 8 + sub * 2 + ((eg_ * 8) >> 6)];
    }
  }
  const int lt = tid >> 4, lc = tid & 15;
  uint4 r0, r1, r2, g0;
  unsigned rdt = 0;
  const uint4 z4 = make_uint4(0, 0, 0, 0);
  r0 = r1 = r2 = g0 = z4;
  auto load_raw = [&](int ch) {
    const int t0 = ch * 16;
    const int nv = (L - t0 < 16) ? (L - t0) : 16;
    const u16* Pr = p.pbuf + (size_t)(row0 + t0 + lt) * NP;
    r0 = r1 = r2 = g0 = z4;
    rdt = 0;
    if (lt < nv) {
      if (MODE == 0) {
        r0 = *(const uint4*)(Pr + C_RQ + sub * 128 + lc * 8);
        r1 = *(const uint4*)(Pr + C_RK + sub * 128 + lc * 8);
        r2 = *(const uint4*)(Pr + C_RV + sub * 128 + lc * 8);
        g0 = *(const uint4*)(Pr + C_RG + sub * 128 + lc * 8);
      } else if (MODE == 2) {
        r0 = *(const uint4*)(Pr + C_HQ + sub * 128 + lc * 8);
        r1 = *(const uint4*)(Pr + C_HF + sub * 128 + lc * 8);
        r2 = *(const uint4*)(Pr + C_HI + sub * 128 + lc * 8);
        g0 = *(const uint4*)(Pr + C_HG + sub * 128 + lc * 8);
      } else {
        r0 = *(const uint4*)(Pr + C_SXBC + gg * 256 + pair * 128 + lc * 8);
        r1 = *(const uint4*)(Pr + C_SXBC + 512 + gg * 128 + lc * 8);
        r2 = *(const uint4*)(Pr + C_SXBC + 768 + gg * 128 + lc * 8);
        g0 = *(const uint4*)(Pr + C_SZ + gg * 256 + pair * 128 + lc * 8);
        if (lc < 2) rdt = Pr[C_SDT + sub * 2 + lc];
      }
    }
  };
  load_raw(ch_begin);

  for (int ch = ch_begin; ch < ch_end; ++ch) {
    const int t0 = ch * 16;
    const int nvalid = (L - t0 < 16) ? (L - t0) : 16;
    float sscale = 1.f;
    int tidv = threadIdx.x;
    asm volatile("" : "+v"(tidv));
    const int tid = tidv, lane = tid & 63, w = tid >> 6, r16 = lane & 15, quad = lane >> 4, lt = tid >> 4, lc = tid & 15;

    *(uint4*)(Raw + lt * 128 + lc * 8) = r0;
    *(uint4*)(Raw + 2048 + lt * 128 + lc * 8) = r1;
    *(uint4*)(Raw + 4096 + lt * 128 + lc * 8) = r2;
    if (MODE == 1) { if (lc < 2) Raw[6144 + lt * 2 + lc] = (u16)rdt; }
    const uint4 gc0 = g0;
    __syncthreads();
    if (ch + 1 < ch_end) load_raw(ch + 1);

    if (MODE == 0) {
      const int which = tid >> 7, pr = tid & 63, th = (tid >> 6) & 1;
      if (which == 1 || !light) {
        const u16* R = Raw + which * 2048;
        float sn, cs;
        sincos_red((float)(pos0 + t0 + th * 8) * rinv, sn, cs);
#pragma unroll
        for (int x = 0; x < 8; ++x) {
          const int t = th * 8 + x;
          float x1 = bf2f(R[t * 128 + pr]);
          float x2 = bf2f(R[t * 128 + pr + 64]);
          float y1 = x1 * cs - x2 * sn, y2 = x1 * sn + x2 * cs;
          if (which) {
            y1 *= 0.08838834764831845f; y2 *= 0.08838834764831845f;
            Ka[t * QS + pr] = f2bf(y1); Ka[t * QS + pr + 64] = f2bf(y2);
            float kd = __expf(lg * (float)(nvalid - 1 - t));
            KuT[pr * TS + t] = f2bf(y1 * kd);
            KuT[(pr + 64) * TS + t] = f2bf(y2 * kd);
          } else {
            Qa[t * QS + pr] = f2bf(y1); Qa[t * QS + pr + 64] = f2bf(y2);
          }
          float ncs = cs * rcD - sn * rsD;
          sn = sn * rcD + cs * rsD; cs = ncs;
        }
      }
      if (tid < 16) cdec[tid] = lg * (float)(tid + 1);
      sscale = __expf(lg * (float)nvalid);
    } else if (MODE == 2) {
      const int d = tid & 127, th = tid >> 7;
      float cl[8], kk[8], qv[8];
      float c = 0.f;
#pragma unroll
      for (int x = 0; x < 8; ++x) {
        const int t = th * 8 + x;
        kk[x] = 0.f; qv[x] = 0.f;
        if (t < nvalid) {
          float z = bf2f(Raw[2048 + t * 128 + d]);
          float sg = sigmoidf_(z);
          float f = lbv + (1.f - lbv) * sg;
          c += __logf(f);
          kk[x] = (1.f - lbv) * (1.f - sg);
          if (!light) qv[x] = siluf_(bf2f(Raw[t * 128 + d]));
        }
        cl[x] = c;
      }
      tot[th * 128 + d] = c;
      __syncthreads();
      const float c_lo = tot[d];
      const float c_all = c_lo + tot[128 + d];
      const float off = th ? c_lo : 0.f;
      const float e_all = __expf(c_all);
#pragma unroll
      for (int x = 0; x < 8; ++x) {
        const int t = th * 8 + x;
        const float ct = off + cl[x];
        const float ein = __expf(-ct);
        if (!light) {
          Qa[t * QS + d] = f2bf(qv[x] * __frcp_rn(ein));
          Ka[t * QS + d] = f2bf(kk[x] * ein);
        }
        KuT[d * TS + t] = f2bf(kk[x] * ein * e_all);
      }
      if (th == 0) { rsc[d] = e_all; hg_tot += c_all; }
    } else {
      if (tid < 32) {
        const int hl = tid >> 4, t = tid & 15;
        float dtv = 0.f, c = 0.f;
        if (t < nvalid) {
          dtv = softplusf_(bf2f(Raw[6144 + t * 2 + hl]) + dt_bias);
          c = dtv * dt_A;
        }
#pragma unroll
        for (int o = 1; o < 16; o <<= 1) {
          float v = __shfl_up(c, o, 16);
          if (t >= o) c += v;
        }
        cdec[hl * 16 + t] = c;
        dtl[hl * 16 + t] = dtv;
        if (t == 15) { clast[hl] = c; segacc[hl] += c; }
      }
      __syncthreads();
#pragma unroll
      for (int k = 0; k < 2; ++k) {
        const int ci = tid + 256 * k;
        if (ci < 256 || (ci < 384 && !light)) {
          const int hl = (ci < 128) ? (ci >> 6) : 0;
          const float cl = clast[hl];
          const u16* R = Raw + ((ci < 128) ? ci : ((ci < 256) ? (2048 + (ci - 128)) : (4096 + (ci - 256))));
#pragma unroll 4
          for (int t = 0; t < 16; ++t) {
            float v = 0.f;
            if (t < nvalid) {
              float raw = bf2f(R[t * 128]);
              float o = cb[k] + cprev[k][0] * cw[k][0] + cprev[k][1] * cw[k][1] + cprev[k][2] * cw[k][2] + raw * cw[k][3];
              cprev[k][0] = cprev[k][1]; cprev[k][1] = cprev[k][2]; cprev[k][2] = raw;
              v = siluf_(o);
            }
            if (ci < 128) {
              float dtv = dtl[hl * 16 + t];
              if (!light) { Xc[t * 128 + ci] = f2bf(v); VaT[ci * TS + t] = f2bf(v * dtv); }
              VuT[ci * TS + t] = f2bf(v * dtv * __expf(cl - cdec[hl * 16 + t]));
            } else if (ci < 256) {
              u16 a = f2bf(v);
              if (!light) Ka[t * QS + (ci - 128)] = a;
              KuT[(ci - 128) * TS + t] = a;
            } else {
              Qa[t * QS + (ci - 256)] = f2bf(v);
            }
          }
        }
      }
    }
    if (MODE != 1) {
      const int e = tid & 127, th = tid >> 7;
#pragma unroll
      for (int x = 0; x < 4; ++x) {
        const int t = th * 8 + 2 * x;
        unsigned lo = Raw[4096 + t * 128 + e], hi = Raw[4096 + (t + 1) * 128 + e];
        *(unsigned*)(VaT + e * TS + t) = lo | (hi << 16);
      }
    }
    __syncthreads();

    {
      const float* cd = cdec + ((MODE == 1) ? (w >> 1) * 16 : 0);
      bf16x8 attA;
      float rr[4];
      bf16x8 qf[4];
      if (!light) {
        f32x4 at = f32x4{0.f, 0.f, 0.f, 0.f};
#pragma unroll
        for (int s = 0; s < 4; ++s) {
          bf16x8 a = *(const bf16x8*)(Ka + r16 * QS + s * 32 + quad * 8);
          bf16x8 b = *(const bf16x8*)(Qa + r16 * QS + s * 32 + quad * 8);
          at = MFMA16(a, b, at);
        }
        float ci_ = (MODE != 2) ? cd[r16] : 0.f;
        float vv[4];
#pragma unroll
        for (int jj = 0; jj < 4; ++jj) {
          int j = quad * 4 + jj;
          float v = at[jj];
          if (MODE != 2) v *= __expf(fminf(ci_ - cd[j], 0.f));
          vv[jj] = (j <= r16) ? v : 0.f;
        }
        unsigned a01 = pack2(vv[0], vv[1]), a23 = pack2(vv[2], vv[3]);
        attA = __builtin_bit_cast(bf16x8, (u32x4){a01, a23, 0u, 0u});
#pragma unroll
        for (int jj = 0; jj < 4; ++jj) rr[jj] = (MODE != 2) ? __expf(cd[quad * 4 + jj]) : 1.f;
#pragma unroll
        for (int s = 0; s < 4; ++s) {
          bf16x4 lo = *(const bf16x4*)(Qa + r16 * QS + s * 32 + quad * 4);
          bf16x4 hi = *(const bf16x4*)(Qa + r16 * QS + s * 32 + 16 + quad * 4);
          qf[s] = bf16x8{lo[0], lo[1], lo[2], lo[3], hi[0], hi[1], hi[2], hi[3]};
        }
      }
      if (!light) {
#pragma unroll
        for (int u = 0; u < NE; ++u) {
          const int e0 = (w * NE + u) * 16;
          bf16x4 v4 = *(const bf16x4*)(VaT + (e0 + r16) * TS + quad * 4);
          bf16x8 vb = bf16x8{v4[0], v4[1], v4[2], v4[3], 0, 0, 0, 0};
          f32x4 o1 = MFMA16(attA, vb, (f32x4{0.f, 0.f, 0.f, 0.f}));
          f32x4 o2 = f32x4{0.f, 0.f, 0.f, 0.f};
#pragma unroll
          for (int s = 0; s < 4; ++s) {
            u32x4 sp = {pack2(S[2 * s][u][0], S[2 * s][u][1]), pack2(S[2 * s][u][2], S[2 * s][u][3]),
                        pack2(S[2 * s + 1][u][0], S[2 * s + 1][u][1]), pack2(S[2 * s + 1][u][2], S[2 * s + 1][u][3])};
            o2 = MFMA16(qf[s], __builtin_bit_cast(bf16x8, sp), o2);
          }
#pragma unroll
          for (int jj = 0; jj < 4; ++jj) Of[(quad * 4 + jj) * OFS + e0 + r16] = o1[jj] + rr[jj] * o2[jj];
        }
      }
      float hs = 1.f;
      if (MODE == 0) hs = sscale;
      if (MODE == 1) hs = __expf(clast[w >> 1]);
#pragma unroll
      for (int u = 0; u < NE; ++u) {
        const int e0 = (w * NE + u) * 16;
        bf16x4 v4 = *(const bf16x4*)(VuT + (e0 + r16) * TS + quad * 4);
        bf16x8 vb = bf16x8{v4[0], v4[1], v4[2], v4[3], 0, 0, 0, 0};
#pragma unroll
        for (int t = 0; t < 8; ++t) {
          bf16x4 k4 = *(const bf16x4*)(KuT + (t * 16 + r16) * TS + quad * 4);
          bf16x8 ka = bf16x8{k4[0], k4[1], k4[2], k4[3], 0, 0, 0, 0};
          f32x4 sv = S[t][u];
          if (MODE == 2) {
            f32x4 r4 = *(const f32x4*)(rsc + t * 16 + quad * 4);
            sv[0] *= r4[0]; sv[1] *= r4[1]; sv[2] *= r4[2]; sv[3] *= r4[3];
          } else {
            sv[0] *= hs; sv[1] *= hs; sv[2] *= hs; sv[3] *= hs;
          }
          S[t][u] = MFMA16(ka, vb, sv);
        }
      }
    }
    __syncthreads();

    if (!light) {
      const int i = tid >> 4, eg = tid & 15;
      const int grow = row0 + t0 + i;
      unsigned gw[4] = {gc0.x, gc0.y, gc0.z, gc0.w};
      if (MODE == 0 || MODE == 2) {
        float o[8];
#pragma unroll
        for (int x = 0; x < 8; ++x) o[x] = Of[i * OFS + eg * 8 + x];
        float s1 = 0.f;
        float mu = 0.f;
        if (MODE == 0) {
#pragma unroll
          for (int x = 0; x < 8; ++x) s1 += o[x];
          mu = sum16(s1) * (1.f / 128.f);
        }
        float s2 = 0.f;
#pragma unroll
        for (int x = 0; x < 8; ++x) { o[x] -= mu; s2 += o[x] * o[x]; }
        float r = rsqrtf(sum16(s2) * (1.f / 128.f) + EPS);
        if (i < nvalid) {
          float res[8];
#pragma unroll
          for (int x = 0; x < 8; ++x) {
            float g = bf2f((u16)((x & 1) ? (gw[x >> 1] >> 16) : (gw[x >> 1] & 0xffff)));
            float gate = (MODE == 0) ? siluf_(g) : sigmoidf_(g);
            res[x] = o[x] * r * fgain[x] * gate;
          }
          uint4 ov = make_uint4(pack2(res[0], res[1]), pack2(res[2], res[3]), pack2(res[4], res[5]), pack2(res[6], res[7]));
          const int ocol = ((MODE == 0) ? 0 : 1024) + sub * 128 + eg * 8;
          *(uint4*)(p.obuf + (size_t)grow * OLD + ocol) = ov;
        }
      } else {
        float y[8];
        const int chb = eg * 8;
        const float Dh = fgain[0];
        float s2 = 0.f;
#pragma unroll
        for (int x = 0; x < 8; ++x) {
          float g = bf2f((u16)((x & 1) ? (gw[x >> 1] >> 16) : (gw[x >> 1] & 0xffff)));
          float v = Of[i * OFS + chb + x] + bf2f(Xc[i * 128 + chb + x]) * Dh;
          v *= siluf_(g);
          y[x] = v; s2 += v * v;
        }
        s2 = sum16(s2);
        if (i < nvalid) {
          if (eg == 0) p.ssq[(size_t)grow * 4 + sub] = s2;
          uint4 ov = make_uint4(pack2(y[0], y[1]), pack2(y[2], y[3]), pack2(y[4], y[5]), pack2(y[6], y[7]));
          *(uint4*)(p.obuf + (size_t)grow * OLD + 512 + sub * 128 + chb) = ov;
        }
      }
    }
  }
  __syncthreads();

  if (store_local) {
    uint2* sl = (uint2*)(p.slocal + (size_t)(cid * (p.nseg - 1) + seg) * 16384) + tid;
#pragma unroll
    for (int t = 0; t < 8; ++t)
#pragma unroll
      for (int u = 0; u < NE; ++u)
        sl[(t * NE + u) * 256] = make_uint2(pack2(S[t][u][0], S[t][u][1]), pack2(S[t][u][2], S[t][u][3]));
    float* sd = p.segdec + (size_t)(cid * 7 + seg) * 128;
    if (MODE == 1) { if (tid < 2) sd[tid] = segacc[tid]; }
    if (MODE == 2) { if (tid < 128) sd[tid] = hg_tot; }
  } else if (last_seg) {
    asm volatile("" : "+v"(sbase));
#pragma unroll
    for (int t = 0; t < 8; ++t)
#pragma unroll
      for (int u = 0; u < NE; ++u) {
        if (MODE == 1) {
          *(f32x4*)(sout + sbase + u * 2048 + t * 16) = S[t][u];
        } else {
#pragma unroll
          for (int jj = 0; jj < 4; ++jj) sout[sbase + t * 2048 + jj * 128 + u * 16] = S[t][u][jj];
        }
      }
    if (MODE == 1) {
      float* co = p.out + (prompt ? p.o_conv_p : p.o_conv_s) + ((size_t)l * NB + bidx) * 3 * 1024;
#pragma unroll
      for (int k = 0; k < 2; ++k) {
        const int ci = tid + 256 * k;
        if (ci < 128 || (ci < 384 && pair == 0)) {
#pragma unroll
          for (int j = 0; j < 3; ++j) co[j * 1024 + ccidx[k]] = cprev[k][j];
        }
      }
    }
  }
}

__device__ void run_s5(const Params& p, int l, int seq, int gq, int seg, int pass, char* smem) {
  const int tid = tidq(), lane = tid & 63, w = tid >> 6, r16 = lane & 15, quad = lane >> 4;
  const int g = gq * 4 + w;
  const bool prompt = seq < 8;
  const int bidx = prompt ? seq : seq - 8;
  const int NB = prompt ? 8 : 128;
  const int row0 = prompt ? seq * 2048 : MPR + (seq - 8) * 8;
  int cps_ = p.cps;
  asm volatile("" : "+s"(cps_));
  const int nch = prompt ? cps_ : 1;
  const int ch_begin = prompt ? seg * nch : 0;
  const int ch_end = ch_begin + nch;
  const int nvalid = prompt ? 16 : 8;
  const bool light = prompt && (pass == 1) && (seg > 0);
  const bool store_local = prompt && (pass == 1);
  const bool last_seg = !prompt || (seg == p.nseg - 1);
  char* wb = smem + w * 5120;
  u16* Hs = (u16*)wb;
  u16* Us = (u16*)(wb + 4352);
  const int lg_ = l * 32 + g;

  const float dt = __expf(p.in[29][lg_]);
  float Ar[4][4], Ai[4][4];
  float fre[4], fim[4];
  float dtare[4], thv[4];
#pragma unroll
  for (int i = 0; i < 4; ++i) {
    const int pi = i * 16 + r16;
    const float are = p.in[22][lg_ * 64 + pi], aim = p.in[23][lg_ * 64 + pi];
    const float th = dt * aim;
    float sn, cs; sincos_red(th, sn, cs);
    float shalf, chalf; sincos_red(0.5f * th, shalf, chalf);
    const float em1 = expm1f(dt * are);
    const float mag = em1 + 1.f;
    const float abr = mag * cs, abi = mag * sn;
    const float nre = em1 * cs - 2.f * shalf * shalf, nim = abi;
    const float den = are * are + aim * aim;
    fre[i] = (nre * are + nim * aim) / den; fim[i] = (nim * are - nre * aim) / den;
    dtare[i] = dt * are; thv[i] = th;
    Ar[0][i] = abr; Ai[0][i] = abi;
    Ar[1][i] = abr * abr - abi * abi; Ai[1][i] = 2.f * abr * abi;
    Ar[2][i] = Ar[1][i] * abr - Ai[1][i] * abi; Ai[2][i] = Ar[1][i] * abi + Ai[1][i] * abr;
    Ar[3][i] = Ar[1][i] * Ar[1][i] - Ai[1][i] * Ai[1][i]; Ai[3][i] = 2.f * Ar[1][i] * Ai[1][i];
  }
  bf16x8 Bop[8];
#pragma unroll
  for (int nt = 0; nt < 8; ++nt) {
    const int i = nt & 3;
    u32x4 pk = {0u, 0u, 0u, 0u};
    if (quad < 2) {
      const size_t bo = ((size_t)lg_ * 64 + i * 16 + r16) * 16 + quad * 8;
      const float4 br0 = *(const float4*)(p.in[24] + bo), br1 = *(const float4*)(p.in[24] + bo + 4);
      const float4 bi0 = *(const float4*)(p.in[25] + bo), bi1 = *(const float4*)(p.in[25] + bo + 4);
      const float brv[8] = {br0.x, br0.y, br0.z, br0.w, br1.x, br1.y, br1.z, br1.w};
      const float biv[8] = {bi0.x, bi0.y, bi0.z, bi0.w, bi1.x, bi1.y, bi1.z, bi1.w};
      float v[8];
#pragma unroll
      for (int j = 0; j < 8; ++j)
        v[j] = (nt < 4) ? (fre[i] * brv[j] - fim[i] * biv[j]) : (fre[i] * biv[j] + fim[i] * brv[j]);
      pk = u32x4{pack2(v[0], v[1]), pack2(v[2], v[3]), pack2(v[4], v[5]), pack2(v[6], v[7])};
    }
    Bop[nt] = __builtin_bit_cast(bf16x8, pk);
  }
  bf16x8 Cop[4];
  float Dm[4] = {0.f, 0.f, 0.f, 0.f};
  if (!light) {
#pragma unroll
    for (int s = 0; s < 4; ++s) {
      const int n0 = 32 * s + quad * 8;
      const float* src = ((n0 >= 64) ? p.in[27] : p.in[26]) + ((size_t)lg_ * 16 + r16) * 64 + (n0 & 63);
      const float sg = (n0 >= 64) ? -1.f : 1.f;
      const float4 c0 = *(const float4*)src, c1 = *(const float4*)(src + 4);
      Cop[s] = __builtin_bit_cast(bf16x8, (u32x4{pack2(sg * c0.x, sg * c0.y), pack2(sg * c0.z, sg * c0.w),
                                                 pack2(sg * c1.x, sg * c1.y), pack2(sg * c1.z, sg * c1.w)}));
    }
#pragma unroll
    for (int jj = 0; jj < 4; ++jj) Dm[jj] = p.in[28][lg_ * 16 + quad * 4 + jj];
  }
  float hr[4], hi[4];
#pragma unroll
  for (int i = 0; i < 4; ++i) { hr[i] = 0.f; hi[i] = 0.f; }
  if (!prompt) {
#pragma unroll
    for (int i = 0; i < 4; ++i) {
      hr[i] = p.in[6][((size_t)(l * 128 + bidx) * 32 + g) * 64 + i * 16 + r16];
      hi[i] = p.in[7][((size_t)(l * 128 + bidx) * 32 + g) * 64 + i * 16 + r16];
    }
  } else if (pass == 2 && seg > 0) {
    const float len = (float)(nch * 16);
#pragma unroll
    for (int i = 0; i < 4; ++i) {
      const float pm = __expf(len * dtare[i]);
      float ps, pc; sincos_red(len * thv[i], ps, pc);
      const float pr_ = pm * pc, pi_ = pm * ps;
      for (int r = 0; r < seg; ++r) {
        const float* hl = p.hlocal + ((size_t)((seq * 32 + g) * 7 + r)) * 128;
        const float lr_ = hl[i * 16 + r16], li_ = hl[64 + i * 16 + r16];
        const float nr = pr_ * hr[i] - pi_ * hi[i] + lr_;
        const float ni = pr_ * hi[i] + pi_ * hr[i] + li_;
        hr[i] = nr; hi[i] = ni;
      }
    }
  }
  const int ut = lane >> 1, uh = lane & 1;
  const u16* ubase = p.pbuf + (size_t)(row0 + ut) * NP + C_SU + g * 16 + uh * 8;
  const uint4 z4 = make_uint4(0, 0, 0, 0);
  uint4 nxt = z4;
  if (lane < 32 && ut < nvalid) nxt = *(const uint4*)(ubase + (size_t)ch_begin * 16 * NP);
  for (int ch = ch_begin; ch < ch_end; ++ch) {
    const uint4 cur = nxt;
    nxt = z4;
    if (ch + 1 < ch_end && lane < 32) nxt = *(const uint4*)(ubase + (size_t)(ch + 1) * 16 * NP);
    if (lane < 32) *(uint4*)(Us + ut * 16 + uh * 8) = cur;
    __syncthreads();
    bf16x8 Uop = bf16x8{0, 0, 0, 0, 0, 0, 0, 0};
    if (quad < 2) Uop = *(const bf16x8*)(Us + r16 * 16 + quad * 8);
    f32x4 bu[8];
#pragma unroll
    for (int nt = 0; nt < 8; ++nt) bu[nt] = MFMA16(Uop, Bop[nt], (f32x4{0.f, 0.f, 0.f, 0.f}));
    float Er[4], Ei[4];
#pragma unroll
    for (int i = 0; i < 4; ++i) {
      float xr = 0.f, xi = 0.f;
#pragma unroll
      for (int jj = 0; jj < 4; ++jj) {
        const float nr = Ar[0][i] * xr - Ai[0][i] * xi + bu[i][jj];
        const float ni = Ar[0][i] * xi + Ai[0][i] * xr + bu[4 + i][jj];
        xr = nr; xi = ni;
        bu[i][jj] = xr; bu[4 + i][jj] = xi;
      }
      Er[i] = xr; Ei[i] = xi;
    }
    float cr[4], ci[4];
#pragma unroll
    for (int i = 0; i < 4; ++i) { cr[i] = hr[i]; ci[i] = hi[i]; }
#pragma unroll
    for (int k = 0; k < 4; ++k) {
#pragma unroll
      for (int i = 0; i < 4; ++i) {
        const float er = __shfl(Er[i], r16 + 16 * k), ei = __shfl(Ei[i], r16 + 16 * k);
        const float nr = Ar[3][i] * hr[i] - Ai[3][i] * hi[i] + er;
        const float ni = Ar[3][i] * hi[i] + Ai[3][i] * hr[i] + ei;
        if (k * 4 < nvalid) { hr[i] = nr; hi[i] = ni; }
        if (k < quad) { cr[i] = nr; ci[i] = ni; }
      }
    }
    if (!light) {
#pragma unroll
      for (int i = 0; i < 4; ++i)
#pragma unroll
        for (int jj = 0; jj < 4; ++jj) {
          const float vr = bu[i][jj] + Ar[jj][i] * cr[i] - Ai[jj][i] * ci[i];
          const float vi = bu[4 + i][jj] + Ar[jj][i] * ci[i] + Ai[jj][i] * cr[i];
          Hs[(quad * 4 + jj) * 136 + i * 16 + r16] = f2bf(vr);
          Hs[(quad * 4 + jj) * 136 + 64 + i * 16 + r16] = f2bf(vi);
        }
      __syncthreads();
      f32x4 ya = f32x4{0.f, 0.f, 0.f, 0.f};
#pragma unroll
      for (int s = 0; s < 4; ++s) {
        const bf16x8 bh = *(const bf16x8*)(Hs + r16 * 136 + s * 32 + quad * 8);
        ya = MFMA16(Cop[s], bh, ya);
      }
      const uint2 uu = *(const uint2*)(Us + r16 * 16 + quad * 4);
      const float u0 = bf2f((u16)(uu.x & 0xffff)), u1 = bf2f((u16)(uu.x >> 16));
      const float u2 = bf2f((u16)(uu.y & 0xffff)), u3 = bf2f((u16)(uu.y >> 16));
      const float z0 = gelu_tanh(ya[0] + Dm[0] * u0), z1 = gelu_tanh(ya[1] + Dm[1] * u1);
      const float z2 = gelu_tanh(ya[2] + Dm[2] * u2), z3 = gelu_tanh(ya[3] + Dm[3] * u3);
      if (r16 < nvalid)
        *(uint2*)(p.zs5 + (size_t)(row0 + ch * 16 + r16) * ZLD + g * 16 + quad * 4) = make_uint2(pack2(z0, z1), pack2(z2, z3));
    }
    __syncthreads();
  }
  if (store_local) {
    if (quad == 0) {
      float* hl = p.hlocal + ((size_t)((seq * 32 + g) * 7 + seg)) * 128;
#pragma unroll
      for (int i = 0; i < 4; ++i) { hl[i * 16 + r16] = hr[i]; hl[64 + i * 16 + r16] = hi[i]; }
    }
  } else if (last_seg) {
    if (quad == 0) {
      float* o_r = p.out + (prompt ? p.o_s5r_p : p.o_s5r_s) + ((size_t)(l * NB + bidx) * 32 + g) * 64;
      float* o_i = p.out + (prompt ? p.o_s5i_p : p.o_s5i_s) + ((size_t)(l * NB + bidx) * 32 + g) * 64;
#pragma unroll
      for (int i = 0; i < 4; ++i) { o_r[i * 16 + r16] = hr[i]; o_i[i * 16 + r16] = hi[i]; }
    }
  }
}

__device__ void phase_mixers(const Params& p, int l, int pass, char* smem, int visit) {
  int* s_item = (int*)(smem + 65536);
  unsigned* cnt = p.counters + l * 64 + (pass - 1) * 32 + visit * 16;
  const int nseg = p.nseg;
  const int ns1 = nseg - 1;
  const int n_chain = 96 * ns1;
  const int n_s5 = 64 * ns1;
  const int n_items = n_chain + n_s5 + ((pass == 1) ? 128 * 20 : 0);
  for (;;) {
    if (tidq() == 0) *s_item = (int)atomicAdd(cnt, 1u);
    __syncthreads();
    const int item = *s_item;
    __syncthreads();
    if (item >= n_items) break;
    int mode, seq, sub, seg = 0;
    const int per = ns1;
    const int seg0 = (pass == 1) ? 0 : 1;
    if (item < n_chain) {
      const int c = item / per; seg = seg0 + item % per;
      const int kind = c >> 5, r = c & 31;
      seq = r >> 2; sub = r & 3;
      mode = (kind == 0) ? 1 : ((kind == 1) ? 2 : 0);
    } else if (item < n_chain + n_s5) {
      const int k = item - n_chain;
      const int c = k / per; seg = seg0 + k % per;
      mode = 3; seq = c >> 3; sub = c & 7;
    } else {
      int k = item - n_chain - n_s5; int b = k / 20; sub = k % 20; seq = 8 + b;
      if (sub < 4) mode = 1;
      else if (sub < 8) { mode = 0; sub -= 4; }
      else if (sub < 12) { mode = 2; sub -= 8; }
      else { mode = 3; sub -= 12; }
    }
    const int ps = (seq >= 8) ? 2 : pass;
    if (mode == 0) { if (EN(2) || ONLY == 20) run_chain<0>(p, l, seq, sub, seg, ps, smem); }
    else if (mode == 1) { if (EN(2) || ONLY == 21) run_chain<1>(p, l, seq, sub, seg, ps, smem); }
    else if (mode == 2) { if (EN(2) || ONLY == 22) run_chain<2>(p, l, seq, sub, seg, ps, smem); }
    else { if (EN(2) || ONLY == 23) run_s5(p, l, seq, sub, seg, ps, smem); }
    __syncthreads();
  }
}

DI bool tile_at(int i, int T, int& t) {
  const int bpx = gridDim.x >> 3;
  t = ((blockIdx.x & 7) + 8 * i) * bpx + (blockIdx.x >> 3);
  return t < T;
}
DI void tile_mn(int t, int nN, int& m0, int& n0) {
  const int per = 8 * nN;
  const int grp = t / per, r = t - grp * per;
  m0 = (grp * 8 + (r & 7)) * 128;
  n0 = (r >> 3) * 128;
}

__device__ void run_phase(const Params& p, int ph, char* smem, int visit) {
  constexpr int NMT = MTOK / 128;
  if (ph == 0) {
    if (EN(9)) phase_convert(p, smem);
    if (EN(0)) phase_rownorm(p, true, nullptr, nullptr, p.in[8], p.hb);
    return;
  }
  if (ph == NPHASE - 1) {
    if (EN(10)) phase_rownorm(p, false, p.tbuf, p.in[11] + 1 * DM, nullptr, nullptr);
    return;
  }
  const int l = (ph <= 9) ? 0 : 1, s0_ = (ph <= 9) ? ph : ph - 10;
  const int s = (s0_ <= 2) ? s0_ : s0_ - 1;
  switch (s) {
    case 0:
      if (!EN(0)) break;
      phase_rownorm(p, false, p.tbuf, p.in[11] + (l - 1) * DM, p.in[8] + l * DM, p.hb);
      break;
    case 1: if (EN(1)) {
      constexpr int NN = NP / 128;
      gemm_stream<EPI_BF16>(p.hb, HLD, p.wt_in + (size_t)l * NIN * WLD1, WLD1, DM, NN, NMT * NN, p.pbuf, NP, nullptr, 0, smem);
    } break;
    case 2: if (EN(2) || (ONLY >= 20 && ONLY <= 23)) phase_mixers(p, l, (s0_ == 2) ? 1 : 2, smem, visit); break;
    case 3: if (EN(3)) {
      constexpr int NG = 32, NGLU = 4;
      {
        const int lane = tidq() & 63, w = tidq() >> 6;
        for (int row = blockIdx.x * 4 + w; row < MTOK; row += gridDim.x * 4) {
          const float4 sq = *(const float4*)(p.ssq + (size_t)row * 4);
          const float ms = (lane < 32) ? (sq.x + sq.y) : (sq.z + sq.w);
          const float r = rsqrtf(ms * (1.f / 256.f) + EPS);
          u16* ptr = p.obuf + (size_t)row * OLD + 512 + lane * 8;
          uint4 v = *(const uint4*)ptr;
          const float* gn = p.in[19] + l * 512 + lane * 8;
          unsigned vw[4] = {v.x, v.y, v.z, v.w};
          unsigned ow[4];
#pragma unroll
          for (int x = 0; x < 4; ++x)
            ow[x] = pack2(bf2f((u16)(vw[x] & 0xffff)) * r * gn[2 * x], bf2f((u16)(vw[x] >> 16)) * r * gn[2 * x + 1]);
          *(uint4*)ptr = make_uint4(ow[0], ow[1], ow[2], ow[3]);
        }
      }
      gemm_stream<EPI_SIG>(p.hb, HLD, p.wt_in + ((size_t)l * NIN + NP) * WLD1, WLD1, DM, NG, NMT * NG, p.pbuf, 4096, nullptr, 0, smem);
      gemm_stream<EPI_GLU>(p.zs5, ZLD, p.wt_glu + (size_t)l * 512 * WLD5, WLD5, 512, NGLU, NMT * NGLU,
                           p.obuf + 1536, OLD, p.zs5, ZLD, smem);
    } break;
    case 4:
      if (EN(4)) {
        int t, m0, n0;
        for (int i = 0; tile_at(i, NMT * 8, t); ++i) { tile_mn(t, 8, m0, n0); merge_tile(p, l, m0, n0, smem); }
      }
      break;
    case 5:
      if (EN(5)) {
        if (gridDim.x == 512) gemm_stream_split(p.hb, HLD, p.wt_out + (size_t)l * DM * WLD1, WLD1, DM, p.tbuf, (float*)p.obuf, smem);
        else gemm_stream<EPI_F32>(p.hb, HLD, p.wt_out + (size_t)l * DM * WLD1, WLD1, DM, 8, NMT * 8, p.tbuf, DM, nullptr, 0, smem);
      }
      break;
    case 6:
      if (EN(6)) phase_rownorm(p, false, p.tbuf, p.in[9] + l * DM, p.in[10] + l * DM, p.hb);
      break;
    case 7:
      if (EN(7)) {
        gemm_stream<EPI_RELU2>(p.hb, HLD, p.wt_ff1 + (size_t)l * DFF * WLD1, WLD1, DM, 32, NMT * 32, p.pbuf, ULD, nullptr, 0, smem);
      }
      break;
    case 8:
      if (EN(8)) {
        if (gridDim.x == 512) gemm_stream_split(p.pbuf, ULD, p.wt_ff2 + (size_t)l * DM * WLD4, WLD4, DFF, p.tbuf, (float*)p.obuf, smem);
        else gemm_stream<EPI_F32>(p.pbuf, ULD, p.wt_ff2 + (size_t)l * DM * WLD4, WLD4, DFF, 8, NMT * 8, p.tbuf, DM, nullptr, 0, smem);
      }
      break;
  }
}

#ifndef DUP_S
#define DUP_S -1
#endif
#define XB_TMO      128
#define XB_XCNT(j)  (256  + 64 * (j))
#define XB_XSUB(j)  (1280 + 64 * (j))
#define XB_XGEN(j)  (2304 + 64 * (j))
#define XB_TOP      3328
#define XB_TOPGEN   3392
#define XCD_BAR_WORDS 3456
#define XB_SPIN_CAP (1u << 22)
#define LAS __attribute__((address_space(3)))
DI unsigned xb_ld(unsigned* p)              { return __hip_atomic_load(p, __ATOMIC_RELAXED, __HIP_MEMORY_SCOPE_AGENT); }
DI unsigned xb_add(unsigned* p, unsigned v) { return __hip_atomic_fetch_add(p, v, __ATOMIC_RELAXED, __HIP_MEMORY_SCOPE_AGENT); }
DI unsigned xb_xcc_id() { return (unsigned)__builtin_amdgcn_s_getreg((3 << 11) | 20) & 0xFu; }
#define XB_SPIN(cond, bar) do { unsigned _sp = 0; while (cond) { __builtin_amdgcn_s_sleep(1); \
    if ((++_sp & 255u) == 0u) { if (xb_ld(&(bar)[XB_TMO])) break; if (_sp > XB_SPIN_CAP) { atomicAdd(&(bar)[XB_TMO], 1u); break; } } } } while (0)
struct XcdBarrier { unsigned* bar; unsigned x; volatile LAS unsigned* st; };
DI XcdBarrier xcd_barrier_post(unsigned* bar, volatile LAS unsigned* st) {
  XcdBarrier b; b.bar = bar; b.x = xb_xcc_id(); b.st = st;
  if (threadIdx.x == 0) (void)xb_add(&bar[XB_XCNT(b.x)], 1u);
  return b;
}
DI void xcd_barrier_complete(unsigned* bar, unsigned x, unsigned& nloc, unsigned& nx) {
  const unsigned G = gridDim.x * gridDim.y * gridDim.z;
  unsigned sum, cnt, mine, sp = 0u;
  for (;;) {
    sum = 0u; cnt = 0u; mine = 0u;
#pragma unroll
    for (unsigned j = 0; j < 16; ++j) { const unsigned c = xb_ld(&bar[XB_XCNT(j)]); sum += c; cnt += (c > 0u) ? 1u : 0u; mine = (j == x) ? c : mine; }
    if (sum == G) break;
    __builtin_amdgcn_s_sleep(1);
    if ((++sp & 255u) == 0u) { if (xb_ld(&bar[XB_TMO])) break; if (sp > XB_SPIN_CAP) { atomicAdd(&bar[XB_TMO], 1u); break; } }
  }
  nloc = mine > 0u ? mine : 1u; nx = cnt > 0u ? cnt : 1u;
}
DI void xcd_barrier(const XcdBarrier& b) {
  asm volatile("s_waitcnt vmcnt(0)" ::: "memory");
  __syncthreads();
  if (threadIdx.x == 0) {
    unsigned* bar = b.bar;
    __builtin_amdgcn_s_waitcnt(0);
    unsigned nloc = b.st[0], nx = b.st[1];
    if (nloc == 0u) { xcd_barrier_complete(bar, b.x, nloc, nx); b.st[0] = nloc; b.st[1] = nx; }
    const unsigned old = xb_add(&bar[XB_XSUB(b.x)], 1u);
    const unsigned gen = old / nloc;
    if (old + 1u == (gen + 1u) * nloc) {
      __builtin_amdgcn_fence(__ATOMIC_RELEASE, "agent");
      asm volatile("s_waitcnt vmcnt(0)" ::: "memory");
      const unsigned og = xb_add(&bar[XB_TOP], 1u);
      const unsigned tg = og / nx;
      if (og + 1u == (tg + 1u) * nx) xb_add(&bar[XB_TOPGEN], 1u);
      else XB_SPIN(xb_ld(&bar[XB_TOPGEN]) == tg, bar);
      __builtin_amdgcn_fence(__ATOMIC_ACQUIRE, "agent");
      xb_add(&bar[XB_XGEN(b.x)], 1u);
      asm volatile("s_waitcnt vmcnt(0)" ::: "memory");
    } else {
      XB_SPIN(xb_ld(&bar[XB_XGEN(b.x)]) == gen, bar);
      __builtin_amdgcn_fence(__ATOMIC_ACQUIRE, "agent");
      asm volatile("s_waitcnt vmcnt(0)" ::: "memory");
    }
  }
  __syncthreads();
}

__global__ void __launch_bounds__(256, 2) mega_kernel(Params p, int ph_lo, int ph_hi) {
  __shared__ __attribute__((aligned(16))) char smem[65536 + 32];
  volatile LAS unsigned* st = (volatile LAS unsigned*)(&smem[65536 + 16]);
  if (threadIdx.x == 0) { st[0] = 0u; st[1] = 0u; }
  __syncthreads();
  const XcdBarrier xb = xcd_barrier_post(p.bar, st);
  for (int ph = ph_lo; ph < ph_hi; ++ph) {
    if (ph > ph_lo) xcd_barrier(xb);
    if (ph_hi < 0) cg::this_grid().sync();
    const int reps = (DUP_S >= 0 && ph == DUP_S) ? 2 : 1;
    for (int r = 0; r < reps; ++r) {
      if (r) xcd_barrier(xb);
#ifdef VAR_NOSTORE
      if (tidq() == 0) *(volatile int*)(smem + 65536 + 8) = r;
      __syncthreads();
#endif
      run_phase(p, ph, smem, r);
    }
  }
}

extern "C" void kernel_launch(void* const* d_in, const int* in_sizes, int n_in, void* d_out, int out_size,
                              void* d_ws, size_t ws_size, hipStream_t stream) {
  Params p{};
  for (int i = 0; i < 35; ++i) p.in[i] = (const float*)d_in[i];
  p.out = (float*)d_out;
  char* ws = (char*)d_ws;
  size_t off = 0;
  auto take = [&](size_t bytes) { char* r = ws + off; off += (bytes + 255) & ~(size_t)255; return r; };
  p.wt_in  = (u16*)take((size_t)2 * NIN * WLD1 * 2);
  p.wt_ff1 = (u16*)take((size_t)2 * DFF * WLD1 * 2);
  p.wt_ff2 = (u16*)take((size_t)2 * DM * WLD4 * 2);
  p.wt_br  = (u16*)take((size_t)2 * 4 * DM * WLD5 * 2);
  p.wt_out = (u16*)take((size_t)2 * DM * WLD1 * 2);
  p.wt_glu = (u16*)take((size_t)2 * 512 * WLD5 * 2);
  p.hb     = (u16*)take((size_t)MTOK * HLD * 2);
  p.pbuf   = (u16*)take((size_t)MTOK * NP * 2);
  p.obuf   = (u16*)take((size_t)MTOK * OLD * 2);
  p.zs5    = (u16*)take((size_t)MTOK * ZLD * 2);
  p.counters = (unsigned*)take(4096);
  p.bar = (unsigned*)take(16384);
  p.ssq = (float*)take((size_t)MTOK * 4 * 4);
  p.segdec = (float*)take((size_t)96 * 7 * 128 * 4);
  p.hlocal = (float*)take((size_t)8 * 32 * 7 * 128 * 4);
  p.nseg = 8;
  if (off + (size_t)96 * 7 * 32768 > ws_size) p.nseg = 4;
  p.cps = 128 / p.nseg;
  p.slocal = (u16*)take((size_t)96 * (p.nseg - 1) * 32768);
  p.tbuf = (float*)(p.pbuf + (size_t)MTOK * ULD);
  if (off > ws_size) { fprintf(stderr, "workspace too small: need %zu have %zu\n", off, ws_size); return; }
  size_t o = (size_t)MTOK * DM;
  p.o_ret_p = o;  o += (size_t)2 * 8 * 65536;
  p.o_ret_s = o;  o += (size_t)2 * 128 * 65536;
  p.o_ssd_p = o;  o += (size_t)2 * 8 * 65536;
  p.o_ssd_s = o;  o += (size_t)2 * 128 * 65536;
  p.o_conv_p = o; o += (size_t)2 * 8 * 3 * 1024;
  p.o_conv_s = o; o += (size_t)2 * 128 * 3 * 1024;
  p.o_hg_p = o;   o += (size_t)2 * 8 * 65536;
  p.o_hg_s = o;   o += (size_t)2 * 128 * 65536;
  p.o_s5r_p = o;  o += (size_t)2 * 8 * 2048;
  p.o_s5r_s = o;  o += (size_t)2 * 128 * 2048;
  p.o_s5i_p = o;  o += (size_t)2 * 8 * 2048;
  p.o_s5i_s = o;  o += (size_t)2 * 128 * 2048;

  static int grid_blocks = 0;
  if (!grid_blocks) {
    int dev = 0, cus = 0, per_cu = 0;
    hipGetDevice(&dev);
    hipDeviceGetAttribute(&cus, hipDeviceAttributeMultiprocessorCount, dev);
    hipOccupancyMaxActiveBlocksPerMultiprocessor(&per_cu, mega_kernel, 256, 0);
    if (per_cu > 2) per_cu = 2;
    if (per_cu < 1) per_cu = 1;
    grid_blocks = cus * per_cu;
  }
  hipMemsetAsync(p.counters, 0, 4096 + 16384, stream);
#if SINGLE_LAUNCH
  int lo = 0, hi = NPHASE;
  void* args[] = {&p, &lo, &hi};
  hipError_t e = hipLaunchCooperativeKernel((void*)mega_kernel, dim3(grid_blocks), dim3(256), args, 0, stream);
  if (e != hipSuccess) fprintf(stderr, "cooperative launch failed: %s (grid %d)\n", hipGetErrorString(e), grid_blocks);
#else
  for (int ph = 0; ph < NPHASE; ++ph)
    hipLaunchKernelGGL(mega_kernel, dim3(grid_blocks), dim3(256), 0, stream, p, ph, ph + 1);
#endif
}
```

```cpp
#include <hip/hip_runtime.h>
#include <hip/hip_cooperative_groups.h>
#include <cstdio>
#include <cstdint>
namespace cg = cooperative_groups;

#ifndef SINGLE_LAUNCH
#define SINGLE_LAUNCH 1
#endif
#ifndef ONLY
#define ONLY -1
#endif
#define EN(k) (ONLY < 0 || ONLY == (k))

typedef unsigned short u16;
using bf16x8 = __attribute__((ext_vector_type(8))) short;
using bf16x4 = __attribute__((ext_vector_type(4))) short;
using f32x4  = __attribute__((ext_vector_type(4))) float;
typedef unsigned u32x4 __attribute__((ext_vector_type(4)));
#define DI __device__ __forceinline__
#define MFMA16(a, b, c) __builtin_amdgcn_mfma_f32_16x16x32_bf16((a), (b), (c), 0, 0, 0)

constexpr int MTOK = 17408;
constexpr int MPR  = 16384;
constexpr int DM   = 1024;
constexpr int NP   = 6272;
constexpr int NIN  = 10368;
constexpr int DFF  = 4096;
constexpr int INC  = 10248;
constexpr int C_RQ = 0, C_RK = 512, C_RV = 1024, C_RG = 1536, C_SZ = 2048, C_SXBC = 2560;
constexpr int C_HQ = 3584, C_HF = 4096, C_HI = 4608, C_HG = 5120, C_SU = 5632, C_SDT = 6144;
constexpr float EPS = 1e-6f;
constexpr int HLD = 1024, WLD1 = 1024, ULD = 4096, WLD4 = 4096, OLD = 2048, ZLD = 512, WLD5 = 512;
constexpr int NITEMS = 160 + 128 * 20;
constexpr int NPHASE = 21;

struct Params {
  const float* in[35];
  float* out;
  u16 *wt_in, *wt_ff1, *wt_ff2, *wt_br, *wt_out, *wt_glu;
  u16 *hb, *pbuf, *obuf, *zs5;
  float* tbuf;
  unsigned* counters;
  unsigned* bar;
  float* ssq;
  u16* slocal;
  float* segdec;
  float* hlocal;
  int nseg, cps;
  size_t o_ret_p, o_ret_s, o_ssd_p, o_ssd_s, o_conv_p, o_conv_s, o_hg_p, o_hg_s, o_s5r_p, o_s5r_s, o_s5i_p, o_s5i_s;
};

DI int tidq() { int t = threadIdx.x; asm volatile("" : "+v"(t)); return t; }
typedef __bf16 bf16v2 __attribute__((ext_vector_type(2)));
typedef float f32v2 __attribute__((ext_vector_type(2)));
DI unsigned pack2(float a, float b) { f32v2 v = {a, b}; return __builtin_bit_cast(unsigned, __builtin_convertvector(v, bf16v2)); }
DI u16 f2bf(float f) { return (u16)(pack2(f, 0.f) & 0xffffu); }
DI float bf2f(u16 h) { return __uint_as_float(((unsigned)h) << 16); }
DI float sigmoidf_(float x) { return __builtin_amdgcn_rcpf(1.f + __expf(-x)); }
DI float siluf_(float x) { return x * __builtin_amdgcn_rcpf(1.f + __expf(-x)); }
DI float softplusf_(float x) { return x > 20.f ? x : log1pf(__expf(x)); }
DI float gelu_tanh(float x) {
  float u = 0.7978845608028654f * (x + 0.044715f * x * x * x);
  float e = __expf(2.f * u);
  float th = 1.f - 2.f * __builtin_amdgcn_rcpf(e + 1.f);
  return 0.5f * x * (1.f + th);
}
DI float wave_sum(float v) {
#pragma unroll
  for (int m = 32; m >= 1; m >>= 1) v += __shfl_xor(v, m);
  return v;
}
DI float sum16(float v) {
#pragma unroll
  for (int m = 8; m >= 1; m >>= 1) v += __shfl_xor(v, m);
  return v;
}
DI void sincos_red(float a, float& s, float& c) {
  float n = rintf(a * 0.15915494309189535f);
  float r = fmaf(-n, 6.28125f, a);
  r = fmaf(-n, 1.9353071795864769e-3f, r);
  s = __sinf(r); c = __cosf(r);
}

DI int map_win(int my) {
  if (my < 3584) return my;
  if (my < 6144) return my + 8;
  if (my < 6152) return my - 6144 + 3584;
  if (my < 6272) return -1;
  return my - 120;
}
DI void transpose_tile(const float* __restrict__ src, int src_ld, u16* __restrict__ dst, int dst_ld,
                       int k0, int n0, int mapmode, char* smem) {
  float* tile = (float*)smem;
  const int tid = tidq();
  {
    const int n = tid & 63;
    int sc = n0 + n;
    if (mapmode) sc = map_win(sc);
    const float* sp = src + (size_t)(k0 + (tid >> 6)) * src_ld + (sc >= 0 ? sc : 0);
    float v[32];
#pragma unroll
    for (int i = 0; i < 32; ++i) v[i] = sp[(size_t)(4 * i) * src_ld];
#pragma unroll
    for (int i = 0; i < 32; ++i) tile[n * 129 + (tid >> 6) + 4 * i] = (sc >= 0) ? v[i] : 0.f;
  }
  __syncthreads();
  {
    const int n = tid >> 2, kc = (tid & 3) * 32;
    unsigned pk[16];
#pragma unroll
    for (int x = 0; x < 16; ++x) pk[x] = pack2(tile[n * 129 + kc + 2 * x], tile[n * 129 + kc + 2 * x + 1]);
    uint4* d = (uint4*)(dst + (size_t)(n0 + n) * dst_ld + k0 + kc);
    d[0] = make_uint4(pk[0], pk[1], pk[2], pk[3]);
    d[1] = make_uint4(pk[4], pk[5], pk[6], pk[7]);
    d[2] = make_uint4(pk[8], pk[9], pk[10], pk[11]);
    d[3] = make_uint4(pk[12], pk[13], pk[14], pk[15]);
  }
  __syncthreads();
}

__device__ void phase_convert(const Params& p, char* smem) {
  constexpr int PER = 2736;
  for (int t = blockIdx.x; t < 2 * PER; t += gridDim.x) {
    int l = t / PER, r = t % PER;
    if (r < 1296) {
      int nt = r / 8, kt = r % 8;
      transpose_tile(p.in[12] + (size_t)l * DM * INC, INC, p.wt_in + (size_t)l * NIN * WLD1, WLD1, kt * 128, nt * 64, 1, smem);
    } else if (r < 1808) {
      r -= 1296; int nt = r / 8, kt = r % 8;
      transpose_tile(p.in[33] + (size_t)l * DM * DFF, DFF, p.wt_ff1 + (size_t)l * DFF * WLD1, WLD1, kt * 128, nt * 64, 0, smem);
    } else if (r < 2320) {
      r -= 1808; int nt = r / 32, kt = r % 32;
      transpose_tile(p.in[34] + (size_t)l * DFF * DM, DM, p.wt_ff2 + (size_t)l * DM * WLD4, WLD4, kt * 128, nt * 64, 0, smem);
    } else if (r < 2448) {
      r -= 2320; int nt = r / 8, kt = r % 8;
      transpose_tile(p.in[32] + (size_t)l * DM * DM, DM, p.wt_out + (size_t)l * DM * WLD1, WLD1, kt * 128, nt * 64, 0, smem);
    } else if (r < 2704) {
      r -= 2448; int b = r / 64; r %= 64; int nt = r / 4, kt = r % 4;
      transpose_tile(p.in[31] + (size_t)(l * 4 + b) * 512 * DM, DM, p.wt_br + (size_t)(l * 4 + b) * DM * WLD5, WLD5, kt * 128, nt * 64, 0, smem);
    } else {
      r -= 2704; int nt = r / 4, kt = r % 4;
      transpose_tile(p.in[30] + (size_t)l * 512 * 512, 512, p.wt_glu + (size_t)l * 512 * WLD5, WLD5, kt * 128, nt * 64, 0, smem);
    }
  }
}

__device__ void phase_rownorm(const Params& p, bool from_input, const float* __restrict__ t, const float* __restrict__ gpost,
                              const float* __restrict__ gpre, u16* __restrict__ hout) {
  const int lane = tidq() & 63, w = tidq() >> 6;
  float* xbuf = p.out;
  for (int row = blockIdx.x * 4 + w; row < MTOK; row += gridDim.x * 4) {
    const float* xin = from_input ? (row < MPR ? p.in[0] + (size_t)row * DM : p.in[1] + (size_t)(row - MPR) * DM)
                                  : xbuf + (size_t)row * DM;
    float4 x[4];
#pragma unroll
    for (int k = 0; k < 4; ++k) x[k] = *(const float4*)(xin + lane * 4 + 256 * k);
    if (t) {
      float4 tv[4];
      float ss = 0.f;
#pragma unroll
      for (int k = 0; k < 4; ++k) {
        if (gridDim.x == 512 && row >= MPR) {
          const float* pp = (const float*)p.obuf + (size_t)(row - MPR) * DM + lane * 4 + 256 * k;
          float4 a = *(const float4*)pp;
#pragma unroll
          for (int sl = 1; sl < 8; ++sl) {
            const float4 b = *(const float4*)(pp + (size_t)sl * 1024 * 1024);
            a.x += b.x; a.y += b.y; a.z += b.z; a.w += b.w;
          }
          tv[k] = a;
        } else {
          tv[k] = *(const float4*)(t + (size_t)row * DM + lane * 4 + 256 * k);
        }
        ss += tv[k].x * tv[k].x + tv[k].y * tv[k].y + tv[k].z * tv[k].z + tv[k].w * tv[k].w;
      }
      ss = wave_sum(ss);
      float r = rsqrtf(ss * (1.f / DM) + EPS);
#pragma unroll
      for (int k = 0; k < 4; ++k) {
        float4 g = *(const float4*)(gpost + lane * 4 + 256 * k);
        x[k].x += tv[k].x * r * g.x; x[k].y += tv[k].y * r * g.y; x[k].z += tv[k].z * r * g.z; x[k].w += tv[k].w * r * g.w;
      }
    }
#pragma unroll
    for (int k = 0; k < 4; ++k) *(float4*)(xbuf + (size_t)row * DM + lane * 4 + 256 * k) = x[k];
    if (hout) {
      float ss = 0.f;
#pragma unroll
      for (int k = 0; k < 4; ++k) ss += x[k].x * x[k].x + x[k].y * x[k].y + x[k].z * x[k].z + x[k].w * x[k].w;
      ss = wave_sum(ss);
      float r = rsqrtf(ss * (1.f / DM) + EPS);
#pragma unroll
      for (int k = 0; k < 4; ++k) {
        float4 g = *(const float4*)(gpre + lane * 4 + 256 * k);
        uint2 o;
        o.x = pack2(x[k].x * r * g.x, x[k].y * r * g.y);
        o.y = pack2(x[k].z * r * g.z, x[k].w * r * g.w);
        *(uint2*)(hout + (size_t)row * HLD + lane * 4 + 256 * k) = o;
      }
    }
  }
}

DI int swz(int r, int c) { return r * 128 + ((c ^ ((r >> 1) & 7)) << 4); }

#define GEMM_COMPUTE(AS_) do { const char* as_ = (AS_); const char* bs_ = as_ + 16384; \
  _Pragma("unroll") for (int s_ = 0; s_ < 2; ++s_) { \
    bf16x8 af_[4], bfr_[4]; \
    _Pragma("unroll") for (int i_ = 0; i_ < 4; ++i_) af_[i_] = *(const bf16x8*)(as_ + swz(wm * 64 + i_ * 16 + r16, s_ * 4 + quad)); \
    _Pragma("unroll") for (int j_ = 0; j_ < 4; ++j_) bfr_[j_] = *(const bf16x8*)(bs_ + swz(wn * 64 + j_ * 16 + r16, s_ * 4 + quad)); \
    _Pragma("unroll") for (int i_ = 0; i_ < 4; ++i_) \
      _Pragma("unroll") for (int j_ = 0; j_ < 4; ++j_) acc[i_][j_] = MFMA16(bfr_[j_], af_[i_], acc[i_][j_]); \
  } } while (0)

struct Stage { u32x4 a0, a1, a2, a3, b0, b1, b2, b3; };
DI void gload(Stage& s, const u16* ag, const u16* bg, int lda, int ldb, int kt) {
  s.a0 = *(const u32x4*)(ag + (size_t)0 * 32 * lda + kt * 64);
  s.a1 = *(const u32x4*)(ag + (size_t)1 * 32 * lda + kt * 64);
  s.a2 = *(const u32x4*)(ag + (size_t)2 * 32 * lda + kt * 64);
  s.a3 = *(const u32x4*)(ag + (size_t)3 * 32 * lda + kt * 64);
  s.b0 = *(const u32x4*)(bg + (size_t)0 * 32 * ldb + kt * 64);
  s.b1 = *(const u32x4*)(bg + (size_t)1 * 32 * ldb + kt * 64);
  s.b2 = *(const u32x4*)(bg + (size_t)2 * 32 * ldb + kt * 64);
  s.b3 = *(const u32x4*)(bg + (size_t)3 * 32 * ldb + kt * 64);
}
DI void lwrite(const Stage& s, char* d, int lr, int lc) {
  *(u32x4*)(d + swz(lr, lc)) = s.a0;
  *(u32x4*)(d + swz(lr + 32, lc)) = s.a1;
  *(u32x4*)(d + swz(lr + 64, lc)) = s.a2;
  *(u32x4*)(d + swz(lr + 96, lc)) = s.a3;
  *(u32x4*)(d + 16384 + swz(lr, lc)) = s.b0;
  *(u32x4*)(d + 16384 + swz(lr + 32, lc)) = s.b1;
  *(u32x4*)(d + 16384 + swz(lr + 64, lc)) = s.b2;
  *(u32x4*)(d + 16384 + swz(lr + 96, lc)) = s.b3;
}

template <bool DEEP>
DI void gemm_kloop(f32x4 (&acc)[4][4], const u16* __restrict__ A, int lda, const u16* __restrict__ Bt, int ldb,
                   int K, int m0, int n0, char* smem) {
  const int tid = tidq(), lane = tid & 63, w = tid >> 6, wm = w >> 1, wn = w & 1, r16 = lane & 15, quad = lane >> 4;
  const int lr = tid >> 3, lc = tid & 7;
  const u16* ag = A + (size_t)(m0 + lr) * lda + lc * 8;
  const u16* bg = Bt + (size_t)(n0 + lr) * ldb + lc * 8;
  const int nk = K >> 6;
  Stage s0;
  gload(s0, ag, bg, lda, ldb, 0);
  if (DEEP) {
    Stage s1;
    gload(s1, ag, bg, lda, ldb, 1);
    lwrite(s0, smem, lr, lc);
    __syncthreads();
    for (int kt = 0; kt < nk; kt += 2) {
      if (kt + 2 < nk) gload(s0, ag, bg, lda, ldb, kt + 2);
      GEMM_COMPUTE(smem);
      lwrite(s1, smem + 32768, lr, lc);
      __syncthreads();
      if (kt + 3 < nk) gload(s1, ag, bg, lda, ldb, kt + 3);
      GEMM_COMPUTE(smem + 32768);
      if (kt + 2 < nk) lwrite(s0, smem, lr, lc);
      __syncthreads();
    }
  } else {
    lwrite(s0, smem, lr, lc);
    __syncthreads();
    for (int kt = 0; kt < nk; ++kt) {
      const bool more = (kt + 1 < nk);
      if (more) gload(s0, ag, bg, lda, ldb, kt + 1);
      GEMM_COMPUTE(smem + (kt & 1) * 32768);
      if (more) lwrite(s0, smem + ((kt + 1) & 1) * 32768, lr, lc);
      __syncthreads();
    }
  }
}

DI void zero_acc(f32x4 (&acc)[4][4]) {
#pragma unroll
  for (int i = 0; i < 4; ++i)
#pragma unroll
    for (int j = 0; j < 4; ++j) acc[i][j] = f32x4{0.f, 0.f, 0.f, 0.f};
}

enum { EPI_BF16 = 0, EPI_SIG = 1, EPI_RELU2 = 2, EPI_F32 = 3, EPI_GLU = 4 };

template <int EPI>
DI void gemm_epilogue(f32x4 (&acc)[4][4], int m0, int n0, void* outp, int ldc, const u16* aux, int ldaux) {
  const int lane = tidq() & 63, w = tidq() >> 6, wm = w >> 1, wn = w & 1, r16 = lane & 15, quad = lane >> 4;
#pragma unroll
  for (int i = 0; i < 4; ++i) {
    const int m = m0 + wm * 64 + i * 16 + r16;
    if (EPI == EPI_F32) {
#pragma unroll
      for (int j = 0; j < 4; ++j) {
        const int n = n0 + wn * 64 + j * 16 + quad * 4;
        const f32x4 v = acc[i][j];
        *(float4*)((float*)outp + (size_t)m * ldc + n) = make_float4(v[0], v[1], v[2], v[3]);
        acc[i][j] = f32x4{0.f, 0.f, 0.f, 0.f};
      }
    } else {
      uint2 o[4];
#pragma unroll
      for (int j = 0; j < 4; ++j) {
        const int n = n0 + wn * 64 + j * 16 + quad * 4;
        f32x4 v = acc[i][j];
        if (EPI == EPI_SIG) {
#pragma unroll
          for (int x = 0; x < 4; ++x) v[x] = sigmoidf_(v[x]);
        } else if (EPI == EPI_RELU2) {
#pragma unroll
          for (int x = 0; x < 4; ++x) { float r = fmaxf(v[x], 0.f); v[x] = r * r; }
        } else if (EPI == EPI_GLU) {
          uint2 zz = *(const uint2*)(aux + (size_t)m * ldaux + n);
          v[0] = bf2f((u16)(zz.x & 0xffff)) * sigmoidf_(v[0]);
          v[1] = bf2f((u16)(zz.x >> 16)) * sigmoidf_(v[1]);
          v[2] = bf2f((u16)(zz.y & 0xffff)) * sigmoidf_(v[2]);
          v[3] = bf2f((u16)(zz.y >> 16)) * sigmoidf_(v[3]);
        }
        o[j].x = pack2(v[0], v[1]); o[j].y = pack2(v[2], v[3]);
        acc[i][j] = f32x4{0.f, 0.f, 0.f, 0.f};
      }
#pragma unroll
      for (int jp = 0; jp < 2; ++jp) {
        const bool odd = quad & 1;
        const uint2 mine = odd ? o[2 * jp + 1] : o[2 * jp];
        const uint2 send = odd ? o[2 * jp] : o[2 * jp + 1];
        uint2 recv;
        recv.x = __shfl_xor(send.x, 16); recv.y = __shfl_xor(send.y, 16);
        const int n = n0 + wn * 64 + (2 * jp + (odd ? 1 : 0)) * 16 + (quad & 2) * 4;
        const uint4 st = odd ? make_uint4(recv.x, recv.y, mine.x, mine.y) : make_uint4(mine.x, mine.y, recv.x, recv.y);
        *(uint4*)((u16*)outp + (size_t)m * ldc + n) = st;
      }
    }
  }
}

DI bool tile_at(int i, int T, int& t);
DI void tile_mn(int t, int nN, int& m0, int& n0);

template <int EPI>
DI void gemm_stream(const u16* __restrict__ A, int lda, const u16* __restrict__ Bt, int ldb, int K, int nN, int T,
                    void* outp, int ldc, const u16* aux, int ldaux, char* smem) {
  const int tid = tidq(), lane = tid & 63, w = tid >> 6, wm = w >> 1, wn = w & 1, r16 = lane & 15, quad = lane >> 4;
  const int lr = tid >> 3, lc = tid & 7;
  asm volatile("" : "+s"(lda), "+s"(ldb), "+s"(K));
  const int nk = K >> 6;
  int t, m0, n0, m1 = 0, n1 = 0;
  if (!tile_at(0, T, t)) return;
  tile_mn(t, nN, m0, n0);
  const size_t aoff = (size_t)lr * lda + lc * 8, boff = (size_t)lr * ldb + lc * 8;
  const u16* ag = A + (size_t)m0 * lda + aoff;
  const u16* bg = Bt + (size_t)n0 * ldb + boff;
  f32x4 acc[4][4];
  zero_acc(acc);
  Stage s0, s1;
  gload(s0, ag, bg, lda, ldb, 0);
  gload(s1, ag, bg, lda, ldb, 1);
  lwrite(s0, smem, lr, lc);
  __syncthreads();
  for (int i = 0;; ++i) {
    const bool has_next = tile_at(i + 1, T, t);
    if (has_next) tile_mn(t, nN, m1, n1);
    const u16* agn = A + (size_t)m1 * lda + aoff;
    const u16* bgn = Bt + (size_t)n1 * ldb + boff;
    for (int kt = 0; kt < nk; kt += 2) {
      if (kt + 2 < nk) gload(s0, ag, bg, lda, ldb, kt + 2);
      else if (has_next) gload(s0, agn, bgn, lda, ldb, 0);
      GEMM_COMPUTE(smem);
      lwrite(s1, smem + 32768, lr, lc);
      __syncthreads();
      if (kt + 2 < nk) gload(s1, ag, bg, lda, ldb, kt + 3);
      else if (has_next) gload(s1, agn, bgn, lda, ldb, 1);
      GEMM_COMPUTE(smem + 32768);
      if (kt + 2 < nk || has_next) lwrite(s0, smem, lr, lc);
      __syncthreads();
    }
    gemm_epilogue<EPI>(acc, m0, n0, outp, ldc, aux, ldaux);
    if (!has_next) break;
    m0 = m1; n0 = n1; ag = agn; bg = bgn;
  }
}

DI void gemm_stream_split(const u16* __restrict__ A, int lda, const u16* __restrict__ Bt, int ldb, int K,
                          float* outp, float* part, char* smem) {
  const int tid = tidq(), lane = tid & 63, w = tid >> 6, wm = w >> 1, wn = w & 1, r16 = lane & 15, quad = lane >> 4;
  const int lr = tid >> 3, lc = tid & 7;
  asm volatile("" : "+s"(lda), "+s"(ldb), "+s"(K));
  const int nk = K >> 6, nks = nk >> 3;
  const size_t aoff = (size_t)lr * lda + lc * 8, boff = (size_t)lr * ldb + lc * 8;
  const int slice = blockIdx.x & 7, tl = blockIdx.x >> 3;
  int t, m0, n0, m1 = 0, n1 = 0;
  tile_at(0, 1024, t);
  tile_mn(t, 8, m0, n0);
  const u16* ag = A + (size_t)m0 * lda + aoff;
  const u16* bg = Bt + (size_t)n0 * ldb + boff;
  int nku = nk;
  f32x4 acc[4][4];
  zero_acc(acc);
  Stage s0, s1;
  gload(s0, ag, bg, lda, ldb, 0);
  gload(s1, ag, bg, lda, ldb, 1);
  lwrite(s0, smem, lr, lc);
  __syncthreads();
  for (int u = 0; u < 3; ++u) {
    const bool has_next = (u < 2);
    int nkn = nk;
    const u16* agn = ag;
    const u16* bgn = bg;
    if (u == 0) {
      tile_at(1, 1024, t);
      tile_mn(t, 8, m1, n1);
      agn = A + (size_t)m1 * lda + aoff;
      bgn = Bt + (size_t)n1 * ldb + boff;
    } else if (u == 1) {
      m1 = MPR + (tl >> 3) * 128; n1 = (tl & 7) * 128;
      agn = A + (size_t)m1 * lda + aoff + (size_t)slice * nks * 64;
      bgn = Bt + (size_t)n1 * ldb + boff + (size_t)slice * nks * 64;
      nkn = nks;
    }
    for (int kt = 0; kt < nku; kt += 2) {
      if (kt + 2 < nku) gload(s0, ag, bg, lda, ldb, kt + 2);
      else if (has_next) gload(s0, agn, bgn, lda, ldb, 0);
      GEMM_COMPUTE(smem);
      lwrite(s1, smem + 32768, lr, lc);
      __syncthreads();
      if (kt + 2 < nku) gload(s1, ag, bg, lda, ldb, kt + 3);
      else if (has_next) gload(s1, agn, bgn, lda, ldb, 1);
      GEMM_COMPUTE(smem + 32768);
      if (kt + 2 < nku || has_next) lwrite(s0, smem, lr, lc);
      __syncthreads();
    }
    if (u < 2) gemm_epilogue<EPI_F32>(acc, m0, n0, outp, DM, nullptr, 0);
    else gemm_epilogue<EPI_F32>(acc, m0 - MPR, n0, part + (size_t)slice * 1024 * 1024, DM, nullptr, 0);
    m0 = m1; n0 = n1; ag = agn; bg = bgn; nku = nkn;
  }
}

DI void merge_tile(const Params& p, int l, int m0, int n0, char* smem) {
  f32x4 macc[4][4];
  zero_acc(macc);
  const int lane = tidq() & 63, w = tidq() >> 6, wm = w >> 1, wn = w & 1, r16 = lane & 15, quad = lane >> 4;
  const bool odd = quad & 1;
  const u16* gates = p.pbuf;
  for (int b = 0; b < 4; ++b) {
    f32x4 acc[4][4];
    zero_acc(acc);
    gemm_kloop<false>(acc, p.obuf + b * 512, OLD, p.wt_br + (size_t)(l * 4 + b) * DM * WLD5, WLD5, 512, m0, n0, smem);
#pragma unroll
    for (int i = 0; i < 4; ++i) {
      const int m = m0 + wm * 64 + i * 16 + r16;
#pragma unroll
      for (int jp = 0; jp < 2; ++jp) {
        const int n = n0 + wn * 64 + (2 * jp + (odd ? 1 : 0)) * 16 + (quad & 2) * 4;
        const uint4 g16 = *(const uint4*)(gates + (size_t)m * 4096 + b * 1024 + n);
        const uint2 lo = make_uint2(g16.x, g16.y), hi = make_uint2(g16.z, g16.w);
        const uint2 send = odd ? lo : hi;
        uint2 recv;
        recv.x = __shfl_xor(send.x, 16); recv.y = __shfl_xor(send.y, 16);
        const uint2 g0 = odd ? recv : lo;
        const uint2 g1 = odd ? hi : recv;
        macc[i][2 * jp][0] += bf2f((u16)(g0.x & 0xffff)) * acc[i][2 * jp][0];
        macc[i][2 * jp][1] += bf2f((u16)(g0.x >> 16)) * acc[i][2 * jp][1];
        macc[i][2 * jp][2] += bf2f((u16)(g0.y & 0xffff)) * acc[i][2 * jp][2];
        macc[i][2 * jp][3] += bf2f((u16)(g0.y >> 16)) * acc[i][2 * jp][3];
        macc[i][2 * jp + 1][0] += bf2f((u16)(g1.x & 0xffff)) * acc[i][2 * jp + 1][0];
        macc[i][2 * jp + 1][1] += bf2f((u16)(g1.x >> 16)) * acc[i][2 * jp + 1][1];
        macc[i][2 * jp + 1][2] += bf2f((u16)(g1.y & 0xffff)) * acc[i][2 * jp + 1][2];
        macc[i][2 * jp + 1][3] += bf2f((u16)(g1.y >> 16)) * acc[i][2 * jp + 1][3];
      }
    }
  }
#pragma unroll
  for (int i = 0; i < 4; ++i) {
    const int m = m0 + wm * 64 + i * 16 + r16;
    uint2 o[4];
#pragma unroll
    for (int j = 0; j < 4; ++j) { o[j].x = pack2(macc[i][j][0], macc[i][j][1]); o[j].y = pack2(macc[i][j][2], macc[i][j][3]); }
#pragma unroll
    for (int jp = 0; jp < 2; ++jp) {
      const uint2 mine = odd ? o[2 * jp + 1] : o[2 * jp];
      const uint2 send = odd ? o[2 * jp] : o[2 * jp + 1];
      uint2 recv;
      recv.x = __shfl_xor(send.x, 16); recv.y = __shfl_xor(send.y, 16);
      const int n = n0 + wn * 64 + (2 * jp + (odd ? 1 : 0)) * 16 + (quad & 2) * 4;
      const uint4 st = odd ? make_uint4(recv.x, recv.y, mine.x, mine.y) : make_uint4(mine.x, mine.y, recv.x, recv.y);
      *(uint4*)(p.hb + (size_t)m * HLD + n) = st;
    }
  }
}

constexpr int QS = 136;
constexpr int TS = 20;
constexpr int OFS = 260;

template <int MODE>
__device__ void run_chain(const Params& p, int l, int seq, int sub, int seg, int pass, char* smem) {
  constexpr int NE = 2;
  const int tid = tidq(), lane = tid & 63, w = tid >> 6, r16 = lane & 15, quad = lane >> 4;
  const bool prompt = seq < 8;
  const int bidx = prompt ? seq : seq - 8;
  const int NB = prompt ? 8 : 128;
  const int L = prompt ? 2048 : 8;
  const int row0 = prompt ? seq * 2048 : MPR + (seq - 8) * 8;
  const int pos0 = prompt ? 0 : 16384;
  int cps = p.cps;
  asm volatile("" : "+s"(cps));
  const int ch_begin = prompt ? seg * cps : 0;
  const int ch_end = prompt ? ch_begin + cps : 1;
  const bool light = prompt && (pass == 1) && (seg > 0);
  const bool store_local = prompt && (pass == 1);
  const bool last_seg = !prompt || (seg == p.nseg - 1);
  const int cid = seq * 12 + MODE * 4 + sub;

  u16* Qa = (u16*)smem;
  u16* Ka = (u16*)(smem + 4352);
  u16* KuT = (u16*)(smem + 8704);
  u16* VaT = (u16*)(smem + 13824);
  u16* VuT = (MODE == 1) ? (u16*)(smem + 18944) : VaT;
  float* Of = (float*)(smem + 24064);
  u16* Raw = (u16*)(smem + 40704);
  u16* Xc = (u16*)(smem + 53248);
  float* tot = (float*)(smem + 57344);
  float* cdec = (float*)(smem + 58368);
  float* dtl = (float*)(smem + 58624);
  float* rsc = (float*)(smem + 58880);
  float* clast = (float*)(smem + 59392);
  float* segacc = (float*)(smem + 59408);

  const float* sin_ = nullptr;
  float* sout = nullptr;
  if (MODE == 0) {
    if (!prompt) sin_ = p.in[2] + (((size_t)l * 128 + bidx) * 4 + sub) * 16384;
    sout = p.out + (prompt ? p.o_ret_p : p.o_ret_s) + (((size_t)l * NB + bidx) * 4 + sub) * 16384;
  } else if (MODE == 2) {
    if (!prompt) sin_ = p.in[5] + (((size_t)l * 128 + bidx) * 4 + sub) * 16384;
    sout = p.out + (prompt ? p.o_hg_p : p.o_hg_s) + (((size_t)l * NB + bidx) * 4 + sub) * 16384;
  } else {
    if (!prompt) sin_ = p.in[3] + (((size_t)l * 128 + bidx) * 8 + sub * 2 + (w >> 1)) * 8192;
    sout = p.out + (prompt ? p.o_ssd_p : p.o_ssd_s) + (((size_t)l * NB + bidx) * 8 + sub * 2 + (w >> 1)) * 8192;
  }

  float lg = 0.f;
  if (MODE == 0) lg = log1pf(-exp2f(-5.f - (float)sub));

  int sbase = (MODE == 1) ? (((w & 1) * 32 + r16) * 128 + quad * 4) : (quad * 512 + w * 32 + r16);
  asm volatile("" : "+v"(sbase));
  f32x4 S[8][NE];
#pragma unroll
  for (int t = 0; t < 8; ++t)
#pragma unroll
    for (int u = 0; u < NE; ++u) {
      if (sin_) {
        if (MODE == 1) {
          S[t][u] = *(const f32x4*)(sin_ + sbase + u * 2048 + t * 16);
        } else {
#pragma unroll
          for (int jj = 0; jj < 4; ++jj) S[t][u][jj] = sin_[sbase + t * 2048 + jj * 128 + u * 16];
        }
      } else {
        S[t][u] = f32x4{0.f, 0.f, 0.f, 0.f};
      }
    }
  if (prompt && pass == 2) {
    for (int r = 0; r < seg; ++r) {
      const uint4* sl = (const uint4*)(p.slocal + (size_t)(cid * (p.nseg - 1) + r) * 16384) + tid;
      const float* sd = p.segdec + (size_t)(cid * 7 + r) * 128;
      float dsc = 1.f;
      if (MODE == 0) dsc = __expf(lg * (float)(16 * cps));
      if (MODE == 1) dsc = __expf(sd[w >> 1]);
#pragma unroll
      for (int t = 0; t < 8; ++t) {
        f32x4 dv = f32x4{dsc, dsc, dsc, dsc};
        if (MODE == 2) {
          f32x4 lv = *(const f32x4*)(sd + t * 16 + quad * 4);
          dv = f32x4{__expf(lv[0]), __expf(lv[1]), __expf(lv[2]), __expf(lv[3])};
        }
        const uint4 pk = sl[t * 256];
        S[t][0][0] = S[t][0][0] * dv[0] + bf2f((u16)(pk.x & 0xffff));
        S[t][0][1] = S[t][0][1] * dv[1] + bf2f((u16)(pk.x >> 16));
        S[t][0][2] = S[t][0][2] * dv[2] + bf2f((u16)(pk.y & 0xffff));
        S[t][0][3] = S[t][0][3] * dv[3] + bf2f((u16)(pk.y >> 16));
        S[t][1][0] = S[t][1][0] * dv[0] + bf2f((u16)(pk.z & 0xffff));
        S[t][1][1] = S[t][1][1] * dv[1] + bf2f((u16)(pk.z >> 16));
        S[t][1][2] = S[t][1][2] * dv[2] + bf2f((u16)(pk.w & 0xffff));
        S[t][1][3] = S[t][1][3] * dv[3] + bf2f((u16)(pk.w >> 16));
      }
    }
  }

  float lbv = 0.f;
  float hg_tot = 0.f;
  float cprev[2][3];
  float cw[2][4], cb[2];
  int ccidx[2];
  float dt_bias = 0.f, dt_A = 0.f;
  float rinv = 0.f, rcD = 1.f, rsD = 0.f;
  const int gg = sub >> 1, pair = sub & 1;
  if (MODE == 0) {
    rinv = exp2f(-(float)(tid & 63) * (13.287712379549449f / 64.f));
    rsD = __sinf(rinv); rcD = __cosf(rinv);
  }
  if (MODE == 2) {
    if (l == 1) {
      float a0 = p.in[20][sub * 128 + (tid & 127)], a1 = p.in[20][512 + sub * 128 + (tid & 127)];
      float mx = fmaxf(a0, a1);
      float e0 = __expf(a0 - mx), e1 = __expf(a1 - mx);
      lbv = e1 / (e0 + e1);
    }
  }
  if (MODE == 1) {
    if (tid < 32) {
      const int hh = sub * 2 + (tid >> 4);
      dt_A = -__expf(p.in[16][l * 8 + hh]);
      dt_bias = p.in[17][l * 8 + hh];
    }
    if (tid < 2) segacc[tid] = 0.f;
#pragma unroll
    for (int k = 0; k < 2; ++k) {
      int ci = tid + 256 * k;
      int cc = 0;
      if (ci < 128) cc = gg * 256 + pair * 128 + ci;
      else if (ci < 256) cc = 512 + gg * 128 + (ci - 128);
      else cc = 768 + gg * 128 + (ci - 256);
      if (ci >= 384) cc = 0;
      ccidx[k] = cc;
#pragma unroll
      for (int j = 0; j < 4; ++j) cw[k][j] = p.in[14][((size_t)l * 4 + j) * 1024 + cc];
      cb[k] = p.in[15][l * 1024 + cc];
#pragma unroll
      for (int j = 0; j < 3; ++j) {
        float v = 0.f;
        if (!prompt) v = p.in[4][(((size_t)l * 128 + bidx) * 3 + j) * 1024 + cc];
        else if (ch_begin > 0) v = bf2f(p.pbuf[(size_t)(row0 + ch_begin * 16 - 3 + j) * NP + C_SXBC + cc]);
        cprev[k][j] = v;
      }
    }
  }

  float fgain[8];
  {
    const int eg_ = tid & 15;
#pragma unroll
    for (int x = 0; x < 8; ++x) {
      if (MODE == 0) fgain[x] = p.in[13][(l * 4 + sub) * 128 + eg_ * 8 + x];
      else if (MODE == 2) fgain[x] = p.in[21][l * 128 + eg_ * 8 + x];
      else fgain[x] = p.in[18][l * 8 + sub * 2 + ((eg_ * 8) >> 6)];
    }
  }
  const int lt = tid >> 4, lc = tid & 15;
  uint4 r0, r1, r2, g0;
  unsigned rdt = 0;
  const uint4 z4 = make_uint4(0, 0, 0, 0);
  r0 = r1 = r2 = g0 = z4;
  auto load_raw = [&](int ch) {
    const int t0 = ch * 16;
    const int nv = (L - t0 < 16) ? (L - t0) : 16;
    const u16* Pr = p.pbuf + (size_t)(row0 + t0 + lt) * NP;
    r0 = r1 = r2 = g0 = z4;
    rdt = 0;
    if (lt < nv) {
      if (MODE == 0) {
        r0 = *(const uint4*)(Pr + C_RQ + sub * 128 + lc * 8);
        r1 = *(const uint4*)(Pr + C_RK + sub * 128 + lc * 8);
        r2 = *(const uint4*)(Pr + C_RV + sub * 128 + lc * 8);
        g0 = *(const uint4*)(Pr + C_RG + sub * 128 + lc * 8);
      } else if (MODE == 2) {
        r0 = *(const uint4*)(Pr + C_HQ + sub * 128 + lc * 8);
        r1 = *(const uint4*)(Pr + C_HF + sub * 128 + lc * 8);
        r2 = *(const uint4*)(Pr + C_HI + sub * 128 + lc * 8);
        g0 = *(const uint4*)(Pr + C_HG + sub * 128 + lc * 8);
      } else {
        r0 = *(const uint4*)(Pr + C_SXBC + gg * 256 + pair * 128 + lc * 8);
        r1 = *(const uint4*)(Pr + C_SXBC + 512 + gg * 128 + lc * 8);
        r2 = *(const uint4*)(Pr + C_SXBC + 768 + gg * 128 + lc * 8);
        g0 = *(const uint4*)(Pr + C_SZ + gg * 256 + pair * 128 + lc * 8);
        if (lc < 2) rdt = Pr[C_SDT + sub * 2 + lc];
      }
    }
  };
  load_raw(ch_begin);

  for (int ch = ch_begin; ch < ch_end; ++ch) {
    const int t0 = ch * 16;
    const int nvalid = (L - t0 < 16) ? (L - t0) : 16;
    float sscale = 1.f;
    int tidv = threadIdx.x;
    asm volatile("" : "+v"(tidv));
    const int tid = tidv, lane = tid & 63, w = tid >> 6, r16 = lane & 15, quad = lane >> 4, lt = tid >> 4, lc = tid & 15;

    *(uint4*)(Raw + lt * 128 + lc * 8) = r0;
    *(uint4*)(Raw + 2048 + lt * 128 + lc * 8) = r1;
    *(uint4*)(Raw + 4096 + lt * 128 + lc * 8) = r2;
    if (MODE == 1) { if (lc < 2) Raw[6144 + lt * 2 + lc] = (u16)rdt; }
    const uint4 gc0 = g0;
    __syncthreads();
    if (ch + 1 < ch_end) load_raw(ch + 1);

    if (MODE == 0) {
      const int which = tid >> 7, pr = tid & 63, th = (tid >> 6) & 1;
      if (which == 1 || !light) {
        const u16* R = Raw + which * 2048;
        float sn, cs;
        sincos_red((float)(pos0 + t0 + th * 8) * rinv, sn, cs);
#pragma unroll
        for (int x = 0; x < 8; ++x) {
          const int t = th * 8 + x;
          float x1 = bf2f(R[t * 128 + pr]);
          float x2 = bf2f(R[t * 128 + pr + 64]);
          float y1 = x1 * cs - x2 * sn, y2 = x1 * sn + x2 * cs;
          if (which) {
            y1 *= 0.08838834764831845f; y2 *= 0.08838834764831845f;
            Ka[t * QS + pr] = f2bf(y1); Ka[t * QS + pr + 64] = f2bf(y2);
            float kd = __expf(lg * (float)(nvalid - 1 - t));
            KuT[pr * TS + t] = f2bf(y1 * kd);
            KuT[(pr + 64) * TS + t] = f2bf(y2 * kd);
          } else {
            Qa[t * QS + pr] = f2bf(y1); Qa[t * QS + pr + 64] = f2bf(y2);
          }
          float ncs = cs * rcD - sn * rsD;
          sn = sn * rcD + cs * rsD; cs = ncs;
        }
      }
      if (tid < 16) cdec[tid] = lg * (float)(tid + 1);
      sscale = __expf(lg * (float)nvalid);
    } else if (MODE == 2) {
      const int d = tid & 127, th = tid >> 7;
      float cl[8], kk[8], qv[8];
      float c = 0.f;
#pragma unroll
      for (int x = 0; x < 8; ++x) {
        const int t = th * 8 + x;
        kk[x] = 0.f; qv[x] = 0.f;
        if (t < nvalid) {
          float z = bf2f(Raw[2048 + t * 128 + d]);
          float sg = sigmoidf_(z);
          float f = lbv + (1.f - lbv) * sg;
          c += __logf(f);
          kk[x] = (1.f - lbv) * (1.f - sg);
          if (!light) qv[x] = siluf_(bf2f(Raw[t * 128 + d]));
        }
        cl[x] = c;
      }
      tot[th * 128 + d] = c;
      __syncthreads();
      const float c_lo = tot[d];
      const float c_all = c_lo + tot[128 + d];
      const float off = th ? c_lo : 0.f;
      const float e_all = __expf(c_all);
#pragma unroll
      for (int x = 0; x < 8; ++x) {
        const int t = th * 8 + x;
        const float ct = off + cl[x];
        const float ein = __expf(-ct);
        if (!light) {
          Qa[t * QS + d] = f2bf(qv[x] * __frcp_rn(ein));
          Ka[t * QS + d] = f2bf(kk[x] * ein);
        }
        KuT[d * TS + t] = f2bf(kk[x] * ein * e_all);
      }
      if (th == 0) { rsc[d] = e_all; hg_tot += c_all; }
    } else {
      if (tid < 32) {
        const int hl = tid >> 4, t = tid & 15;
        float dtv = 0.f, c = 0.f;
        if (t < nvalid) {
          dtv = softplusf_(bf2f(Raw[6144 + t * 2 + hl]) + dt_bias);
          c = dtv * dt_A;
        }
#pragma unroll
        for (int o = 1; o < 16; o <<= 1) {
          float v = __shfl_up(c, o, 16);
          if (t >= o) c += v;
        }
        cdec[hl * 16 + t] = c;
        dtl[hl * 16 + t] = dtv;
        if (t == 15) { clast[hl] = c; segacc[hl] += c; }
      }
      __syncthreads();
#pragma unroll
      for (int k = 0; k < 2; ++k) {
        const int ci = tid + 256 * k;
        if (ci < 256 || (ci < 384 && !light)) {
          const int hl = (ci < 128) ? (ci >> 6) : 0;
          const float cl = clast[hl];
          const u16* R = Raw + ((ci < 128) ? ci : ((ci < 256) ? (2048 + (ci - 128)) : (4096 + (ci - 256))));
#pragma unroll 4
          for (int t = 0; t < 16; ++t) {
            float v = 0.f;
            if (t < nvalid) {
              float raw = bf2f(R[t * 128]);
              float o = cb[k] + cprev[k][0] * cw[k][0] + cprev[k][1] * cw[k][1] + cprev[k][2] * cw[k][2] + raw * cw[k][3];
              cprev[k][0] = cprev[k][1]; cprev[k][1] = cprev[k][2]; cprev[k][2] = raw;
              v = siluf_(o);
            }
            if (ci < 128) {
              float dtv = dtl[hl * 16 + t];
              if (!light) { Xc[t * 128 + ci] = f2bf(v); VaT[ci * TS + t] = f2bf(v * dtv); }
              VuT[ci * TS + t] = f2bf(v * dtv * __expf(cl - cdec[hl * 16 + t]));
            } else if (ci < 256) {
              u16 a = f2bf(v);
              if (!light) Ka[t * QS + (ci - 128)] = a;
              KuT[(ci - 128) * TS + t] = a;
            } else {
              Qa[t * QS + (ci - 256)] = f2bf(v);
            }
          }
        }
      }
    }
    if (MODE != 1) {
      const int e = tid & 127, th = tid >> 7;
#pragma unroll
      for (int x = 0; x < 4; ++x) {
        const int t = th * 8 + 2 * x;
        unsigned lo = Raw[4096 + t * 128 + e], hi = Raw[4096 + (t + 1) * 128 + e];
        *(unsigned*)(VaT + e * TS + t) = lo | (hi << 16);
      }
    }
    __syncthreads();

    {
      const float* cd = cdec + ((MODE == 1) ? (w >> 1) * 16 : 0);
      bf16x8 attA;
      float rr[4];
      bf16x8 qf[4];
      if (!light) {
        f32x4 at = f32x4{0.f, 0.f, 0.f, 0.f};
#pragma unroll
        for (int s = 0; s < 4; ++s) {
          bf16x8 a = *(const bf16x8*)(Ka + r16 * QS + s * 32 + quad * 8);
          bf16x8 b = *(const bf16x8*)(Qa + r16 * QS + s * 32 + quad * 8);
          at = MFMA16(a, b, at);
        }
        float ci_ = (MODE != 2) ? cd[r16] : 0.f;
        float vv[4];
#pragma unroll
        for (int jj = 0; jj < 4; ++jj) {
          int j = quad * 4 + jj;
          float v = at[jj];
          if (MODE != 2) v *= __expf(fminf(ci_ - cd[j], 0.f));
          vv[jj] = (j <= r16) ? v : 0.f;
        }
        unsigned a01 = pack2(vv[0], vv[1]), a23 = pack2(vv[2], vv[3]);
        attA = __builtin_bit_cast(bf16x8, (u32x4){a01, a23, 0u, 0u});
#pragma unroll
        for (int jj = 0; jj < 4; ++jj) rr[jj] = (MODE != 2) ? __expf(cd[quad * 4 + jj]) : 1.f;
#pragma unroll
        for (int s = 0; s < 4; ++s) {
          bf16x4 lo = *(const bf16x4*)(Qa + r16 * QS + s * 32 + quad * 4);
          bf16x4 hi = *(const bf16x4*)(Qa + r16 * QS + s * 32 + 16 + quad * 4);
          qf[s] = bf16x8{lo[0], lo[1], lo[2], lo[3], hi[0], hi[1], hi[2], hi[3]};
        }
      }
      if (!light) {
#pragma unroll
        for (int u = 0; u < NE; ++u) {
          const int e0 = (w * NE + u) * 16;
          bf16x4 v4 = *(const bf16x4*)(VaT + (e0 + r16) * TS + quad * 4);
          bf16x8 vb = bf16x8{v4[0], v4[1], v4[2], v4[3], 0, 0, 0, 0};
          f32x4 o1 = MFMA16(attA, vb, (f32x4{0.f, 0.f, 0.f, 0.f}));
          f32x4 o2 = f32x4{0.f, 0.f, 0.f, 0.f};
#pragma unroll
          for (int s = 0; s < 4; ++s) {
            u32x4 sp = {pack2(S[2 * s][u][0], S[2 * s][u][1]), pack2(S[2 * s][u][2], S[2 * s][u][3]),
                        pack2(S[2 * s + 1][u][0], S[2 * s + 1][u][1]), pack2(S[2 * s + 1][u][2], S[2 * s + 1][u][3])};
            o2 = MFMA16(qf[s], __builtin_bit_cast(bf16x8, sp), o2);
          }
#pragma unroll
          for (int jj = 0; jj < 4; ++jj) Of[(quad * 4 + jj) * OFS + e0 + r16] = o1[jj] + rr[jj] * o2[jj];
        }
      }
      float hs = 1.f;
      if (MODE == 0) hs = sscale;
      if (MODE == 1) hs = __expf(clast[w >> 1]);
#pragma unroll
      for (int u = 0; u < NE; ++u) {
        const int e0 = (w * NE + u) * 16;
        bf16x4 v4 = *(const bf16x4*)(VuT + (e0 + r16) * TS + quad * 4);
        bf16x8 vb = bf16x8{v4[0], v4[1], v4[2], v4[3], 0, 0, 0, 0};
#pragma unroll
        for (int t = 0; t < 8; ++t) {
          bf16x4 k4 = *(const bf16x4*)(KuT + (t * 16 + r16) * TS + quad * 4);
          bf16x8 ka = bf16x8{k4[0], k4[1], k4[2], k4[3], 0, 0, 0, 0};
          f32x4 sv = S[t][u];
          if (MODE == 2) {
            f32x4 r4 = *(const f32x4*)(rsc + t * 16 + quad * 4);
            sv[0] *= r4[0]; sv[1] *= r4[1]; sv[2] *= r4[2]; sv[3] *= r4[3];
          } else {
            sv[0] *= hs; sv[1] *= hs; sv[2] *= hs; sv[3] *= hs;
          }
          S[t][u] = MFMA16(ka, vb, sv);
        }
      }
    }
    __syncthreads();

    if (!light) {
      const int i = tid >> 4, eg = tid & 15;
      const int grow = row0 + t0 + i;
      unsigned gw[4] = {gc0.x, gc0.y, gc0.z, gc0.w};
      if (MODE == 0 || MODE == 2) {
        float o[8];
#pragma unroll
        for (int x = 0; x < 8; ++x) o[x] = Of[i * OFS + eg * 8 + x];
        float s1 = 0.f;
        float mu = 0.f;
        if (MODE == 0) {
#pragma unroll
          for (int x = 0; x < 8; ++x) s1 += o[x];
          mu = sum16(s1) * (1.f / 128.f);
        }
        float s2 = 0.f;
#pragma unroll
        for (int x = 0; x < 8; ++x) { o[x] -= mu; s2 += o[x] * o[x]; }
        float r = rsqrtf(sum16(s2) * (1.f / 128.f) + EPS);
        if (i < nvalid) {
          float res[8];
#pragma unroll
          for (int x = 0; x < 8; ++x) {
            float g = bf2f((u16)((x & 1) ? (gw[x >> 1] >> 16) : (gw[x >> 1] & 0xffff)));
            float gate = (MODE == 0) ? siluf_(g) : sigmoidf_(g);
            res[x] = o[x] * r * fgain[x] * gate;
          }
          uint4 ov = make_uint4(pack2(res[0], res[1]), pack2(res[2], res[3]), pack2(res[4], res[5]), pack2(res[6], res[7]));
          const int ocol = ((MODE == 0) ? 0 : 1024) + sub * 128 + eg * 8;
          *(uint4*)(p.obuf + (size_t)grow * OLD + ocol) = ov;
        }
      } else {
        float y[8];
        const int chb = eg * 8;
        const float Dh = fgain[0];
        float s2 = 0.f;
#pragma unroll
        for (int x = 0; x < 8; ++x) {
          float g = bf2f((u16)((x & 1) ? (gw[x >> 1] >> 16) : (gw[x >> 1] & 0xffff)));
          float v = Of[i * OFS + chb + x] + bf2f(Xc[i * 128 + chb + x]) * Dh;
          v *= siluf_(g);
          y[x] = v; s2 += v * v;
        }
        s2 = sum16(s2);
        if (i < nvalid) {
          if (eg == 0) p.ssq[(size_t)grow * 4 + sub] = s2;
          uint4 ov = make_uint4(pack2(y[0], y[1]), pack2(y[2], y[3]), pack2(y[4], y[5]), pack2(y[6], y[7]));
          *(uint4*)(p.obuf + (size_t)grow * OLD + 512 + sub * 128 + chb) = ov;
        }
      }
    }
  }
  __syncthreads();

  if (store_local) {
    uint4* sl = (uint4*)(p.slocal + (size_t)(cid * (p.nseg - 1) + seg) * 16384) + tid;
#pragma unroll
    for (int t = 0; t < 8; ++t)
      sl[t * 256] = make_uint4(pack2(S[t][0][0], S[t][0][1]), pack2(S[t][0][2], S[t][0][3]),
                               pack2(S[t][1][0], S[t][1][1]), pack2(S[t][1][2], S[t][1][3]));
    float* sd = p.segdec + (size_t)(cid * 7 + seg) * 128;
    if (MODE == 1) { if (tid < 2) sd[tid] = segacc[tid]; }
    if (MODE == 2) { if (tid < 128) sd[tid] = hg_tot; }
  } else if (last_seg) {
    asm volatile("" : "+v"(sbase));
#pragma unroll
    for (int t = 0; t < 8; ++t)
#pragma unroll
      for (int u = 0; u < NE; ++u) {
        if (MODE == 1) {
          *(f32x4*)(sout + sbase + u * 2048 + t * 16) = S[t][u];
        } else {
#pragma unroll
          for (int jj = 0; jj < 4; ++jj) sout[sbase + t * 2048 + jj * 128 + u * 16] = S[t][u][jj];
        }
      }
    if (MODE == 1) {
      float* co = p.out + (prompt ? p.o_conv_p : p.o_conv_s) + ((size_t)l * NB + bidx) * 3 * 1024;
#pragma unroll
      for (int k = 0; k < 2; ++k) {
        const int ci = tid + 256 * k;
        if (ci < 128 || (ci < 384 && pair == 0)) {
#pragma unroll
          for (int j = 0; j < 3; ++j) co[j * 1024 + ccidx[k]] = cprev[k][j];
        }
      }
    }
  }
}

__device__ void run_s5(const Params& p, int l, int seq, int gq, int seg, int pass, char* smem) {
  const int tid = tidq(), lane = tid & 63, w = tid >> 6, r16 = lane & 15, quad = lane >> 4;
  const int g = gq * 4 + w;
  const bool prompt = seq < 8;
  const int bidx = prompt ? seq : seq - 8;
  const int NB = prompt ? 8 : 128;
  const int row0 = prompt ? seq * 2048 : MPR + (seq - 8) * 8;
  int cps_ = p.cps;
  asm volatile("" : "+s"(cps_));
  const int nch = prompt ? cps_ : 1;
  const int ch_begin = prompt ? seg * nch : 0;
  const int ch_end = ch_begin + nch;
  const int nvalid = prompt ? 16 : 8;
  const bool light = prompt && (pass == 1) && (seg > 0);
  const bool store_local = prompt && (pass == 1);
  const bool last_seg = !prompt || (seg == p.nseg - 1);
  char* wb = smem + w * 5120;
  u16* Hs = (u16*)wb;
  u16* Us = (u16*)(wb + 4352);
  const int lg_ = l * 32 + g;

  const float dt = __expf(p.in[29][lg_]);
  float Ar[4][4], Ai[4][4];
  float fre[4], fim[4];
  float dtare[4], thv[4];
#pragma unroll
  for (int i = 0; i < 4; ++i) {
    const int pi = i * 16 + r16;
    const float are = p.in[22][lg_ * 64 + pi], aim = p.in[23][lg_ * 64 + pi];
    const float th = dt * aim;
    float sn, cs; sincos_red(th, sn, cs);
    float shalf, chalf; sincos_red(0.5f * th, shalf, chalf);
    const float em1 = expm1f(dt * are);
    const float mag = em1 + 1.f;
    const float abr = mag * cs, abi = mag * sn;
    const float nre = em1 * cs - 2.f * shalf * shalf, nim = abi;
    const float den = are * are + aim * aim;
    fre[i] = (nre * are + nim * aim) / den; fim[i] = (nim * are - nre * aim) / den;
    dtare[i] = dt * are; thv[i] = th;
    Ar[0][i] = abr; Ai[0][i] = abi;
    Ar[1][i] = abr * abr - abi * abi; Ai[1][i] = 2.f * abr * abi;
    Ar[2][i] = Ar[1][i] * abr - Ai[1][i] * abi; Ai[2][i] = Ar[1][i] * abi + Ai[1][i] * abr;
    Ar[3][i] = Ar[1][i] * Ar[1][i] - Ai[1][i] * Ai[1][i]; Ai[3][i] = 2.f * Ar[1][i] * Ai[1][i];
  }
  bf16x8 Bop[8];
#pragma unroll
  for (int nt = 0; nt < 8; ++nt) {
    const int i = nt & 3;
    u32x4 pk = {0u, 0u, 0u, 0u};
    if (quad < 2) {
      const size_t bo = ((size_t)lg_ * 64 + i * 16 + r16) * 16 + quad * 8;
      const float4 br0 = *(const float4*)(p.in[24] + bo), br1 = *(const float4*)(p.in[24] + bo + 4);
      const float4 bi0 = *(const float4*)(p.in[25] + bo), bi1 = *(const float4*)(p.in[25] + bo + 4);
      const float brv[8] = {br0.x, br0.y, br0.z, br0.w, br1.x, br1.y, br1.z, br1.w};
      const float biv[8] = {bi0.x, bi0.y, bi0.z, bi0.w, bi1.x, bi1.y, bi1.z, bi1.w};
      float v[8];
#pragma unroll
      for (int j = 0; j < 8; ++j)
        v[j] = (nt < 4) ? (fre[i] * brv[j] - fim[i] * biv[j]) : (fre[i] * biv[j] + fim[i] * brv[j]);
      pk = u32x4{pack2(v[0], v[1]), pack2(v[2], v[3]), pack2(v[4], v[5]), pack2(v[6], v[7])};
    }
    Bop[nt] = __builtin_bit_cast(bf16x8, pk);
  }
  bf16x8 Cop[4];
  float Dm[4] = {0.f, 0.f, 0.f, 0.f};
  if (!light) {
#pragma unroll
    for (int s = 0; s < 4; ++s) {
      const int n0 = 32 * s + quad * 8;
      const float* src = ((n0 >= 64) ? p.in[27] : p.in[26]) + ((size_t)lg_ * 16 + r16) * 64 + (n0 & 63);
      const float sg = (n0 >= 64) ? -1.f : 1.f;
      const float4 c0 = *(const float4*)src, c1 = *(const float4*)(src + 4);
      Cop[s] = __builtin_bit_cast(bf16x8, (u32x4{pack2(sg * c0.x, sg * c0.y), pack2(sg * c0.z, sg * c0.w),
                                                 pack2(sg * c1.x, sg * c1.y), pack2(sg * c1.z, sg * c1.w)}));
    }
#pragma unroll
    for (int jj = 0; jj < 4; ++jj) Dm[jj] = p.in[28][lg_ * 16 + quad * 4 + jj];
  }
  float hr[4], hi[4];
#pragma unroll
  for (int i = 0; i < 4; ++i) { hr[i] = 0.f; hi[i] = 0.f; }
  if (!prompt) {
#pragma unroll
    for (int i = 0; i < 4; ++i) {
      hr[i] = p.in[6][((size_t)(l * 128 + bidx) * 32 + g) * 64 + i * 16 + r16];
      hi[i] = p.in[7][((size_t)(l * 128 + bidx) * 32 + g) * 64 + i * 16 + r16];
    }
  } else if (pass == 2 && seg > 0) {
    const float len = (float)(nch * 16);
#pragma unroll
    for (int i = 0; i < 4; ++i) {
      const float pm = __expf(len * dtare[i]);
      float ps, pc; sincos_red(len * thv[i], ps, pc);
      const float pr_ = pm * pc, pi_ = pm * ps;
      for (int r = 0; r < seg; ++r) {
        const float* hl = p.hlocal + ((size_t)((seq * 32 + g) * 7 + r)) * 128;
        const float lr_ = hl[i * 16 + r16], li_ = hl[64 + i * 16 + r16];
        const float nr = pr_ * hr[i] - pi_ * hi[i] + lr_;
        const float ni = pr_ * hi[i] + pi_ * hr[i] + li_;
        hr[i] = nr; hi[i] = ni;
      }
    }
  }
  const int ut = lane >> 1, uh = lane & 1;
  const u16* ubase = p.pbuf + (size_t)(row0 + ut) * NP + C_SU + g * 16 + uh * 8;
  const uint4 z4 = make_uint4(0, 0, 0, 0);
  uint4 nxt = z4;
  if (lane < 32 && ut < nvalid) nxt = *(const uint4*)(ubase + (size_t)ch_begin * 16 * NP);
  for (int ch = ch_begin; ch < ch_end; ++ch) {
    const uint4 cur = nxt;
    nxt = z4;
    if (ch + 1 < ch_end && lane < 32) nxt = *(const uint4*)(ubase + (size_t)(ch + 1) * 16 * NP);
    if (lane < 32) *(uint4*)(Us + ut * 16 + uh * 8) = cur;
    __syncthreads();
    bf16x8 Uop = bf16x8{0, 0, 0, 0, 0, 0, 0, 0};
    if (quad < 2) Uop = *(const bf16x8*)(Us + r16 * 16 + quad * 8);
    f32x4 bu[8];
#pragma unroll
    for (int nt = 0; nt < 8; ++nt) bu[nt] = MFMA16(Uop, Bop[nt], (f32x4{0.f, 0.f, 0.f, 0.f}));
    float Er[4], Ei[4];
#pragma unroll
    for (int i = 0; i < 4; ++i) {
      float xr = 0.f, xi = 0.f;
#pragma unroll
      for (int jj = 0; jj < 4; ++jj) {
        const float nr = Ar[0][i] * xr - Ai[0][i] * xi + bu[i][jj];
        const float ni = Ar[0][i] * xi + Ai[0][i] * xr + bu[4 + i][jj];
        xr = nr; xi = ni;
        bu[i][jj] = xr; bu[4 + i][jj] = xi;
      }
      Er[i] = xr; Ei[i] = xi;
    }
    float cr[4], ci[4];
#pragma unroll
    for (int i = 0; i < 4; ++i) { cr[i] = hr[i]; ci[i] = hi[i]; }
#pragma unroll
    for (int k = 0; k < 4; ++k) {
#pragma unroll
      for (int i = 0; i < 4; ++i) {
        const float er = __shfl(Er[i], r16 + 16 * k), ei = __shfl(Ei[i], r16 + 16 * k);
        const float nr = Ar[3][i] * hr[i] - Ai[3][i] * hi[i] + er;
        const float ni = Ar[3][i] * hi[i] + Ai[3][i] * hr[i] + ei;
        if (k * 4 < nvalid) { hr[i] = nr; hi[i] = ni; }
        if (k < quad) { cr[i] = nr; ci[i] = ni; }
      }
    }
    if (!light) {
#pragma unroll
      for (int i = 0; i < 4; ++i)
#pragma unroll
        for (int jj = 0; jj < 4; ++jj) {
          const float vr = bu[i][jj] + Ar[jj][i] * cr[i] - Ai[jj][i] * ci[i];
          const float vi = bu[4 + i][jj] + Ar[jj][i] * ci[i] + Ai[jj][i] * cr[i];
          Hs[(quad * 4 + jj) * 136 + i * 16 + r16] = f2bf(vr);
          Hs[(quad * 4 + jj) * 136 + 64 + i * 16 + r16] = f2bf(vi);
        }
      __syncthreads();
      f32x4 ya = f32x4{0.f, 0.f, 0.f, 0.f};
#pragma unroll
      for (int s = 0; s < 4; ++s) {
        const bf16x8 bh = *(const bf16x8*)(Hs + r16 * 136 + s * 32 + quad * 8);
        ya = MFMA16(Cop[s], bh, ya);
      }
      const uint2 uu = *(const uint2*)(Us + r16 * 16 + quad * 4);
      const float u0 = bf2f((u16)(uu.x & 0xffff)), u1 = bf2f((u16)(uu.x >> 16));
      const float u2 = bf2f((u16)(uu.y & 0xffff)), u3 = bf2f((u16)(uu.y >> 16));
      const float z0 = gelu_tanh(ya[0] + Dm[0] * u0), z1 = gelu_tanh(ya[1] + Dm[1] * u1);
      const float z2 = gelu_tanh(ya[2] + Dm[2] * u2), z3 = gelu_tanh(ya[3] + Dm[3] * u3);
      if (r16 < nvalid)
        *(uint2*)(p.zs5 + (size_t)(row0 + ch * 16 + r16) * ZLD + g * 16 + quad * 4) = make_uint2(pack2(z0, z1), pack2(z2, z3));
    }
    __syncthreads();
  }
  if (store_local) {
    if (quad == 0) {
      float* hl = p.hlocal + ((size_t)((seq * 32 + g) * 7 + seg)) * 128;
#pragma unroll
      for (int i = 0; i < 4; ++i) { hl[i * 16 + r16] = hr[i]; hl[64 + i * 16 + r16] = hi[i]; }
    }
  } else if (last_seg) {
    if (quad == 0) {
      float* o_r = p.out + (prompt ? p.o_s5r_p : p.o_s5r_s) + ((size_t)(l * NB + bidx) * 32 + g) * 64;
      float* o_i = p.out + (prompt ? p.o_s5i_p : p.o_s5i_s) + ((size_t)(l * NB + bidx) * 32 + g) * 64;
#pragma unroll
      for (int i = 0; i < 4; ++i) { o_r[i * 16 + r16] = hr[i]; o_i[i * 16 + r16] = hi[i]; }
    }
  }
}

__device__ void phase_mixers(const Params& p, int l, int pass, char* smem, int visit) {
  int* s_item = (int*)(smem + 65536);
  unsigned* cnt = p.counters + l * 64 + (pass - 1) * 32 + visit * 16;
  const int nseg = p.nseg;
  const int ns1 = nseg - 1;
  const int n_chain = 96 * ns1;
  const int n_s5 = 64 * ns1;
  const int n_items = n_chain + n_s5 + ((pass == 1) ? 128 * 20 : 0);
  for (;;) {
    if (tidq() == 0) *s_item = (int)atomicAdd(cnt, 1u);
    __syncthreads();
    const int item = *s_item;
    __syncthreads();
    if (item >= n_items) break;
    int mode, seq, sub, seg = 0;
    const int per = ns1;
    const int seg0 = (pass == 1) ? 0 : 1;
    if (item < n_chain) {
      const int c = item / per; seg = seg0 + item % per;
      const int kind = c >> 5, r = c & 31;
      seq = r >> 2; sub = r & 3;
      mode = (kind == 0) ? 1 : ((kind == 1) ? 2 : 0);
    } else if (item < n_chain + n_s5) {
      const int k = item - n_chain;
      const int c = k / per; seg = seg0 + k % per;
      mode = 3; seq = c >> 3; sub = c & 7;
    } else {
      int k = item - n_chain - n_s5; int b = k / 20; sub = k % 20; seq = 8 + b;
      if (sub < 4) mode = 1;
      else if (sub < 8) { mode = 0; sub -= 4; }
      else if (sub < 12) { mode = 2; sub -= 8; }
      else { mode = 3; sub -= 12; }
    }
    const int ps = (seq >= 8) ? 2 : pass;
    if (mode == 0) { if (EN(2) || ONLY == 20) run_chain<0>(p, l, seq, sub, seg, ps, smem); }
    else if (mode == 1) { if (EN(2) || ONLY == 21) run_chain<1>(p, l, seq, sub, seg, ps, smem); }
    else if (mode == 2) { if (EN(2) || ONLY == 22) run_chain<2>(p, l, seq, sub, seg, ps, smem); }
    else { if (EN(2) || ONLY == 23) run_s5(p, l, seq, sub, seg, ps, smem); }
    __syncthreads();
  }
}

DI bool tile_at(int i, int T, int& t) {
  const int bpx = gridDim.x >> 3;
  t = ((blockIdx.x & 7) + 8 * i) * bpx + (blockIdx.x >> 3);
  return t < T;
}
DI void tile_mn(int t, int nN, int& m0, int& n0) {
  const int per = 8 * nN;
  const int grp = t / per, r = t - grp * per;
  m0 = (grp * 8 + (r & 7)) * 128;
  n0 = (r >> 3) * 128;
}

__device__ void run_phase(const Params& p, int ph, char* smem, int visit) {
  constexpr int NMT = MTOK / 128;
  if (ph == 0) {
    if (EN(9)) phase_convert(p, smem);
    if (EN(0)) phase_rownorm(p, true, nullptr, nullptr, p.in[8], p.hb);
    return;
  }
  if (ph == NPHASE - 1) {
    if (EN(10)) phase_rownorm(p, false, p.tbuf, p.in[11] + 1 * DM, nullptr, nullptr);
    return;
  }
  const int l = (ph <= 9) ? 0 : 1, s0_ = (ph <= 9) ? ph : ph - 10;
  const int s = (s0_ <= 2) ? s0_ : s0_ - 1;
  switch (s) {
    case 0:
      if (!EN(0)) break;
      phase_rownorm(p, false, p.tbuf, p.in[11] + (l - 1) * DM, p.in[8] + l * DM, p.hb);
      break;
    case 1: if (EN(1)) {
      constexpr int NN = NP / 128;
      gemm_stream<EPI_BF16>(p.hb, HLD, p.wt_in + (size_t)l * NIN * WLD1, WLD1, DM, NN, NMT * NN, p.pbuf, NP, nullptr, 0, smem);
    } break;
    case 2: if (EN(2) || (ONLY >= 20 && ONLY <= 23)) phase_mixers(p, l, (s0_ == 2) ? 1 : 2, smem, visit); break;
    case 3: if (EN(3)) {
      constexpr int NG = 32, NGLU = 4;
      {
        const int lane = tidq() & 63, w = tidq() >> 6;
        for (int row = blockIdx.x * 4 + w; row < MTOK; row += gridDim.x * 4) {
          const float4 sq = *(const float4*)(p.ssq + (size_t)row * 4);
          const float ms = (lane < 32) ? (sq.x + sq.y) : (sq.z + sq.w);
          const float r = rsqrtf(ms * (1.f / 256.f) + EPS);
          u16* ptr = p.obuf + (size_t)row * OLD + 512 + lane * 8;
          uint4 v = *(const uint4*)ptr;
          const float* gn = p.in[19] + l * 512 + lane * 8;
          unsigned vw[4] = {v.x, v.y, v.z, v.w};
          unsigned ow[4];
#pragma unroll
          for (int x = 0; x < 4; ++x)
            ow[x] = pack2(bf2f((u16)(vw[x] & 0xffff)) * r * gn[2 * x], bf2f((u16)(vw[x] >> 16)) * r * gn[2 * x + 1]);
          *(uint4*)ptr = make_uint4(ow[0], ow[1], ow[2], ow[3]);
        }
      }
      gemm_stream<EPI_SIG>(p.hb, HLD, p.wt_in + ((size_t)l * NIN + NP) * WLD1, WLD1, DM, NG, NMT * NG, p.pbuf, 4096, nullptr, 0, smem);
      gemm_stream<EPI_GLU>(p.zs5, ZLD, p.wt_glu + (size_t)l * 512 * WLD5, WLD5, 512, NGLU, NMT * NGLU,
                           p.obuf + 1536, OLD, p.zs5, ZLD, smem);
    } break;
    case 4:
      if (EN(4)) {
        int t, m0, n0;
        for (int i = 0; tile_at(i, NMT * 8, t); ++i) { tile_mn(t, 8, m0, n0); merge_tile(p, l, m0, n0, smem); }
      }
      break;
    case 5:
      if (EN(5)) {
        if (gridDim.x == 512) gemm_stream_split(p.hb, HLD, p.wt_out + (size_t)l * DM * WLD1, WLD1, DM, p.tbuf, (float*)p.obuf, smem);
        else gemm_stream<EPI_F32>(p.hb, HLD, p.wt_out + (size_t)l * DM * WLD1, WLD1, DM, 8, NMT * 8, p.tbuf, DM, nullptr, 0, smem);
      }
      break;
    case 6:
      if (EN(6)) phase_rownorm(p, false, p.tbuf, p.in[9] + l * DM, p.in[10] + l * DM, p.hb);
      break;
    case 7:
      if (EN(7)) {
        gemm_stream<EPI_RELU2>(p.hb, HLD, p.wt_ff1 + (size_t)l * DFF * WLD1, WLD1, DM, 32, NMT * 32, p.pbuf, ULD, nullptr, 0, smem);
      }
      break;
    case 8:
      if (EN(8)) {
        if (gridDim.x == 512) gemm_stream_split(p.pbuf, ULD, p.wt_ff2 + (size_t)l * DM * WLD4, WLD4, DFF, p.tbuf, (float*)p.obuf, smem);
        else gemm_stream<EPI_F32>(p.pbuf, ULD, p.wt_ff2 + (size_t)l * DM * WLD4, WLD4, DFF, 8, NMT * 8, p.tbuf, DM, nullptr, 0, smem);
      }
      break;
  }
}

#ifndef DUP_S
#define DUP_S -1
#endif
#define XB_TMO      128
#define XB_XCNT(j)  (256  + 64 * (j))
#define XB_XSUB(j)  (1280 + 64 * (j))
#define XB_XGEN(j)  (2304 + 64 * (j))
#define XB_TOP      3328
#define XB_TOPGEN   3392
#define XCD_BAR_WORDS 3456
#define XB_SPIN_CAP (1u << 22)
#define LAS __attribute__((address_space(3)))
DI unsigned xb_ld(unsigned* p)              { return __hip_atomic_load(p, __ATOMIC_RELAXED, __HIP_MEMORY_SCOPE_AGENT); }
DI unsigned xb_add(unsigned* p, unsigned v) { return __hip_atomic_fetch_add(p, v, __ATOMIC_RELAXED, __HIP_MEMORY_SCOPE_AGENT); }
DI unsigned xb_xcc_id() { return (unsigned)__builtin_amdgcn_s_getreg((3 << 11) | 20) & 0xFu; }
#define XB_SPIN(cond, bar) do { unsigned _sp = 0; while (cond) { __builtin_amdgcn_s_sleep(1); \
    if ((++_sp & 255u) == 0u) { if (xb_ld(&(bar)[XB_TMO])) break; if (_sp > XB_SPIN_CAP) { atomicAdd(&(bar)[XB_TMO], 1u); break; } } } } while (0)
struct XcdBarrier { unsigned* bar; unsigned x; volatile LAS unsigned* st; };
DI XcdBarrier xcd_barrier_post(unsigned* bar, volatile LAS unsigned* st) {
  XcdBarrier b; b.bar = bar; b.x = xb_xcc_id(); b.st = st;
  if (threadIdx.x == 0) (void)xb_add(&bar[XB_XCNT(b.x)], 1u);
  return b;
}
DI void xcd_barrier_complete(unsigned* bar, unsigned x, unsigned& nloc, unsigned& nx) {
  const unsigned G = gridDim.x * gridDim.y * gridDim.z;
  unsigned sum, cnt, mine, sp = 0u;
  for (;;) {
    sum = 0u; cnt = 0u; mine = 0u;
#pragma unroll
    for (unsigned j = 0; j < 16; ++j) { const unsigned c = xb_ld(&bar[XB_XCNT(j)]); sum += c; cnt += (c > 0u) ? 1u : 0u; mine = (j == x) ? c : mine; }
    if (sum == G) break;
    __builtin_amdgcn_s_sleep(1);
    if ((++sp & 255u) == 0u) { if (xb_ld(&bar[XB_TMO])) break; if (sp > XB_SPIN_CAP) { atomicAdd(&bar[XB_TMO], 1u); break; } }
  }
  nloc = mine > 0u ? mine : 1u; nx = cnt > 0u ? cnt : 1u;
}
DI void xcd_barrier(const XcdBarrier& b) {
  asm volatile("s_waitcnt vmcnt(0)" ::: "memory");
  __syncthreads();
  if (threadIdx.x == 0) {
    unsigned* bar = b.bar;
    __builtin_amdgcn_s_waitcnt(0);
    unsigned nloc = b.st[0], nx = b.st[1];
    if (nloc == 0u) { xcd_barrier_complete(bar, b.x, nloc, nx); b.st[0] = nloc; b.st[1] = nx; }
    const unsigned old = xb_add(&bar[XB_XSUB(b.x)], 1u);
    const unsigned gen = old / nloc;
    if (old + 1u == (gen + 1u) * nloc) {
      __builtin_amdgcn_fence(__ATOMIC_RELEASE, "agent");
      asm volatile("s_waitcnt vmcnt(0)" ::: "memory");
      const unsigned og = xb_add(&bar[XB_TOP], 1u);
      const unsigned tg = og / nx;
      if (og + 1u == (tg + 1u) * nx) xb_add(&bar[XB_TOPGEN], 1u);
      else XB_SPIN(xb_ld(&bar[XB_TOPGEN]) == tg, bar);
      __builtin_amdgcn_fence(__ATOMIC_ACQUIRE, "agent");
      xb_add(&bar[XB_XGEN(b.x)], 1u);
      asm volatile("s_waitcnt vmcnt(0)" ::: "memory");
    } else {
      XB_SPIN(xb_ld(&bar[XB_XGEN(b.x)]) == gen, bar);
      __builtin_amdgcn_fence(__ATOMIC_ACQUIRE, "agent");
      asm volatile("s_waitcnt vmcnt(0)" ::: "memory");
    }
  }
  __syncthreads();
}

__global__ void __launch_bounds__(256, 2) mega_kernel(Params p, int ph_lo, int ph_hi) {
  __shared__ __attribute__((aligned(16))) char smem[65536 + 32];
  volatile LAS unsigned* st = (volatile LAS unsigned*)(&smem[65536 + 16]);
  if (threadIdx.x == 0) { st[0] = 0u; st[1] = 0u; }
  __syncthreads();
  const XcdBarrier xb = xcd_barrier_post(p.bar, st);
  for (int ph = ph_lo; ph < ph_hi; ++ph) {
    if (ph > ph_lo) xcd_barrier(xb);
    if (ph_hi < 0) cg::this_grid().sync();
    const int reps = (DUP_S >= 0 && ph == DUP_S) ? 2 : 1;
    for (int r = 0; r < reps; ++r) {
      if (r) xcd_barrier(xb);
#ifdef VAR_NOSTORE
      if (tidq() == 0) *(volatile int*)(smem + 65536 + 8) = r;
      __syncthreads();
#endif
      run_phase(p, ph, smem, r);
    }
  }
}

extern "C" void kernel_launch(void* const* d_in, const int* in_sizes, int n_in, void* d_out, int out_size,
                              void* d_ws, size_t ws_size, hipStream_t stream) {
  Params p{};
  for (int i = 0; i < 35; ++i) p.in[i] = (const float*)d_in[i];
  p.out = (float*)d_out;
  char* ws = (char*)d_ws;
  size_t off = 0;
  auto take = [&](size_t bytes) { char* r = ws + off; off += (bytes + 255) & ~(size_t)255; return r; };
  p.wt_in  = (u16*)take((size_t)2 * NIN * WLD1 * 2);
  p.wt_ff1 = (u16*)take((size_t)2 * DFF * WLD1 * 2);
  p.wt_ff2 = (u16*)take((size_t)2 * DM * WLD4 * 2);
  p.wt_br  = (u16*)take((size_t)2 * 4 * DM * WLD5 * 2);
  p.wt_out = (u16*)take((size_t)2 * DM * WLD1 * 2);
  p.wt_glu = (u16*)take((size_t)2 * 512 * WLD5 * 2);
  p.hb     = (u16*)take((size_t)MTOK * HLD * 2);
  p.pbuf   = (u16*)take((size_t)MTOK * NP * 2);
  p.obuf   = (u16*)take((size_t)MTOK * OLD * 2);
  p.zs5    = (u16*)take((size_t)MTOK * ZLD * 2);
  p.counters = (unsigned*)take(4096);
  p.bar = (unsigned*)take(16384);
  p.ssq = (float*)take((size_t)MTOK * 4 * 4);
  p.segdec = (float*)take((size_t)96 * 7 * 128 * 4);
  p.hlocal = (float*)take((size_t)8 * 32 * 7 * 128 * 4);
  p.nseg = 8;
  if (off + (size_t)96 * 7 * 32768 > ws_size) p.nseg = 4;
  p.cps = 128 / p.nseg;
  p.slocal = (u16*)take((size_t)96 * (p.nseg - 1) * 32768);
  p.tbuf = (float*)(p.pbuf + (size_t)MTOK * ULD);
  if (off > ws_size) { fprintf(stderr, "workspace too small: need %zu have %zu\n", off, ws_size); return; }
  size_t o = (size_t)MTOK * DM;
  p.o_ret_p = o;  o += (size_t)2 * 8 * 65536;
  p.o_ret_s = o;  o += (size_t)2 * 128 * 65536;
  p.o_ssd_p = o;  o += (size_t)2 * 8 * 65536;
  p.o_ssd_s = o;  o += (size_t)2 * 128 * 65536;
  p.o_conv_p = o; o += (size_t)2 * 8 * 3 * 1024;
  p.o_conv_s = o; o += (size_t)2 * 128 * 3 * 1024;
  p.o_hg_p = o;   o += (size_t)2 * 8 * 65536;
  p.o_hg_s = o;   o += (size_t)2 * 128 * 65536;
  p.o_s5r_p = o;  o += (size_t)2 * 8 * 2048;
  p.o_s5r_s = o;  o += (size_t)2 * 128 * 2048;
  p.o_s5i_p = o;  o += (size_t)2 * 8 * 2048;
  p.o_s5i_s = o;  o += (size_t)2 * 128 * 2048;

  static int grid_blocks = 0;
  if (!grid_blocks) {
    int dev = 0, cus = 0, per_cu = 0;
    hipGetDevice(&dev);
    hipDeviceGetAttribute(&cus, hipDeviceAttributeMultiprocessorCount, dev);
    hipOccupancyMaxActiveBlocksPerMultiprocessor(&per_cu, mega_kernel, 256, 0);
    if (per_cu > 2) per_cu = 2;
    if (per_cu < 1) per_cu = 1;
    grid_blocks = cus * per_cu;
  }
  hipMemsetAsync(p.counters, 0, 4096 + 16384, stream);
#if SINGLE_LAUNCH
  int lo = 0, hi = NPHASE;
  void* args[] = {&p, &lo, &hi};
  hipError_t e = hipLaunchCooperativeKernel((void*)mega_kernel, dim3(grid_blocks), dim3(256), args, 0, stream);
  if (e != hipSuccess) fprintf(stderr, "cooperative launch failed: %s (grid %d)\n", hipGetErrorString(e), grid_blocks);
#else
  for (int ph = 0; ph < NPHASE; ++ph)
    hipLaunchKernelGGL(mega_kernel, dim3(grid_blocks), dim3(256), 0, stream, p, ph, ph + 1);
#endif
}
```
